# Optimizing an MI355X kernel written in HIP

```python
import jax, jax.numpy as jnp
from jax import lax
import numpy as np

D_MODEL = 1024
BATCH = 4
SEQ = 4096
DEPTH = 1

PLE_DIM = 256
HEAD_DIM = 64
DILATED_CFG = ((128, 1), (512, 4), (2048, 16))
N_GROUPS = 3
HEADS_PER_GROUP = 8
ATT_HEADS = N_GROUPS * HEADS_PER_GROUP
ATT_QKV = ATT_HEADS * HEAD_DIM
ATT_OUT = HEADS_PER_GROUP * HEAD_DIM
ROT_DIM = HEAD_DIM // 4
ROPE_THETA = 500000.0
GLA_HEADS = 4
GLA_DK = 128
GLA_DV = 256
GLA_KEY = GLA_HEADS * GLA_DK
GLA_VAL = GLA_HEADS * GLA_DV
GLA_GATE_RANK = 16
GLA_TAU = 16.0
GLA_CHUNK = 64
EPS = 1e-6
IN_SPLITS = (ATT_QKV, ATT_QKV, ATT_QKV, ATT_OUT,
             GLA_KEY, GLA_KEY, GLA_VAL, GLA_GATE_RANK, GLA_VAL,
             D_MODEL, D_MODEL)
IN_COLS = sum(IN_SPLITS)

kernel_name = "hybrid_dilated_swa_gla_gated_merge"


def _rmsnorm(x, g):
    xf = x.astype(jnp.float32)
    y = xf * lax.rsqrt(jnp.mean(xf * xf, axis=-1, keepdims=True) + EPS)
    return (y * g.astype(jnp.float32)).astype(x.dtype)


def _head_rmsnorm(t, g):
    return t * lax.rsqrt(jnp.mean(t * t, axis=-1, keepdims=True) + EPS) * g.astype(jnp.float32)


def _rotary_partial(t, pos):
    half = ROT_DIM // 2
    inv = jnp.power(jnp.float32(ROPE_THETA), -jnp.arange(half, dtype=jnp.float32) * 2.0 / ROT_DIM)
    ang = pos[..., None] * inv
    cos = jnp.cos(ang)[:, :, None, :]
    sin = jnp.sin(ang)[:, :, None, :]
    t1 = t[..., :half]
    t2 = t[..., half:ROT_DIM]
    return jnp.concatenate([t1 * cos - t2 * sin, t2 * cos + t1 * sin, t[..., ROT_DIM:]], axis=-1)


def _strided_window_attention(q, k, v, n_steps):
    N, L, H, hd = q.shape
    blk = n_steps
    nb = -(-L // blk)
    pad = nb * blk - L
    if pad:
        pw = ((0, 0), (0, pad), (0, 0), (0, 0))
        q, k, v = jnp.pad(q, pw), jnp.pad(k, pw), jnp.pad(v, pw)
    qb = q.reshape(N, nb, blk, H, hd)
    kb = k.reshape(N, nb, blk, H, hd)
    vb = v.reshape(N, nb, blk, H, hd)
    shift = ((0, 0), (1, 0), (0, 0), (0, 0), (0, 0))
    k2 = jnp.concatenate([jnp.pad(kb, shift)[:, :-1], kb], axis=2)
    v2 = jnp.concatenate([jnp.pad(vb, shift)[:, :-1], vb], axis=2)
    s = jnp.einsum('nbqhd,nbkhd->nbhqk', qb, k2) * (hd ** -0.5)
    a = jnp.arange(blk)[:, None]
    c = jnp.arange(2 * blk)[None, :]
    dist = blk + a - c
    in_band = (dist >= 0) & (dist <= n_steps)
    exists = (jnp.arange(nb)[:, None, None] > 0) | (c >= blk)[None]
    mask = in_band[None] & exists
    s = jnp.where(mask[None, :, None], s, -jnp.inf)
    m = jnp.max(s, axis=-1)
    pr = jnp.exp(s - m[..., None])
    l = jnp.sum(pr, axis=-1)
    o = jnp.einsum('nbhqk,nbkhd->nbqhd', pr, v2) / jnp.swapaxes(l, 2, 3)[..., None]
    o = o.reshape(N, nb * blk, H, hd)[:, :L]
    m = jnp.swapaxes(m, 2, 3).reshape(N, nb * blk, H)[:, :L]
    l = jnp.swapaxes(l, 2, 3).reshape(N, nb * blk, H)[:, :L]
    return o, m, l


def _dilated_group(q, k, v, window, dilation):
    B, S, H, hd = q.shape
    L = S // dilation

    def to_res(t):
        return t.reshape(B, L, dilation, H, hd).transpose(0, 2, 1, 3, 4).reshape(B * dilation, L, H, hd)

    o, m, l = _strided_window_attention(to_res(q), to_res(k), to_res(v), window // dilation)
    o = o.reshape(B, dilation, L, H, hd).transpose(0, 2, 1, 3, 4).reshape(B, S, H, hd)
    m = m.reshape(B, dilation, L, H).transpose(0, 2, 1, 3).reshape(B, S, H)
    l = l.reshape(B, dilation, L, H).transpose(0, 2, 1, 3).reshape(B, S, H)
    return o, m, l


def _dilated_attention(qa, ka, va, pos, gq, gk):
    B, S, _ = qa.shape
    q = _head_rmsnorm(qa.astype(jnp.float32).reshape(B, S, ATT_HEADS, HEAD_DIM), gq)
    k = _head_rmsnorm(ka.astype(jnp.float32).reshape(B, S, ATT_HEADS, HEAD_DIM), gk)
    v = va.astype(jnp.float32).reshape(B, S, ATT_HEADS, HEAD_DIM)
    q = _rotary_partial(q, pos)
    k = _rotary_partial(k, pos)
    q = q.reshape(B, S, N_GROUPS, HEADS_PER_GROUP, HEAD_DIM)
    k = k.reshape(B, S, N_GROUPS, HEADS_PER_GROUP, HEAD_DIM)
    v = v.reshape(B, S, N_GROUPS, HEADS_PER_GROUP, HEAD_DIM)
    outs, maxs, dens = [], [], []
    for g, (window, dilation) in enumerate(DILATED_CFG):
        o, m, l = _dilated_group(q[:, :, g], k[:, :, g], v[:, :, g], window, dilation)
        outs.append(o); maxs.append(m); dens.append(l)
    o = jnp.stack(outs)
    m = jnp.stack(maxs)
    l = jnp.stack(dens)
    w = l * jnp.exp(m - jnp.max(m, axis=0, keepdims=True))
    out = jnp.sum(w[..., None] * o, axis=0) / jnp.sum(w, axis=0)[..., None]
    return out.reshape(B, S, ATT_OUT)


def _gla_chunk_step(state, inp):
    q, k, v, lg = inp
    cum = jnp.cumsum(lg, axis=2)
    o_inter = jnp.einsum('bhid,bhde->bhie', q * jnp.exp(cum), state)
    C = q.shape[2]
    causal = jnp.tril(jnp.ones((C, C), dtype=bool))
    diff = cum[:, :, :, None, :] - cum[:, :, None, :, :]
    decay = jnp.exp(jnp.where(causal[:, :, None], diff, -jnp.inf))
    att = jnp.einsum('bhid,bhjd,bhijd->bhij', q, k, decay)
    o_intra = jnp.einsum('bhij,bhje->bhie', att, v)
    last = cum[:, :, -1:, :]
    new_state = jnp.exp(last[:, :, 0, :])[..., None] * state + \
        jnp.einsum('bhjd,bhje->bhde', k * jnp.exp(last - cum), v)
    return new_state, o_intra + o_inter


def _gla(qg, kg, vg, glr, w_g2, b_g, g_norm):
    B, S, _ = qg.shape
    nc = S // GLA_CHUNK
    q = qg.astype(jnp.float32).reshape(B, S, GLA_HEADS, GLA_DK) * (GLA_DK ** -0.5)
    k = kg.astype(jnp.float32).reshape(B, S, GLA_HEADS, GLA_DK)
    v = vg.astype(jnp.float32).reshape(B, S, GLA_HEADS, GLA_DV)
    logit = (glr @ w_g2 + b_g).astype(jnp.float32)
    lg = (jax.nn.log_sigmoid(logit) / GLA_TAU).reshape(B, S, GLA_HEADS, GLA_DK)

    def chunks(t):
        return t.reshape(B, nc, GLA_CHUNK, GLA_HEADS, t.shape[-1]).transpose(1, 0, 3, 2, 4)

    s0 = jnp.zeros((B, GLA_HEADS, GLA_DK, GLA_DV), jnp.float32)
    _, o = lax.scan(_gla_chunk_step, s0, (chunks(q), chunks(k), chunks(v), chunks(lg)))
    o = o.transpose(1, 0, 3, 2, 4).reshape(B, S, GLA_HEADS, GLA_DV)
    o = _head_rmsnorm(o, g_norm)
    return o.reshape(B, S, GLA_VAL)


def setup_inputs(seed: int = 0) -> dict:
    key = jax.random.key(seed)
    ks = jax.random.split(key, 18)
    f32 = jnp.float32

    def nrm(k, shape, fan_in):
        return jax.random.normal(k, shape, f32) * (fan_in ** -0.5)

    def gain(k, shape):
        return 1.0 + 0.1 * jax.random.normal(k, shape, f32)

    return {
        "x": jax.random.normal(ks[0], (BATCH, SEQ, D_MODEL), f32),
        "p": jax.random.normal(ks[1], (DEPTH, BATCH, SEQ, PLE_DIM), f32),
        "positions": jnp.broadcast_to(jnp.arange(SEQ, dtype=jnp.int32), (BATCH, SEQ)),
        "norm_g": gain(ks[2], (DEPTH, D_MODEL)),
        "w_in": nrm(ks[3], (DEPTH, D_MODEL, IN_COLS), D_MODEL),
        "qk_norm_q": gain(ks[4], (DEPTH, HEAD_DIM)),
        "qk_norm_k": gain(ks[5], (DEPTH, HEAD_DIM)),
        "gla_gate_w2": nrm(ks[6], (DEPTH, GLA_GATE_RANK, GLA_KEY), GLA_GATE_RANK),
        "gla_gate_b": 0.1 * jax.random.normal(ks[7], (DEPTH, GLA_KEY), f32),
        "gla_norm_g": gain(ks[8], (DEPTH, GLA_DV)),
        "w_att_proj": nrm(ks[9], (DEPTH, ATT_OUT, D_MODEL), ATT_OUT),
        "w_gla_proj": nrm(ks[10], (DEPTH, GLA_VAL, D_MODEL), GLA_VAL),
        "w_out": nrm(ks[11], (DEPTH, D_MODEL, D_MODEL), D_MODEL),
        "ple_norm_g": gain(ks[12], (DEPTH, D_MODEL)),
        "w_ple_gate": nrm(ks[13], (DEPTH, D_MODEL, D_MODEL), D_MODEL),
        "w_ple": nrm(ks[14], (DEPTH, PLE_DIM, D_MODEL), PLE_DIM),
    }


def reference(x, p, positions, norm_g, w_in, qk_norm_q, qk_norm_k, gla_gate_w2, gla_gate_b,
              gla_norm_g, w_att_proj, w_gla_proj, w_out, ple_norm_g, w_ple_gate, w_ple):
    pos = positions.astype(jnp.float32)
    split_idx = tuple(int(s) for s in np.cumsum(IN_SPLITS)[:-1])
    for i in range(DEPTH):
        h = _rmsnorm(x, norm_g[i])
        proj = h @ w_in[i]
        qa, ka, va, za, qg, kg, vg, glr, zg, gate_a, gate_b = jnp.split(proj, split_idx, axis=-1)
        att = _dilated_attention(qa, ka, va, pos, qk_norm_q[i], qk_norm_k[i]).astype(x.dtype)
        y_a = (att * jax.nn.silu(za)) @ w_att_proj[i]
        lin = _gla(qg, kg, vg, glr, gla_gate_w2[i], gla_gate_b[i], gla_norm_g[i]).astype(x.dtype)
        y_b = (lin * jax.nn.silu(zg)) @ w_gla_proj[i]
        y = jax.nn.sigmoid(gate_a) * y_a + jax.nn.sigmoid(gate_b) * y_b
        x = x + y @ w_out[i]
        ple_gate = jax.nn.sigmoid(_rmsnorm(x, ple_norm_g[i]) @ w_ple_gate[i])
        x = x + (p[i] @ w_ple[i]) * ple_gate
    return x
```

```cpp
#define REP_MASK 0
#define DBG_STOP 0
#include <hip/hip_runtime.h>
#include <hip/hip_cooperative_groups.h>
#include <cstdio>
#include <cstdint>
namespace cg = cooperative_groups;

namespace pg8 {
#define PG8_LAS __attribute__((address_space(3)))
typedef unsigned short bf16_t;
typedef short bf16x8 __attribute__((ext_vector_type(8)));
typedef float f32x4 __attribute__((ext_vector_type(4)));
typedef unsigned u32x4 __attribute__((ext_vector_type(4)));
typedef unsigned u32x2 __attribute__((ext_vector_type(2)));
constexpr int BM = 256, BK = 64, HALF = 128, HTB = HALF * BK * 2  , STAGE_BYTES = 8 * HTB, NXCD = 8, WGM = 8;

__host__ __device__ __forceinline__ int lds_byte(int r, int c) { const int st = (r >> 4) * 2 + (c >> 5), rr = r & 15, cc = c & 31, ob = rr * 64 + cc * 2; return st * 1024 + (ob ^ (((ob >> 9) & 1) << 5)); }
__host__ __device__ __forceinline__ void stage_rc(int b, int& R, int& C) { const int st = b / 1024, sb = b % 1024, swz = sb ^ (((sb >> 9) & 1) << 5); R = (st >> 1) * 16 + swz / 64; C = (st & 1) * 32 + (swz % 64) / 2; }
__host__ __device__ __forceinline__ int perm32(int rho) { const int n = rho >> 4, i = rho & 15; return 8 * (i >> 2) + 4 * n + (i & 3); }

struct Unit { int pm, pn, seg; };
struct Gemm {
    const bf16_t* A0; const bf16_t* A1; const bf16_t* A2; const bf16_t* B0; const bf16_t* B1; const bf16_t* B2; int nt0, nt1, nt2, lda, ldb;
    __device__ __forceinline__ const bf16_t* selA(int s) const { const bf16_t* a0 = +A0; const bf16_t* a1 = +A1; const bf16_t* a2 = +A2; return s == 0 ? +a0 : (s == 1 ? +a1 : +a2); }
    __device__ __forceinline__ const bf16_t* selB(int s) const { const bf16_t* b0 = +B0; const bf16_t* b1 = +B1; const bf16_t* b2 = +B2; return s == 0 ? +b0 : (s == 1 ? +b1 : +b2); }
    __device__ __forceinline__ int selNt(int s) const { const int n0 = +nt0, n1 = +nt1, n2 = +nt2; return s == 0 ? +n0 : (s == 1 ? +n1 : +n2); }
};
struct SegOrder {
    int nM, nN, nwg, G, c, nseg;
    __device__ void init(int M, int N, int G_, int c_, int nseg_) { nM = M / BM; nN = N / BM; nwg = nM * nN; G = G_; c = c_; nseg = nseg_; }
    __device__ bool next(int i, Unit& u) const {
        const int ti = i / nseg; u.seg = i - ti * nseg;
        const long L = (long)ti * G + c; if (L >= nwg) return false;
        int wgid = (int)L; { const int q = nwg / NXCD, r = nwg % NXCD, xcd = wgid % NXCD, off = wgid / NXCD; wgid = (xcd < r ? xcd * (q + 1) : r * (q + 1) + (xcd - r) * q) + off; }
        const int nig = WGM * nN, gid = wgid / nig, fm = gid * WGM, gsz = (nM - fm) < WGM ? (nM - fm) : WGM;
        u.pm = fm + ((wgid % nig) % gsz); u.pn = (wgid % nig) / gsz; return true;
    }
    __device__ __forceinline__ void a_ready(const Unit&) const {}
    __device__ __forceinline__ void done(const Unit&) const {}
};
typedef __bf16 bf16x2_t __attribute__((ext_vector_type(2)));
typedef float f32x2_t __attribute__((ext_vector_type(2)));
__device__ __forceinline__ unsigned cvt_pk_bf16(float lo, float hi) { f32x2_t f = {lo, hi}; bf16x2_t v = __builtin_convertvector(f, bf16x2_t); return __builtin_bit_cast(unsigned, v); }
__device__ __forceinline__ float sigmoidf_(float x) { return __builtin_amdgcn_rcpf(1.0f + __expf(-x)); }

struct EpiBf16 {
    static constexpr bool PERM = true, AFTER_DRAIN = false;
    bf16_t* O; int ldc;
    __device__ __forceinline__ void operator()(const f32x4 (&acc)[2][2][4][2], const Unit& u, int wr, int wc, int fr, int fq) const {
        const int row0 = u.pm * BM + wr * 64 + fr; const int col0 = u.pn * BM + wc * 32 + 8 * fq;
#pragma unroll
        for (int ai = 0; ai < 2; ++ai)
#pragma unroll
            for (int m = 0; m < 4; ++m) { bf16_t* rowp = O + (size_t)(row0 + ai * HALF + m * 16) * ldc + col0;
#pragma unroll
                for (int bj = 0; bj < 2; ++bj) { const f32x4 v0 = acc[ai][bj][m][0], v1 = acc[ai][bj][m][1];
                    u32x4 w; w.x = cvt_pk_bf16(v0[0], v0[1]); w.y = cvt_pk_bf16(v0[2], v0[3]); w.z = cvt_pk_bf16(v1[0], v1[1]); w.w = cvt_pk_bf16(v1[2], v1[3]);
                    *(u32x4*)(rowp + bj * HALF) = w; } }
    }
};
#define PG8_FOR_ACC(body) \
    _Pragma("unroll") for (int ai = 0; ai < 2; ++ai) _Pragma("unroll") for (int m = 0; m < 4; ++m) { const int row = u.pm * BM + ai * HALF + wr * 64 + m * 16 + fr; \
    _Pragma("unroll") for (int bj = 0; bj < 2; ++bj) _Pragma("unroll") for (int n = 0; n < 2; ++n) { const size_t off = (size_t)row * ldc + (u.pn * BM + bj * HALF + wc * 32 + n * 16 + 4 * fq); const f32x4 a = acc[ai][bj][m][n]; body } }
struct EpiStoreF32 {
    static constexpr bool PERM = false, AFTER_DRAIN = false;
    float* tmp; int ldc;
    __device__ __forceinline__ void operator()(const f32x4 (&acc)[2][2][4][2], const Unit& u, int wr, int wc, int fr, int fq) const {
        PG8_FOR_ACC( *(f32x4*)(tmp + off) = a; )
    }
};
struct EpiMerge {
    static constexpr bool PERM = false, AFTER_DRAIN = false;
    float* tmp1; float* tmp2; bf16_t* y; int ldc;
    __device__ __forceinline__ void operator()(const f32x4 (&acc)[2][2][4][2], const Unit& u, int wr, int wc, int fr, int fq) const {
        if (u.seg == 0) {
            PG8_FOR_ACC( f32x4 t = *(const f32x4*)(tmp1 + off); t[0] *= sigmoidf_(a[0]); t[1] *= sigmoidf_(a[1]); t[2] *= sigmoidf_(a[2]); t[3] *= sigmoidf_(a[3]); *(f32x4*)(tmp1 + off) = t; )
        } else if (u.seg == 1) {
            PG8_FOR_ACC( *(f32x4*)(tmp2 + off) = a; )
        } else {
            PG8_FOR_ACC( const f32x4 t1 = *(const f32x4*)(tmp1 + off); const f32x4 t2 = *(const f32x4*)(tmp2 + off);
                u32x2 w; w.x = cvt_pk_bf16(t1[0] + sigmoidf_(a[0]) * t2[0], t1[1] + sigmoidf_(a[1]) * t2[1]); w.y = cvt_pk_bf16(t1[2] + sigmoidf_(a[2]) * t2[2], t1[3] + sigmoidf_(a[3]) * t2[3]);
                *(u32x2*)(y + off) = w; )
        }
    }
};
struct EpiResid {
    static constexpr bool PERM = false, AFTER_DRAIN = false;
    const float* x; float* out; bf16_t* x1b; float* ps; int ldc;
    __device__ __forceinline__ void operator()(const f32x4 (&acc)[2][2][4][2], const Unit& u, int wr, int wc, int fr, int fq) const {
#pragma unroll
        for (int ai = 0; ai < 2; ++ai)
#pragma unroll
            for (int m = 0; m < 4; ++m) { const int row = u.pm * BM + ai * HALF + wr * 64 + m * 16 + fr; float s = 0.f;
#pragma unroll
                for (int bj = 0; bj < 2; ++bj)
#pragma unroll
                    for (int n = 0; n < 2; ++n) { const size_t off = (size_t)row * ldc + (u.pn * BM + bj * HALF + wc * 32 + n * 16 + 4 * fq);
                        const f32x4 v = *(const f32x4*)(x + off) + acc[ai][bj][m][n]; *(f32x4*)(out + off) = v;
                        u32x2 w; w.x = cvt_pk_bf16(v[0], v[1]); w.y = cvt_pk_bf16(v[2], v[3]);
                        __hip_atomic_store((unsigned long long*)(x1b + off), ((unsigned long long)w.y << 32) | w.x, __ATOMIC_RELAXED, __HIP_MEMORY_SCOPE_AGENT);
                        s += (v[0] * v[0] + v[1] * v[1]) + (v[2] * v[2] + v[3] * v[3]); }
                s += __shfl_xor(s, 16); s += __shfl_xor(s, 32);
                if (fq == 0) __hip_atomic_store(ps + (size_t)row * 16 + u.pn * 4 + wc, s, __ATOMIC_RELAXED, __HIP_MEMORY_SCOPE_AGENT); }
    }
};
struct EpiPle {
    static constexpr bool PERM = false, AFTER_DRAIN = false;
    float* out; const float* tmp; const float* ps; int ldc; float eps;
    __device__ __forceinline__ void operator()(const f32x4 (&acc)[2][2][4][2], const Unit& u, int wr, int wc, int fr, int fq) const {
#pragma unroll
        for (int ai = 0; ai < 2; ++ai)
#pragma unroll
            for (int m = 0; m < 4; ++m) { const int row = u.pm * BM + ai * HALF + wr * 64 + m * 16 + fr;
                const f32x4* pp = (const f32x4*)(ps + (size_t)row * 16); const f32x4 p0 = pp[0], p1 = pp[1], p2 = pp[2], p3 = pp[3];
                const float ss = ((p0[0] + p0[1]) + (p0[2] + p0[3])) + ((p1[0] + p1[1]) + (p1[2] + p1[3])) + ((p2[0] + p2[1]) + (p2[2] + p2[3])) + ((p3[0] + p3[1]) + (p3[2] + p3[3]));
                const float rstd = rsqrtf(ss * (1.0f / 1024.0f) + eps);
#pragma unroll
                for (int bj = 0; bj < 2; ++bj)
#pragma unroll
                    for (int n = 0; n < 2; ++n) { const size_t off = (size_t)row * ldc + (u.pn * BM + bj * HALF + wc * 32 + n * 16 + 4 * fq);
                        const f32x4 a = acc[ai][bj][m][n]; const f32x4 t = *(const f32x4*)(tmp + off); f32x4 o = *(const f32x4*)(out + off);
                        o[0] += t[0] * sigmoidf_(rstd * a[0]); o[1] += t[1] * sigmoidf_(rstd * a[1]); o[2] += t[2] * sigmoidf_(rstd * a[2]); o[3] += t[3] * sigmoidf_(rstd * a[3]);
                        *(f32x4*)(out + off) = o; } }
    }
};

__device__ __forceinline__ f32x4 unpack_bf16x4(u32x2 w) { f32x4 r; r[0] = __uint_as_float(w.x << 16); r[1] = __uint_as_float(w.x & 0xffff0000u); r[2] = __uint_as_float(w.y << 16); r[3] = __uint_as_float(w.y & 0xffff0000u); return r; }
struct EpiSig2 {
    static constexpr bool PERM = false, AFTER_DRAIN = false;
    bf16_t* s0; bf16_t* s1; int ldc;
    __device__ __forceinline__ void operator()(const f32x4 (&acc)[2][2][4][2], const Unit& u, int wr, int wc, int fr, int fq) const {
        bf16_t* dst = u.seg == 0 ? s0 : s1;
        PG8_FOR_ACC( u32x2 w; w.x = cvt_pk_bf16(sigmoidf_(a[0]), sigmoidf_(a[1])); w.y = cvt_pk_bf16(sigmoidf_(a[2]), sigmoidf_(a[3])); *(u32x2*)(dst + off) = w; )
    }
};
struct EpiGateMul {
    static constexpr bool PERM = false, AFTER_DRAIN = false;
    const bf16_t* sg; bf16_t* t1; int ldc;
    __device__ __forceinline__ void operator()(const f32x4 (&acc)[2][2][4][2], const Unit& u, int wr, int wc, int fr, int fq) const {
        PG8_FOR_ACC( const f32x4 g = unpack_bf16x4(*(const u32x2*)(sg + off)); u32x2 w; w.x = cvt_pk_bf16(g[0] * a[0], g[1] * a[1]); w.y = cvt_pk_bf16(g[2] * a[2], g[3] * a[3]); *(u32x2*)(t1 + off) = w; )
    }
};
struct EpiMergeY {
    static constexpr bool PERM = false, AFTER_DRAIN = false;
    const bf16_t* sg; const bf16_t* t1; bf16_t* y; int ldc;
    __device__ __forceinline__ void operator()(const f32x4 (&acc)[2][2][4][2], const Unit& u, int wr, int wc, int fr, int fq) const {
        PG8_FOR_ACC( const f32x4 g = unpack_bf16x4(*(const u32x2*)(sg + off)); const f32x4 t = unpack_bf16x4(*(const u32x2*)(t1 + off));
            u32x2 w; w.x = cvt_pk_bf16(t[0] + g[0] * a[0], t[1] + g[1] * a[1]); w.y = cvt_pk_bf16(t[2] + g[2] * a[2], t[3] + g[3] * a[3]); *(u32x2*)(y + off) = w; )
    }
};
struct EpiSigRow {
    static constexpr bool PERM = false, AFTER_DRAIN = false;
    const float* ps; bf16_t* sg; int ldc; float eps;
    __device__ __forceinline__ void operator()(const f32x4 (&acc)[2][2][4][2], const Unit& u, int wr, int wc, int fr, int fq) const {
#pragma unroll
        for (int ai = 0; ai < 2; ++ai)
#pragma unroll
            for (int m = 0; m < 4; ++m) { const int row = u.pm * BM + ai * HALF + wr * 64 + m * 16 + fr;
                const f32x4* pp = (const f32x4*)(ps + (size_t)row * 16); const f32x4 p0 = pp[0], p1 = pp[1], p2 = pp[2], p3 = pp[3];
                const float ss = ((p0[0] + p0[1]) + (p0[2] + p0[3])) + ((p1[0] + p1[1]) + (p1[2] + p1[3])) + ((p2[0] + p2[1]) + (p2[2] + p2[3])) + ((p3[0] + p3[1]) + (p3[2] + p3[3]));
                const float rstd = rsqrtf(ss * (1.0f / 1024.0f) + eps);
#pragma unroll
                for (int bj = 0; bj < 2; ++bj)
#pragma unroll
                    for (int n = 0; n < 2; ++n) { const size_t off = (size_t)row * ldc + (u.pn * BM + bj * HALF + wc * 32 + n * 16 + 4 * fq);
                        const f32x4 a = acc[ai][bj][m][n]; u32x2 w; w.x = cvt_pk_bf16(sigmoidf_(rstd * a[0]), sigmoidf_(rstd * a[1])); w.y = cvt_pk_bf16(sigmoidf_(rstd * a[2]), sigmoidf_(rstd * a[3]));
                        *(u32x2*)(sg + off) = w; } }
    }
};
struct EpiPle2 {
    static constexpr bool PERM = false, AFTER_DRAIN = false;
    float* out; const bf16_t* sg; int ldc;
    __device__ __forceinline__ void operator()(const f32x4 (&acc)[2][2][4][2], const Unit& u, int wr, int wc, int fr, int fq) const {
        PG8_FOR_ACC( const f32x4 g = unpack_bf16x4(*(const u32x2*)(sg + off)); f32x4 o = *(const f32x4*)(out + off); o[0] += a[0] * g[0]; o[1] += a[1] * g[1]; o[2] += a[2] * g[2]; o[3] += a[3] * g[3]; *(f32x4*)(out + off) = o; )
    }
};

struct EpiQKV {
    static constexpr bool PERM = true, AFTER_DRAIN = false;
    bf16_t* QKV; bf16_t* ZA; const float* gq; const float* gk; const float* rot; float eps;
    const bf16_t* OI; const float* SS; const float* gla_g; bf16_t* AB;
    __device__ __forceinline__ void operator()(const f32x4 (&acc)[2][2][4][2], const Unit& u, int wr, int wc, int fr, int fq) const {
        const int row0 = u.pm * BM + wr * 64 + fr; const int cl = u.pn * BM + 64 * wc;
        if (cl >= 5120) {
            const int zc0 = cl - 5120 + 8 * fq, hB = (cl - 5120) >> 8;
            const f32x4 ga0 = *(const f32x4*)(gla_g + (zc0 & 255)), ga1 = *(const f32x4*)(gla_g + (zc0 & 255) + 4), gb0 = *(const f32x4*)(gla_g + ((zc0 + 32) & 255)), gb1 = *(const f32x4*)(gla_g + ((zc0 + 32) & 255) + 4);
#pragma unroll
            for (int ai = 0; ai < 2; ++ai)
#pragma unroll
                for (int m = 0; m < 4; ++m) { const int row = row0 + ai * HALF + m * 16;
                    const f32x4* sp = (const f32x4*)(SS + (size_t)row * 64 + hB * 16); const f32x4 s0 = sp[0], s1 = sp[1], s2 = sp[2], s3 = sp[3];
                    const float ss = ((s0[0] + s0[1]) + (s0[2] + s0[3])) + ((s1[0] + s1[1]) + (s1[2] + s1[3])) + ((s2[0] + s2[1]) + (s2[2] + s2[3])) + ((s3[0] + s3[1]) + (s3[2] + s3[3]));
                    const float rstd = rsqrtf(ss * (1.0f / 256.0f) + eps);
#pragma unroll
                    for (int bj = 0; bj < 2; ++bj) { const size_t off = (size_t)row * 1024 + zc0 + 32 * bj; const u32x4 o8 = *(const u32x4*)(OI + off);
                        const f32x4 z0 = acc[ai][bj][m][0], z1 = acc[ai][bj][m][1]; const f32x4 g0 = bj ? gb0 : ga0, g1 = bj ? gb1 : ga1;
                        u32x4 w;
                        w.x = cvt_pk_bf16(__uint_as_float(o8.x << 16) * rstd * g0[0] * (z0[0] * sigmoidf_(z0[0])), __uint_as_float(o8.x & 0xffff0000u) * rstd * g0[1] * (z0[1] * sigmoidf_(z0[1])));
                        w.y = cvt_pk_bf16(__uint_as_float(o8.y << 16) * rstd * g0[2] * (z0[2] * sigmoidf_(z0[2])), __uint_as_float(o8.y & 0xffff0000u) * rstd * g0[3] * (z0[3] * sigmoidf_(z0[3])));
                        w.z = cvt_pk_bf16(__uint_as_float(o8.z << 16) * rstd * g1[0] * (z1[0] * sigmoidf_(z1[0])), __uint_as_float(o8.z & 0xffff0000u) * rstd * g1[1] * (z1[1] * sigmoidf_(z1[1])));
                        w.w = cvt_pk_bf16(__uint_as_float(o8.w << 16) * rstd * g1[2] * (z1[2] * sigmoidf_(z1[2])), __uint_as_float(o8.w & 0xffff0000u) * rstd * g1[3] * (z1[3] * sigmoidf_(z1[3])));
                        *(u32x4*)(AB + off) = w; } }
            return;
        }
        if (cl >= 4608) {
#pragma unroll
            for (int ai = 0; ai < 2; ++ai)
#pragma unroll
                for (int m = 0; m < 4; ++m) { const int row = row0 + ai * HALF + m * 16;
#pragma unroll
                    for (int bj = 0; bj < 2; ++bj) { const f32x4 v0 = acc[ai][bj][m][0], v1 = acc[ai][bj][m][1];
                        u32x4 w; w.x = cvt_pk_bf16(v0[0], v0[1]); w.y = cvt_pk_bf16(v0[2], v0[3]); w.z = cvt_pk_bf16(v1[0], v1[1]); w.w = cvt_pk_bf16(v1[2], v1[3]);
                        *(u32x4*)(ZA + (size_t)row * 512 + (cl - 4608) + 32 * bj + 8 * fq) = w; } }
            return;
        }
        const int which = cl / 1536, hc = cl - which * 1536, h = hc >> 6, dsh = 2 * (h >> 3);
        bf16_t* base = QKV + (size_t)which * ((size_t)16384 * 1536) + 8 * fq;
        const bool qk = which < 2;
        const float* gp = which == 0 ? gq : gk; const float sc = which == 0 ? 0.125f * 1.4426950408889634f : 1.0f;
        f32x4 g00 = {1.f, 1.f, 1.f, 1.f}, g01 = g00, g10 = g00, g11 = g00;
        if (qk) { g00 = *(const f32x4*)(gp + 8 * fq); g01 = *(const f32x4*)(gp + 8 * fq + 4); g10 = *(const f32x4*)(gp + 32 + 8 * fq); g11 = *(const f32x4*)(gp + 32 + 8 * fq + 4); }
#pragma unroll
        for (int ai = 0; ai < 2; ++ai)
#pragma unroll
            for (int m = 0; m < 4; ++m) { const int row = row0 + ai * HALF + m * 16; const int b = row >> 12, t = row & 4095;
                const int idx = ((t & ((1 << dsh) - 1)) << (12 - dsh)) + (t >> dsh);
                bf16_t* dst = base + ((size_t)(b * 24 + h) * 4096 + idx) * 64;
                f32x4 a0 = acc[ai][0][m][0], a1 = acc[ai][0][m][1], c0 = acc[ai][1][m][0], c1 = acc[ai][1][m][1];
                if (qk) {
                    float ss = ((a0[0] * a0[0] + a0[1] * a0[1]) + (a0[2] * a0[2] + a0[3] * a0[3])) + ((a1[0] * a1[0] + a1[1] * a1[1]) + (a1[2] * a1[2] + a1[3] * a1[3]))
                             + ((c0[0] * c0[0] + c0[1] * c0[1]) + (c0[2] * c0[2] + c0[3] * c0[3])) + ((c1[0] * c1[0] + c1[1] * c1[1]) + (c1[2] * c1[2] + c1[3] * c1[3]));
                    ss += __shfl_xor(ss, 16); ss += __shfl_xor(ss, 32);
                    const float rstd = rsqrtf(ss * (1.0f / 64.0f) + eps);
                    a0 = a0 * rstd * g00; a1 = a1 * rstd * g01; c0 = c0 * rstd * g10; c1 = c1 * rstd * g11;
                    f32x4 p0, p1;
                    p0[0] = __shfl_xor(a0[0], 16); p0[1] = __shfl_xor(a0[1], 16); p0[2] = __shfl_xor(a0[2], 16); p0[3] = __shfl_xor(a0[3], 16);
                    p1[0] = __shfl_xor(a1[0], 16); p1[1] = __shfl_xor(a1[1], 16); p1[2] = __shfl_xor(a1[2], 16); p1[3] = __shfl_xor(a1[3], 16);
                    if (fq < 2) { const float* rp = rot + (size_t)row * 16; const f32x4 cs0 = *(const f32x4*)(rp), cs1 = *(const f32x4*)(rp + 4), sn0 = *(const f32x4*)(rp + 8), sn1 = *(const f32x4*)(rp + 12);
                        const float sg = fq == 0 ? -1.f : 1.f; a0 = a0 * cs0 + (p0 * sn0) * sg; a1 = a1 * cs1 + (p1 * sn1) * sg; }
                    a0 = a0 * sc; a1 = a1 * sc; c0 = c0 * sc; c1 = c1 * sc;
                }
                u32x4 w0, w1; w0.x = cvt_pk_bf16(a0[0], a0[1]); w0.y = cvt_pk_bf16(a0[2], a0[3]); w0.z = cvt_pk_bf16(a1[0], a1[1]); w0.w = cvt_pk_bf16(a1[2], a1[3]);
                w1.x = cvt_pk_bf16(c0[0], c0[1]); w1.y = cvt_pk_bf16(c0[2], c0[3]); w1.z = cvt_pk_bf16(c1[0], c1[1]); w1.w = cvt_pk_bf16(c1[2], c1[3]);
                *(u32x4*)dst = w0; *(u32x4*)(dst + 32) = w1; }
    }
};

template <class Epi, class Sched, bool ALIGN_EPI = false, bool SP2 = false>
__device__ __forceinline__ void gemm_phase(PG8_LAS unsigned char* lds, const Gemm g, const Sched& S, const Epi& E) {
    const int tid = threadIdx.x, wid = __builtin_amdgcn_readfirstlane(tid >> 6), lane = tid & 63, wr = wid >> 2, wc = wid & 3, fr = lane & 15, fq = lane >> 4;
    const int lda = g.lda, ldb = g.ldb;
    unsigned voffA[2], voffB[2];
#pragma unroll
    for (int i = 0; i < 2; ++i) { int R, C; stage_rc(tid * 16 + i * 8192, R, C); const int Rb = Epi::PERM ? ((R & ~31) + perm32(R & 31)) : R;
        voffA[i] = (unsigned)(R * lda + C) * 2u; voffB[i] = (unsigned)(Rb * ldb + C) * 2u; }
    const size_t kstep = (size_t)(BK * 2);
    const size_t hstepA = (size_t)HALF * lda * 2, hstepB = (size_t)HALF * ldb * 2;
    const size_t tstepA = 2 * hstepA, tstepB = 2 * hstepB;
    const unsigned ldsw = (unsigned)wid * 1024u;
    const int aoff = lds_byte(wr * 64 + fr, fq * 8), boff = lds_byte(wc * 32 + fr, fq * 8);
#define PG8_SA(b, h) (((b) * 2 + (h)) * HTB)
#define PG8_SB(b, h) ((4 + (b) * 2 + (h)) * HTB)
#define PG8_STAGE(bufoff, gbase, voff) do { _Pragma("unroll") for (int _i = 0; _i < 2; ++_i) \
        __builtin_amdgcn_global_load_lds((const unsigned*)((const char*)(gbase) + (voff)[_i]), (PG8_LAS unsigned*)(lds + (bufoff) + ldsw + _i * 8192), 16, 0, 0); } while (0)
#define PG8_LDA(dst, b, h) do { _Pragma("unroll") for (int m = 0; m < 4; ++m) _Pragma("unroll") for (int k = 0; k < 2; ++k) dst[m][k] = *(const PG8_LAS bf16x8*)(lds + PG8_SA(b, h) + aoff + m * 2048 + k * 1024); } while (0)
#define PG8_LDB(dst, b, h) do { _Pragma("unroll") for (int n = 0; n < 2; ++n) _Pragma("unroll") for (int k = 0; k < 2; ++k) dst[n][k] = *(const PG8_LAS bf16x8*)(lds + PG8_SB(b, h) + boff + n * 2048 + k * 1024); } while (0)
#define PG8_MMA(ai, bj, At, Bt) do { __builtin_amdgcn_s_setprio(1); _Pragma("unroll") for (int m = 0; m < 4; ++m) _Pragma("unroll") for (int n = 0; n < 2; ++n) _Pragma("unroll") for (int k = 0; k < 2; ++k) \
        acc[ai][bj][m][n] = __builtin_amdgcn_mfma_f32_16x16x32_bf16(Bt[n][k], At[m][k], acc[ai][bj][m][n], 0, 0, 0); __builtin_amdgcn_s_setprio(0); } while (0)
#define PG8_WAIT_V(n) asm volatile("s_waitcnt vmcnt(" #n ")" ::: "memory")
#define PG8_WAIT_L(n) asm volatile("s_waitcnt lgkmcnt(" #n ")" ::: "memory")
#define PG8_BAR __builtin_amdgcn_s_barrier()
#define PG8_SCHED __builtin_amdgcn_sched_barrier(0)
    Unit cur, nxt; int ui = 0;
    if (!S.next(0, cur)) return;
    f32x4 acc[2][2][4][2];
#pragma unroll
    for (int a = 0; a < 2; ++a)
#pragma unroll
        for (int b = 0; b < 2; ++b)
#pragma unroll
            for (int m = 0; m < 4; ++m)
#pragma unroll
                for (int n = 0; n < 2; ++n) acc[a][b][m][n] = (f32x4){0.f, 0.f, 0.f, 0.f};
    bf16x8 At[4][2], B0[2][2], B1[2][2];
    const char* cA = (const char*)g.selA(cur.seg) + (size_t)cur.pm * tstepA; const char* cB = (const char*)g.selB(cur.seg) + (size_t)cur.pn * tstepB;
    S.a_ready(cur);
    if constexpr (SP2) {
        PG8_STAGE(PG8_SB(0, 0), cB, voffB); PG8_STAGE(PG8_SB(0, 1), cB + hstepB, voffB); PG8_STAGE(PG8_SA(0, 0), cA, voffA); PG8_STAGE(PG8_SA(0, 1), cA + hstepA, voffA);
        if (wr == 1) PG8_BAR;
        PG8_WAIT_V(2); PG8_BAR;
        PG8_STAGE(PG8_SB(1, 0), cB + kstep, voffB); PG8_STAGE(PG8_SA(1, 0), cA + kstep, voffA); PG8_STAGE(PG8_SB(1, 1), cB + hstepB + kstep, voffB);
        PG8_WAIT_V(6); PG8_BAR;
    } else {
        PG8_STAGE(PG8_SB(0, 0), cB, voffB); PG8_STAGE(PG8_SA(0, 0), cA, voffA); PG8_STAGE(PG8_SB(0, 1), cB + hstepB, voffB); PG8_STAGE(PG8_SA(0, 1), cA + hstepA, voffA);
        if (wr == 1) PG8_BAR;
        PG8_WAIT_V(4); PG8_BAR;
        PG8_STAGE(PG8_SB(1, 0), cB + kstep, voffB); PG8_STAGE(PG8_SA(1, 0), cA + kstep, voffA); PG8_STAGE(PG8_SB(1, 1), cB + hstepB + kstep, voffB);
        PG8_WAIT_V(6); PG8_BAR;
    }
    for (;;) {
        const bool has_next = S.next(ui + 1, nxt);
        const char* nA = has_next ? (const char*)g.selA(nxt.seg) + (size_t)nxt.pm * tstepA : cA; const char* nB = has_next ? (const char*)g.selB(nxt.seg) + (size_t)nxt.pn * tstepB : cB;
        const int nt = g.selNt(cur.seg);
        for (int t = 0; t < nt; t += 2) {
            const bool last = (t == nt - 2);
            const char* a1 = cA + (size_t)(t + 1) * kstep;
            const char* a2 = last ? nA : cA + (size_t)(t + 2) * kstep; const char* b2 = last ? nB : cB + (size_t)(t + 2) * kstep;
            const char* a3 = a2 + kstep; const char* b3 = b2 + kstep;
            if (last && has_next) S.a_ready(nxt);
            if constexpr (SP2) {
            PG8_LDB(B0, 0, 0); PG8_LDB(B1, 0, 1); PG8_SCHED; PG8_LDA(At, 0, 0); PG8_STAGE(PG8_SA(1, 1), a1 + hstepA, voffA);
            PG8_WAIT_V(8); PG8_WAIT_L(0); PG8_BAR; PG8_MMA(0, 0, At, B0); PG8_MMA(0, 1, At, B1); PG8_BAR; PG8_SCHED;
            PG8_LDA(At, 0, 1); PG8_STAGE(PG8_SB(0, 0), b2, voffB); PG8_STAGE(PG8_SB(0, 1), b2 + hstepB, voffB); PG8_STAGE(PG8_SA(0, 0), a2, voffA);
            PG8_WAIT_V(8); PG8_WAIT_L(0); PG8_BAR; PG8_MMA(1, 0, At, B0); PG8_MMA(1, 1, At, B1); PG8_BAR; PG8_SCHED;
            PG8_LDB(B0, 1, 0); PG8_LDB(B1, 1, 1); PG8_SCHED; PG8_LDA(At, 1, 0); PG8_STAGE(PG8_SA(0, 1), a2 + hstepA, voffA);
            PG8_WAIT_V(8); PG8_WAIT_L(0); PG8_BAR; PG8_MMA(0, 0, At, B0); PG8_MMA(0, 1, At, B1); PG8_BAR; PG8_SCHED;
            PG8_LDA(At, 1, 1); PG8_STAGE(PG8_SB(1, 0), b3, voffB); PG8_STAGE(PG8_SB(1, 1), b3 + hstepB, voffB); PG8_STAGE(PG8_SA(1, 0), a3, voffA);
            PG8_WAIT_V(8); PG8_WAIT_L(0); PG8_BAR; PG8_MMA(1, 0, At, B0); PG8_MMA(1, 1, At, B1); PG8_BAR; PG8_SCHED;
            } else {
            PG8_LDB(B0, 0, 0); PG8_SCHED; PG8_LDA(At, 0, 0); PG8_STAGE(PG8_SA(1, 1), a1 + hstepA, voffA);
            PG8_WAIT_L(8); PG8_BAR; PG8_WAIT_L(0); PG8_MMA(0, 0, At, B0); PG8_BAR; PG8_SCHED;
            PG8_LDB(B1, 0, 1); PG8_STAGE(PG8_SB(0, 0), b2, voffB);
            PG8_BAR; PG8_WAIT_L(0); PG8_MMA(0, 1, At, B1); PG8_BAR;
            PG8_LDA(At, 0, 1); PG8_STAGE(PG8_SA(0, 0), a2, voffA);
            PG8_BAR; PG8_WAIT_L(0); PG8_MMA(1, 0, At, B0); PG8_BAR; PG8_SCHED;
            PG8_STAGE(PG8_SB(0, 1), b2 + hstepB, voffB);
            PG8_WAIT_V(6); PG8_BAR; PG8_MMA(1, 1, At, B1); PG8_BAR;
            PG8_LDB(B0, 1, 0); PG8_SCHED; PG8_LDA(At, 1, 0); PG8_STAGE(PG8_SA(0, 1), a2 + hstepA, voffA);
            PG8_WAIT_L(8); PG8_BAR; PG8_WAIT_L(0); PG8_MMA(0, 0, At, B0); PG8_BAR; PG8_SCHED;
            PG8_LDB(B1, 1, 1); PG8_STAGE(PG8_SB(1, 0), b3, voffB);
            PG8_BAR; PG8_WAIT_L(0); PG8_MMA(0, 1, At, B1); PG8_BAR;
            PG8_LDA(At, 1, 1); PG8_STAGE(PG8_SA(1, 0), a3, voffA);
            PG8_BAR; PG8_WAIT_L(0); PG8_MMA(1, 0, At, B0); PG8_BAR; PG8_SCHED;
            PG8_STAGE(PG8_SB(1, 1), b3 + hstepB, voffB);
            PG8_WAIT_V(6); PG8_BAR; PG8_MMA(1, 1, At, B1); PG8_BAR;
            }
        }
        if constexpr (ALIGN_EPI) { if (wr == 0) PG8_BAR; }
        if constexpr (!Epi::AFTER_DRAIN) { E(acc, cur, wr, wc, fr, fq); S.done(cur); }
        if (!has_next) break;
#pragma unroll
        for (int a = 0; a < 2; ++a)
#pragma unroll
            for (int b = 0; b < 2; ++b)
#pragma unroll
                for (int m = 0; m < 4; ++m)
#pragma unroll
                    for (int n = 0; n < 2; ++n) acc[a][b][m][n] = (f32x4){0.f, 0.f, 0.f, 0.f};
        cur = nxt; cA = nA; cB = nB; ++ui;
        if constexpr (ALIGN_EPI) { if (wr == 1) PG8_BAR; }
    }
    PG8_WAIT_V(0);
    if constexpr (!ALIGN_EPI) { if (wr == 0) PG8_BAR; }
    PG8_BAR;
    if constexpr (Epi::AFTER_DRAIN) { E.fused(acc, cur, wr, wc, fr, fq, lds, wid, lane); S.done(cur); }
#undef PG8_SA
#undef PG8_SB
#undef PG8_STAGE
#undef PG8_LDA
#undef PG8_LDB
#undef PG8_MMA
#undef PG8_WAIT_V
#undef PG8_WAIT_L
#undef PG8_BAR
#undef PG8_SCHED
}
}

constexpr int NWAVES = 8;
constexpr int T = 16384, D = 1024, SEQ = 4096, INC = 10256;
constexpr int PA = 5120;
constexpr int PG = 2048;
constexpr float EPS = 1e-6f;
constexpr size_t MiB = 1u << 20;
constexpr size_t WS_W1A = 0, WS_W1G = 12 * MiB, WS_WGT = 16 * MiB, WS_WPA = 20 * MiB, WS_WPB = 21 * MiB, WS_WOUT = 23 * MiB, WS_WPG = 25 * MiB, WS_WPLE = 27 * MiB, WS_WGLR = 27 * MiB + 512 * 1024;
constexpr size_t WS_ROT = 28 * MiB, WS_GLR = 29 * MiB, WS_GAMMA = 30 * MiB, WS_ML = 29 * MiB  , WS_PS = 29 * MiB  ;
constexpr size_t WS_PROJG = 32 * MiB, WS_QP = 96 * MiB, WS_L = 112 * MiB, WS_OI = 192 * MiB, WS_SS = 224 * MiB;
constexpr size_t WS_PROJA = 32 * MiB, WS_ZA = 176 * MiB  , WS_OG = 192 * MiB, WS_AA = 240 * MiB;
constexpr size_t WS_TMP1 = 32 * MiB, WS_TMP2 = 96 * MiB, WS_SGA = 32 * MiB, WS_SGB = 64 * MiB, WS_T1 = 96 * MiB, WS_Y = 160 * MiB, WS_PB = 200 * MiB, WS_X1B = 208 * MiB, WS_END = 256 * MiB;
constexpr int LDS_BYTES = 147456, MISC_OFF = 131072 + 320;
constexpr size_t WS_BAR = 27 * MiB + 512 * 1024 + 65536, WS_PCNT = WS_BAR + 16384, BAR_BYTES = 16384 + 2 * 16384;

#define LAS __attribute__((address_space(3)))
typedef unsigned short bf16;
typedef unsigned v4u __attribute__((ext_vector_type(4)));
typedef unsigned v2u __attribute__((ext_vector_type(2)));
typedef float f32x4 __attribute__((ext_vector_type(4)));
typedef short bf16x8 __attribute__((ext_vector_type(8)));
typedef short s16x4 __attribute__((ext_vector_type(4)));
__device__ __forceinline__ float bflo(unsigned w) { return __uint_as_float(w << 16); }
__device__ __forceinline__ float bfhi(unsigned w) { return __uint_as_float(w & 0xffff0000u); }
__device__ __forceinline__ float bf2f(unsigned short b) { return __uint_as_float(((unsigned)b) << 16); }
__device__ __forceinline__ unsigned pk2(float lo, float hi) { return pg8::cvt_pk_bf16(lo, hi); }
__device__ __forceinline__ bf16x8 mk8(v2u lo, v2u hi) { v4u t; t.x = lo.x; t.y = lo.y; t.z = hi.x; t.w = hi.y; return __builtin_bit_cast(bf16x8, t); }
__device__ __forceinline__ f32x4 mfma16(bf16x8 a, bf16x8 b, f32x4 c) { return __builtin_amdgcn_mfma_f32_16x16x32_bf16(a, b, c, 0, 0, 0); }
__device__ __forceinline__ float siluf_(float x) { return x * pg8::sigmoidf_(x); }
#define LDS_WAIT() asm volatile("s_waitcnt lgkmcnt(0)" ::: "memory")

struct Args {
    const float* x; const float* p; const int* pos; const float* norm_g; const float* w_in; const float* gq; const float* gk; const float* gate_w2; const float* gate_b;
    const float* gla_g; const float* w_att; const float* w_gla; const float* w_out; const float* ple_g; const float* w_pg; const float* w_ple; float* out; unsigned char* ws; int one; int zero;
};

__device__ __forceinline__ float wave_sum(float v) {
#pragma unroll
    for (int o = 1; o < 64; o <<= 1) v += __shfl_xor(v, o);
    return v;
}
__device__ __forceinline__ void p0_transpose_item(const float* W, int wpitch, int ncols, const float* kscale, bf16* WT, int tpitch, int row_off, LAS float* scr, int item, int lane, bool headperm = false) {
    const int nblk = ncols / 32, kb = item / nblk, nb = item % nblk, k0 = 64 * kb, n0 = 32 * nb;
    const int d0 = headperm ? ((nb & ~7) + (nb & 1) * 4 + ((nb & 7) >> 1)) * 32 : n0;
#pragma unroll 8
    for (int i = 0; i < 32; ++i) { const int kk = 2 * i + (lane >> 5); float v = W[(size_t)(k0 + kk) * wpitch + n0 + (lane & 31)]; if (kscale) v *= kscale[k0 + kk]; scr[kk * 33 + (lane & 31)] = v; }
    LDS_WAIT(); asm volatile("" ::: "memory");
    const int c = lane & 7;
#pragma unroll
    for (int j = 0; j < 4; ++j) { const int n = (lane >> 3) + 8 * j; const LAS float* s = scr + (8 * c) * 33 + n;
        v4u o; o.x = pk2(s[0 * 33], s[1 * 33]); o.y = pk2(s[2 * 33], s[3 * 33]); o.z = pk2(s[4 * 33], s[5 * 33]); o.w = pk2(s[6 * 33], s[7 * 33]);
        *(v4u*)(WT + (size_t)(row_off + d0 + n) * tpitch + k0 + 8 * c) = o; }
    LDS_WAIT(); asm volatile("" ::: "memory");
}

__device__ __forceinline__ void phase0(const Args& a, LAS unsigned char* lds, int tid, int lane, int wave, int G) {
    unsigned char* ws = a.ws;
    LAS float* scr = (LAS float*)(lds + wave * 16384);
    const int gw = blockIdx.x * NWAVES + wave, NGW = G * NWAVES;
    constexpr int I0 = 16 * 160, I1 = 16 * 64, I2 = 16 * 32, I3 = 16 * 64, I4 = 8 * 32, I5 = 16 * 32, I6 = 16 * 32, I7 = 16 * 32, I8 = 4 * 32;
    constexpr int NITEMS = I0 + I1 + I2 + I3 + I4 + I5 + I6 + I7 + I8;
    for (int it = gw; it < NITEMS; it += NGW) {
        int r = it;
        if (r < I0) { p0_transpose_item(a.w_in, INC, 5120, nullptr, (bf16*)(ws + WS_W1A), 1024, 0, scr, r, lane, true); continue; } r -= I0;
        if (r < I1) { p0_transpose_item(a.w_in + 5120, INC, 2048, nullptr, (bf16*)(ws + WS_W1G), 1024, 0, scr, r, lane); continue; } r -= I1;
        if (r < I2) { p0_transpose_item(a.w_in + 7184, INC, 1024, nullptr, (bf16*)(ws + WS_W1A), 1024, 5120, scr, r, lane, true); continue; } r -= I2;
        if (r < I3) { p0_transpose_item(a.w_in + 8208, INC, 2048, nullptr, (bf16*)(ws + WS_WGT), 1024, 0, scr, r, lane); continue; } r -= I3;
        if (r < I4) { p0_transpose_item(a.w_att, 1024, 1024, nullptr, (bf16*)(ws + WS_WPA), 512, 0, scr, r, lane); continue; } r -= I4;
        if (r < I5) { p0_transpose_item(a.w_gla, 1024, 1024, nullptr, (bf16*)(ws + WS_WPB), 1024, 0, scr, r, lane); continue; } r -= I5;
        if (r < I6) { p0_transpose_item(a.w_out, 1024, 1024, nullptr, (bf16*)(ws + WS_WOUT), 1024, 0, scr, r, lane); continue; } r -= I6;
        if (r < I7) { p0_transpose_item(a.w_pg, 1024, 1024, a.ple_g, (bf16*)(ws + WS_WPG), 1024, 0, scr, r, lane); continue; } r -= I7;
        p0_transpose_item(a.w_ple, 1024, 1024, nullptr, (bf16*)(ws + WS_WPLE), 256, 0, scr, r, lane);
    }
    const int gtid = blockIdx.x * 512 + tid, NT = G * 512;
    for (int i = gtid; i < 16 * 1024; i += NT) { const int k = i >> 4, r = i & 15; ((bf16*)(ws + WS_WGLR))[r * 1024 + k] = (bf16)(pk2(a.w_in[(size_t)k * INC + 7168 + r], 0.f) & 0xffffu); }
    for (int i = gtid; i < T * 8; i += NT) { const int t = i >> 3, j = i & 7;
        const float inv = exp2f(-(float)j * 0.125f * 18.931568569324174f);
        const float ang = (float)a.pos[t] * inv;
        const double ad = (double)ang; const double kq = __builtin_rint(ad * 0.15915494309189535); const float rf = (float)(ad - kq * 6.283185307179586);
        float* rt = (float*)(ws + WS_ROT) + (size_t)t * 16; rt[j] = __cosf(rf); rt[8 + j] = __sinf(rf); }
    bf16* hb = (bf16*)a.out;
    for (int m = gw; m < T; m += NGW) {
        const f32x4* xr = (const f32x4*)(a.x + (size_t)m * D) + lane; const f32x4* gr = (const f32x4*)a.norm_g + lane;
        f32x4 v[4]; float s = 0.f;
#pragma unroll
        for (int j = 0; j < 4; ++j) { v[j] = xr[64 * j]; s += (v[j][0] * v[j][0] + v[j][1] * v[j][1]) + (v[j][2] * v[j][2] + v[j][3] * v[j][3]); }
        const float rstd = rsqrtf(wave_sum(s) * (1.f / D) + EPS);
        v2u* o8 = (v2u*)(hb + (size_t)m * D) + lane;
#pragma unroll
        for (int j = 0; j < 4; ++j) { const f32x4 g = gr[64 * j]; v2u w; w.x = pk2(v[j][0] * rstd * g[0], v[j][1] * rstd * g[1]); w.y = pk2(v[j][2] * rstd * g[2], v[j][3] * rstd * g[3]); o8[64 * j] = w; }
    }
}

__device__ __forceinline__ void glr_step(const Args& a, int lane, int wave, int G) {
    const bf16* hb = (const bf16*)a.out; const bf16* wg = (const bf16*)(a.ws + WS_WGLR); float* glr = (float*)(a.ws + WS_GLR);
    const int l15 = lane & 15, quad = lane >> 4;
    for (int rt = blockIdx.x * NWAVES + wave; rt < T / 16; rt += G * NWAVES) {
        f32x4 acc = {0.f, 0.f, 0.f, 0.f};
        const bf16* ap = hb + (size_t)(rt * 16 + l15) * 1024 + 8 * quad; const bf16* bp = wg + (size_t)l15 * 1024 + 8 * quad;
#pragma unroll 8
        for (int i = 0; i < 32; ++i) acc = mfma16(*(const bf16x8*)(ap + 32 * i), *(const bf16x8*)(bp + 32 * i), acc);
#pragma unroll
        for (int j = 0; j < 4; ++j) glr[(size_t)(rt * 16 + 4 * quad + j) * 16 + l15] = acc[j];
    }
}

constexpr int GL_GLR = 0, GL_CUMX = 4096, GL_QS = 6144, GL_KS = GL_QS + 64 * 272, GL_KT = GL_KS + 64 * 272, GL_VS = GL_KT + 128 * 144, GL_AT = GL_VS + 64 * 528, GL_END = GL_AT + 64 * 144;
static_assert(GL_END <= 131072, "gla lds");
__device__ __forceinline__ void gla_local_phase(const Args& a, LAS unsigned char* lds, int tid, int lane, int wave, int G) {
    asm volatile("" : "+v"(tid), "+v"(lane));
    unsigned char* ws = a.ws;
    const bf16* PROJ = (const bf16*)(ws + WS_PROJG); const float* glr = (const float*)(ws + WS_GLR);
    bf16* Qp = (bf16*)(ws + WS_QP); bf16* OI = (bf16*)(ws + WS_OI); bf16* Lg = (bf16*)(ws + WS_L); float* gamma = (float*)(ws + WS_GAMMA);
    const int d = tid & 127, tg = tid >> 7, l15 = lane & 15, quad = lane >> 4;
    for (int unit = blockIdx.x; unit < 1024; unit += G) {
        const int b = unit >> 8, h = (unit >> 6) & 3, c = unit & 63; const int row0 = b * SEQ + c * 64;
        const bf16* P = PROJ + (size_t)row0 * PG;
        unsigned short qv[16], kv[16];
#pragma unroll
        for (int i = 0; i < 16; ++i) { const int t = tg * 16 + i; qv[i] = P[(size_t)t * PG + h * 128 + d]; kv[i] = P[(size_t)t * PG + 512 + h * 128 + d]; }
        if (tid < 256) ((LAS f32x4*)(lds + GL_GLR))[tid] = ((const f32x4*)(glr + (size_t)row0 * 16))[tid];
#pragma unroll
        for (int i = 0; i < 4; ++i) { const int p = tid + 512 * i, tok = p >> 5, part = p & 31;
            *(LAS v4u*)(lds + GL_VS + tok * 528 + part * 16) = *(const v4u*)(P + (size_t)tok * PG + 1024 + h * 256 + part * 8); }
        float w2r[16];
#pragma unroll
        for (int r = 0; r < 16; ++r) w2r[r] = a.gate_w2[r * 512 + h * 128 + d];
        const float bias = a.gate_b[h * 128 + d];
        __syncthreads();
        float cum[16]; float run = 0.f;
#pragma unroll
        for (int i = 0; i < 16; ++i) { const int t = tg * 16 + i; const LAS f32x4* gp = (const LAS f32x4*)(lds + GL_GLR + t * 64);
            const f32x4 g0 = gp[0], g1 = gp[1], g2 = gp[2], g3 = gp[3];
            float lo = bias;
            lo += g0[0] * w2r[0] + g0[1] * w2r[1] + g0[2] * w2r[2] + g0[3] * w2r[3];
            lo += g1[0] * w2r[4] + g1[1] * w2r[5] + g1[2] * w2r[6] + g1[3] * w2r[7];
            lo += g2[0] * w2r[8] + g2[1] * w2r[9] + g2[2] * w2r[10] + g2[3] * w2r[11];
            lo += g3[0] * w2r[12] + g3[1] * w2r[13] + g3[2] * w2r[14] + g3[3] * w2r[15];
            const float ls = fminf(lo, 0.f) - __logf(1.0f + __expf(-fabsf(lo)));
            run += ls * (1.0f / 16.0f); cum[i] = run; }
        ((LAS float*)(lds + GL_CUMX))[tg * 128 + d] = run;
        __syncthreads();
        float prefix = 0.f, last = 0.f;
#pragma unroll
        for (int g = 0; g < 4; ++g) { const float v = ((LAS float*)(lds + GL_CUMX))[g * 128 + d]; last += v; if (g < tg) prefix += v; }
        unsigned ktp[8];
#pragma unroll
        for (int i = 0; i < 16; ++i) { const int t = tg * 16 + i; const float cm = cum[i] + prefix; const float q = bf2f(qv[i]), k = bf2f(kv[i]);
            const float qp = q * __expf(cm) * 0.08838834764831845f, kp = k * __expf(-cm), kpp = k * __expf(last - cm);
            const unsigned qb = pk2(qp, 0.f) & 0xffffu;
            *(LAS unsigned short*)(lds + GL_QS + t * 272 + d * 2) = (unsigned short)qb;
            *(LAS unsigned short*)(lds + GL_KS + t * 272 + d * 2) = (unsigned short)(pk2(kp, 0.f) & 0xffffu);
            Qp[(size_t)(row0 + t) * 512 + h * 128 + d] = (bf16)qb;
            const unsigned kb = pk2(kpp, 0.f) & 0xffffu;
            if (i & 1) ktp[i >> 1] |= kb << 16; else ktp[i >> 1] = kb; }
        { v4u w0, w1; w0.x = ktp[0]; w0.y = ktp[1]; w0.z = ktp[2]; w0.w = ktp[3]; w1.x = ktp[4]; w1.y = ktp[5]; w1.z = ktp[6]; w1.w = ktp[7];
          *(LAS v4u*)(lds + GL_KT + d * 144 + tg * 32) = w0; *(LAS v4u*)(lds + GL_KT + d * 144 + tg * 32 + 16) = w1; }
        if (tg == 0) gamma[(size_t)unit * 128 + d] = __expf(last);
        __syncthreads();
        { const int it = wave >> 1;
#pragma unroll
          for (int jj = 0; jj < 2; ++jj) { const int jt = (wave & 1) * 2 + jj; f32x4 acc = {0.f, 0.f, 0.f, 0.f};
#pragma unroll
            for (int ks = 0; ks < 4; ++ks) { const bf16x8 ka = *(const LAS bf16x8*)(lds + GL_KS + (16 * jt + l15) * 272 + (32 * ks + 8 * quad) * 2);
                const bf16x8 qb = *(const LAS bf16x8*)(lds + GL_QS + (16 * it + l15) * 272 + (32 * ks + 8 * quad) * 2); acc = mfma16(ka, qb, acc); }
            const int i = 16 * it + l15, j0 = 16 * jt + 4 * quad;
            v2u w; w.x = pk2(j0 + 0 <= i ? acc[0] : 0.f, j0 + 1 <= i ? acc[1] : 0.f); w.y = pk2(j0 + 2 <= i ? acc[2] : 0.f, j0 + 3 <= i ? acc[3] : 0.f);
            *(LAS v2u*)(lds + GL_AT + i * 144 + j0 * 2) = w; } }
        __syncthreads();
#pragma unroll 1
        for (int dd = 0; dd < 2; ++dd) { const int dvt = 2 * wave + dd;
            bf16x8 VF[2];
#pragma unroll
            for (int ks = 0; ks < 2; ++ks) { unsigned short e[8];
#pragma unroll
                for (int q = 0; q < 8; ++q) e[q] = *(const LAS unsigned short*)(lds + GL_VS + (32 * ks + 8 * quad + q) * 528 + (16 * dvt + l15) * 2);
                v4u t; t.x = e[0] | ((unsigned)e[1] << 16); t.y = e[2] | ((unsigned)e[3] << 16); t.z = e[4] | ((unsigned)e[5] << 16); t.w = e[6] | ((unsigned)e[7] << 16);
                VF[ks] = __builtin_bit_cast(bf16x8, t); }
#pragma unroll
            for (int it = 0; it < 4; ++it) { f32x4 acc = {0.f, 0.f, 0.f, 0.f};
#pragma unroll
                for (int ks = 0; ks < 2; ++ks) acc = mfma16(VF[ks], *(const LAS bf16x8*)(lds + GL_AT + (16 * it + l15) * 144 + (32 * ks + 8 * quad) * 2), acc);
                v2u w; w.x = pk2(acc[0], acc[1]); w.y = pk2(acc[2], acc[3]);
                *(v2u*)(OI + (size_t)(row0 + 16 * it + l15) * 1024 + h * 256 + 16 * dvt + 4 * quad) = w; }
#pragma unroll
            for (int R = 0; R < 8; ++R) { f32x4 acc = {0.f, 0.f, 0.f, 0.f};
#pragma unroll
                for (int ks = 0; ks < 2; ++ks) acc = mfma16(*(const LAS bf16x8*)(lds + GL_KT + (16 * R + l15) * 144 + (32 * ks + 8 * quad) * 2), VF[ks], acc);
                v2u w; w.x = pk2(acc[0], acc[1]); w.y = pk2(acc[2], acc[3]);
                *(v2u*)(Lg + ((size_t)(unit * 16 + dvt) * 8 + R) * 256 + lane * 4) = w; }
        }
        __syncthreads();
    }
}

constexpr int CH_L = 0, CH_Q = 4096, CH_G = 20480, CH_O = 20992, CH_STAGE = 23040;
struct ChReg { v4u l, q0, q1, q2, q3, x; };
__device__ __forceinline__ void ch_load(ChReg& r, const bf16* Lg, const float* gamma, const bf16* Qp, const bf16* OI, int unit, int dvt, int row0, int h, int lt) {
    r.l = *(const v4u*)(Lg + ((size_t)(unit * 16 + dvt) * 8) * 256 + lt * 8);
    const int rr = lt >> 4, j = (lt & 15) ^ rr;
    const bf16* qb = Qp + (size_t)(row0 + rr) * 512 + h * 128 + j * 8;
    r.q0 = *(const v4u*)(qb); r.q1 = *(const v4u*)(qb + 16 * 512); r.q2 = *(const v4u*)(qb + 32 * 512); r.q3 = *(const v4u*)(qb + 48 * 512);
    if (lt < 32) r.x = *(const v4u*)(gamma + (size_t)unit * 128 + lt * 4);
    else if (lt >= 128) { const int go = lt - 128; r.x = *(const v4u*)(OI + (size_t)(row0 + (go >> 1)) * 1024 + h * 256 + 16 * dvt + (go & 1) * 8); }
}
__device__ __forceinline__ void ch_store(const ChReg& r, LAS unsigned char* st, int lt) {
    *(LAS v4u*)(st + CH_L + lt * 16) = r.l;
    *(LAS v4u*)(st + CH_Q + lt * 16) = r.q0; *(LAS v4u*)(st + CH_Q + (lt + 256) * 16) = r.q1; *(LAS v4u*)(st + CH_Q + (lt + 512) * 16) = r.q2; *(LAS v4u*)(st + CH_Q + (lt + 768) * 16) = r.q3;
    if (lt < 32) *(LAS v4u*)(st + CH_G + lt * 16) = r.x; else if (lt >= 128) *(LAS v4u*)(st + CH_O + (lt - 128) * 16) = r.x;
}
__device__ __forceinline__ void gla_chain_phase(const Args& a, LAS unsigned char* lds, int tid, int lane, int wave, int G, int st_en) {
    asm volatile("" : "+v"(tid), "+v"(lane));
    unsigned char* ws = a.ws;
    const bf16* Qp = (const bf16*)(ws + WS_QP); bf16* OI = (bf16*)(ws + WS_OI); const bf16* Lg = (const bf16*)(ws + WS_L); const float* gamma = (const float*)(ws + WS_GAMMA); float* SS = (float*)(ws + WS_SS);
    const int l15 = lane & 15, quad = lane >> 4, lt = tid - 256, it = wave;
    const int vcu = (G % 8 == 0) ? ((int)blockIdx.x % 8) * (G / 8) + (int)blockIdx.x / 8 : (int)blockIdx.x;
    for (int item = vcu; item < 256; item += G) {
        const int bh = item >> 4, dvt = item & 15, b = bh >> 2, h = bh & 3, unit0 = bh * 64, rowb = b * SEQ;
        if (wave >= 4) {
            ChReg r0, r1, r2, r3, r4, r5, r6, r7;
#define CH_LD(rr, st) ch_load(rr, Lg, gamma, Qp, OI, unit0 + (st), dvt, rowb + (st) * 64, h, lt)
            CH_LD(r0, 0); ch_store(r0, lds, lt);
            CH_LD(r1, 1); CH_LD(r2, 2); CH_LD(r3, 3); CH_LD(r4, 4); CH_LD(r5, 5); CH_LD(r6, 6); CH_LD(r7, 7); CH_LD(r0, 8);
            __syncthreads();
#pragma unroll 1
            for (int cc = 0; cc < 8; ++cc) {
#pragma unroll
                for (int j = 0; j < 8; ++j) {
                    const int c = 8 * cc + j;
                    const int cn = (c + 9 < 64) ? c + 9 : 63;
                    LAS unsigned char* stn = lds + ((c + 1) & 1) * CH_STAGE;
#define CH_ROT(rr) do { ch_store(rr, stn, lt); CH_LD(rr, cn); } while (0)
                    if (j == 0) CH_ROT(r1); else if (j == 1) CH_ROT(r2); else if (j == 2) CH_ROT(r3); else if (j == 3) CH_ROT(r4); else if (j == 4) CH_ROT(r5); else if (j == 5) CH_ROT(r6); else if (j == 6) CH_ROT(r7); else CH_ROT(r0);
#undef CH_ROT
                    __syncthreads();
                }
            }
#undef CH_LD
        } else {
            f32x4 S[8];
#pragma unroll
            for (int R = 0; R < 8; ++R) S[R] = (f32x4){0.f, 0.f, 0.f, 0.f};
            __syncthreads();
#pragma unroll 1
            for (int c = 0; c < 64; ++c) {
                const LAS unsigned char* st = lds + (c & 1) * CH_STAGE;
                const int r = 16 * it + l15; const int row = rowb + c * 64 + r;
                f32x4 acc = {0.f, 0.f, 0.f, 0.f};
#pragma unroll
                for (int ks = 0; ks < 4; ++ks) { const int jq = 4 * ks + (quad >> 1), sub = (quad & 1) * 8;
                    const v2u qlo = *(const LAS v2u*)(st + CH_Q + r * 256 + ((jq ^ l15) << 4) + sub), qhi = *(const LAS v2u*)(st + CH_Q + r * 256 + (((jq + 2) ^ l15) << 4) + sub);
                    v4u sa; sa.x = pk2(S[2 * ks][0], S[2 * ks][1]); sa.y = pk2(S[2 * ks][2], S[2 * ks][3]); sa.z = pk2(S[2 * ks + 1][0], S[2 * ks + 1][1]); sa.w = pk2(S[2 * ks + 1][2], S[2 * ks + 1][3]);
                    acc = mfma16(__builtin_bit_cast(bf16x8, sa), mk8(qlo, qhi), acc); }
                const v2u oi = *(const LAS v2u*)(st + CH_O + r * 32 + quad * 8);
                const float o0 = acc[0] + bflo(oi.x), o1 = acc[1] + bfhi(oi.x), o2 = acc[2] + bflo(oi.y), o3 = acc[3] + bfhi(oi.y);
                v2u w; w.x = pk2(o0, o1); w.y = pk2(o2, o3);
                if (st_en) *(v2u*)(OI + (size_t)row * 1024 + h * 256 + 16 * dvt + 4 * quad) = w;
                float s = (o0 * o0 + o1 * o1) + (o2 * o2 + o3 * o3); s += __shfl_xor(s, 16); s += __shfl_xor(s, 32);
                if (quad == 0 && st_en) SS[(size_t)row * 64 + h * 16 + dvt] = s;
#pragma unroll
                for (int R = 0; R < 8; ++R) { const v2u Lr = *(const LAS v2u*)(st + CH_L + R * 512 + lane * 8); const f32x4 gm = *(const LAS f32x4*)(st + CH_G + (16 * R + 4 * quad) * 4);
                    S[R][0] = gm[0] * S[R][0] + bflo(Lr.x); S[R][1] = gm[1] * S[R][1] + bfhi(Lr.x); S[R][2] = gm[2] * S[R][2] + bflo(Lr.y); S[R][3] = gm[3] * S[R][3] + bfhi(Lr.y); }
                __syncthreads();
            }
        }
    }
}

constexpr int ATS_V = 16384, ATS_SLOT = 32768;
struct AtUnit { int b, h, dsh, r, qt; };
__device__ __forceinline__ AtUnit at_decode(int unit) { AtUnit U; const int u = unit & 31, hb = unit >> 5; U.h = hb % 24; U.b = hb / 24; U.dsh = 2 * (U.h >> 3); const int ntc = 32 >> U.dsh; U.r = u / ntc; U.qt = u - U.r * ntc; return U; }
__device__ __forceinline__ const bf16* at_qbase(const bf16* PROJ, const AtUnit& U) { return PROJ + ((size_t)(U.b * 24 + U.h) * 4096 + ((size_t)U.r << (12 - U.dsh))) * 64; }
__device__ __forceinline__ void at_dma_chunk(const bf16* PROJ, const AtUnit& U, int c, LAS unsigned char* slot, int wave, int lane) {
    constexpr size_t WHICH = (size_t)T * 1536;
    const bf16* Pb = at_qbase(PROJ, U) + (size_t)c * 128 * 64;
    const int rl = lane >> 3, j = (lane & 7) ^ rl;
#pragma unroll
    for (int i = 0; i < 2; ++i) { const int rb = wave + 8 * i; const bf16* src = Pb + (size_t)(rb * 8 + rl) * 64 + j * 8;
        __builtin_amdgcn_global_load_lds((const unsigned*)(src + WHICH), (LAS unsigned*)(slot + rb * 1024), 16, 0, 0);
        __builtin_amdgcn_global_load_lds((const unsigned*)(src + 2 * WHICH), (LAS unsigned*)(slot + ATS_V + rb * 1024), 16, 0, 0); }
}
__device__ __forceinline__ void attn_phase(const Args& a, LAS unsigned char* lds, int tid, int lane, int wave, int G) {
    asm volatile("" : "+v"(tid), "+v"(lane));
    unsigned char* ws = a.ws; const bf16* PROJ = (const bf16*)(ws + WS_PROJA);
    bf16* OG = (bf16*)(ws + WS_OG); float* ML = (float*)(ws + WS_ML);
    const int l15 = lane & 15, quad = lane >> 4, w = wave;
    const int vcu = (G % 8 == 0) ? ((int)blockIdx.x % 8) * (G / 8) + (int)blockIdx.x / 8 : (int)blockIdx.x;
    const int tpb = (3072 + G - 1) / G, t0 = vcu * tpb, t1 = (t0 + tpb < 3072) ? t0 + tpb : 3072;
    bf16x8 QB[2];
    if (t0 < t1) { const AtUnit U = at_decode(t0);
        if (U.qt > 0) at_dma_chunk(PROJ, U, U.qt - 1, lds + ((t0 + 2) % 3) * ATS_SLOT, wave, lane);
        at_dma_chunk(PROJ, U, U.qt, lds + (t0 % 3) * ATS_SLOT, wave, lane);
        const bf16* qp = at_qbase(PROJ, U) + (size_t)(128 * U.qt + 16 * w + l15) * 64 + 8 * quad; QB[0] = *(const bf16x8*)qp; QB[1] = *(const bf16x8*)(qp + 32); }
    v2u pend[4]; float pmx = 0.f, pl = 0.f; size_t prow = 0; int ph = 0; bool have = false;
    for (int unit = t0; unit < t1; ++unit) {
        const AtUnit U = at_decode(unit);
        const int sc = unit % 3, sp = (U.qt > 0) ? (unit + 2) % 3 : sc;
        asm volatile("s_waitcnt vmcnt(0)" ::: "memory");
        __syncthreads();
        if (have) {
#pragma unroll
            for (int dt = 0; dt < 4; ++dt) *(v2u*)(OG + prow * 1536 + ph * 64 + 16 * dt + 4 * quad) = pend[dt];
            if (quad == 0) { v2u mlv; mlv.x = __float_as_uint(pmx); mlv.y = __float_as_uint(pl); *(v2u*)(ML + prow * 48 + ph * 2) = mlv; } }
        const bf16x8 q0 = QB[0], q1 = QB[1];
        if (unit + 1 < t1) { const AtUnit Un = at_decode(unit + 1); at_dma_chunk(PROJ, Un, Un.qt, lds + ((unit + 1) % 3) * ATS_SLOT, wave, lane);
            const bf16* qp = at_qbase(PROJ, Un) + (size_t)(128 * Un.qt + 16 * w + l15) * 64 + 8 * quad; QB[0] = *(const bf16x8*)qp; QB[1] = *(const bf16x8*)(qp + 32); }
        {
            const int qt = U.qt;
            const LAS unsigned char* bp = lds + sp * ATS_SLOT; const LAS unsigned char* bc = lds + sc * ATS_SLOT;
            f32x4 ST[9]; float mx = -INFINITY;
#pragma unroll
            for (int Tt = 0; Tt < 9; ++Tt) { f32x4 acc = {0.f, 0.f, 0.f, 0.f}; const int kr = ((16 * (w + Tt)) & 127) + l15; const LAS unsigned char* kb = (w + Tt >= 8) ? bc : bp;
                acc = mfma16(*(const LAS bf16x8*)(kb + kr * 128 + (((0 + quad) ^ (kr & 7)) << 4)), q0, acc);
                acc = mfma16(*(const LAS bf16x8*)(kb + kr * 128 + (((4 + quad) ^ (kr & 7)) << 4)), q1, acc);
#pragma unroll
                for (int e = 0; e < 4; ++e) { const int kk = 4 * quad + e; bool valid = true; if (Tt == 0) valid = kk >= l15; if (Tt == 8) valid = kk <= l15;
                    if (qt == 0) valid = valid && (w + Tt >= 8);
                    acc[e] = valid ? acc[e] : -INFINITY; mx = fmaxf(mx, acc[e]); }
                ST[Tt] = acc; }
            mx = fmaxf(mx, __shfl_xor(mx, 16)); mx = fmaxf(mx, __shfl_xor(mx, 32));
            float l = 0.f;
#pragma unroll
            for (int Tt = 0; Tt < 9; ++Tt)
#pragma unroll
                for (int e = 0; e < 4; ++e) { const float pv = __builtin_amdgcn_exp2f(ST[Tt][e] - mx); ST[Tt][e] = pv; l += pv; }
            l += __shfl_xor(l, 16); l += __shfl_xor(l, 32);
            f32x4 O[4];
#pragma unroll
            for (int dt = 0; dt < 4; ++dt) O[dt] = (f32x4){0.f, 0.f, 0.f, 0.f};
#pragma unroll
            for (int pr = 0; pr < 5; ++pr) { const int T1 = 2 * pr, T2 = (2 * pr + 1 < 9) ? 2 * pr + 1 : 8;
                v4u pf; pf.x = pk2(ST[T1][0], ST[T1][1]); pf.y = pk2(ST[T1][2], ST[T1][3]);
                if (pr < 4) { pf.z = pk2(ST[T2][0], ST[T2][1]); pf.w = pk2(ST[T2][2], ST[T2][3]); } else { pf.z = 0u; pf.w = 0u; }
                const int k1 = ((16 * (w + T1)) & 127) + 4 * quad + (l15 >> 2), k2 = ((16 * (w + T2)) & 127) + 4 * quad + (l15 >> 2);
                const LAS unsigned char* v1 = ((w + T1 >= 8) ? bc : bp) + ATS_V; const LAS unsigned char* v2 = ((w + T2 >= 8) ? bc : bp) + ATS_V;
#pragma unroll
                for (int dt = 0; dt < 4; ++dt) {
                    const int jv = 2 * dt + ((l15 & 3) >> 1), sub = (l15 & 1) * 8;
                    const s16x4 lo = __builtin_amdgcn_ds_read_tr16_b64_v4i16((LAS s16x4*)(v1 + k1 * 128 + ((jv ^ (k1 & 7)) << 4) + sub));
                    const s16x4 hi = (pr < 4) ? __builtin_amdgcn_ds_read_tr16_b64_v4i16((LAS s16x4*)(v2 + k2 * 128 + ((jv ^ (k2 & 7)) << 4) + sub)) : lo;
                    bf16x8 av; av[0] = lo[0]; av[1] = lo[1]; av[2] = lo[2]; av[3] = lo[3]; av[4] = hi[0]; av[5] = hi[1]; av[6] = hi[2]; av[7] = hi[3];
                    O[dt] = mfma16(av, __builtin_bit_cast(bf16x8, pf), O[dt]); } }
            const float inv = 1.0f / l;
            const int tokq = ((128 * qt + 16 * w + l15) << U.dsh) + U.r; const size_t trow = (size_t)U.b * SEQ + tokq;
#pragma unroll
            for (int dt = 0; dt < 4; ++dt) { pend[dt].x = pk2(O[dt][0] * inv, O[dt][1] * inv); pend[dt].y = pk2(O[dt][2] * inv, O[dt][3] * inv); }
            pmx = mx; pl = l; prow = trow; ph = U.h; have = true;
        }
    }
    if (have) {
#pragma unroll
        for (int dt = 0; dt < 4; ++dt) *(v2u*)(OG + prow * 1536 + ph * 64 + 16 * dt + 4 * quad) = pend[dt];
        if (quad == 0) { v2u mlv; mlv.x = __float_as_uint(pmx); mlv.y = __float_as_uint(pl); *(v2u*)(ML + prow * 48 + ph * 2) = mlv; } }
    asm volatile("s_waitcnt vmcnt(0)" ::: "memory"); __syncthreads();
}
__device__ __forceinline__ void prep_a_phase(const Args& a, int tid, int G) {
    asm volatile("" : "+v"(tid));
    unsigned char* ws = a.ws; const bf16* OG = (const bf16*)(ws + WS_OG); const float* ML = (const float*)(ws + WS_ML); const bf16* ZA = (const bf16*)(ws + WS_ZA);
    bf16* AA = (bf16*)(ws + WS_AA);
    for (int p = blockIdx.x * 512 + tid; p < T * 64; p += G * 512) { const int t = p >> 6, col = (p & 63) * 8, s = col >> 6, dc = col & 63;
        v4u o[3]; float m[3], l[3];
#pragma unroll
        for (int g = 0; g < 3; ++g) { const int hh = 8 * g + s; o[g] = *(const v4u*)(OG + (size_t)t * 1536 + hh * 64 + dc); m[g] = ML[(size_t)t * 48 + hh * 2]; l[g] = ML[(size_t)t * 48 + hh * 2 + 1]; }
        const float M = fmaxf(m[0], fmaxf(m[1], m[2]));
        float w0 = l[0] * __builtin_amdgcn_exp2f(m[0] - M), w1 = l[1] * __builtin_amdgcn_exp2f(m[1] - M), w2 = l[2] * __builtin_amdgcn_exp2f(m[2] - M);
        const float iw = 1.0f / (w0 + w1 + w2); w0 *= iw; w1 *= iw; w2 *= iw;
        const v4u z8 = *(const v4u*)(ZA + (size_t)t * 512 + col);
        v4u w;
        w.x = pk2((w0 * bflo(o[0].x) + w1 * bflo(o[1].x) + w2 * bflo(o[2].x)) * siluf_(bflo(z8.x)), (w0 * bfhi(o[0].x) + w1 * bfhi(o[1].x) + w2 * bfhi(o[2].x)) * siluf_(bfhi(z8.x)));
        w.y = pk2((w0 * bflo(o[0].y) + w1 * bflo(o[1].y) + w2 * bflo(o[2].y)) * siluf_(bflo(z8.y)), (w0 * bfhi(o[0].y) + w1 * bfhi(o[1].y) + w2 * bfhi(o[2].y)) * siluf_(bfhi(z8.y)));
        w.z = pk2((w0 * bflo(o[0].z) + w1 * bflo(o[1].z) + w2 * bflo(o[2].z)) * siluf_(bflo(z8.z)), (w0 * bfhi(o[0].z) + w1 * bfhi(o[1].z) + w2 * bfhi(o[2].z)) * siluf_(bfhi(z8.z)));
        w.w = pk2((w0 * bflo(o[0].w) + w1 * bflo(o[1].w) + w2 * bflo(o[2].w)) * siluf_(bflo(z8.w)), (w0 * bfhi(o[0].w) + w1 * bfhi(o[1].w) + w2 * bfhi(o[2].w)) * siluf_(bfhi(z8.w)));
        *(v4u*)(AA + (size_t)t * 512 + col) = w; }
}


#ifndef REP_MASK
#define REP_MASK 0
#endif
#ifndef DBG_STOP
#define DBG_STOP 0
#endif
#if DBG_STOP
__device__ __forceinline__ float dbg_san(float v) { return (fabsf(v) < 1e30f) ? v : 777.0f; }
__device__ __forceinline__ float dbg_sum_bf16(const void* p, size_t bytes, int gtid, int NT) { const unsigned* q = (const unsigned*)p; float s = 0.f; for (size_t i = gtid; i < bytes / 4; i += NT) { const unsigned w = q[i]; s += dbg_san(bflo(w)) + dbg_san(bfhi(w)); } return s; }
__device__ __forceinline__ float dbg_sum_f32(const void* p, size_t bytes, int gtid, int NT) { const float* q = (const float*)p; float s = 0.f; for (size_t i = gtid; i < bytes / 4; i += NT) s += dbg_san(q[i]); return s; }
#define DBG_DUMP(k, NS, ...) if (DBG_STOP == (k)) { const int gtid_ = blockIdx.x * 512 + tid, NT_ = G * 512; float sv_[NS] = { __VA_ARGS__ }; GRID_SYNC(); \
    for (size_t i = gtid_; i < (size_t)T * D; i += NT_) args.out[i] = 0.f; _Pragma("unroll") for (int q_ = 0; q_ < NS; ++q_) args.out[(size_t)q_ * NT_ + gtid_] = sv_[q_]; return; }
#define SB(off, mib) dbg_sum_bf16(ws + (off), (size_t)(mib) * MiB, gtid_, NT_)
#define SF(off, mib) dbg_sum_f32(ws + (off), (size_t)(mib) * MiB, gtid_, NT_)
#else
#define DBG_DUMP(k, NS, ...)
#endif
typedef __attribute__((address_space(1))) unsigned gu32;
#define XB_TMO      128
#define XB_XCNT(j)  (256  + 64 * (j))
#define XB_XSUB(j)  (1280 + 64 * (j))
#define XB_XGEN(j)  (2304 + 64 * (j))
#define XB_TOP      3328
#define XB_TOPGEN   3392
#define XCD_BAR_WORDS 3456
#define XB_SPIN_CAP (1u << 18)

__device__ __forceinline__ unsigned xb_ld(unsigned* p)              { return __hip_atomic_load(p, __ATOMIC_RELAXED, __HIP_MEMORY_SCOPE_AGENT); }
__device__ __forceinline__ unsigned xb_add(unsigned* p, unsigned v) { return __hip_atomic_fetch_add(p, v, __ATOMIC_RELAXED, __HIP_MEMORY_SCOPE_AGENT); }
__device__ __forceinline__ unsigned xb_xcc_id() { return (unsigned)__builtin_amdgcn_s_getreg((3 << 11) | 20) & 0xFu; }
#define XB_SPIN(cond, bar) do { unsigned _sp = 0; while (cond) { __builtin_amdgcn_s_sleep(1); \
    if ((++_sp & 255u) == 0u) { if (xb_ld(&(bar)[XB_TMO])) break; if (_sp > XB_SPIN_CAP) { atomicAdd(&(bar)[XB_TMO], 1u); break; } } } } while (0)

struct XcdBarrier {
    unsigned* bar; unsigned x;
    volatile LAS unsigned* st;
};

__device__ __forceinline__ XcdBarrier xcd_barrier_post(unsigned* bar, volatile LAS unsigned* st) {
    XcdBarrier b; b.bar = bar; b.x = xb_xcc_id(); b.st = st;
    if (threadIdx.x == 0) (void)xb_add(&bar[XB_XCNT(b.x)], 1u);
    return b;
}
__device__ __forceinline__ void xcd_barrier_complete(unsigned* bar, unsigned x, unsigned& nloc, unsigned& nx) {
    const unsigned G = gridDim.x * gridDim.y * gridDim.z;
    unsigned sum, cnt, mine, sp = 0u;
    for (;;) {
        sum = 0u; cnt = 0u; mine = 0u;
#pragma unroll
        for (unsigned j = 0; j < 16; ++j) { const unsigned c = xb_ld(&bar[XB_XCNT(j)]); sum += c; cnt += (c > 0u) ? 1u : 0u; mine = (j == x) ? c : mine; }
        if (sum == G) break;
        __builtin_amdgcn_s_sleep(1);
        if ((++sp & 255u) == 0u) { if (xb_ld(&bar[XB_TMO])) break; if (sp > XB_SPIN_CAP) { atomicAdd(&bar[XB_TMO], 1u); break; } }
    }
    nloc = mine > 0u ? mine : 1u; nx = cnt > 0u ? cnt : 1u;
}

__device__ __forceinline__ void xcd_barrier(const XcdBarrier& b) {
    asm volatile("s_waitcnt vmcnt(0)" ::: "memory");
    __syncthreads();
    if (threadIdx.x == 0) {
        unsigned* bar = b.bar;
        __builtin_amdgcn_s_waitcnt(0);
        unsigned nloc = b.st[0], nx = b.st[1];
        if (nloc == 0u) { xcd_barrier_complete(bar, b.x, nloc, nx); b.st[0] = nloc; b.st[1] = nx; }
        const unsigned old = xb_add(&bar[XB_XSUB(b.x)], 1u);
        const unsigned gen = old / nloc;
        if (old + 1u == (gen + 1u) * nloc) {
            __builtin_amdgcn_fence(__ATOMIC_RELEASE, "agent");
            asm volatile("s_waitcnt vmcnt(0)" ::: "memory");
            const unsigned og = xb_add(&bar[XB_TOP], 1u);
            const unsigned tg = og / nx;
            if (og + 1u == (tg + 1u) * nx) xb_add(&bar[XB_TOPGEN], 1u);
            else XB_SPIN(xb_ld(&bar[XB_TOPGEN]) == tg, bar);
            __builtin_amdgcn_fence(__ATOMIC_ACQUIRE, "agent");
            xb_add(&bar[XB_XGEN(b.x)], 1u);
            asm volatile("s_waitcnt vmcnt(0)" ::: "memory");
        } else {
            XB_SPIN(xb_ld(&bar[XB_XGEN(b.x)]) == gen, bar);
            __builtin_amdgcn_fence(__ATOMIC_ACQUIRE, "agent");
            asm volatile("s_waitcnt vmcnt(0)" ::: "memory");
        }
    }
    __syncthreads();
}


__device__ __forceinline__ void panel_handoff(unsigned* cnt, int pm, unsigned want) {
    asm volatile("s_waitcnt vmcnt(0)" ::: "memory");
    __syncthreads();
    if (threadIdx.x == 0) {
        unsigned* c = cnt + 64 * pm;
        __hip_atomic_fetch_add(c, 1u, __ATOMIC_RELAXED, __HIP_MEMORY_SCOPE_AGENT);
        unsigned sp = 0;
        while (__hip_atomic_load(c, __ATOMIC_RELAXED, __HIP_MEMORY_SCOPE_AGENT) < want) { __builtin_amdgcn_s_sleep(1); if (++sp > (1u << 22)) break; }
        __builtin_amdgcn_fence(__ATOMIC_ACQUIRE, "agent");
        asm volatile("s_waitcnt vmcnt(0)" ::: "memory");
    }
    __syncthreads();
}
#define GRID_SYNC_CG() do { asm volatile("s_waitcnt vmcnt(0) lgkmcnt(0)" ::: "memory"); grid.sync(); __builtin_amdgcn_fence(__ATOMIC_ACQUIRE, "agent"); asm volatile("s_waitcnt vmcnt(0)" ::: "memory"); } while (0)
#define GRID_SYNC() xcd_barrier(xbar)
__global__ void __launch_bounds__(NWAVES * 64, 2) mega_fwd(Args args) {
    extern __shared__ __attribute__((aligned(16))) unsigned char lds_raw[];
    LAS unsigned char* lds = (LAS unsigned char*)lds_raw;
    cg::grid_group grid = cg::this_grid();
    const int tid = threadIdx.x, lane = tid & 63, wave = __builtin_amdgcn_readfirstlane(tid >> 6), G = gridDim.x;
    unsigned char* ws = args.ws;
    if (tid < 32) ((LAS unsigned*)(lds + MISC_OFF))[tid] = 0u;
    __syncthreads();
    const XcdBarrier xbar = xcd_barrier_post((unsigned*)(ws + WS_BAR), (volatile LAS unsigned*)(lds + MISC_OFF) + 8);
    const pg8::bf16_t* hb = (const pg8::bf16_t*)args.out;
    const pg8::bf16_t* AB = (const pg8::bf16_t*)args.out + (size_t)T * 1024;

#if REP_MASK & 32
    for (int q_ = 0; q_ < 10; ++q_) { GRID_SYNC(); }
#endif
    phase0(args, lds, tid, lane, wave, G);
#if REP_MASK & 1
    phase0(args, lds, tid, lane, wave, G);
#endif
    if (args.zero) { GRID_SYNC_CG(); }
    GRID_SYNC();
    glr_step(args, lane, wave, G);
    { pg8::Gemm g{hb, hb, hb, (const pg8::bf16_t*)(ws + WS_W1G), (const pg8::bf16_t*)(ws + WS_W1G), (const pg8::bf16_t*)(ws + WS_W1G), 16, 16, 16, 1024, 1024};
      pg8::SegOrder S; S.init(T, PG, G, (int)blockIdx.x, 1); pg8::EpiBf16 E{(pg8::bf16_t*)(ws + WS_PROJG), PG};
      pg8::gemm_phase<pg8::EpiBf16, pg8::SegOrder, true, true>(lds, g, S, E); }
#if REP_MASK & 128
    { pg8::Gemm g{hb, hb, hb, (const pg8::bf16_t*)(ws + WS_W1G), (const pg8::bf16_t*)(ws + WS_W1G), (const pg8::bf16_t*)(ws + WS_W1G), 16, 16, 16, 1024, 1024};
      pg8::SegOrder S; S.init(T, PG, G, (int)blockIdx.x, 1); pg8::EpiBf16 E{(pg8::bf16_t*)(ws + WS_PROJG), PG};
      pg8::gemm_phase<pg8::EpiBf16, pg8::SegOrder, true, true>(lds, g, S, E); }
#endif
    GRID_SYNC();
    DBG_DUMP(2, 7, SB(WS_W1A, 10), SB(WS_W1G, 6), SB(WS_WGT, 4), SF(WS_ROT, 1), dbg_sum_bf16(args.out, 32 * MiB, gtid_, NT_), SF(WS_GLR, 1), SB(WS_PROJG, 96))
    gla_local_phase(args, lds, tid, lane, wave, G);
#if REP_MASK & 2
    gla_local_phase(args, lds, tid, lane, wave, G);
#endif
    GRID_SYNC();
    DBG_DUMP(3, 4, SB(WS_QP, 16), SB(WS_OI, 32), SB(WS_L, 64), SF(WS_GAMMA, 0.5))
    DBG_DUMP(31, 1, SB(WS_QP, 16))
    DBG_DUMP(32, 1, SB(WS_OI, 32))
    DBG_DUMP(33, 1, SB(WS_L, 64))
    gla_chain_phase(args, lds, tid, lane, wave, G, args.one);
#if REP_MASK & 64
    gla_chain_phase(args, lds, tid, lane, wave, G, args.zero);
#endif
    GRID_SYNC();
    DBG_DUMP(4, 2, SB(WS_OI, 32), SF(WS_SS, 4))
    { pg8::Gemm g{hb, hb, hb, (const pg8::bf16_t*)(ws + WS_W1A), (const pg8::bf16_t*)(ws + WS_W1A), (const pg8::bf16_t*)(ws + WS_W1A), 16, 16, 16, 1024, 1024};
      pg8::SegOrder S; S.init(T, 6144, G, (int)blockIdx.x, 1);
      pg8::EpiQKV E{(pg8::bf16_t*)(ws + WS_PROJA), (pg8::bf16_t*)(ws + WS_ZA), args.gq, args.gk, (const float*)(ws + WS_ROT), EPS, (const pg8::bf16_t*)(ws + WS_OI), (const float*)(ws + WS_SS), args.gla_g, (pg8::bf16_t*)args.out + (size_t)T * 1024};
      pg8::gemm_phase<pg8::EpiQKV, pg8::SegOrder, true, true>(lds, g, S, E); }
#if REP_MASK & 256
    { pg8::Gemm g{hb, hb, hb, (const pg8::bf16_t*)(ws + WS_W1A), (const pg8::bf16_t*)(ws + WS_W1A), (const pg8::bf16_t*)(ws + WS_W1A), 16, 16, 16, 1024, 1024};
      pg8::SegOrder S; S.init(T, 6144, G, (int)blockIdx.x, 1);
      pg8::EpiQKV E{(pg8::bf16_t*)(ws + WS_PROJA), (pg8::bf16_t*)(ws + WS_ZA), args.gq, args.gk, (const float*)(ws + WS_ROT), EPS, (const pg8::bf16_t*)(ws + WS_OI), (const float*)(ws + WS_SS), args.gla_g, (pg8::bf16_t*)args.out + (size_t)T * 1024};
      pg8::gemm_phase<pg8::EpiQKV, pg8::SegOrder, true, true>(lds, g, S, E); }
#endif
    GRID_SYNC();
    attn_phase(args, lds, tid, lane, wave, G);
#if REP_MASK & 8
    attn_phase(args, lds, tid, lane, wave, G);
#endif
    GRID_SYNC();
    prep_a_phase(args, tid, G);
#if REP_MASK & 16
    prep_a_phase(args, tid, G);
#endif
    GRID_SYNC();
    DBG_DUMP(8, 4, SB(WS_PROJA, 160), SB(WS_OG, 48), SF(WS_ML, 3), SB(WS_AA, 16))
    { bf16* pb = (bf16*)(ws + WS_PB);
      for (int i = blockIdx.x * 512 + tid; i < T * 256 / 8; i += G * 512) { const f32x4 v0 = ((const f32x4*)args.p)[2 * i], v1 = ((const f32x4*)args.p)[2 * i + 1];
          v4u w; w.x = pk2(v0[0], v0[1]); w.y = pk2(v0[2], v0[3]); w.z = pk2(v1[0], v1[1]); w.w = pk2(v1[2], v1[3]); ((v4u*)pb)[i] = w; } }
    { const pg8::bf16_t* WGT = (const pg8::bf16_t*)(ws + WS_WGT);
      pg8::Gemm g{hb, hb, hb, WGT, WGT + (size_t)1024 * 1024, WGT, 16, 16, 16, 1024, 1024};
      pg8::SegOrder S; S.init(T, 1024, G, (int)blockIdx.x, 2); pg8::EpiSig2 E{(pg8::bf16_t*)(ws + WS_SGA), (pg8::bf16_t*)(ws + WS_SGB), 1024};
      pg8::gemm_phase<pg8::EpiSig2, pg8::SegOrder, true, true>(lds, g, S, E); }
    { const pg8::bf16_t* AA = (const pg8::bf16_t*)(ws + WS_AA); const pg8::bf16_t* WPA = (const pg8::bf16_t*)(ws + WS_WPA);
      pg8::Gemm g{AA, AA, AA, WPA, WPA, WPA, 8, 8, 8, 512, 512};
      pg8::SegOrder S; S.init(T, 1024, G, (int)blockIdx.x, 1); pg8::EpiGateMul E{(const pg8::bf16_t*)(ws + WS_SGA), (pg8::bf16_t*)(ws + WS_T1), 1024};
      pg8::gemm_phase<pg8::EpiGateMul, pg8::SegOrder, true, true>(lds, g, S, E); }
    { const pg8::bf16_t* WPB = (const pg8::bf16_t*)(ws + WS_WPB);
      pg8::Gemm g{AB, AB, AB, WPB, WPB, WPB, 16, 16, 16, 1024, 1024};
      pg8::SegOrder S; S.init(T, 1024, G, (int)blockIdx.x, 1); pg8::EpiMergeY E{(const pg8::bf16_t*)(ws + WS_SGB), (const pg8::bf16_t*)(ws + WS_T1), (pg8::bf16_t*)(ws + WS_Y), 1024};
      pg8::gemm_phase<pg8::EpiMergeY, pg8::SegOrder, true, true>(lds, g, S, E); }
    GRID_SYNC();
    DBG_DUMP(9, 5, SF(WS_TMP1, 64), SF(WS_TMP2, 64), SB(WS_Y, 32), SB(WS_PB, 8), SB(WS_WPA, 7))
    { const pg8::bf16_t* Y = (const pg8::bf16_t*)(ws + WS_Y); const pg8::bf16_t* W = (const pg8::bf16_t*)(ws + WS_WOUT);
      pg8::Gemm g{Y, Y, Y, W, W, W, 16, 16, 16, 1024, 1024};
      pg8::SegOrder S; S.init(T, 1024, G, (int)blockIdx.x, 1); pg8::EpiResid E{args.x, args.out, (pg8::bf16_t*)(ws + WS_X1B), (float*)(ws + WS_PS), 1024};
      pg8::gemm_phase<pg8::EpiResid, pg8::SegOrder, true, true>(lds, g, S, E); }
#if REP_MASK & 1024
    { const pg8::bf16_t* Y = (const pg8::bf16_t*)(ws + WS_Y); const pg8::bf16_t* W = (const pg8::bf16_t*)(ws + WS_WOUT);
      pg8::Gemm g{Y, Y, Y, W, W, W, 16, 16, 16, 1024, 1024};
      pg8::SegOrder S; S.init(T, 1024, G, (int)blockIdx.x, 1); pg8::EpiResid E{args.x, args.out, (pg8::bf16_t*)(ws + WS_X1B), (float*)(ws + WS_PS), 1024};
      pg8::gemm_phase<pg8::EpiResid, pg8::SegOrder, true, true>(lds, g, S, E); }
#endif
    { pg8::SegOrder S; S.init(T, 1024, G, (int)blockIdx.x, 1); pg8::Unit u0;
      if (S.nwg == G && S.next(0, u0)) panel_handoff((unsigned*)(ws + WS_PCNT), u0.pm, 4u); else { GRID_SYNC(); } }
    DBG_DUMP(10, 3, SB(WS_X1B, 32), SF(WS_PS, 1), dbg_sum_f32(args.out, 64 * MiB, gtid_, NT_))
    { const pg8::bf16_t* X1 = (const pg8::bf16_t*)(ws + WS_X1B); const pg8::bf16_t* W = (const pg8::bf16_t*)(ws + WS_WPG);
      pg8::Gemm g{X1, X1, X1, W, W, W, 16, 16, 16, 1024, 1024};
      pg8::SegOrder S; S.init(T, 1024, G, (int)blockIdx.x, 1); pg8::EpiSigRow E{(const float*)(ws + WS_PS), (pg8::bf16_t*)(ws + WS_SGA), 1024, EPS};
      pg8::gemm_phase<pg8::EpiSigRow, pg8::SegOrder, true, true>(lds, g, S, E); }
    { const pg8::bf16_t* PBm = (const pg8::bf16_t*)(ws + WS_PB); const pg8::bf16_t* W = (const pg8::bf16_t*)(ws + WS_WPLE);
      pg8::Gemm g{PBm, PBm, PBm, W, W, W, 4, 4, 4, 256, 256};
      pg8::SegOrder S; S.init(T, 1024, G, (int)blockIdx.x, 1); pg8::EpiPle2 E{args.out, (const pg8::bf16_t*)(ws + WS_SGA), 1024};
      pg8::gemm_phase<pg8::EpiPle2, pg8::SegOrder, true, true>(lds, g, S, E); }
}

extern "C" void kernel_launch(void* const* d_in, const int* in_sizes, int n_in, void* d_out, int out_size, void* d_ws, size_t ws_size, hipStream_t stream) {
    static int grid = 0;
    if (grid == 0) {
        if (n_in != 16 || out_size != T * D || ws_size < WS_END) { fprintf(stderr, "kernel_launch: unexpected shapes (n_in %d out %d ws %zu)\n", n_in, out_size, ws_size); grid = -1; return; }
        int dev = 0, cus = 0, per_cu = 0;
        (void)hipGetDevice(&dev); (void)hipDeviceGetAttribute(&cus, hipDeviceAttributeMultiprocessorCount, dev);
        (void)hipFuncSetAttribute((const void*)mega_fwd, hipFuncAttributeMaxDynamicSharedMemorySize, LDS_BYTES);
        (void)hipOccupancyMaxActiveBlocksPerMultiprocessor(&per_cu, (const void*)mega_fwd, NWAVES * 64, LDS_BYTES);
        if (per_cu < 1) { fprintf(stderr, "kernel_launch: occupancy query says %d blocks per CU\n", per_cu); per_cu = 1; }
        (void)hipGetLastError();
        grid = cus;
    }
    if (grid < 0) return;
    Args a{};
    a.x = (const float*)d_in[0]; a.p = (const float*)d_in[1]; a.pos = (const int*)d_in[2]; a.norm_g = (const float*)d_in[3]; a.w_in = (const float*)d_in[4];
    a.gq = (const float*)d_in[5]; a.gk = (const float*)d_in[6]; a.gate_w2 = (const float*)d_in[7]; a.gate_b = (const float*)d_in[8]; a.gla_g = (const float*)d_in[9];
    a.w_att = (const float*)d_in[10]; a.w_gla = (const float*)d_in[11]; a.w_out = (const float*)d_in[12]; a.ple_g = (const float*)d_in[13]; a.w_pg = (const float*)d_in[14]; a.w_ple = (const float*)d_in[15];
    a.out = (float*)d_out; a.ws = (unsigned char*)d_ws; a.one = 1; a.zero = 0;
    if (hipMemsetAsync((char*)d_ws + WS_BAR, 0, BAR_BYTES, stream) != hipSuccess) { fprintf(stderr, "kernel_launch: memset of barrier words failed\n"); return; }
    void* kargs[] = {&a};
    hipError_t e = hipLaunchCooperativeKernel((const void*)mega_fwd, dim3(grid), dim3(NWAVES * 64), kargs, LDS_BYTES, stream);
    if (e != hipSuccess) fprintf(stderr, "cooperative launch failed: %s (grid %d)\n", hipGetErrorString(e), grid);
}
```

```cpp
#define REP_MASK 0
#define DBG_STOP 0
#include <hip/hip_runtime.h>
#include <hip/hip_cooperative_groups.h>
#include <cstdio>
#include <cstdint>
namespace cg = cooperative_groups;

namespace pg8 {
#define PG8_LAS __attribute__((address_space(3)))
typedef unsigned short bf16_t;
typedef short bf16x8 __attribute__((ext_vector_type(8)));
typedef float f32x4 __attribute__((ext_vector_type(4)));
typedef unsigned u32x4 __attribute__((ext_vector_type(4)));
typedef unsigned u32x2 __attribute__((ext_vector_type(2)));
constexpr int BM = 256, BK = 64, HALF = 128, HTB = HALF * BK * 2  , STAGE_BYTES = 8 * HTB, NXCD = 8, WGM = 8;

__host__ __device__ __forceinline__ int lds_byte(int r, int c) { const int st = (r >> 4) * 2 + (c >> 5), rr = r & 15, cc = c & 31, ob = rr * 64 + cc * 2; return st * 1024 + (ob ^ (((ob >> 9) & 1) << 5)); }
__host__ __device__ __forceinline__ void stage_rc(int b, int& R, int& C) { const int st = b / 1024, sb = b % 1024, swz = sb ^ (((sb >> 9) & 1) << 5); R = (st >> 1) * 16 + swz / 64; C = (st & 1) * 32 + (swz % 64) / 2; }
__host__ __device__ __forceinline__ int perm32(int rho) { const int n = rho >> 4, i = rho & 15; return 8 * (i >> 2) + 4 * n + (i & 3); }

struct Unit { int pm, pn, seg; };
struct Gemm {
    const bf16_t* A0; const bf16_t* A1; const bf16_t* A2; const bf16_t* B0; const bf16_t* B1; const bf16_t* B2; int nt0, nt1, nt2, lda, ldb;
    __device__ __forceinline__ const bf16_t* selA(int s) const { const bf16_t* a0 = +A0; const bf16_t* a1 = +A1; const bf16_t* a2 = +A2; return s == 0 ? +a0 : (s == 1 ? +a1 : +a2); }
    __device__ __forceinline__ const bf16_t* selB(int s) const { const bf16_t* b0 = +B0; const bf16_t* b1 = +B1; const bf16_t* b2 = +B2; return s == 0 ? +b0 : (s == 1 ? +b1 : +b2); }
    __device__ __forceinline__ int selNt(int s) const { const int n0 = +nt0, n1 = +nt1, n2 = +nt2; return s == 0 ? +n0 : (s == 1 ? +n1 : +n2); }
};
struct SegOrder {
    int nM, nN, nwg, G, c, nseg;
    __device__ void init(int M, int N, int G_, int c_, int nseg_) { nM = M / BM; nN = N / BM; nwg = nM * nN; G = G_; c = c_; nseg = nseg_; }
    __device__ bool next(int i, Unit& u) const {
        const int ti = i / nseg; u.seg = i - ti * nseg;
        const long L = (long)ti * G + c; if (L >= nwg) return false;
        int wgid = (int)L; { const int q = nwg / NXCD, r = nwg % NXCD, xcd = wgid % NXCD, off = wgid / NXCD; wgid = (xcd < r ? xcd * (q + 1) : r * (q + 1) + (xcd - r) * q) + off; }
        const int nig = WGM * nN, gid = wgid / nig, fm = gid * WGM, gsz = (nM - fm) < WGM ? (nM - fm) : WGM;
        u.pm = fm + ((wgid % nig) % gsz); u.pn = (wgid % nig) / gsz; return true;
    }
    __device__ __forceinline__ void a_ready(const Unit&) const {}
    __device__ __forceinline__ void done(const Unit&) const {}
};
typedef __bf16 bf16x2_t __attribute__((ext_vector_type(2)));
typedef float f32x2_t __attribute__((ext_vector_type(2)));
__device__ __forceinline__ unsigned cvt_pk_bf16(float lo, float hi) { f32x2_t f = {lo, hi}; bf16x2_t v = __builtin_convertvector(f, bf16x2_t); return __builtin_bit_cast(unsigned, v); }
__device__ __forceinline__ float sigmoidf_(float x) { return __builtin_amdgcn_rcpf(1.0f + __expf(-x)); }

struct EpiBf16 {
    static constexpr bool PERM = true, AFTER_DRAIN = false;
    bf16_t* O; int ldc;
    __device__ __forceinline__ void operator()(const f32x4 (&acc)[2][2][4][2], const Unit& u, int wr, int wc, int fr, int fq) const {
        const int row0 = u.pm * BM + wr * 64 + fr; const int col0 = u.pn * BM + wc * 32 + 8 * fq;
#pragma unroll
        for (int ai = 0; ai < 2; ++ai)
#pragma unroll
            for (int m = 0; m < 4; ++m) { bf16_t* rowp = O + (size_t)(row0 + ai * HALF + m * 16) * ldc + col0;
#pragma unroll
                for (int bj = 0; bj < 2; ++bj) { const f32x4 v0 = acc[ai][bj][m][0], v1 = acc[ai][bj][m][1];
                    u32x4 w; w.x = cvt_pk_bf16(v0[0], v0[1]); w.y = cvt_pk_bf16(v0[2], v0[3]); w.z = cvt_pk_bf16(v1[0], v1[1]); w.w = cvt_pk_bf16(v1[2], v1[3]);
                    *(u32x4*)(rowp + bj * HALF) = w; } }
    }
};
#define PG8_FOR_ACC(body) \
    _Pragma("unroll") for (int ai = 0; ai < 2; ++ai) _Pragma("unroll") for (int m = 0; m < 4; ++m) { const int row = u.pm * BM + ai * HALF + wr * 64 + m * 16 + fr; \
    _Pragma("unroll") for (int bj = 0; bj < 2; ++bj) _Pragma("unroll") for (int n = 0; n < 2; ++n) { const size_t off = (size_t)row * ldc + (u.pn * BM + bj * HALF + wc * 32 + n * 16 + 4 * fq); const f32x4 a = acc[ai][bj][m][n]; body } }
struct EpiStoreF32 {
    static constexpr bool PERM = false, AFTER_DRAIN = false;
    float* tmp; int ldc;
    __device__ __forceinline__ void operator()(const f32x4 (&acc)[2][2][4][2], const Unit& u, int wr, int wc, int fr, int fq) const {
        PG8_FOR_ACC( *(f32x4*)(tmp + off) = a; )
    }
};
struct EpiMerge {
    static constexpr bool PERM = false, AFTER_DRAIN = false;
    float* tmp1; float* tmp2; bf16_t* y; int ldc;
    __device__ __forceinline__ void operator()(const f32x4 (&acc)[2][2][4][2], const Unit& u, int wr, int wc, int fr, int fq) const {
        if (u.seg == 0) {
            PG8_FOR_ACC( f32x4 t = *(const f32x4*)(tmp1 + off); t[0] *= sigmoidf_(a[0]); t[1] *= sigmoidf_(a[1]); t[2] *= sigmoidf_(a[2]); t[3] *= sigmoidf_(a[3]); *(f32x4*)(tmp1 + off) = t; )
        } else if (u.seg == 1) {
            PG8_FOR_ACC( *(f32x4*)(tmp2 + off) = a; )
        } else {
            PG8_FOR_ACC( const f32x4 t1 = *(const f32x4*)(tmp1 + off); const f32x4 t2 = *(const f32x4*)(tmp2 + off);
                u32x2 w; w.x = cvt_pk_bf16(t1[0] + sigmoidf_(a[0]) * t2[0], t1[1] + sigmoidf_(a[1]) * t2[1]); w.y = cvt_pk_bf16(t1[2] + sigmoidf_(a[2]) * t2[2], t1[3] + sigmoidf_(a[3]) * t2[3]);
                *(u32x2*)(y + off) = w; )
        }
    }
};
struct EpiResid {
    static constexpr bool PERM = false, AFTER_DRAIN = false;
    const float* x; float* out; bf16_t* x1b; float* ps; int ldc;
    __device__ __forceinline__ void operator()(const f32x4 (&acc)[2][2][4][2], const Unit& u, int wr, int wc, int fr, int fq) const {
#pragma unroll
        for (int ai = 0; ai < 2; ++ai)
#pragma unroll
            for (int m = 0; m < 4; ++m) { const int row = u.pm * BM + ai * HALF + wr * 64 + m * 16 + fr; float s = 0.f;
#pragma unroll
                for (int bj = 0; bj < 2; ++bj)
#pragma unroll
                    for (int n = 0; n < 2; ++n) { const size_t off = (size_t)row * ldc + (u.pn * BM + bj * HALF + wc * 32 + n * 16 + 4 * fq);
                        const f32x4 v = *(const f32x4*)(x + off) + acc[ai][bj][m][n]; *(f32x4*)(out + off) = v;
                        u32x2 w; w.x = cvt_pk_bf16(v[0], v[1]); w.y = cvt_pk_bf16(v[2], v[3]);
                        __hip_atomic_store((unsigned long long*)(x1b + off), ((unsigned long long)w.y << 32) | w.x, __ATOMIC_RELAXED, __HIP_MEMORY_SCOPE_AGENT);
                        s += (v[0] * v[0] + v[1] * v[1]) + (v[2] * v[2] + v[3] * v[3]); }
                s += __shfl_xor(s, 16); s += __shfl_xor(s, 32);
                if (fq == 0) __hip_atomic_store(ps + (size_t)row * 16 + u.pn * 4 + wc, s, __ATOMIC_RELAXED, __HIP_MEMORY_SCOPE_AGENT); }
    }
};
struct EpiPle {
    static constexpr bool PERM = false, AFTER_DRAIN = false;
    float* out; const float* tmp; const float* ps; int ldc; float eps;
    __device__ __forceinline__ void operator()(const f32x4 (&acc)[2][2][4][2], const Unit& u, int wr, int wc, int fr, int fq) const {
#pragma unroll
        for (int ai = 0; ai < 2; ++ai)
#pragma unroll
            for (int m = 0; m < 4; ++m) { const int row = u.pm * BM + ai * HALF + wr * 64 + m * 16 + fr;
                const f32x4* pp = (const f32x4*)(ps + (size_t)row * 16); const f32x4 p0 = pp[0], p1 = pp[1], p2 = pp[2], p3 = pp[3];
                const float ss = ((p0[0] + p0[1]) + (p0[2] + p0[3])) + ((p1[0] + p1[1]) + (p1[2] + p1[3])) + ((p2[0] + p2[1]) + (p2[2] + p2[3])) + ((p3[0] + p3[1]) + (p3[2] + p3[3]));
                const float rstd = rsqrtf(ss * (1.0f / 1024.0f) + eps);
#pragma unroll
                for (int bj = 0; bj < 2; ++bj)
#pragma unroll
                    for (int n = 0; n < 2; ++n) { const size_t off = (size_t)row * ldc + (u.pn * BM + bj * HALF + wc * 32 + n * 16 + 4 * fq);
                        const f32x4 a = acc[ai][bj][m][n]; const f32x4 t = *(const f32x4*)(tmp + off); f32x4 o = *(const f32x4*)(out + off);
                        o[0] += t[0] * sigmoidf_(rstd * a[0]); o[1] += t[1] * sigmoidf_(rstd * a[1]); o[2] += t[2] * sigmoidf_(rstd * a[2]); o[3] += t[3] * sigmoidf_(rstd * a[3]);
                        *(f32x4*)(out + off) = o; } }
    }
};

__device__ __forceinline__ f32x4 unpack_bf16x4(u32x2 w) { f32x4 r; r[0] = __uint_as_float(w.x << 16); r[1] = __uint_as_float(w.x & 0xffff0000u); r[2] = __uint_as_float(w.y << 16); r[3] = __uint_as_float(w.y & 0xffff0000u); return r; }
struct EpiSig2 {
    static constexpr bool PERM = false, AFTER_DRAIN = false;
    bf16_t* s0; bf16_t* s1; int ldc;
    __device__ __forceinline__ void operator()(const f32x4 (&acc)[2][2][4][2], const Unit& u, int wr, int wc, int fr, int fq) const {
        bf16_t* dst = u.seg == 0 ? s0 : s1;
        PG8_FOR_ACC( u32x2 w; w.x = cvt_pk_bf16(sigmoidf_(a[0]), sigmoidf_(a[1])); w.y = cvt_pk_bf16(sigmoidf_(a[2]), sigmoidf_(a[3])); *(u32x2*)(dst + off) = w; )
    }
};
struct EpiGateMul {
    static constexpr bool PERM = false, AFTER_DRAIN = false;
    const bf16_t* sg; bf16_t* t1; int ldc;
    __device__ __forceinline__ void operator()(const f32x4 (&acc)[2][2][4][2], const Unit& u, int wr, int wc, int fr, int fq) const {
        PG8_FOR_ACC( const f32x4 g = unpack_bf16x4(*(const u32x2*)(sg + off)); u32x2 w; w.x = cvt_pk_bf16(g[0] * a[0], g[1] * a[1]); w.y = cvt_pk_bf16(g[2] * a[2], g[3] * a[3]); *(u32x2*)(t1 + off) = w; )
    }
};
struct EpiMergeY {
    static constexpr bool PERM = false, AFTER_DRAIN = false;
    const bf16_t* sg; const bf16_t* t1; bf16_t* y; int ldc;
    __device__ __forceinline__ void operator()(const f32x4 (&acc)[2][2][4][2], const Unit& u, int wr, int wc, int fr, int fq) const {
        PG8_FOR_ACC( const f32x4 g = unpack_bf16x4(*(const u32x2*)(sg + off)); const f32x4 t = unpack_bf16x4(*(const u32x2*)(t1 + off));
            u32x2 w; w.x = cvt_pk_bf16(t[0] + g[0] * a[0], t[1] + g[1] * a[1]); w.y = cvt_pk_bf16(t[2] + g[2] * a[2], t[3] + g[3] * a[3]); *(u32x2*)(y + off) = w; )
    }
};
struct EpiSigRow {
    static constexpr bool PERM = false, AFTER_DRAIN = false;
    const float* ps; bf16_t* sg; int ldc; float eps;
    __device__ __forceinline__ void operator()(const f32x4 (&acc)[2][2][4][2], const Unit& u, int wr, int wc, int fr, int fq) const {
#pragma unroll
        for (int ai = 0; ai < 2; ++ai)
#pragma unroll
            for (int m = 0; m < 4; ++m) { const int row = u.pm * BM + ai * HALF + wr * 64 + m * 16 + fr;
                const f32x4* pp = (const f32x4*)(ps + (size_t)row * 16); const f32x4 p0 = pp[0], p1 = pp[1], p2 = pp[2], p3 = pp[3];
                const float ss = ((p0[0] + p0[1]) + (p0[2] + p0[3])) + ((p1[0] + p1[1]) + (p1[2] + p1[3])) + ((p2[0] + p2[1]) + (p2[2] + p2[3])) + ((p3[0] + p3[1]) + (p3[2] + p3[3]));
                const float rstd = rsqrtf(ss * (1.0f / 1024.0f) + eps);
#pragma unroll
                for (int bj = 0; bj < 2; ++bj)
#pragma unroll
                    for (int n = 0; n < 2; ++n) { const size_t off = (size_t)row * ldc + (u.pn * BM + bj * HALF + wc * 32 + n * 16 + 4 * fq);
                        const f32x4 a = acc[ai][bj][m][n]; u32x2 w; w.x = cvt_pk_bf16(sigmoidf_(rstd * a[0]), sigmoidf_(rstd * a[1])); w.y = cvt_pk_bf16(sigmoidf_(rstd * a[2]), sigmoidf_(rstd * a[3]));
                        *(u32x2*)(sg + off) = w; } }
    }
};
struct EpiPle2 {
    static constexpr bool PERM = false, AFTER_DRAIN = false;
    float* out; const bf16_t* sg; int ldc;
    __device__ __forceinline__ void operator()(const f32x4 (&acc)[2][2][4][2], const Unit& u, int wr, int wc, int fr, int fq) const {
        PG8_FOR_ACC( const f32x4 g = unpack_bf16x4(*(const u32x2*)(sg + off)); f32x4 o = *(const f32x4*)(out + off); o[0] += a[0] * g[0]; o[1] += a[1] * g[1]; o[2] += a[2] * g[2]; o[3] += a[3] * g[3]; *(f32x4*)(out + off) = o; )
    }
};

struct EpiQKV {
    static constexpr bool PERM = true, AFTER_DRAIN = false;
    bf16_t* QKV; bf16_t* ZA; const float* gq; const float* gk; const float* rot; float eps;
    const bf16_t* OI; const float* SS; const float* gla_g; bf16_t* AB;
    __device__ __forceinline__ void operator()(const f32x4 (&acc)[2][2][4][2], const Unit& u, int wr, int wc, int fr, int fq) const {
        const int row0 = u.pm * BM + wr * 64 + fr; const int cl = u.pn * BM + 64 * wc;
        if (cl >= 5120) {
            const int zc0 = cl - 5120 + 8 * fq, hB = (cl - 5120) >> 8;
            const f32x4 ga0 = *(const f32x4*)(gla_g + (zc0 & 255)), ga1 = *(const f32x4*)(gla_g + (zc0 & 255) + 4), gb0 = *(const f32x4*)(gla_g + ((zc0 + 32) & 255)), gb1 = *(const f32x4*)(gla_g + ((zc0 + 32) & 255) + 4);
#pragma unroll
            for (int ai = 0; ai < 2; ++ai)
#pragma unroll
                for (int m = 0; m < 4; ++m) { const int row = row0 + ai * HALF + m * 16;
                    const f32x4* sp = (const f32x4*)(SS + (size_t)row * 64 + hB * 16); const f32x4 s0 = sp[0], s1 = sp[1], s2 = sp[2], s3 = sp[3];
                    const float ss = ((s0[0] + s0[1]) + (s0[2] + s0[3])) + ((s1[0] + s1[1]) + (s1[2] + s1[3])) + ((s2[0] + s2[1]) + (s2[2] + s2[3])) + ((s3[0] + s3[1]) + (s3[2] + s3[3]));
                    const float rstd = rsqrtf(ss * (1.0f / 256.0f) + eps);
#pragma unroll
                    for (int bj = 0; bj < 2; ++bj) { const size_t off = (size_t)row * 1024 + zc0 + 32 * bj; const u32x4 o8 = *(const u32x4*)(OI + off);
                        const f32x4 z0 = acc[ai][bj][m][0], z1 = acc[ai][bj][m][1]; const f32x4 g0 = bj ? gb0 : ga0, g1 = bj ? gb1 : ga1;
                        u32x4 w;
                        w.x = cvt_pk_bf16(__uint_as_float(o8.x << 16) * rstd * g0[0] * (z0[0] * sigmoidf_(z0[0])), __uint_as_float(o8.x & 0xffff0000u) * rstd * g0[1] * (z0[1] * sigmoidf_(z0[1])));
                        w.y = cvt_pk_bf16(__uint_as_float(o8.y << 16) * rstd * g0[2] * (z0[2] * sigmoidf_(z0[2])), __uint_as_float(o8.y & 0xffff0000u) * rstd * g0[3] * (z0[3] * sigmoidf_(z0[3])));
                        w.z = cvt_pk_bf16(__uint_as_float(o8.z << 16) * rstd * g1[0] * (z1[0] * sigmoidf_(z1[0])), __uint_as_float(o8.z & 0xffff0000u) * rstd * g1[1] * (z1[1] * sigmoidf_(z1[1])));
                        w.w = cvt_pk_bf16(__uint_as_float(o8.w << 16) * rstd * g1[2] * (z1[2] * sigmoidf_(z1[2])), __uint_as_float(o8.w & 0xffff0000u) * rstd * g1[3] * (z1[3] * sigmoidf_(z1[3])));
                        *(u32x4*)(AB + off) = w; } }
            return;
        }
        if (cl >= 4608) {
#pragma unroll
            for (int ai = 0; ai < 2; ++ai)
#pragma unroll
                for (int m = 0; m < 4; ++m) { const int row = row0 + ai * HALF + m * 16;
#pragma unroll
                    for (int bj = 0; bj < 2; ++bj) { const f32x4 v0 = acc[ai][bj][m][0], v1 = acc[ai][bj][m][1];
                        u32x4 w; w.x = cvt_pk_bf16(v0[0], v0[1]); w.y = cvt_pk_bf16(v0[2], v0[3]); w.z = cvt_pk_bf16(v1[0], v1[1]); w.w = cvt_pk_bf16(v1[2], v1[3]);
                        *(u32x4*)(ZA + (size_t)row * 512 + (cl - 4608) + 32 * bj + 8 * fq) = w; } }
            return;
        }
        const int which = cl / 1536, hc = cl - which * 1536, h = hc >> 6, dsh = 2 * (h >> 3);
        bf16_t* base = QKV + (size_t)which * ((size_t)16384 * 1536) + 8 * fq;
        const bool qk = which < 2;
        const float* gp = which == 0 ? gq : gk; const float sc = which == 0 ? 0.125f * 1.4426950408889634f : 1.0f;
        f32x4 g00 = {1.f, 1.f, 1.f, 1.f}, g01 = g00, g10 = g00, g11 = g00;
        if (qk) { g00 = *(const f32x4*)(gp + 8 * fq); g01 = *(const f32x4*)(gp + 8 * fq + 4); g10 = *(const f32x4*)(gp + 32 + 8 * fq); g11 = *(const f32x4*)(gp + 32 + 8 * fq + 4); }
#pragma unroll
        for (int ai = 0; ai < 2; ++ai)
#pragma unroll
            for (int m = 0; m < 4; ++m) { const int row = row0 + ai * HALF + m * 16; const int b = row >> 12, t = row & 4095;
                const int idx = ((t & ((1 << dsh) - 1)) << (12 - dsh)) + (t >> dsh);
                bf16_t* dst = base + ((size_t)(b * 24 + h) * 4096 + idx) * 64;
                f32x4 a0 = acc[ai][0][m][0], a1 = acc[ai][0][m][1], c0 = acc[ai][1][m][0], c1 = acc[ai][1][m][1];
                if (qk) {
                    float ss = ((a0[0] * a0[0] + a0[1] * a0[1]) + (a0[2] * a0[2] + a0[3] * a0[3])) + ((a1[0] * a1[0] + a1[1] * a1[1]) + (a1[2] * a1[2] + a1[3] * a1[3]))
                             + ((c0[0] * c0[0] + c0[1] * c0[1]) + (c0[2] * c0[2] + c0[3] * c0[3])) + ((c1[0] * c1[0] + c1[1] * c1[1]) + (c1[2] * c1[2] + c1[3] * c1[3]));
                    ss += __shfl_xor(ss, 16); ss += __shfl_xor(ss, 32);
                    const float rstd = rsqrtf(ss * (1.0f / 64.0f) + eps);
                    a0 = a0 * rstd * g00; a1 = a1 * rstd * g01; c0 = c0 * rstd * g10; c1 = c1 * rstd * g11;
                    f32x4 p0, p1;
                    p0[0] = __shfl_xor(a0[0], 16); p0[1] = __shfl_xor(a0[1], 16); p0[2] = __shfl_xor(a0[2], 16); p0[3] = __shfl_xor(a0[3], 16);
                    p1[0] = __shfl_xor(a1[0], 16); p1[1] = __shfl_xor(a1[1], 16); p1[2] = __shfl_xor(a1[2], 16); p1[3] = __shfl_xor(a1[3], 16);
                    if (fq < 2) { const float* rp = rot + (size_t)row * 16; const f32x4 cs0 = *(const f32x4*)(rp), cs1 = *(const f32x4*)(rp + 4), sn0 = *(const f32x4*)(rp + 8), sn1 = *(const f32x4*)(rp + 12);
                        const float sg = fq == 0 ? -1.f : 1.f; a0 = a0 * cs0 + (p0 * sn0) * sg; a1 = a1 * cs1 + (p1 * sn1) * sg; }
                    a0 = a0 * sc; a1 = a1 * sc; c0 = c0 * sc; c1 = c1 * sc;
                }
                u32x4 w0, w1; w0.x = cvt_pk_bf16(a0[0], a0[1]); w0.y = cvt_pk_bf16(a0[2], a0[3]); w0.z = cvt_pk_bf16(a1[0], a1[1]); w0.w = cvt_pk_bf16(a1[2], a1[3]);
                w1.x = cvt_pk_bf16(c0[0], c0[1]); w1.y = cvt_pk_bf16(c0[2], c0[3]); w1.z = cvt_pk_bf16(c1[0], c1[1]); w1.w = cvt_pk_bf16(c1[2], c1[3]);
                *(u32x4*)dst = w0; *(u32x4*)(dst + 32) = w1; }
    }
};

template <class Epi, class Sched, bool ALIGN_EPI = false, bool SP2 = false>
__device__ __forceinline__ void gemm_phase(PG8_LAS unsigned char* lds, const Gemm g, const Sched& S, const Epi& E) {
    const int tid = threadIdx.x, wid = __builtin_amdgcn_readfirstlane(tid >> 6), lane = tid & 63, wr = wid >> 2, wc = wid & 3, fr = lane & 15, fq = lane >> 4;
    const int lda = g.lda, ldb = g.ldb;
    unsigned voffA[2], voffB[2];
#pragma unroll
    for (int i = 0; i < 2; ++i) { int R, C; stage_rc(tid * 16 + i * 8192, R, C); const int Rb = Epi::PERM ? ((R & ~31) + perm32(R & 31)) : R;
        voffA[i] = (unsigned)(R * lda + C) * 2u; voffB[i] = (unsigned)(Rb * ldb + C) * 2u; }
    const size_t kstep = (size_t)(BK * 2);
    const size_t hstepA = (size_t)HALF * lda * 2, hstepB = (size_t)HALF * ldb * 2;
    const size_t tstepA = 2 * hstepA, tstepB = 2 * hstepB;
    const unsigned ldsw = (unsigned)wid * 1024u;
    const int aoff = lds_byte(wr * 64 + fr, fq * 8), boff = lds_byte(wc * 32 + fr, fq * 8);
#define PG8_SA(b, h) (((b) * 2 + (h)) * HTB)
#define PG8_SB(b, h) ((4 + (b) * 2 + (h)) * HTB)
#define PG8_STAGE(bufoff, gbase, voff) do { _Pragma("unroll") for (int _i = 0; _i < 2; ++_i) \
        __builtin_amdgcn_global_load_lds((const unsigned*)((const char*)(gbase) + (voff)[_i]), (PG8_LAS unsigned*)(lds + (bufoff) + ldsw + _i * 8192), 16, 0, 0); } while (0)
#define PG8_LDA(dst, b, h) do { _Pragma("unroll") for (int m = 0; m < 4; ++m) _Pragma("unroll") for (int k = 0; k < 2; ++k) dst[m][k] = *(const PG8_LAS bf16x8*)(lds + PG8_SA(b, h) + aoff + m * 2048 + k * 1024); } while (0)
#define PG8_LDB(dst, b, h) do { _Pragma("unroll") for (int n = 0; n < 2; ++n) _Pragma("unroll") for (int k = 0; k < 2; ++k) dst[n][k] = *(const PG8_LAS bf16x8*)(lds + PG8_SB(b, h) + boff + n * 2048 + k * 1024); } while (0)
#define PG8_MMA(ai, bj, At, Bt) do { __builtin_amdgcn_s_setprio(1); _Pragma("unroll") for (int m = 0; m < 4; ++m) _Pragma("unroll") for (int n = 0; n < 2; ++n) _Pragma("unroll") for (int k = 0; k < 2; ++k) \
        acc[ai][bj][m][n] = __builtin_amdgcn_mfma_f32_16x16x32_bf16(Bt[n][k], At[m][k], acc[ai][bj][m][n], 0, 0, 0); __builtin_amdgcn_s_setprio(0); } while (0)
#define PG8_WAIT_V(n) asm volatile("s_waitcnt vmcnt(" #n ")" ::: "memory")
#define PG8_WAIT_L(n) asm volatile("s_waitcnt lgkmcnt(" #n ")" ::: "memory")
#define PG8_BAR __builtin_amdgcn_s_barrier()
#define PG8_SCHED __builtin_amdgcn_sched_barrier(0)
    Unit cur, nxt; int ui = 0;
    if (!S.next(0, cur)) return;
    f32x4 acc[2][2][4][2];
#pragma unroll
    for (int a = 0; a < 2; ++a)
#pragma unroll
        for (int b = 0; b < 2; ++b)
#pragma unroll
            for (int m = 0; m < 4; ++m)
#pragma unroll
                for (int n = 0; n < 2; ++n) acc[a][b][m][n] = (f32x4){0.f, 0.f, 0.f, 0.f};
    bf16x8 At[4][2], B0[2][2], B1[2][2];
    const char* cA = (const char*)g.selA(cur.seg) + (size_t)cur.pm * tstepA; const char* cB = (const char*)g.selB(cur.seg) + (size_t)cur.pn * tstepB;
    S.a_ready(cur);
    if constexpr (SP2) {
        PG8_STAGE(PG8_SB(0, 0), cB, voffB); PG8_STAGE(PG8_SB(0, 1), cB + hstepB, voffB); PG8_STAGE(PG8_SA(0, 0), cA, voffA); PG8_STAGE(PG8_SA(0, 1), cA + hstepA, voffA);
        if (wr == 1) PG8_BAR;
        PG8_WAIT_V(2); PG8_BAR;
        PG8_STAGE(PG8_SB(1, 0), cB + kstep, voffB); PG8_STAGE(PG8_SA(1, 0), cA + kstep, voffA); PG8_STAGE(PG8_SB(1, 1), cB + hstepB + kstep, voffB);
        PG8_WAIT_V(6); PG8_BAR;
    } else {
        PG8_STAGE(PG8_SB(0, 0), cB, voffB); PG8_STAGE(PG8_SA(0, 0), cA, voffA); PG8_STAGE(PG8_SB(0, 1), cB + hstepB, voffB); PG8_STAGE(PG8_SA(0, 1), cA + hstepA, voffA);
        if (wr == 1) PG8_BAR;
        PG8_WAIT_V(4); PG8_BAR;
        PG8_STAGE(PG8_SB(1, 0), cB + kstep, voffB); PG8_STAGE(PG8_SA(1, 0), cA + kstep, voffA); PG8_STAGE(PG8_SB(1, 1), cB + hstepB + kstep, voffB);
        PG8_WAIT_V(6); PG8_BAR;
    }
    for (;;) {
        const bool has_next = S.next(ui + 1, nxt);
        const char* nA = has_next ? (const char*)g.selA(nxt.seg) + (size_t)nxt.pm * tstepA : cA; const char* nB = has_next ? (const char*)g.selB(nxt.seg) + (size_t)nxt.pn * tstepB : cB;
        const int nt = g.selNt(cur.seg);
        for (int t = 0; t < nt; t += 2) {
            const bool last = (t == nt - 2);
            const char* a1 = cA + (size_t)(t + 1) * kstep;
            const char* a2 = last ? nA : cA + (size_t)(t + 2) * kstep; const char* b2 = last ? nB : cB + (size_t)(t + 2) * kstep;
            const char* a3 = a2 + kstep; const char* b3 = b2 + kstep;
            if (last && has_next) S.a_ready(nxt);
            if constexpr (SP2) {
            PG8_LDB(B0, 0, 0); PG8_LDB(B1, 0, 1); PG8_SCHED; PG8_LDA(At, 0, 0); PG8_STAGE(PG8_SA(1, 1), a1 + hstepA, voffA);
            PG8_WAIT_V(8); PG8_WAIT_L(0); PG8_BAR; PG8_MMA(0, 0, At, B0); PG8_MMA(0, 1, At, B1); PG8_BAR; PG8_SCHED;
            PG8_LDA(At, 0, 1); PG8_STAGE(PG8_SB(0, 0), b2, voffB); PG8_STAGE(PG8_SB(0, 1), b2 + hstepB, voffB); PG8_STAGE(PG8_SA(0, 0), a2, voffA);
            PG8_WAIT_V(8); PG8_WAIT_L(0); PG8_BAR; PG8_MMA(1, 0, At, B0); PG8_MMA(1, 1, At, B1); PG8_BAR; PG8_SCHED;
            PG8_LDB(B0, 1, 0); PG8_LDB(B1, 1, 1); PG8_SCHED; PG8_LDA(At, 1, 0); PG8_STAGE(PG8_SA(0, 1), a2 + hstepA, voffA);
            PG8_WAIT_V(8); PG8_WAIT_L(0); PG8_BAR; PG8_MMA(0, 0, At, B0); PG8_MMA(0, 1, At, B1); PG8_BAR; PG8_SCHED;
            PG8_LDA(At, 1, 1); PG8_STAGE(PG8_SB(1, 0), b3, voffB); PG8_STAGE(PG8_SB(1, 1), b3 + hstepB, voffB); PG8_STAGE(PG8_SA(1, 0), a3, voffA);
            PG8_WAIT_V(8); PG8_WAIT_L(0); PG8_BAR; PG8_MMA(1, 0, At, B0); PG8_MMA(1, 1, At, B1); PG8_BAR; PG8_SCHED;
            } else {
            PG8_LDB(B0, 0, 0); PG8_SCHED; PG8_LDA(At, 0, 0); PG8_STAGE(PG8_SA(1, 1), a1 + hstepA, voffA);
            PG8_WAIT_L(8); PG8_BAR; PG8_WAIT_L(0); PG8_MMA(0, 0, At, B0); PG8_BAR; PG8_SCHED;
            PG8_LDB(B1, 0, 1); PG8_STAGE(PG8_SB(0, 0), b2, voffB);
            PG8_BAR; PG8_WAIT_L(0); PG8_MMA(0, 1, At, B1); PG8_BAR;
            PG8_LDA(At, 0, 1); PG8_STAGE(PG8_SA(0, 0), a2, voffA);
            PG8_BAR; PG8_WAIT_L(0); PG8_MMA(1, 0, At, B0); PG8_BAR; PG8_SCHED;
            PG8_STAGE(PG8_SB(0, 1), b2 + hstepB, voffB);
            PG8_WAIT_V(6); PG8_BAR; PG8_MMA(1, 1, At, B1); PG8_BAR;
            PG8_LDB(B0, 1, 0); PG8_SCHED; PG8_LDA(At, 1, 0); PG8_STAGE(PG8_SA(0, 1), a2 + hstepA, voffA);
            PG8_WAIT_L(8); PG8_BAR; PG8_WAIT_L(0); PG8_MMA(0, 0, At, B0); PG8_BAR; PG8_SCHED;
            PG8_LDB(B1, 1, 1); PG8_STAGE(PG8_SB(1, 0), b3, voffB);
            PG8_BAR; PG8_WAIT_L(0); PG8_MMA(0, 1, At, B1); PG8_BAR;
            PG8_LDA(At, 1, 1); PG8_STAGE(PG8_SA(1, 0), a3, voffA);
            PG8_BAR; PG8_WAIT_L(0); PG8_MMA(1, 0, At, B0); PG8_BAR; PG8_SCHED;
            PG8_STAGE(PG8_SB(1, 1), b3 + hstepB, voffB);
            PG8_WAIT_V(6); PG8_BAR; PG8_MMA(1, 1, At, B1); PG8_BAR;
            }
        }
        if constexpr (ALIGN_EPI) { if (wr == 0) PG8_BAR; }
        if constexpr (!Epi::AFTER_DRAIN) { E(acc, cur, wr, wc, fr, fq); S.done(cur); }
        if (!has_next) break;
#pragma unroll
        for (int a = 0; a < 2; ++a)
#pragma unroll
            for (int b = 0; b < 2; ++b)
#pragma unroll
                for (int m = 0; m < 4; ++m)
#pragma unroll
                    for (int n = 0; n < 2; ++n) acc[a][b][m][n] = (f32x4){0.f, 0.f, 0.f, 0.f};
        cur = nxt; cA = nA; cB = nB; ++ui;
        if constexpr (ALIGN_EPI) { if (wr == 1) PG8_BAR; }
    }
    PG8_WAIT_V(0);
    if constexpr (!ALIGN_EPI) { if (wr == 0) PG8_BAR; }
    PG8_BAR;
    if constexpr (Epi::AFTER_DRAIN) { E.fused(acc, cur, wr, wc, fr, fq, lds, wid, lane); S.done(cur); }
#undef PG8_SA
#undef PG8_SB
#undef PG8_STAGE
#undef PG8_LDA
#undef PG8_LDB
#undef PG8_MMA
#undef PG8_WAIT_V
#undef PG8_WAIT_L
#undef PG8_BAR
#undef PG8_SCHED
}
}

constexpr int NWAVES = 8;
constexpr int T = 16384, D = 1024, SEQ = 4096, INC = 10256;
constexpr int PA = 5120;
constexpr int PG = 2048;
constexpr float EPS = 1e-6f;
constexpr size_t MiB = 1u << 20;
constexpr size_t WS_W1A = 0, WS_W1G = 12 * MiB, WS_WGT = 16 * MiB, WS_WPA = 20 * MiB, WS_WPB = 21 * MiB, WS_WOUT = 23 * MiB, WS_WPG = 25 * MiB, WS_WPLE = 27 * MiB, WS_WGLR = 27 * MiB + 512 * 1024;
constexpr size_t WS_ROT = 28 * MiB, WS_GLR = 29 * MiB, WS_GAMMA = 30 * MiB, WS_ML = 29 * MiB  , WS_PS = 29 * MiB  ;
constexpr size_t WS_PROJG = 32 * MiB, WS_QP = 96 * MiB, WS_L = 112 * MiB, WS_OI = 192 * MiB, WS_SS = 224 * MiB;
constexpr size_t WS_PROJA = 32 * MiB, WS_ZA = 176 * MiB  , WS_OG = 192 * MiB, WS_AA = 240 * MiB;
constexpr size_t WS_TMP1 = 32 * MiB, WS_TMP2 = 96 * MiB, WS_SGA = 32 * MiB, WS_SGB = 64 * MiB, WS_T1 = 96 * MiB, WS_Y = 160 * MiB, WS_PB = 200 * MiB, WS_X1B = 208 * MiB, WS_END = 256 * MiB;
constexpr int LDS_BYTES = 147456, MISC_OFF = 131072 + 320;
constexpr size_t WS_BAR = 27 * MiB + 512 * 1024 + 65536, WS_PCNT = WS_BAR + 16384, BAR_BYTES = 16384 + 2 * 16384;

#define LAS __attribute__((address_space(3)))
typedef unsigned short bf16;
typedef unsigned v4u __attribute__((ext_vector_type(4)));
typedef unsigned v2u __attribute__((ext_vector_type(2)));
typedef float f32x4 __attribute__((ext_vector_type(4)));
typedef short bf16x8 __attribute__((ext_vector_type(8)));
typedef short s16x4 __attribute__((ext_vector_type(4)));
__device__ __forceinline__ float bflo(unsigned w) { return __uint_as_float(w << 16); }
__device__ __forceinline__ float bfhi(unsigned w) { return __uint_as_float(w & 0xffff0000u); }
__device__ __forceinline__ float bf2f(unsigned short b) { return __uint_as_float(((unsigned)b) << 16); }
__device__ __forceinline__ unsigned pk2(float lo, float hi) { return pg8::cvt_pk_bf16(lo, hi); }
__device__ __forceinline__ bf16x8 mk8(v2u lo, v2u hi) { v4u t; t.x = lo.x; t.y = lo.y; t.z = hi.x; t.w = hi.y; return __builtin_bit_cast(bf16x8, t); }
__device__ __forceinline__ f32x4 mfma16(bf16x8 a, bf16x8 b, f32x4 c) { return __builtin_amdgcn_mfma_f32_16x16x32_bf16(a, b, c, 0, 0, 0); }
__device__ __forceinline__ float siluf_(float x) { return x * pg8::sigmoidf_(x); }
#define LDS_WAIT() asm volatile("s_waitcnt lgkmcnt(0)" ::: "memory")

struct Args {
    const float* x; const float* p; const int* pos; const float* norm_g; const float* w_in; const float* gq; const float* gk; const float* gate_w2; const float* gate_b;
    const float* gla_g; const float* w_att; const float* w_gla; const float* w_out; const float* ple_g; const float* w_pg; const float* w_ple; float* out; unsigned char* ws; int one; int zero;
};

__device__ __forceinline__ float wave_sum(float v) {
#pragma unroll
    for (int o = 1; o < 64; o <<= 1) v += __shfl_xor(v, o);
    return v;
}
__device__ __forceinline__ void p0_transpose_item(const float* W, int wpitch, int ncols, const float* kscale, bf16* WT, int tpitch, int row_off, LAS float* scr, int item, int lane, bool headperm = false) {
    const int nblk = ncols / 32, kb = item / nblk, nb = item % nblk, k0 = 64 * kb, n0 = 32 * nb;
    const int d0 = headperm ? ((nb & ~7) + (nb & 1) * 4 + ((nb & 7) >> 1)) * 32 : n0;
#pragma unroll 8
    for (int i = 0; i < 32; ++i) { const int kk = 2 * i + (lane >> 5); float v = W[(size_t)(k0 + kk) * wpitch + n0 + (lane & 31)]; if (kscale) v *= kscale[k0 + kk]; scr[kk * 33 + (lane & 31)] = v; }
    LDS_WAIT(); asm volatile("" ::: "memory");
    const int c = lane & 7;
#pragma unroll
    for (int j = 0; j < 4; ++j) { const int n = (lane >> 3) + 8 * j; const LAS float* s = scr + (8 * c) * 33 + n;
        v4u o; o.x = pk2(s[0 * 33], s[1 * 33]); o.y = pk2(s[2 * 33], s[3 * 33]); o.z = pk2(s[4 * 33], s[5 * 33]); o.w = pk2(s[6 * 33], s[7 * 33]);
        *(v4u*)(WT + (size_t)(row_off + d0 + n) * tpitch + k0 + 8 * c) = o; }
    LDS_WAIT(); asm volatile("" ::: "memory");
}

__device__ __forceinline__ void phase0(const Args& a, LAS unsigned char* lds, int tid, int lane, int wave, int G) {
    unsigned char* ws = a.ws;
    LAS float* scr = (LAS float*)(lds + wave * 16384);
    const int gw = blockIdx.x * NWAVES + wave, NGW = G * NWAVES;
    constexpr int I0 = 16 * 160, I1 = 16 * 64, I2 = 16 * 32, I3 = 16 * 64, I4 = 8 * 32, I5 = 16 * 32, I6 = 16 * 32, I7 = 16 * 32, I8 = 4 * 32;
    constexpr int NITEMS = I0 + I1 + I2 + I3 + I4 + I5 + I6 + I7 + I8;
    for (int it = gw; it < NITEMS; it += NGW) {
        int r = it;
        if (r < I0) { p0_transpose_item(a.w_in, INC, 5120, nullptr, (bf16*)(ws + WS_W1A), 1024, 0, scr, r, lane, true); continue; } r -= I0;
        if (r < I1) { p0_transpose_item(a.w_in + 5120, INC, 2048, nullptr, (bf16*)(ws + WS_W1G), 1024, 0, scr, r, lane); continue; } r -= I1;
        if (r < I2) { p0_transpose_item(a.w_in + 7184, INC, 1024, nullptr, (bf16*)(ws + WS_W1A), 1024, 5120, scr, r, lane, true); continue; } r -= I2;
        if (r < I3) { p0_transpose_item(a.w_in + 8208, INC, 2048, nullptr, (bf16*)(ws + WS_WGT), 1024, 0, scr, r, lane); continue; } r -= I3;
        if (r < I4) { p0_transpose_item(a.w_att, 1024, 1024, nullptr, (bf16*)(ws + WS_WPA), 512, 0, scr, r, lane); continue; } r -= I4;
        if (r < I5) { p0_transpose_item(a.w_gla, 1024, 1024, nullptr, (bf16*)(ws + WS_WPB), 1024, 0, scr, r, lane); continue; } r -= I5;
        if (r < I6) { p0_transpose_item(a.w_out, 1024, 1024, nullptr, (bf16*)(ws + WS_WOUT), 1024, 0, scr, r, lane); continue; } r -= I6;
        if (r < I7) { p0_transpose_item(a.w_pg, 1024, 1024, a.ple_g, (bf16*)(ws + WS_WPG), 1024, 0, scr, r, lane); continue; } r -= I7;
        p0_transpose_item(a.w_ple, 1024, 1024, nullptr, (bf16*)(ws + WS_WPLE), 256, 0, scr, r, lane);
    }
    const int gtid = blockIdx.x * 512 + tid, NT = G * 512;
    for (int i = gtid; i < 16 * 1024; i += NT) { const int k = i >> 4, r = i & 15; ((bf16*)(ws + WS_WGLR))[r * 1024 + k] = (bf16)(pk2(a.w_in[(size_t)k * INC + 7168 + r], 0.f) & 0xffffu); }
    for (int i = gtid; i < T * 8; i += NT) { const int t = i >> 3, j = i & 7;
        const float inv = exp2f(-(float)j * 0.125f * 18.931568569324174f);
        const float ang = (float)a.pos[t] * inv;
        const double ad = (double)ang; const double kq = __builtin_rint(ad * 0.15915494309189535); const float rf = (float)(ad - kq * 6.283185307179586);
        float* rt = (float*)(ws + WS_ROT) + (size_t)t * 16; rt[j] = __cosf(rf); rt[8 + j] = __sinf(rf); }
    bf16* hb = (bf16*)a.out;
    for (int m = gw; m < T; m += NGW) {
        const f32x4* xr = (const f32x4*)(a.x + (size_t)m * D) + lane; const f32x4* gr = (const f32x4*)a.norm_g + lane;
        f32x4 v[4]; float s = 0.f;
#pragma unroll
        for (int j = 0; j < 4; ++j) { v[j] = xr[64 * j]; s += (v[j][0] * v[j][0] + v[j][1] * v[j][1]) + (v[j][2] * v[j][2] + v[j][3] * v[j][3]); }
        const float rstd = rsqrtf(wave_sum(s) * (1.f / D) + EPS);
        v2u* o8 = (v2u*)(hb + (size_t)m * D) + lane;
#pragma unroll
        for (int j = 0; j < 4; ++j) { const f32x4 g = gr[64 * j]; v2u w; w.x = pk2(v[j][0] * rstd * g[0], v[j][1] * rstd * g[1]); w.y = pk2(v[j][2] * rstd * g[2], v[j][3] * rstd * g[3]); o8[64 * j] = w; }
    }
}

__device__ __forceinline__ void glr_step(const Args& a, int lane, int wave, int G) {
    const bf16* hb = (const bf16*)a.out; const bf16* wg = (const bf16*)(a.ws + WS_WGLR); float* glr = (float*)(a.ws + WS_GLR);
    const int l15 = lane & 15, quad = lane >> 4;
    for (int rt = blockIdx.x * NWAVES + wave; rt < T / 16; rt += G * NWAVES) {
        f32x4 acc = {0.f, 0.f, 0.f, 0.f};
        const bf16* ap = hb + (size_t)(rt * 16 + l15) * 1024 + 8 * quad; const bf16* bp = wg + (size_t)l15 * 1024 + 8 * quad;
#pragma unroll 8
        for (int i = 0; i < 32; ++i) acc = mfma16(*(const bf16x8*)(ap + 32 * i), *(const bf16x8*)(bp + 32 * i), acc);
#pragma unroll
        for (int j = 0; j < 4; ++j) glr[(size_t)(rt * 16 + 4 * quad + j) * 16 + l15] = acc[j];
    }
}

constexpr int GL_GLR = 0, GL_CUMX = 4096, GL_QS = 6144, GL_KS = GL_QS + 64 * 272, GL_KT = GL_KS + 64 * 272, GL_VS = GL_KT + 128 * 144, GL_AT = GL_VS + 64 * 528, GL_END = GL_AT + 64 * 144;
static_assert(GL_END <= 131072, "gla lds");
__device__ __forceinline__ void gla_local_phase(const Args& a, LAS unsigned char* lds, int tid, int lane, int wave, int G) {
    asm volatile("" : "+v"(tid), "+v"(lane));
    unsigned char* ws = a.ws;
    const bf16* PROJ = (const bf16*)(ws + WS_PROJG); const float* glr = (const float*)(ws + WS_GLR);
    bf16* Qp = (bf16*)(ws + WS_QP); bf16* OI = (bf16*)(ws + WS_OI); bf16* Lg = (bf16*)(ws + WS_L); float* gamma = (float*)(ws + WS_GAMMA);
    const int d = tid & 127, tg = tid >> 7, l15 = lane & 15, quad = lane >> 4;
    for (int unit = blockIdx.x; unit < 1024; unit += G) {
        const int b = unit >> 8, h = (unit >> 6) & 3, c = unit & 63; const int row0 = b * SEQ + c * 64;
        const bf16* P = PROJ + (size_t)row0 * PG;
#pragma unroll
        for (int i = 0; i < 2; ++i) { const int p = tid + 512 * i, tok = p >> 4, part = p & 15;
            *(LAS v4u*)(lds + GL_QS + tok * 272 + part * 16) = *(const v4u*)(P + (size_t)tok * PG + h * 128 + part * 8);
            *(LAS v4u*)(lds + GL_KS + tok * 272 + part * 16) = *(const v4u*)(P + (size_t)tok * PG + 512 + h * 128 + part * 8); }
        if (tid < 256) ((LAS f32x4*)(lds + GL_GLR))[tid] = ((const f32x4*)(glr + (size_t)row0 * 16))[tid];
#pragma unroll
        for (int i = 0; i < 4; ++i) { const int p = tid + 512 * i, tok = p >> 5, part = p & 31;
            *(LAS v4u*)(lds + GL_VS + tok * 528 + part * 16) = *(const v4u*)(P + (size_t)tok * PG + 1024 + h * 256 + part * 8); }
        float w2r[16];
#pragma unroll
        for (int r = 0; r < 16; ++r) w2r[r] = a.gate_w2[r * 512 + h * 128 + d];
        const float bias = a.gate_b[h * 128 + d];
        __syncthreads();
        float cum[16]; float run = 0.f;
#pragma unroll
        for (int i = 0; i < 16; ++i) { const int t = tg * 16 + i; const LAS f32x4* gp = (const LAS f32x4*)(lds + GL_GLR + t * 64);
            const f32x4 g0 = gp[0], g1 = gp[1], g2 = gp[2], g3 = gp[3];
            float lo = bias;
            lo += g0[0] * w2r[0] + g0[1] * w2r[1] + g0[2] * w2r[2] + g0[3] * w2r[3];
            lo += g1[0] * w2r[4] + g1[1] * w2r[5] + g1[2] * w2r[6] + g1[3] * w2r[7];
            lo += g2[0] * w2r[8] + g2[1] * w2r[9] + g2[2] * w2r[10] + g2[3] * w2r[11];
            lo += g3[0] * w2r[12] + g3[1] * w2r[13] + g3[2] * w2r[14] + g3[3] * w2r[15];
            const float ls = fminf(lo, 0.f) - __logf(1.0f + __expf(-fabsf(lo)));
            run += ls * (1.0f / 16.0f); cum[i] = run; }
        ((LAS float*)(lds + GL_CUMX))[tg * 128 + d] = run;
        __syncthreads();
        float prefix = 0.f, last = 0.f;
#pragma unroll
        for (int g = 0; g < 4; ++g) { const float v = ((LAS float*)(lds + GL_CUMX))[g * 128 + d]; last += v; if (g < tg) prefix += v; }
        unsigned ktp[8];
#pragma unroll
        for (int i = 0; i < 16; ++i) { const int t = tg * 16 + i; const float cm = cum[i] + prefix; const float q = bf2f(*(const LAS unsigned short*)(lds + GL_QS + t * 272 + d * 2)), k = bf2f(*(const LAS unsigned short*)(lds + GL_KS + t * 272 + d * 2));
            const float qp = q * __expf(cm) * 0.08838834764831845f, kp = k * __expf(-cm), kpp = k * __expf(last - cm);
            const unsigned qb = pk2(qp, 0.f) & 0xffffu;
            *(LAS unsigned short*)(lds + GL_QS + t * 272 + d * 2) = (unsigned short)qb;
            *(LAS unsigned short*)(lds + GL_KS + t * 272 + d * 2) = (unsigned short)(pk2(kp, 0.f) & 0xffffu);
            const unsigned kb = pk2(kpp, 0.f) & 0xffffu;
            if (i & 1) ktp[i >> 1] |= kb << 16; else ktp[i >> 1] = kb; }
        { v4u w0, w1; w0.x = ktp[0]; w0.y = ktp[1]; w0.z = ktp[2]; w0.w = ktp[3]; w1.x = ktp[4]; w1.y = ktp[5]; w1.z = ktp[6]; w1.w = ktp[7];
          *(LAS v4u*)(lds + GL_KT + d * 144 + tg * 32) = w0; *(LAS v4u*)(lds + GL_KT + d * 144 + tg * 32 + 16) = w1; }
        if (tg == 0) gamma[(size_t)unit * 128 + d] = __expf(last);
        __syncthreads();
#pragma unroll
        for (int i = 0; i < 2; ++i) { const int p = tid + 512 * i, tok = p >> 4, part = p & 15;
            *(v4u*)(Qp + (size_t)(row0 + tok) * 512 + h * 128 + part * 8) = *(const LAS v4u*)(lds + GL_QS + tok * 272 + part * 16); }
        { const int it = wave >> 1;
#pragma unroll
          for (int jj = 0; jj < 2; ++jj) { const int jt = (wave & 1) * 2 + jj; f32x4 acc = {0.f, 0.f, 0.f, 0.f};
#pragma unroll
            for (int ks = 0; ks < 4; ++ks) { const bf16x8 ka = *(const LAS bf16x8*)(lds + GL_KS + (16 * jt + l15) * 272 + (32 * ks + 8 * quad) * 2);
                const bf16x8 qb = *(const LAS bf16x8*)(lds + GL_QS + (16 * it + l15) * 272 + (32 * ks + 8 * quad) * 2); acc = mfma16(ka, qb, acc); }
            const int i = 16 * it + l15, j0 = 16 * jt + 4 * quad;
            v2u w; w.x = pk2(j0 + 0 <= i ? acc[0] : 0.f, j0 + 1 <= i ? acc[1] : 0.f); w.y = pk2(j0 + 2 <= i ? acc[2] : 0.f, j0 + 3 <= i ? acc[3] : 0.f);
            *(LAS v2u*)(lds + GL_AT + i * 144 + j0 * 2) = w; } }
        __syncthreads();
#pragma unroll 1
        for (int dd = 0; dd < 2; ++dd) { const int dvt = 2 * wave + dd;
            bf16x8 VF[2];
#pragma unroll
            for (int ks = 0; ks < 2; ++ks) { unsigned short e[8];
#pragma unroll
                for (int q = 0; q < 8; ++q) e[q] = *(const LAS unsigned short*)(lds + GL_VS + (32 * ks + 8 * quad + q) * 528 + (16 * dvt + l15) * 2);
                v4u t; t.x = e[0] | ((unsigned)e[1] << 16); t.y = e[2] | ((unsigned)e[3] << 16); t.z = e[4] | ((unsigned)e[5] << 16); t.w = e[6] | ((unsigned)e[7] << 16);
                VF[ks] = __builtin_bit_cast(bf16x8, t); }
#pragma unroll
            for (int it = 0; it < 4; ++it) { f32x4 acc = {0.f, 0.f, 0.f, 0.f};
#pragma unroll
                for (int ks = 0; ks < 2; ++ks) acc = mfma16(VF[ks], *(const LAS bf16x8*)(lds + GL_AT + (16 * it + l15) * 144 + (32 * ks + 8 * quad) * 2), acc);
                v2u w; w.x = pk2(acc[0], acc[1]); w.y = pk2(acc[2], acc[3]);
                *(v2u*)(OI + (size_t)(row0 + 16 * it + l15) * 1024 + h * 256 + 16 * dvt + 4 * quad) = w; }
#pragma unroll
            for (int R = 0; R < 8; ++R) { f32x4 acc = {0.f, 0.f, 0.f, 0.f};
#pragma unroll
                for (int ks = 0; ks < 2; ++ks) acc = mfma16(*(const LAS bf16x8*)(lds + GL_KT + (16 * R + l15) * 144 + (32 * ks + 8 * quad) * 2), VF[ks], acc);
                v2u w; w.x = pk2(acc[0], acc[1]); w.y = pk2(acc[2], acc[3]);
                *(v2u*)(Lg + ((size_t)(unit * 16 + dvt) * 8 + R) * 256 + lane * 4) = w; }
        }
        __syncthreads();
    }
}

constexpr int CH_L = 0, CH_Q = 4096, CH_G = 20480, CH_O = 20992, CH_STAGE = 23040;
struct ChReg { v4u l, q0, q1, q2, q3, x; };
__device__ __forceinline__ void ch_load(ChReg& r, const bf16* Lg, const float* gamma, const bf16* Qp, const bf16* OI, int unit, int dvt, int row0, int h, int lt) {
    r.l = *(const v4u*)(Lg + ((size_t)(unit * 16 + dvt) * 8) * 256 + lt * 8);
    const int rr = lt >> 4, j = (lt & 15) ^ rr;
    const bf16* qb = Qp + (size_t)(row0 + rr) * 512 + h * 128 + j * 8;
    r.q0 = *(const v4u*)(qb); r.q1 = *(const v4u*)(qb + 16 * 512); r.q2 = *(const v4u*)(qb + 32 * 512); r.q3 = *(const v4u*)(qb + 48 * 512);
    if (lt < 32) r.x = *(const v4u*)(gamma + (size_t)unit * 128 + lt * 4);
    else if (lt >= 128) { const int go = lt - 128; r.x = *(const v4u*)(OI + (size_t)(row0 + (go >> 1)) * 1024 + h * 256 + 16 * dvt + (go & 1) * 8); }
}
__device__ __forceinline__ void ch_store(const ChReg& r, LAS unsigned char* st, int lt) {
    *(LAS v4u*)(st + CH_L + lt * 16) = r.l;
    *(LAS v4u*)(st + CH_Q + lt * 16) = r.q0; *(LAS v4u*)(st + CH_Q + (lt + 256) * 16) = r.q1; *(LAS v4u*)(st + CH_Q + (lt + 512) * 16) = r.q2; *(LAS v4u*)(st + CH_Q + (lt + 768) * 16) = r.q3;
    if (lt < 32) *(LAS v4u*)(st + CH_G + lt * 16) = r.x; else if (lt >= 128) *(LAS v4u*)(st + CH_O + (lt - 128) * 16) = r.x;
}
__device__ __forceinline__ void gla_chain_phase(const Args& a, LAS unsigned char* lds, int tid, int lane, int wave, int G, int st_en) {
    asm volatile("" : "+v"(tid), "+v"(lane));
    unsigned char* ws = a.ws;
    const bf16* Qp = (const bf16*)(ws + WS_QP); bf16* OI = (bf16*)(ws + WS_OI); const bf16* Lg = (const bf16*)(ws + WS_L); const float* gamma = (const float*)(ws + WS_GAMMA); float* SS = (float*)(ws + WS_SS);
    const int l15 = lane & 15, quad = lane >> 4, lt = tid - 256, it = wave;
    const int vcu = (G % 8 == 0) ? ((int)blockIdx.x % 8) * (G / 8) + (int)blockIdx.x / 8 : (int)blockIdx.x;
    for (int item = vcu; item < 256; item += G) {
        const int bh = item >> 4, dvt = item & 15, b = bh >> 2, h = bh & 3, unit0 = bh * 64, rowb = b * SEQ;
        if (wave >= 4) {
            ChReg r0, r1, r2, r3, r4, r5, r6, r7;
#define CH_LD(rr, st) ch_load(rr, Lg, gamma, Qp, OI, unit0 + (st), dvt, rowb + (st) * 64, h, lt)
            CH_LD(r0, 0); ch_store(r0, lds, lt);
            CH_LD(r1, 1); CH_LD(r2, 2); CH_LD(r3, 3); CH_LD(r4, 4); CH_LD(r5, 5); CH_LD(r6, 6); CH_LD(r7, 7); CH_LD(r0, 8);
            __syncthreads();
#pragma unroll 1
            for (int cc = 0; cc < 8; ++cc) {
#pragma unroll
                for (int j = 0; j < 8; ++j) {
                    const int c = 8 * cc + j;
                    const int cn = (c + 9 < 64) ? c + 9 : 63;
                    LAS unsigned char* stn = lds + ((c + 1) & 1) * CH_STAGE;
#define CH_ROT(rr) do { ch_store(rr, stn, lt); CH_LD(rr, cn); } while (0)
                    if (j == 0) CH_ROT(r1); else if (j == 1) CH_ROT(r2); else if (j == 2) CH_ROT(r3); else if (j == 3) CH_ROT(r4); else if (j == 4) CH_ROT(r5); else if (j == 5) CH_ROT(r6); else if (j == 6) CH_ROT(r7); else CH_ROT(r0);
#undef CH_ROT
                    __syncthreads();
                }
            }
#undef CH_LD
        } else {
            f32x4 S[8];
#pragma unroll
            for (int R = 0; R < 8; ++R) S[R] = (f32x4){0.f, 0.f, 0.f, 0.f};
            __syncthreads();
#pragma unroll 1
            for (int c = 0; c < 64; ++c) {
                const LAS unsigned char* st = lds + (c & 1) * CH_STAGE;
                const int r = 16 * it + l15; const int row = rowb + c * 64 + r;
                f32x4 acc = {0.f, 0.f, 0.f, 0.f};
#pragma unroll
                for (int ks = 0; ks < 4; ++ks) { const int jq = 4 * ks + (quad >> 1), sub = (quad & 1) * 8;
                    const v2u qlo = *(const LAS v2u*)(st + CH_Q + r * 256 + ((jq ^ l15) << 4) + sub), qhi = *(const LAS v2u*)(st + CH_Q + r * 256 + (((jq + 2) ^ l15) << 4) + sub);
                    v4u sa; sa.x = pk2(S[2 * ks][0], S[2 * ks][1]); sa.y = pk2(S[2 * ks][2], S[2 * ks][3]); sa.z = pk2(S[2 * ks + 1][0], S[2 * ks + 1][1]); sa.w = pk2(S[2 * ks + 1][2], S[2 * ks + 1][3]);
                    acc = mfma16(__builtin_bit_cast(bf16x8, sa), mk8(qlo, qhi), acc); }
                const v2u oi = *(const LAS v2u*)(st + CH_O + r * 32 + quad * 8);
                const float o0 = acc[0] + bflo(oi.x), o1 = acc[1] + bfhi(oi.x), o2 = acc[2] + bflo(oi.y), o3 = acc[3] + bfhi(oi.y);
                v2u w; w.x = pk2(o0, o1); w.y = pk2(o2, o3);
                if (st_en) *(v2u*)(OI + (size_t)row * 1024 + h * 256 + 16 * dvt + 4 * quad) = w;
                float s = (o0 * o0 + o1 * o1) + (o2 * o2 + o3 * o3); s += __shfl_xor(s, 16); s += __shfl_xor(s, 32);
                if (quad == 0 && st_en) SS[(size_t)row * 64 + h * 16 + dvt] = s;
#pragma unroll
                for (int R = 0; R < 8; ++R) { const v2u Lr = *(const LAS v2u*)(st + CH_L + R * 512 + lane * 8); const f32x4 gm = *(const LAS f32x4*)(st + CH_G + (16 * R + 4 * quad) * 4);
                    S[R][0] = gm[0] * S[R][0] + bflo(Lr.x); S[R][1] = gm[1] * S[R][1] + bfhi(Lr.x); S[R][2] = gm[2] * S[R][2] + bflo(Lr.y); S[R][3] = gm[3] * S[R][3] + bfhi(Lr.y); }
                __syncthreads();
            }
        }
    }
}

constexpr int ATS_V = 16384, ATS_SLOT = 32768;
struct AtUnit { int b, h, dsh, r, qt; };
__device__ __forceinline__ AtUnit at_decode(int unit) { AtUnit U; const int u = unit & 31, hb = unit >> 5; U.h = hb % 24; U.b = hb / 24; U.dsh = 2 * (U.h >> 3); const int ntc = 32 >> U.dsh; U.r = u / ntc; U.qt = u - U.r * ntc; return U; }
__device__ __forceinline__ const bf16* at_qbase(const bf16* PROJ, const AtUnit& U) { return PROJ + ((size_t)(U.b * 24 + U.h) * 4096 + ((size_t)U.r << (12 - U.dsh))) * 64; }
__device__ __forceinline__ void at_dma_chunk(const bf16* PROJ, const AtUnit& U, int c, LAS unsigned char* slot, int wave, int lane) {
    constexpr size_t WHICH = (size_t)T * 1536;
    const bf16* Pb = at_qbase(PROJ, U) + (size_t)c * 128 * 64;
    const int rl = lane >> 3, j = (lane & 7) ^ rl;
#pragma unroll
    for (int i = 0; i < 2; ++i) { const int rb = wave + 8 * i; const bf16* src = Pb + (size_t)(rb * 8 + rl) * 64 + j * 8;
        __builtin_amdgcn_global_load_lds((const unsigned*)(src + WHICH), (LAS unsigned*)(slot + rb * 1024), 16, 0, 0);
        __builtin_amdgcn_global_load_lds((const unsigned*)(src + 2 * WHICH), (LAS unsigned*)(slot + ATS_V + rb * 1024), 16, 0, 0); }
}
__device__ __forceinline__ void attn_phase(const Args& a, LAS unsigned char* lds, int tid, int lane, int wave, int G) {
    asm volatile("" : "+v"(tid), "+v"(lane));
    unsigned char* ws = a.ws; const bf16* PROJ = (const bf16*)(ws + WS_PROJA);
    bf16* OG = (bf16*)(ws + WS_OG); float* ML = (float*)(ws + WS_ML);
    const int l15 = lane & 15, quad = lane >> 4, w = wave;
    const int vcu = (G % 8 == 0) ? ((int)blockIdx.x % 8) * (G / 8) + (int)blockIdx.x / 8 : (int)blockIdx.x;
    const int tpb = (3072 + G - 1) / G, t0 = vcu * tpb, t1 = (t0 + tpb < 3072) ? t0 + tpb : 3072;
    bf16x8 QB[2];
    if (t0 < t1) { const AtUnit U = at_decode(t0);
        if (U.qt > 0) at_dma_chunk(PROJ, U, U.qt - 1, lds + ((t0 + 2) % 3) * ATS_SLOT, wave, lane);
        at_dma_chunk(PROJ, U, U.qt, lds + (t0 % 3) * ATS_SLOT, wave, lane);
        const bf16* qp = at_qbase(PROJ, U) + (size_t)(128 * U.qt + 16 * w + l15) * 64 + 8 * quad; QB[0] = *(const bf16x8*)qp; QB[1] = *(const bf16x8*)(qp + 32); }
    v2u pend[4]; float pmx = 0.f, pl = 0.f; size_t prow = 0; int ph = 0; bool have = false;
    for (int unit = t0; unit < t1; ++unit) {
        const AtUnit U = at_decode(unit);
        const int sc = unit % 3, sp = (U.qt > 0) ? (unit + 2) % 3 : sc;
        asm volatile("s_waitcnt vmcnt(0)" ::: "memory");
        __syncthreads();
        if (have) {
#pragma unroll
            for (int dt = 0; dt < 4; ++dt) *(v2u*)(OG + prow * 1536 + ph * 64 + 16 * dt + 4 * quad) = pend[dt];
            if (quad == 0) { v2u mlv; mlv.x = __float_as_uint(pmx); mlv.y = __float_as_uint(pl); *(v2u*)(ML + prow * 48 + ph * 2) = mlv; } }
        const bf16x8 q0 = QB[0], q1 = QB[1];
        if (unit + 1 < t1) { const AtUnit Un = at_decode(unit + 1); at_dma_chunk(PROJ, Un, Un.qt, lds + ((unit + 1) % 3) * ATS_SLOT, wave, lane);
            const bf16* qp = at_qbase(PROJ, Un) + (size_t)(128 * Un.qt + 16 * w + l15) * 64 + 8 * quad; QB[0] = *(const bf16x8*)qp; QB[1] = *(const bf16x8*)(qp + 32); }
        {
            const int qt = U.qt;
            const LAS unsigned char* bp = lds + sp * ATS_SLOT; const LAS unsigned char* bc = lds + sc * ATS_SLOT;
            f32x4 ST[9]; float mx = -INFINITY;
#pragma unroll
            for (int Tt = 0; Tt < 9; ++Tt) { f32x4 acc = {0.f, 0.f, 0.f, 0.f}; const int kr = ((16 * (w + Tt)) & 127) + l15; const LAS unsigned char* kb = (w + Tt >= 8) ? bc : bp;
                acc = mfma16(*(const LAS bf16x8*)(kb + kr * 128 + (((0 + quad) ^ (kr & 7)) << 4)), q0, acc);
                acc = mfma16(*(const LAS bf16x8*)(kb + kr * 128 + (((4 + quad) ^ (kr & 7)) << 4)), q1, acc);
#pragma unroll
                for (int e = 0; e < 4; ++e) { const int kk = 4 * quad + e; bool valid = true; if (Tt == 0) valid = kk >= l15; if (Tt == 8) valid = kk <= l15;
                    if (qt == 0) valid = valid && (w + Tt >= 8);
                    acc[e] = valid ? acc[e] : -INFINITY; mx = fmaxf(mx, acc[e]); }
                ST[Tt] = acc; }
            mx = fmaxf(mx, __shfl_xor(mx, 16)); mx = fmaxf(mx, __shfl_xor(mx, 32));
            float l = 0.f;
#pragma unroll
            for (int Tt = 0; Tt < 9; ++Tt)
#pragma unroll
                for (int e = 0; e < 4; ++e) { const float pv = __builtin_amdgcn_exp2f(ST[Tt][e] - mx); ST[Tt][e] = pv; l += pv; }
            l += __shfl_xor(l, 16); l += __shfl_xor(l, 32);
            f32x4 O[4];
#pragma unroll
            for (int dt = 0; dt < 4; ++dt) O[dt] = (f32x4){0.f, 0.f, 0.f, 0.f};
#pragma unroll
            for (int pr = 0; pr < 5; ++pr) { const int T1 = 2 * pr, T2 = (2 * pr + 1 < 9) ? 2 * pr + 1 : 8;
                v4u pf; pf.x = pk2(ST[T1][0], ST[T1][1]); pf.y = pk2(ST[T1][2], ST[T1][3]);
                if (pr < 4) { pf.z = pk2(ST[T2][0], ST[T2][1]); pf.w = pk2(ST[T2][2], ST[T2][3]); } else { pf.z = 0u; pf.w = 0u; }
                const int k1 = ((16 * (w + T1)) & 127) + 4 * quad + (l15 >> 2), k2 = ((16 * (w + T2)) & 127) + 4 * quad + (l15 >> 2);
                const LAS unsigned char* v1 = ((w + T1 >= 8) ? bc : bp) + ATS_V; const LAS unsigned char* v2 = ((w + T2 >= 8) ? bc : bp) + ATS_V;
#pragma unroll
                for (int dt = 0; dt < 4; ++dt) {
                    const int jv = 2 * dt + ((l15 & 3) >> 1), sub = (l15 & 1) * 8;
                    const s16x4 lo = __builtin_amdgcn_ds_read_tr16_b64_v4i16((LAS s16x4*)(v1 + k1 * 128 + ((jv ^ (k1 & 7)) << 4) + sub));
                    const s16x4 hi = (pr < 4) ? __builtin_amdgcn_ds_read_tr16_b64_v4i16((LAS s16x4*)(v2 + k2 * 128 + ((jv ^ (k2 & 7)) << 4) + sub)) : lo;
                    bf16x8 av; av[0] = lo[0]; av[1] = lo[1]; av[2] = lo[2]; av[3] = lo[3]; av[4] = hi[0]; av[5] = hi[1]; av[6] = hi[2]; av[7] = hi[3];
                    O[dt] = mfma16(av, __builtin_bit_cast(bf16x8, pf), O[dt]); } }
            const float inv = 1.0f / l;
            const int tokq = ((128 * qt + 16 * w + l15) << U.dsh) + U.r; const size_t trow = (size_t)U.b * SEQ + tokq;
#pragma unroll
            for (int dt = 0; dt < 4; ++dt) { pend[dt].x = pk2(O[dt][0] * inv, O[dt][1] * inv); pend[dt].y = pk2(O[dt][2] * inv, O[dt][3] * inv); }
            pmx = mx; pl = l; prow = trow; ph = U.h; have = true;
        }
    }
    if (have) {
#pragma unroll
        for (int dt = 0; dt < 4; ++dt) *(v2u*)(OG + prow * 1536 + ph * 64 + 16 * dt + 4 * quad) = pend[dt];
        if (quad == 0) { v2u mlv; mlv.x = __float_as_uint(pmx); mlv.y = __float_as_uint(pl); *(v2u*)(ML + prow * 48 + ph * 2) = mlv; } }
    asm volatile("s_waitcnt vmcnt(0)" ::: "memory"); __syncthreads();
}
__device__ __forceinline__ void prep_a_phase(const Args& a, int tid, int G) {
    asm volatile("" : "+v"(tid));
    unsigned char* ws = a.ws; const bf16* OG = (const bf16*)(ws + WS_OG); const float* ML = (const float*)(ws + WS_ML); const bf16* ZA = (const bf16*)(ws + WS_ZA);
    bf16* AA = (bf16*)(ws + WS_AA);
    for (int p = blockIdx.x * 512 + tid; p < T * 64; p += G * 512) { const int t = p >> 6, col = (p & 63) * 8, s = col >> 6, dc = col & 63;
        v4u o[3]; float m[3], l[3];
#pragma unroll
        for (int g = 0; g < 3; ++g) { const int hh = 8 * g + s; o[g] = *(const v4u*)(OG + (size_t)t * 1536 + hh * 64 + dc); m[g] = ML[(size_t)t * 48 + hh * 2]; l[g] = ML[(size_t)t * 48 + hh * 2 + 1]; }
        const float M = fmaxf(m[0], fmaxf(m[1], m[2]));
        float w0 = l[0] * __builtin_amdgcn_exp2f(m[0] - M), w1 = l[1] * __builtin_amdgcn_exp2f(m[1] - M), w2 = l[2] * __builtin_amdgcn_exp2f(m[2] - M);
        const float iw = 1.0f / (w0 + w1 + w2); w0 *= iw; w1 *= iw; w2 *= iw;
        const v4u z8 = *(const v4u*)(ZA + (size_t)t * 512 + col);
        v4u w;
        w.x = pk2((w0 * bflo(o[0].x) + w1 * bflo(o[1].x) + w2 * bflo(o[2].x)) * siluf_(bflo(z8.x)), (w0 * bfhi(o[0].x) + w1 * bfhi(o[1].x) + w2 * bfhi(o[2].x)) * siluf_(bfhi(z8.x)));
        w.y = pk2((w0 * bflo(o[0].y) + w1 * bflo(o[1].y) + w2 * bflo(o[2].y)) * siluf_(bflo(z8.y)), (w0 * bfhi(o[0].y) + w1 * bfhi(o[1].y) + w2 * bfhi(o[2].y)) * siluf_(bfhi(z8.y)));
        w.z = pk2((w0 * bflo(o[0].z) + w1 * bflo(o[1].z) + w2 * bflo(o[2].z)) * siluf_(bflo(z8.z)), (w0 * bfhi(o[0].z) + w1 * bfhi(o[1].z) + w2 * bfhi(o[2].z)) * siluf_(bfhi(z8.z)));
        w.w = pk2((w0 * bflo(o[0].w) + w1 * bflo(o[1].w) + w2 * bflo(o[2].w)) * siluf_(bflo(z8.w)), (w0 * bfhi(o[0].w) + w1 * bfhi(o[1].w) + w2 * bfhi(o[2].w)) * siluf_(bfhi(z8.w)));
        *(v4u*)(AA + (size_t)t * 512 + col) = w; }
}


#ifndef REP_MASK
#define REP_MASK 0
#endif
#ifndef DBG_STOP
#define DBG_STOP 0
#endif
#if DBG_STOP
__device__ __forceinline__ float dbg_san(float v) { return (fabsf(v) < 1e30f) ? v : 777.0f; }
__device__ __forceinline__ float dbg_sum_bf16(const void* p, size_t bytes, int gtid, int NT) { const unsigned* q = (const unsigned*)p; float s = 0.f; for (size_t i = gtid; i < bytes / 4; i += NT) { const unsigned w = q[i]; s += dbg_san(bflo(w)) + dbg_san(bfhi(w)); } return s; }
__device__ __forceinline__ float dbg_sum_f32(const void* p, size_t bytes, int gtid, int NT) { const float* q = (const float*)p; float s = 0.f; for (size_t i = gtid; i < bytes / 4; i += NT) s += dbg_san(q[i]); return s; }
#define DBG_DUMP(k, NS, ...) if (DBG_STOP == (k)) { const int gtid_ = blockIdx.x * 512 + tid, NT_ = G * 512; float sv_[NS] = { __VA_ARGS__ }; GRID_SYNC(); \
    for (size_t i = gtid_; i < (size_t)T * D; i += NT_) args.out[i] = 0.f; _Pragma("unroll") for (int q_ = 0; q_ < NS; ++q_) args.out[(size_t)q_ * NT_ + gtid_] = sv_[q_]; return; }
#define SB(off, mib) dbg_sum_bf16(ws + (off), (size_t)(mib) * MiB, gtid_, NT_)
#define SF(off, mib) dbg_sum_f32(ws + (off), (size_t)(mib) * MiB, gtid_, NT_)
#else
#define DBG_DUMP(k, NS, ...)
#endif
typedef __attribute__((address_space(1))) unsigned gu32;
#define XB_TMO      128
#define XB_XCNT(j)  (256  + 64 * (j))
#define XB_XSUB(j)  (1280 + 64 * (j))
#define XB_XGEN(j)  (2304 + 64 * (j))
#define XB_TOP      3328
#define XB_TOPGEN   3392
#define XCD_BAR_WORDS 3456
#define XB_SPIN_CAP (1u << 18)

__device__ __forceinline__ unsigned xb_ld(unsigned* p)              { return __hip_atomic_load(p, __ATOMIC_RELAXED, __HIP_MEMORY_SCOPE_AGENT); }
__device__ __forceinline__ unsigned xb_add(unsigned* p, unsigned v) { return __hip_atomic_fetch_add(p, v, __ATOMIC_RELAXED, __HIP_MEMORY_SCOPE_AGENT); }
__device__ __forceinline__ unsigned xb_xcc_id() { return (unsigned)__builtin_amdgcn_s_getreg((3 << 11) | 20) & 0xFu; }
#define XB_SPIN(cond, bar) do { unsigned _sp = 0; while (cond) { __builtin_amdgcn_s_sleep(1); \
    if ((++_sp & 255u) == 0u) { if (xb_ld(&(bar)[XB_TMO])) break; if (_sp > XB_SPIN_CAP) { atomicAdd(&(bar)[XB_TMO], 1u); break; } } } } while (0)

struct XcdBarrier {
    unsigned* bar; unsigned x;
    volatile LAS unsigned* st;
};

__device__ __forceinline__ XcdBarrier xcd_barrier_post(unsigned* bar, volatile LAS unsigned* st) {
    XcdBarrier b; b.bar = bar; b.x = xb_xcc_id(); b.st = st;
    if (threadIdx.x == 0) (void)xb_add(&bar[XB_XCNT(b.x)], 1u);
    return b;
}
__device__ __forceinline__ void xcd_barrier_complete(unsigned* bar, unsigned x, unsigned& nloc, unsigned& nx) {
    const unsigned G = gridDim.x * gridDim.y * gridDim.z;
    unsigned sum, cnt, mine, sp = 0u;
    for (;;) {
        sum = 0u; cnt = 0u; mine = 0u;
#pragma unroll
        for (unsigned j = 0; j < 16; ++j) { const unsigned c = xb_ld(&bar[XB_XCNT(j)]); sum += c; cnt += (c > 0u) ? 1u : 0u; mine = (j == x) ? c : mine; }
        if (sum == G) break;
        __builtin_amdgcn_s_sleep(1);
        if ((++sp & 255u) == 0u) { if (xb_ld(&bar[XB_TMO])) break; if (sp > XB_SPIN_CAP) { atomicAdd(&bar[XB_TMO], 1u); break; } }
    }
    nloc = mine > 0u ? mine : 1u; nx = cnt > 0u ? cnt : 1u;
}

__device__ __forceinline__ void xcd_barrier(const XcdBarrier& b) {
    asm volatile("s_waitcnt vmcnt(0)" ::: "memory");
    __syncthreads();
    if (threadIdx.x == 0) {
        unsigned* bar = b.bar;
        __builtin_amdgcn_s_waitcnt(0);
        unsigned nloc = b.st[0], nx = b.st[1];
        if (nloc == 0u) { xcd_barrier_complete(bar, b.x, nloc, nx); b.st[0] = nloc; b.st[1] = nx; }
        const unsigned old = xb_add(&bar[XB_XSUB(b.x)], 1u);
        const unsigned gen = old / nloc;
        if (old + 1u == (gen + 1u) * nloc) {
            __builtin_amdgcn_fence(__ATOMIC_RELEASE, "agent");
            asm volatile("s_waitcnt vmcnt(0)" ::: "memory");
            const unsigned og = xb_add(&bar[XB_TOP], 1u);
            const unsigned tg = og / nx;
            if (og + 1u == (tg + 1u) * nx) xb_add(&bar[XB_TOPGEN], 1u);
            else XB_SPIN(xb_ld(&bar[XB_TOPGEN]) == tg, bar);
            __builtin_amdgcn_fence(__ATOMIC_ACQUIRE, "agent");
            xb_add(&bar[XB_XGEN(b.x)], 1u);
            asm volatile("s_waitcnt vmcnt(0)" ::: "memory");
        } else {
            XB_SPIN(xb_ld(&bar[XB_XGEN(b.x)]) == gen, bar);
            __builtin_amdgcn_fence(__ATOMIC_ACQUIRE, "agent");
            asm volatile("s_waitcnt vmcnt(0)" ::: "memory");
        }
    }
    __syncthreads();
}


__device__ __forceinline__ void panel_handoff(unsigned* cnt, int pm, unsigned want) {
    asm volatile("s_waitcnt vmcnt(0)" ::: "memory");
    __syncthreads();
    if (threadIdx.x == 0) {
        unsigned* c = cnt + 64 * pm;
        __hip_atomic_fetch_add(c, 1u, __ATOMIC_RELAXED, __HIP_MEMORY_SCOPE_AGENT);
        unsigned sp = 0;
        while (__hip_atomic_load(c, __ATOMIC_RELAXED, __HIP_MEMORY_SCOPE_AGENT) < want) { __builtin_amdgcn_s_sleep(1); if (++sp > (1u << 22)) break; }
        __builtin_amdgcn_fence(__ATOMIC_ACQUIRE, "agent");
        asm volatile("s_waitcnt vmcnt(0)" ::: "memory");
    }
    __syncthreads();
}
#define GRID_SYNC_CG() do { asm volatile("s_waitcnt vmcnt(0) lgkmcnt(0)" ::: "memory"); grid.sync(); __builtin_amdgcn_fence(__ATOMIC_ACQUIRE, "agent"); asm volatile("s_waitcnt vmcnt(0)" ::: "memory"); } while (0)
#define GRID_SYNC() xcd_barrier(xbar)
__global__ void __launch_bounds__(NWAVES * 64, 2) mega_fwd(Args args) {
    extern __shared__ __attribute__((aligned(16))) unsigned char lds_raw[];
    LAS unsigned char* lds = (LAS unsigned char*)lds_raw;
    cg::grid_group grid = cg::this_grid();
    const int tid = threadIdx.x, lane = tid & 63, wave = __builtin_amdgcn_readfirstlane(tid >> 6), G = gridDim.x;
    unsigned char* ws = args.ws;
    if (tid < 32) ((LAS unsigned*)(lds + MISC_OFF))[tid] = 0u;
    __syncthreads();
    const XcdBarrier xbar = xcd_barrier_post((unsigned*)(ws + WS_BAR), (volatile LAS unsigned*)(lds + MISC_OFF) + 8);
    const pg8::bf16_t* hb = (const pg8::bf16_t*)args.out;
    const pg8::bf16_t* AB = (const pg8::bf16_t*)args.out + (size_t)T * 1024;

#if REP_MASK & 32
    for (int q_ = 0; q_ < 10; ++q_) { GRID_SYNC(); }
#endif
    phase0(args, lds, tid, lane, wave, G);
#if REP_MASK & 1
    phase0(args, lds, tid, lane, wave, G);
#endif
    if (args.zero) { GRID_SYNC_CG(); }
    GRID_SYNC();
    glr_step(args, lane, wave, G);
    { pg8::Gemm g{hb, hb, hb, (const pg8::bf16_t*)(ws + WS_W1G), (const pg8::bf16_t*)(ws + WS_W1G), (const pg8::bf16_t*)(ws + WS_W1G), 16, 16, 16, 1024, 1024};
      pg8::SegOrder S; S.init(T, PG, G, (int)blockIdx.x, 1); pg8::EpiBf16 E{(pg8::bf16_t*)(ws + WS_PROJG), PG};
      pg8::gemm_phase<pg8::EpiBf16, pg8::SegOrder, true, true>(lds, g, S, E); }
#if REP_MASK & 128
    { pg8::Gemm g{hb, hb, hb, (const pg8::bf16_t*)(ws + WS_W1G), (const pg8::bf16_t*)(ws + WS_W1G), (const pg8::bf16_t*)(ws + WS_W1G), 16, 16, 16, 1024, 1024};
      pg8::SegOrder S; S.init(T, PG, G, (int)blockIdx.x, 1); pg8::EpiBf16 E{(pg8::bf16_t*)(ws + WS_PROJG), PG};
      pg8::gemm_phase<pg8::EpiBf16, pg8::SegOrder, true, true>(lds, g, S, E); }
#endif
    GRID_SYNC();
    DBG_DUMP(2, 7, SB(WS_W1A, 10), SB(WS_W1G, 6), SB(WS_WGT, 4), SF(WS_ROT, 1), dbg_sum_bf16(args.out, 32 * MiB, gtid_, NT_), SF(WS_GLR, 1), SB(WS_PROJG, 96))
    gla_local_phase(args, lds, tid, lane, wave, G);
#if REP_MASK & 2
    gla_local_phase(args, lds, tid, lane, wave, G);
#endif
    GRID_SYNC();
    DBG_DUMP(3, 4, SB(WS_QP, 16), SB(WS_OI, 32), SB(WS_L, 64), SF(WS_GAMMA, 0.5))
    DBG_DUMP(31, 1, SB(WS_QP, 16))
    DBG_DUMP(32, 1, SB(WS_OI, 32))
    DBG_DUMP(33, 1, SB(WS_L, 64))
    gla_chain_phase(args, lds, tid, lane, wave, G, args.one);
#if REP_MASK & 64
    gla_chain_phase(args, lds, tid, lane, wave, G, args.zero);
#endif
    GRID_SYNC();
    DBG_DUMP(4, 2, SB(WS_OI, 32), SF(WS_SS, 4))
    { pg8::Gemm g{hb, hb, hb, (const pg8::bf16_t*)(ws + WS_W1A), (const pg8::bf16_t*)(ws + WS_W1A), (const pg8::bf16_t*)(ws + WS_W1A), 16, 16, 16, 1024, 1024};
      pg8::SegOrder S; S.init(T, 6144, G, (int)blockIdx.x, 1);
      pg8::EpiQKV E{(pg8::bf16_t*)(ws + WS_PROJA), (pg8::bf16_t*)(ws + WS_ZA), args.gq, args.gk, (const float*)(ws + WS_ROT), EPS, (const pg8::bf16_t*)(ws + WS_OI), (const float*)(ws + WS_SS), args.gla_g, (pg8::bf16_t*)args.out + (size_t)T * 1024};
      pg8::gemm_phase<pg8::EpiQKV, pg8::SegOrder, true, true>(lds, g, S, E); }
#if REP_MASK & 256
    { pg8::Gemm g{hb, hb, hb, (const pg8::bf16_t*)(ws + WS_W1A), (const pg8::bf16_t*)(ws + WS_W1A), (const pg8::bf16_t*)(ws + WS_W1A), 16, 16, 16, 1024, 1024};
      pg8::SegOrder S; S.init(T, 6144, G, (int)blockIdx.x, 1);
      pg8::EpiQKV E{(pg8::bf16_t*)(ws + WS_PROJA), (pg8::bf16_t*)(ws + WS_ZA), args.gq, args.gk, (const float*)(ws + WS_ROT), EPS, (const pg8::bf16_t*)(ws + WS_OI), (const float*)(ws + WS_SS), args.gla_g, (pg8::bf16_t*)args.out + (size_t)T * 1024};
      pg8::gemm_phase<pg8::EpiQKV, pg8::SegOrder, true, true>(lds, g, S, E); }
#endif
    GRID_SYNC();
    attn_phase(args, lds, tid, lane, wave, G);
#if REP_MASK & 8
    attn_phase(args, lds, tid, lane, wave, G);
#endif
    GRID_SYNC();
    prep_a_phase(args, tid, G);
#if REP_MASK & 16
    prep_a_phase(args, tid, G);
#endif
    GRID_SYNC();
    DBG_DUMP(8, 4, SB(WS_PROJA, 160), SB(WS_OG, 48), SF(WS_ML, 3), SB(WS_AA, 16))
    { bf16* pb = (bf16*)(ws + WS_PB);
      for (int i = blockIdx.x * 512 + tid; i < T * 256 / 8; i += G * 512) { const f32x4 v0 = ((const f32x4*)args.p)[2 * i], v1 = ((const f32x4*)args.p)[2 * i + 1];
          v4u w; w.x = pk2(v0[0], v0[1]); w.y = pk2(v0[2], v0[3]); w.z = pk2(v1[0], v1[1]); w.w = pk2(v1[2], v1[3]); ((v4u*)pb)[i] = w; } }
    { const pg8::bf16_t* WGT = (const pg8::bf16_t*)(ws + WS_WGT);
      pg8::Gemm g{hb, hb, hb, WGT, WGT + (size_t)1024 * 1024, WGT, 16, 16, 16, 1024, 1024};
      pg8::SegOrder S; S.init(T, 1024, G, (int)blockIdx.x, 2); pg8::EpiSig2 E{(pg8::bf16_t*)(ws + WS_SGA), (pg8::bf16_t*)(ws + WS_SGB), 1024};
      pg8::gemm_phase<pg8::EpiSig2, pg8::SegOrder, true, true>(lds, g, S, E); }
    { const pg8::bf16_t* AA = (const pg8::bf16_t*)(ws + WS_AA); const pg8::bf16_t* WPA = (const pg8::bf16_t*)(ws + WS_WPA);
      pg8::Gemm g{AA, AA, AA, WPA, WPA, WPA, 8, 8, 8, 512, 512};
      pg8::SegOrder S; S.init(T, 1024, G, (int)blockIdx.x, 1); pg8::EpiGateMul E{(const pg8::bf16_t*)(ws + WS_SGA), (pg8::bf16_t*)(ws + WS_T1), 1024};
      pg8::gemm_phase<pg8::EpiGateMul, pg8::SegOrder, true, true>(lds, g, S, E); }
    { const pg8::bf16_t* WPB = (const pg8::bf16_t*)(ws + WS_WPB);
      pg8::Gemm g{AB, AB, AB, WPB, WPB, WPB, 16, 16, 16, 1024, 1024};
      pg8::SegOrder S; S.init(T, 1024, G, (int)blockIdx.x, 1); pg8::EpiMergeY E{(const pg8::bf16_t*)(ws + WS_SGB), (const pg8::bf16_t*)(ws + WS_T1), (pg8::bf16_t*)(ws + WS_Y), 1024};
      pg8::gemm_phase<pg8::EpiMergeY, pg8::SegOrder, true, true>(lds, g, S, E); }
    GRID_SYNC();
    DBG_DUMP(9, 5, SF(WS_TMP1, 64), SF(WS_TMP2, 64), SB(WS_Y, 32), SB(WS_PB, 8), SB(WS_WPA, 7))
    { const pg8::bf16_t* Y = (const pg8::bf16_t*)(ws + WS_Y); const pg8::bf16_t* W = (const pg8::bf16_t*)(ws + WS_WOUT);
      pg8::Gemm g{Y, Y, Y, W, W, W, 16, 16, 16, 1024, 1024};
      pg8::SegOrder S; S.init(T, 1024, G, (int)blockIdx.x, 1); pg8::EpiResid E{args.x, args.out, (pg8::bf16_t*)(ws + WS_X1B), (float*)(ws + WS_PS), 1024};
      pg8::gemm_phase<pg8::EpiResid, pg8::SegOrder, true, true>(lds, g, S, E); }
#if REP_MASK & 1024
    { const pg8::bf16_t* Y = (const pg8::bf16_t*)(ws + WS_Y); const pg8::bf16_t* W = (const pg8::bf16_t*)(ws + WS_WOUT);
      pg8::Gemm g{Y, Y, Y, W, W, W, 16, 16, 16, 1024, 1024};
      pg8::SegOrder S; S.init(T, 1024, G, (int)blockIdx.x, 1); pg8::EpiResid E{args.x, args.out, (pg8::bf16_t*)(ws + WS_X1B), (float*)(ws + WS_PS), 1024};
      pg8::gemm_phase<pg8::EpiResid, pg8::SegOrder, true, true>(lds, g, S, E); }
#endif
    { pg8::SegOrder S; S.init(T, 1024, G, (int)blockIdx.x, 1); pg8::Unit u0;
      if (S.nwg == G && S.next(0, u0)) panel_handoff((unsigned*)(ws + WS_PCNT), u0.pm, 4u); else { GRID_SYNC(); } }
    DBG_DUMP(10, 3, SB(WS_X1B, 32), SF(WS_PS, 1), dbg_sum_f32(args.out, 64 * MiB, gtid_, NT_))
    { const pg8::bf16_t* X1 = (const pg8::bf16_t*)(ws + WS_X1B); const pg8::bf16_t* W = (const pg8::bf16_t*)(ws + WS_WPG);
      pg8::Gemm g{X1, X1, X1, W, W, W, 16, 16, 16, 1024, 1024};
      pg8::SegOrder S; S.init(T, 1024, G, (int)blockIdx.x, 1); pg8::EpiSigRow E{(const float*)(ws + WS_PS), (pg8::bf16_t*)(ws + WS_SGA), 1024, EPS};
      pg8::gemm_phase<pg8::EpiSigRow, pg8::SegOrder, true, true>(lds, g, S, E); }
    { const pg8::bf16_t* PBm = (const pg8::bf16_t*)(ws + WS_PB); const pg8::bf16_t* W = (const pg8::bf16_t*)(ws + WS_WPLE);
      pg8::Gemm g{PBm, PBm, PBm, W, W, W, 4, 4, 4, 256, 256};
      pg8::SegOrder S; S.init(T, 1024, G, (int)blockIdx.x, 1); pg8::EpiPle2 E{args.out, (const pg8::bf16_t*)(ws + WS_SGA), 1024};
      pg8::gemm_phase<pg8::EpiPle2, pg8::SegOrder, true, true>(lds, g, S, E); }
}

extern "C" void kernel_launch(void* const* d_in, const int* in_sizes, int n_in, void* d_out, int out_size, void* d_ws, size_t ws_size, hipStream_t stream) {
    static int grid = 0;
    if (grid == 0) {
        if (n_in != 16 || out_size != T * D || ws_size < WS_END) { fprintf(stderr, "kernel_launch: unexpected shapes (n_in %d out %d ws %zu)\n", n_in, out_size, ws_size); grid = -1; return; }
        int dev = 0, cus = 0, per_cu = 0;
        (void)hipGetDevice(&dev); (void)hipDeviceGetAttribute(&cus, hipDeviceAttributeMultiprocessorCount, dev);
        (void)hipFuncSetAttribute((const void*)mega_fwd, hipFuncAttributeMaxDynamicSharedMemorySize, LDS_BYTES);
        (void)hipOccupancyMaxActiveBlocksPerMultiprocessor(&per_cu, (const void*)mega_fwd, NWAVES * 64, LDS_BYTES);
        if (per_cu < 1) { fprintf(stderr, "kernel_launch: occupancy query says %d blocks per CU\n", per_cu); per_cu = 1; }
        (void)hipGetLastError();
        grid = cus;
    }
    if (grid < 0) return;
    Args a{};
    a.x = (const float*)d_in[0]; a.p = (const float*)d_in[1]; a.pos = (const int*)d_in[2]; a.norm_g = (const float*)d_in[3]; a.w_in = (const float*)d_in[4];
    a.gq = (const float*)d_in[5]; a.gk = (const float*)d_in[6]; a.gate_w2 = (const float*)d_in[7]; a.gate_b = (const float*)d_in[8]; a.gla_g = (const float*)d_in[9];
    a.w_att = (const float*)d_in[10]; a.w_gla = (const float*)d_in[11]; a.w_out = (const float*)d_in[12]; a.ple_g = (const float*)d_in[13]; a.w_pg = (const float*)d_in[14]; a.w_ple = (const float*)d_in[15];
    a.out = (float*)d_out; a.ws = (unsigned char*)d_ws; a.one = 1; a.zero = 0;
    if (hipMemsetAsync((char*)d_ws + WS_BAR, 0, BAR_BYTES, stream) != hipSuccess) { fprintf(stderr, "kernel_launch: memset of barrier words failed\n"); return; }
    void* kargs[] = {&a};
    hipError_t e = hipLaunchCooperativeKernel((const void*)mega_fwd, dim3(grid), dim3(NWAVES * 64), kargs, LDS_BYTES, stream);
    if (e != hipSuccess) fprintf(stderr, "cooperative launch failed: %s (grid %d)\n", hipGetErrorString(e), grid);
}
```

```cpp
#define REP_MASK 0
#define DBG_STOP 0
#include <hip/hip_runtime.h>
#include <hip/hip_cooperative_groups.h>
#include <cstdio>
#include <cstdint>
namespace cg = cooperative_groups;

namespace pg8 {
#define PG8_LAS __attribute__((address_space(3)))
typedef unsigned short bf16_t;
typedef short bf16x8 __attribute__((ext_vector_type(8)));
typedef float f32x4 __attribute__((ext_vector_type(4)));
typedef unsigned u32x4 __attribute__((ext_vector_type(4)));
typedef unsigned u32x2 __attribute__((ext_vector_type(2)));
constexpr int BM = 256, BK = 64, HALF = 128, HTB = HALF * BK * 2  , STAGE_BYTES = 8 * HTB, NXCD = 8, WGM = 8;

__host__ __device__ __forceinline__ int lds_byte(int r, int c) { const int st = (r >> 4) * 2 + (c >> 5), rr = r & 15, cc = c & 31, ob = rr * 64 + cc * 2; return st * 1024 + (ob ^ (((ob >> 9) & 1) << 5)); }
__host__ __device__ __forceinline__ void stage_rc(int b, int& R, int& C) { const int st = b / 1024, sb = b % 1024, swz = sb ^ (((sb >> 9) & 1) << 5); R = (st >> 1) * 16 + swz / 64; C = (st & 1) * 32 + (swz % 64) / 2; }
__host__ __device__ __forceinline__ int perm32(int rho) { const int n = rho >> 4, i = rho & 15; return 8 * (i >> 2) + 4 * n + (i & 3); }

struct Unit { int pm, pn, seg; };
struct Gemm {
    const bf16_t* A0; const bf16_t* A1; const bf16_t* A2; const bf16_t* B0; const bf16_t* B1; const bf16_t* B2; int nt0, nt1, nt2, lda, ldb;
    __device__ __forceinline__ const bf16_t* selA(int s) const { const bf16_t* a0 = +A0; const bf16_t* a1 = +A1; const bf16_t* a2 = +A2; return s == 0 ? +a0 : (s == 1 ? +a1 : +a2); }
    __device__ __forceinline__ const bf16_t* selB(int s) const { const bf16_t* b0 = +B0; const bf16_t* b1 = +B1; const bf16_t* b2 = +B2; return s == 0 ? +b0 : (s == 1 ? +b1 : +b2); }
    __device__ __forceinline__ int selNt(int s) const { const int n0 = +nt0, n1 = +nt1, n2 = +nt2; return s == 0 ? +n0 : (s == 1 ? +n1 : +n2); }
};
struct SegOrder {
    int nM, nN, nwg, G, c, nseg;
    __device__ void init(int M, int N, int G_, int c_, int nseg_) { nM = M / BM; nN = N / BM; nwg = nM * nN; G = G_; c = c_; nseg = nseg_; }
    __device__ bool next(int i, Unit& u) const {
        const int ti = i / nseg; u.seg = i - ti * nseg;
        const long L = (long)ti * G + c; if (L >= nwg) return false;
        int wgid = (int)L; { const int q = nwg / NXCD, r = nwg % NXCD, xcd = wgid % NXCD, off = wgid / NXCD; wgid = (xcd < r ? xcd * (q + 1) : r * (q + 1) + (xcd - r) * q) + off; }
        const int nig = WGM * nN, gid = wgid / nig, fm = gid * WGM, gsz = (nM - fm) < WGM ? (nM - fm) : WGM;
        u.pm = fm + ((wgid % nig) % gsz); u.pn = (wgid % nig) / gsz; return true;
    }
    __device__ __forceinline__ void a_ready(const Unit&) const {}
    __device__ __forceinline__ void done(const Unit&) const {}
};
typedef __bf16 bf16x2_t __attribute__((ext_vector_type(2)));
typedef float f32x2_t __attribute__((ext_vector_type(2)));
__device__ __forceinline__ unsigned cvt_pk_bf16(float lo, float hi) { f32x2_t f = {lo, hi}; bf16x2_t v = __builtin_convertvector(f, bf16x2_t); return __builtin_bit_cast(unsigned, v); }
__device__ __forceinline__ float sigmoidf_(float x) { return __builtin_amdgcn_rcpf(1.0f + __expf(-x)); }

struct EpiBf16 {
    static constexpr bool PERM = true, AFTER_DRAIN = false;
    bf16_t* O; int ldc;
    __device__ __forceinline__ void operator()(const f32x4 (&acc)[2][2][4][2], const Unit& u, int wr, int wc, int fr, int fq) const {
        const int row0 = u.pm * BM + wr * 64 + fr; const int col0 = u.pn * BM + wc * 32 + 8 * fq;
#pragma unroll
        for (int ai = 0; ai < 2; ++ai)
#pragma unroll
            for (int m = 0; m < 4; ++m) { bf16_t* rowp = O + (size_t)(row0 + ai * HALF + m * 16) * ldc + col0;
#pragma unroll
                for (int bj = 0; bj < 2; ++bj) { const f32x4 v0 = acc[ai][bj][m][0], v1 = acc[ai][bj][m][1];
                    u32x4 w; w.x = cvt_pk_bf16(v0[0], v0[1]); w.y = cvt_pk_bf16(v0[2], v0[3]); w.z = cvt_pk_bf16(v1[0], v1[1]); w.w = cvt_pk_bf16(v1[2], v1[3]);
                    *(u32x4*)(rowp + bj * HALF) = w; } }
    }
};
#define PG8_FOR_ACC(body) \
    _Pragma("unroll") for (int ai = 0; ai < 2; ++ai) _Pragma("unroll") for (int m = 0; m < 4; ++m) { const int row = u.pm * BM + ai * HALF + wr * 64 + m * 16 + fr; \
    _Pragma("unroll") for (int bj = 0; bj < 2; ++bj) _Pragma("unroll") for (int n = 0; n < 2; ++n) { const size_t off = (size_t)row * ldc + (u.pn * BM + bj * HALF + wc * 32 + n * 16 + 4 * fq); const f32x4 a = acc[ai][bj][m][n]; body } }
struct EpiStoreF32 {
    static constexpr bool PERM = false, AFTER_DRAIN = false;
    float* tmp; int ldc;
    __device__ __forceinline__ void operator()(const f32x4 (&acc)[2][2][4][2], const Unit& u, int wr, int wc, int fr, int fq) const {
        PG8_FOR_ACC( *(f32x4*)(tmp + off) = a; )
    }
};
struct EpiMerge {
    static constexpr bool PERM = false, AFTER_DRAIN = false;
    float* tmp1; float* tmp2; bf16_t* y; int ldc;
    __device__ __forceinline__ void operator()(const f32x4 (&acc)[2][2][4][2], const Unit& u, int wr, int wc, int fr, int fq) const {
        if (u.seg == 0) {
            PG8_FOR_ACC( f32x4 t = *(const f32x4*)(tmp1 + off); t[0] *= sigmoidf_(a[0]); t[1] *= sigmoidf_(a[1]); t[2] *= sigmoidf_(a[2]); t[3] *= sigmoidf_(a[3]); *(f32x4*)(tmp1 + off) = t; )
        } else if (u.seg == 1) {
            PG8_FOR_ACC( *(f32x4*)(tmp2 + off) = a; )
        } else {
            PG8_FOR_ACC( const f32x4 t1 = *(const f32x4*)(tmp1 + off); const f32x4 t2 = *(const f32x4*)(tmp2 + off);
                u32x2 w; w.x = cvt_pk_bf16(t1[0] + sigmoidf_(a[0]) * t2[0], t1[1] + sigmoidf_(a[1]) * t2[1]); w.y = cvt_pk_bf16(t1[2] + sigmoidf_(a[2]) * t2[2], t1[3] + sigmoidf_(a[3]) * t2[3]);
                *(u32x2*)(y + off) = w; )
        }
    }
};
struct EpiResid {
    static constexpr bool PERM = false, AFTER_DRAIN = false;
    const float* x; float* out; bf16_t* x1b; float* ps; int ldc;
    __device__ __forceinline__ void operator()(const f32x4 (&acc)[2][2][4][2], const Unit& u, int wr, int wc, int fr, int fq) const {
#pragma unroll
        for (int ai = 0; ai < 2; ++ai)
#pragma unroll
            for (int m = 0; m < 4; ++m) { const int row = u.pm * BM + ai * HALF + wr * 64 + m * 16 + fr; float s = 0.f;
#pragma unroll
                for (int bj = 0; bj < 2; ++bj)
#pragma unroll
                    for (int n = 0; n < 2; ++n) { const size_t off = (size_t)row * ldc + (u.pn * BM + bj * HALF + wc * 32 + n * 16 + 4 * fq);
                        const f32x4 v = *(const f32x4*)(x + off) + acc[ai][bj][m][n]; *(f32x4*)(out + off) = v;
                        u32x2 w; w.x = cvt_pk_bf16(v[0], v[1]); w.y = cvt_pk_bf16(v[2], v[3]);
                        __hip_atomic_store((unsigned long long*)(x1b + off), ((unsigned long long)w.y << 32) | w.x, __ATOMIC_RELAXED, __HIP_MEMORY_SCOPE_AGENT);
                        s += (v[0] * v[0] + v[1] * v[1]) + (v[2] * v[2] + v[3] * v[3]); }
                s += __shfl_xor(s, 16); s += __shfl_xor(s, 32);
                if (fq == 0) __hip_atomic_store(ps + (size_t)row * 16 + u.pn * 4 + wc, s, __ATOMIC_RELAXED, __HIP_MEMORY_SCOPE_AGENT); }
    }
};
struct EpiPle {
    static constexpr bool PERM = false, AFTER_DRAIN = false;
    float* out; const float* tmp; const float* ps; int ldc; float eps;
    __device__ __forceinline__ void operator()(const f32x4 (&acc)[2][2][4][2], const Unit& u, int wr, int wc, int fr, int fq) const {
#pragma unroll
        for (int ai = 0; ai < 2; ++ai)
#pragma unroll
            for (int m = 0; m < 4; ++m) { const int row = u.pm * BM + ai * HALF + wr * 64 + m * 16 + fr;
                const f32x4* pp = (const f32x4*)(ps + (size_t)row * 16); const f32x4 p0 = pp[0], p1 = pp[1], p2 = pp[2], p3 = pp[3];
                const float ss = ((p0[0] + p0[1]) + (p0[2] + p0[3])) + ((p1[0] + p1[1]) + (p1[2] + p1[3])) + ((p2[0] + p2[1]) + (p2[2] + p2[3])) + ((p3[0] + p3[1]) + (p3[2] + p3[3]));
                const float rstd = rsqrtf(ss * (1.0f / 1024.0f) + eps);
#pragma unroll
                for (int bj = 0; bj < 2; ++bj)
#pragma unroll
                    for (int n = 0; n < 2; ++n) { const size_t off = (size_t)row * ldc + (u.pn * BM + bj * HALF + wc * 32 + n * 16 + 4 * fq);
                        const f32x4 a = acc[ai][bj][m][n]; const f32x4 t = *(const f32x4*)(tmp + off); f32x4 o = *(const f32x4*)(out + off);
                        o[0] += t[0] * sigmoidf_(rstd * a[0]); o[1] += t[1] * sigmoidf_(rstd * a[1]); o[2] += t[2] * sigmoidf_(rstd * a[2]); o[3] += t[3] * sigmoidf_(rstd * a[3]);
                        *(f32x4*)(out + off) = o; } }
    }
};

__device__ __forceinline__ f32x4 unpack_bf16x4(u32x2 w) { f32x4 r; r[0] = __uint_as_float(w.x << 16); r[1] = __uint_as_float(w.x & 0xffff0000u); r[2] = __uint_as_float(w.y << 16); r[3] = __uint_as_float(w.y & 0xffff0000u); return r; }
struct EpiSig2 {
    static constexpr bool PERM = false, AFTER_DRAIN = false;
    bf16_t* s0; bf16_t* s1; int ldc;
    __device__ __forceinline__ void operator()(const f32x4 (&acc)[2][2][4][2], const Unit& u, int wr, int wc, int fr, int fq) const {
        bf16_t* dst = u.seg == 0 ? s0 : s1;
        PG8_FOR_ACC( u32x2 w; w.x = cvt_pk_bf16(sigmoidf_(a[0]), sigmoidf_(a[1])); w.y = cvt_pk_bf16(sigmoidf_(a[2]), sigmoidf_(a[3])); *(u32x2*)(dst + off) = w; )
    }
};
struct EpiGateMul {
    static constexpr bool PERM = false, AFTER_DRAIN = false;
    const bf16_t* sg; bf16_t* t1; int ldc;
    __device__ __forceinline__ void operator()(const f32x4 (&acc)[2][2][4][2], const Unit& u, int wr, int wc, int fr, int fq) const {
        PG8_FOR_ACC( const f32x4 g = unpack_bf16x4(*(const u32x2*)(sg + off)); u32x2 w; w.x = cvt_pk_bf16(g[0] * a[0], g[1] * a[1]); w.y = cvt_pk_bf16(g[2] * a[2], g[3] * a[3]); *(u32x2*)(t1 + off) = w; )
    }
};
struct EpiMergeY {
    static constexpr bool PERM = false, AFTER_DRAIN = false;
    const bf16_t* sg; const bf16_t* t1; bf16_t* y; int ldc;
    __device__ __forceinline__ void operator()(const f32x4 (&acc)[2][2][4][2], const Unit& u, int wr, int wc, int fr, int fq) const {
        PG8_FOR_ACC( const f32x4 g = unpack_bf16x4(*(const u32x2*)(sg + off)); const f32x4 t = unpack_bf16x4(*(const u32x2*)(t1 + off));
            u32x2 w; w.x = cvt_pk_bf16(t[0] + g[0] * a[0], t[1] + g[1] * a[1]); w.y = cvt_pk_bf16(t[2] + g[2] * a[2], t[3] + g[3] * a[3]); *(u32x2*)(y + off) = w; )
    }
};
struct EpiSigRow {
    static constexpr bool PERM = false, AFTER_DRAIN = false;
    const float* ps; bf16_t* sg; int ldc; float eps;
    __device__ __forceinline__ void operator()(const f32x4 (&acc)[2][2][4][2], const Unit& u, int wr, int wc, int fr, int fq) const {
#pragma unroll
        for (int ai = 0; ai < 2; ++ai)
#pragma unroll
            for (int m = 0; m < 4; ++m) { const int row = u.pm * BM + ai * HALF + wr * 64 + m * 16 + fr;
                const f32x4* pp = (const f32x4*)(ps + (size_t)row * 16); const f32x4 p0 = pp[0], p1 = pp[1], p2 = pp[2], p3 = pp[3];
                const float ss = ((p0[0] + p0[1]) + (p0[2] + p0[3])) + ((p1[0] + p1[1]) + (p1[2] + p1[3])) + ((p2[0] + p2[1]) + (p2[2] + p2[3])) + ((p3[0] + p3[1]) + (p3[2] + p3[3]));
                const float rstd = rsqrtf(ss * (1.0f / 1024.0f) + eps);
#pragma unroll
                for (int bj = 0; bj < 2; ++bj)
#pragma unroll
                    for (int n = 0; n < 2; ++n) { const size_t off = (size_t)row * ldc + (u.pn * BM + bj * HALF + wc * 32 + n * 16 + 4 * fq);
                        const f32x4 a = acc[ai][bj][m][n]; u32x2 w; w.x = cvt_pk_bf16(sigmoidf_(rstd * a[0]), sigmoidf_(rstd * a[1])); w.y = cvt_pk_bf16(sigmoidf_(rstd * a[2]), sigmoidf_(rstd * a[3]));
                        *(u32x2*)(sg + off) = w; } }
    }
};
struct EpiPle2 {
    static constexpr bool PERM = false, AFTER_DRAIN = false;
    float* out; const bf16_t* sg; int ldc;
    __device__ __forceinline__ void operator()(const f32x4 (&acc)[2][2][4][2], const Unit& u, int wr, int wc, int fr, int fq) const {
        PG8_FOR_ACC( const f32x4 g = unpack_bf16x4(*(const u32x2*)(sg + off)); f32x4 o = *(const f32x4*)(out + off); o[0] += a[0] * g[0]; o[1] += a[1] * g[1]; o[2] += a[2] * g[2]; o[3] += a[3] * g[3]; *(f32x4*)(out + off) = o; )
    }
};

struct EpiQKV {
    static constexpr bool PERM = true, AFTER_DRAIN = false;
    bf16_t* QKV; bf16_t* ZA; const float* gq; const float* gk; const float* rot; float eps;
    const bf16_t* OI; const float* SS; const float* gla_g; bf16_t* AB;
    __device__ __forceinline__ void operator()(const f32x4 (&acc)[2][2][4][2], const Unit& u, int wr, int wc, int fr, int fq) const {
        const int row0 = u.pm * BM + wr * 64 + fr; const int cl = u.pn * BM + 64 * wc;
        if (cl >= 5120) {
            const int zc0 = cl - 5120 + 8 * fq, hB = (cl - 5120) >> 8;
            const f32x4 ga0 = *(const f32x4*)(gla_g + (zc0 & 255)), ga1 = *(const f32x4*)(gla_g + (zc0 & 255) + 4), gb0 = *(const f32x4*)(gla_g + ((zc0 + 32) & 255)), gb1 = *(const f32x4*)(gla_g + ((zc0 + 32) & 255) + 4);
#pragma unroll
            for (int ai = 0; ai < 2; ++ai)
#pragma unroll
                for (int m = 0; m < 4; ++m) { const int row = row0 + ai * HALF + m * 16;
                    const f32x4* sp = (const f32x4*)(SS + (size_t)row * 64 + hB * 16); const f32x4 s0 = sp[0], s1 = sp[1], s2 = sp[2], s3 = sp[3];
                    const float ss = ((s0[0] + s0[1]) + (s0[2] + s0[3])) + ((s1[0] + s1[1]) + (s1[2] + s1[3])) + ((s2[0] + s2[1]) + (s2[2] + s2[3])) + ((s3[0] + s3[1]) + (s3[2] + s3[3]));
                    const float rstd = rsqrtf(ss * (1.0f / 256.0f) + eps);
#pragma unroll
                    for (int bj = 0; bj < 2; ++bj) { const size_t off = (size_t)row * 1024 + zc0 + 32 * bj; const u32x4 o8 = *(const u32x4*)(OI + off);
                        const f32x4 z0 = acc[ai][bj][m][0], z1 = acc[ai][bj][m][1]; const f32x4 g0 = bj ? gb0 : ga0, g1 = bj ? gb1 : ga1;
                        u32x4 w;
                        w.x = cvt_pk_bf16(__uint_as_float(o8.x << 16) * rstd * g0[0] * (z0[0] * sigmoidf_(z0[0])), __uint_as_float(o8.x & 0xffff0000u) * rstd * g0[1] * (z0[1] * sigmoidf_(z0[1])));
                        w.y = cvt_pk_bf16(__uint_as_float(o8.y << 16) * rstd * g0[2] * (z0[2] * sigmoidf_(z0[2])), __uint_as_float(o8.y & 0xffff0000u) * rstd * g0[3] * (z0[3] * sigmoidf_(z0[3])));
                        w.z = cvt_pk_bf16(__uint_as_float(o8.z << 16) * rstd * g1[0] * (z1[0] * sigmoidf_(z1[0])), __uint_as_float(o8.z & 0xffff0000u) * rstd * g1[1] * (z1[1] * sigmoidf_(z1[1])));
                        w.w = cvt_pk_bf16(__uint_as_float(o8.w << 16) * rstd * g1[2] * (z1[2] * sigmoidf_(z1[2])), __uint_as_float(o8.w & 0xffff0000u) * rstd * g1[3] * (z1[3] * sigmoidf_(z1[3])));
                        *(u32x4*)(AB + off) = w; } }
            return;
        }
        if (cl >= 4608) {
#pragma unroll
            for (int ai = 0; ai < 2; ++ai)
#pragma unroll
                for (int m = 0; m < 4; ++m) { const int row = row0 + ai * HALF + m * 16;
#pragma unroll
                    for (int bj = 0; bj < 2; ++bj) { const f32x4 v0 = acc[ai][bj][m][0], v1 = acc[ai][bj][m][1];
                        u32x4 w; w.x = cvt_pk_bf16(v0[0], v0[1]); w.y = cvt_pk_bf16(v0[2], v0[3]); w.z = cvt_pk_bf16(v1[0], v1[1]); w.w = cvt_pk_bf16(v1[2], v1[3]);
                        *(u32x4*)(ZA + (size_t)row * 512 + (cl - 4608) + 32 * bj + 8 * fq) = w; } }
            return;
        }
        const int which = cl / 1536, hc = cl - which * 1536, h = hc >> 6, dsh = 2 * (h >> 3);
        bf16_t* base = QKV + (size_t)which * ((size_t)16384 * 1536) + 8 * fq;
        const bool qk = which < 2;
        const float* gp = which == 0 ? gq : gk; const float sc = which == 0 ? 0.125f * 1.4426950408889634f : 1.0f;
        f32x4 g00 = {1.f, 1.f, 1.f, 1.f}, g01 = g00, g10 = g00, g11 = g00;
        if (qk) { g00 = *(const f32x4*)(gp + 8 * fq); g01 = *(const f32x4*)(gp + 8 * fq + 4); g10 = *(const f32x4*)(gp + 32 + 8 * fq); g11 = *(const f32x4*)(gp + 32 + 8 * fq + 4); }
#pragma unroll
        for (int ai = 0; ai < 2; ++ai)
#pragma unroll
            for (int m = 0; m < 4; ++m) { const int row = row0 + ai * HALF + m * 16; const int b = row >> 12, t = row & 4095;
                const int idx = ((t & ((1 << dsh) - 1)) << (12 - dsh)) + (t >> dsh);
                bf16_t* dst = base + ((size_t)(b * 24 + h) * 4096 + idx) * 64;
                f32x4 a0 = acc[ai][0][m][0], a1 = acc[ai][0][m][1], c0 = acc[ai][1][m][0], c1 = acc[ai][1][m][1];
                if (qk) {
                    float ss = ((a0[0] * a0[0] + a0[1] * a0[1]) + (a0[2] * a0[2] + a0[3] * a0[3])) + ((a1[0] * a1[0] + a1[1] * a1[1]) + (a1[2] * a1[2] + a1[3] * a1[3]))
                             + ((c0[0] * c0[0] + c0[1] * c0[1]) + (c0[2] * c0[2] + c0[3] * c0[3])) + ((c1[0] * c1[0] + c1[1] * c1[1]) + (c1[2] * c1[2] + c1[3] * c1[3]));
                    ss += __shfl_xor(ss, 16); ss += __shfl_xor(ss, 32);
                    const float rstd = rsqrtf(ss * (1.0f / 64.0f) + eps);
                    a0 = a0 * rstd * g00; a1 = a1 * rstd * g01; c0 = c0 * rstd * g10; c1 = c1 * rstd * g11;
                    f32x4 p0, p1;
                    p0[0] = __shfl_xor(a0[0], 16); p0[1] = __shfl_xor(a0[1], 16); p0[2] = __shfl_xor(a0[2], 16); p0[3] = __shfl_xor(a0[3], 16);
                    p1[0] = __shfl_xor(a1[0], 16); p1[1] = __shfl_xor(a1[1], 16); p1[2] = __shfl_xor(a1[2], 16); p1[3] = __shfl_xor(a1[3], 16);
                    if (fq < 2) { const float* rp = rot + (size_t)row * 16; const f32x4 cs0 = *(const f32x4*)(rp), cs1 = *(const f32x4*)(rp + 4), sn0 = *(const f32x4*)(rp + 8), sn1 = *(const f32x4*)(rp + 12);
                        const float sg = fq == 0 ? -1.f : 1.f; a0 = a0 * cs0 + (p0 * sn0) * sg; a1 = a1 * cs1 + (p1 * sn1) * sg; }
                    a0 = a0 * sc; a1 = a1 * sc; c0 = c0 * sc; c1 = c1 * sc;
                }
                u32x4 w0, w1; w0.x = cvt_pk_bf16(a0[0], a0[1]); w0.y = cvt_pk_bf16(a0[2], a0[3]); w0.z = cvt_pk_bf16(a1[0], a1[1]); w0.w = cvt_pk_bf16(a1[2], a1[3]);
                w1.x = cvt_pk_bf16(c0[0], c0[1]); w1.y = cvt_pk_bf16(c0[2], c0[3]); w1.z = cvt_pk_bf16(c1[0], c1[1]); w1.w = cvt_pk_bf16(c1[2], c1[3]);
                *(u32x4*)dst = w0; *(u32x4*)(dst + 32) = w1; }
    }
};

template <class Epi, class Sched, bool ALIGN_EPI = false, bool SP2 = false>
__device__ __forceinline__ void gemm_phase(PG8_LAS unsigned char* lds, const Gemm g, const Sched& S, const Epi& E) {
    const int tid = threadIdx.x, wid = __builtin_amdgcn_readfirstlane(tid >> 6), lane = tid & 63, wr = wid >> 2, wc = wid & 3, fr = lane & 15, fq = lane >> 4;
    const int lda = g.lda, ldb = g.ldb;
    unsigned voffA[2], voffB[2];
#pragma unroll
    for (int i = 0; i < 2; ++i) { int R, C; stage_rc(tid * 16 + i * 8192, R, C); const int Rb = Epi::PERM ? ((R & ~31) + perm32(R & 31)) : R;
        voffA[i] = (unsigned)(R * lda + C) * 2u; voffB[i] = (unsigned)(Rb * ldb + C) * 2u; }
    const size_t kstep = (size_t)(BK * 2);
    const size_t hstepA = (size_t)HALF * lda * 2, hstepB = (size_t)HALF * ldb * 2;
    const size_t tstepA = 2 * hstepA, tstepB = 2 * hstepB;
    const unsigned ldsw = (unsigned)wid * 1024u;
    const int aoff = lds_byte(wr * 64 + fr, fq * 8), boff = lds_byte(wc * 32 + fr, fq * 8);
#define PG8_SA(b, h) (((b) * 2 + (h)) * HTB)
#define PG8_SB(b, h) ((4 + (b) * 2 + (h)) * HTB)
#define PG8_STAGE(bufoff, gbase, voff) do { _Pragma("unroll") for (int _i = 0; _i < 2; ++_i) \
        __builtin_amdgcn_global_load_lds((const unsigned*)((const char*)(gbase) + (voff)[_i]), (PG8_LAS unsigned*)(lds + (bufoff) + ldsw + _i * 8192), 16, 0, 0); } while (0)
#define PG8_LDA(dst, b, h) do { _Pragma("unroll") for (int m = 0; m < 4; ++m) _Pragma("unroll") for (int k = 0; k < 2; ++k) dst[m][k] = *(const PG8_LAS bf16x8*)(lds + PG8_SA(b, h) + aoff + m * 2048 + k * 1024); } while (0)
#define PG8_LDB(dst, b, h) do { _Pragma("unroll") for (int n = 0; n < 2; ++n) _Pragma("unroll") for (int k = 0; k < 2; ++k) dst[n][k] = *(const PG8_LAS bf16x8*)(lds + PG8_SB(b, h) + boff + n * 2048 + k * 1024); } while (0)
#define PG8_MMA(ai, bj, At, Bt) do { __builtin_amdgcn_s_setprio(1); _Pragma("unroll") for (int m = 0; m < 4; ++m) _Pragma("unroll") for (int n = 0; n < 2; ++n) _Pragma("unroll") for (int k = 0; k < 2; ++k) \
        acc[ai][bj][m][n] = __builtin_amdgcn_mfma_f32_16x16x32_bf16(Bt[n][k], At[m][k], acc[ai][bj][m][n], 0, 0, 0); __builtin_amdgcn_s_setprio(0); } while (0)
#define PG8_WAIT_V(n) asm volatile("s_waitcnt vmcnt(" #n ")" ::: "memory")
#define PG8_WAIT_L(n) asm volatile("s_waitcnt lgkmcnt(" #n ")" ::: "memory")
#define PG8_BAR __builtin_amdgcn_s_barrier()
#define PG8_SCHED __builtin_amdgcn_sched_barrier(0)
    Unit cur, nxt; int ui = 0;
    if (!S.next(0, cur)) return;
    f32x4 acc[2][2][4][2];
#pragma unroll
    for (int a = 0; a < 2; ++a)
#pragma unroll
        for (int b = 0; b < 2; ++b)
#pragma unroll
            for (int m = 0; m < 4; ++m)
#pragma unroll
                for (int n = 0; n < 2; ++n) acc[a][b][m][n] = (f32x4){0.f, 0.f, 0.f, 0.f};
    bf16x8 At[4][2], B0[2][2], B1[2][2];
    const char* cA = (const char*)g.selA(cur.seg) + (size_t)cur.pm * tstepA; const char* cB = (const char*)g.selB(cur.seg) + (size_t)cur.pn * tstepB;
    S.a_ready(cur);
    if constexpr (SP2) {
        PG8_STAGE(PG8_SB(0, 0), cB, voffB); PG8_STAGE(PG8_SB(0, 1), cB + hstepB, voffB); PG8_STAGE(PG8_SA(0, 0), cA, voffA); PG8_STAGE(PG8_SA(0, 1), cA + hstepA, voffA);
        if (wr == 1) PG8_BAR;
        PG8_WAIT_V(2); PG8_BAR;
        PG8_STAGE(PG8_SB(1, 0), cB + kstep, voffB); PG8_STAGE(PG8_SA(1, 0), cA + kstep, voffA); PG8_STAGE(PG8_SB(1, 1), cB + hstepB + kstep, voffB);
        PG8_WAIT_V(6); PG8_BAR;
    } else {
        PG8_STAGE(PG8_SB(0, 0), cB, voffB); PG8_STAGE(PG8_SA(0, 0), cA, voffA); PG8_STAGE(PG8_SB(0, 1), cB + hstepB, voffB); PG8_STAGE(PG8_SA(0, 1), cA + hstepA, voffA);
        if (wr == 1) PG8_BAR;
        PG8_WAIT_V(4); PG8_BAR;
        PG8_STAGE(PG8_SB(1, 0), cB + kstep, voffB); PG8_STAGE(PG8_SA(1, 0), cA + kstep, voffA); PG8_STAGE(PG8_SB(1, 1), cB + hstepB + kstep, voffB);
        PG8_WAIT_V(6); PG8_BAR;
    }
    for (;;) {
        const bool has_next = S.next(ui + 1, nxt);
        const char* nA = has_next ? (const char*)g.selA(nxt.seg) + (size_t)nxt.pm * tstepA : cA; const char* nB = has_next ? (const char*)g.selB(nxt.seg) + (size_t)nxt.pn * tstepB : cB;
        const int nt = g.selNt(cur.seg);
        for (int t = 0; t < nt; t += 2) {
            const bool last = (t == nt - 2);
            const char* a1 = cA + (size_t)(t + 1) * kstep;
            const char* a2 = last ? nA : cA + (size_t)(t + 2) * kstep; const char* b2 = last ? nB : cB + (size_t)(t + 2) * kstep;
            const char* a3 = a2 + kstep; const char* b3 = b2 + kstep;
            if (last && has_next) S.a_ready(nxt);
            if constexpr (SP2) {
            PG8_LDB(B0, 0, 0); PG8_LDB(B1, 0, 1); PG8_SCHED; PG8_LDA(At, 0, 0); PG8_STAGE(PG8_SA(1, 1), a1 + hstepA, voffA);
            PG8_WAIT_V(8); PG8_WAIT_L(0); PG8_BAR; PG8_MMA(0, 0, At, B0); PG8_MMA(0, 1, At, B1); PG8_BAR; PG8_SCHED;
            PG8_LDA(At, 0, 1); PG8_STAGE(PG8_SB(0, 0), b2, voffB); PG8_STAGE(PG8_SB(0, 1), b2 + hstepB, voffB); PG8_STAGE(PG8_SA(0, 0), a2, voffA);
            PG8_WAIT_V(8); PG8_WAIT_L(0); PG8_BAR; PG8_MMA(1, 0, At, B0); PG8_MMA(1, 1, At, B1); PG8_BAR; PG8_SCHED;
            PG8_LDB(B0, 1, 0); PG8_LDB(B1, 1, 1); PG8_SCHED; PG8_LDA(At, 1, 0); PG8_STAGE(PG8_SA(0, 1), a2 + hstepA, voffA);
            PG8_WAIT_V(8); PG8_WAIT_L(0); PG8_BAR; PG8_MMA(0, 0, At, B0); PG8_MMA(0, 1, At, B1); PG8_BAR; PG8_SCHED;
            PG8_LDA(At, 1, 1); PG8_STAGE(PG8_SB(1, 0), b3, voffB); PG8_STAGE(PG8_SB(1, 1), b3 + hstepB, voffB); PG8_STAGE(PG8_SA(1, 0), a3, voffA);
            PG8_WAIT_V(8); PG8_WAIT_L(0); PG8_BAR; PG8_MMA(1, 0, At, B0); PG8_MMA(1, 1, At, B1); PG8_BAR; PG8_SCHED;
            } else {
            PG8_LDB(B0, 0, 0); PG8_SCHED; PG8_LDA(At, 0, 0); PG8_STAGE(PG8_SA(1, 1), a1 + hstepA, voffA);
            PG8_WAIT_L(8); PG8_BAR; PG8_WAIT_L(0); PG8_MMA(0, 0, At, B0); PG8_BAR; PG8_SCHED;
            PG8_LDB(B1, 0, 1); PG8_STAGE(PG8_SB(0, 0), b2, voffB);
            PG8_BAR; PG8_WAIT_L(0); PG8_MMA(0, 1, At, B1); PG8_BAR;
            PG8_LDA(At, 0, 1); PG8_STAGE(PG8_SA(0, 0), a2, voffA);
            PG8_BAR; PG8_WAIT_L(0); PG8_MMA(1, 0, At, B0); PG8_BAR; PG8_SCHED;
            PG8_STAGE(PG8_SB(0, 1), b2 + hstepB, voffB);
            PG8_WAIT_V(6); PG8_BAR; PG8_MMA(1, 1, At, B1); PG8_BAR;
            PG8_LDB(B0, 1, 0); PG8_SCHED; PG8_LDA(At, 1, 0); PG8_STAGE(PG8_SA(0, 1), a2 + hstepA, voffA);
            PG8_WAIT_L(8); PG8_BAR; PG8_WAIT_L(0); PG8_MMA(0, 0, At, B0); PG8_BAR; PG8_SCHED;
            PG8_LDB(B1, 1, 1); PG8_STAGE(PG8_SB(1, 0), b3, voffB);
            PG8_BAR; PG8_WAIT_L(0); PG8_MMA(0, 1, At, B1); PG8_BAR;
            PG8_LDA(At, 1, 1); PG8_STAGE(PG8_SA(1, 0), a3, voffA);
            PG8_BAR; PG8_WAIT_L(0); PG8_MMA(1, 0, At, B0); PG8_BAR; PG8_SCHED;
            PG8_STAGE(PG8_SB(1, 1), b3 + hstepB, voffB);
            PG8_WAIT_V(6); PG8_BAR; PG8_MMA(1, 1, At, B1); PG8_BAR;
            }
        }
        if constexpr (ALIGN_EPI) { if (wr == 0) PG8_BAR; }
        if constexpr (!Epi::AFTER_DRAIN) { E(acc, cur, wr, wc, fr, fq); S.done(cur); }
        if (!has_next) break;
#pragma unroll
        for (int a = 0; a < 2; ++a)
#pragma unroll
            for (int b = 0; b < 2; ++b)
#pragma unroll
                for (int m = 0; m < 4; ++m)
#pragma unroll
                    for (int n = 0; n < 2; ++n) acc[a][b][m][n] = (f32x4){0.f, 0.f, 0.f, 0.f};
        cur = nxt; cA = nA; cB = nB; ++ui;
        if constexpr (ALIGN_EPI) { if (wr == 1) PG8_BAR; }
    }
    PG8_WAIT_V(0);
    if constexpr (!ALIGN_EPI) { if (wr == 0) PG8_BAR; }
    PG8_BAR;
    if constexpr (Epi::AFTER_DRAIN) { E.fused(acc, cur, wr, wc, fr, fq, lds, wid, lane); S.done(cur); }
#undef PG8_SA
#undef PG8_SB
#undef PG8_STAGE
#undef PG8_LDA
#undef PG8_LDB
#undef PG8_MMA
#undef PG8_WAIT_V
#undef PG8_WAIT_L
#undef PG8_BAR
#undef PG8_SCHED
}
}

constexpr int NWAVES = 8;
constexpr int T = 16384, D = 1024, SEQ = 4096, INC = 10256;
constexpr int PA = 5120;
constexpr int PG = 2048;
constexpr float EPS = 1e-6f;
constexpr size_t MiB = 1u << 20;
constexpr size_t WS_W1A = 0, WS_W1G = 12 * MiB, WS_WGT = 16 * MiB, WS_WPA = 20 * MiB, WS_WPB = 21 * MiB, WS_WOUT = 23 * MiB, WS_WPG = 25 * MiB, WS_WPLE = 27 * MiB, WS_WGLR = 27 * MiB + 512 * 1024;
constexpr size_t WS_ROT = 28 * MiB, WS_GLR = 29 * MiB, WS_GAMMA = 30 * MiB, WS_ML = 29 * MiB  , WS_PS = 29 * MiB  ;
constexpr size_t WS_PROJG = 32 * MiB, WS_QP = 96 * MiB, WS_L = 112 * MiB, WS_OI = 192 * MiB, WS_SS = 224 * MiB;
constexpr size_t WS_PROJA = 32 * MiB, WS_ZA = 176 * MiB  , WS_OG = 192 * MiB, WS_AA = 240 * MiB;
constexpr size_t WS_TMP1 = 32 * MiB, WS_TMP2 = 96 * MiB, WS_SGA = 32 * MiB, WS_SGB = 64 * MiB, WS_T1 = 96 * MiB, WS_Y = 160 * MiB, WS_PB = 200 * MiB, WS_X1B = 208 * MiB, WS_END = 256 * MiB;
constexpr int LDS_BYTES = 147456, MISC_OFF = 131072 + 320;
constexpr size_t WS_BAR = 27 * MiB + 512 * 1024 + 65536, WS_PCNT = WS_BAR + 16384, BAR_BYTES = 16384 + 2 * 16384;

#define LAS __attribute__((address_space(3)))
typedef unsigned short bf16;
typedef unsigned v4u __attribute__((ext_vector_type(4)));
typedef unsigned v2u __attribute__((ext_vector_type(2)));
typedef float f32x4 __attribute__((ext_vector_type(4)));
typedef short bf16x8 __attribute__((ext_vector_type(8)));
typedef short s16x4 __attribute__((ext_vector_type(4)));
__device__ __forceinline__ float bflo(unsigned w) { return __uint_as_float(w << 16); }
__device__ __forceinline__ float bfhi(unsigned w) { return __uint_as_float(w & 0xffff0000u); }
__device__ __forceinline__ float bf2f(unsigned short b) { return __uint_as_float(((unsigned)b) << 16); }
__device__ __forceinline__ unsigned pk2(float lo, float hi) { return pg8::cvt_pk_bf16(lo, hi); }
__device__ __forceinline__ bf16x8 mk8(v2u lo, v2u hi) { v4u t; t.x = lo.x; t.y = lo.y; t.z = hi.x; t.w = hi.y; return __builtin_bit_cast(bf16x8, t); }
__device__ __forceinline__ f32x4 mfma16(bf16x8 a, bf16x8 b, f32x4 c) { return __builtin_amdgcn_mfma_f32_16x16x32_bf16(a, b, c, 0, 0, 0); }
__device__ __forceinline__ float siluf_(float x) { return x * pg8::sigmoidf_(x); }
#define LDS_WAIT() asm volatile("s_waitcnt lgkmcnt(0)" ::: "memory")

struct Args {
    const float* x; const float* p; const int* pos; const float* norm_g; const float* w_in; const float* gq; const float* gk; const float* gate_w2; const float* gate_b;
    const float* gla_g; const float* w_att; const float* w_gla; const float* w_out; const float* ple_g; const float* w_pg; const float* w_ple; float* out; unsigned char* ws; int one; int zero;
};

__device__ __forceinline__ float wave_sum(float v) {
#pragma unroll
    for (int o = 1; o < 64; o <<= 1) v += __shfl_xor(v, o);
    return v;
}
__device__ __forceinline__ void p0_transpose_item(const float* W, int wpitch, int ncols, const float* kscale, bf16* WT, int tpitch, int row_off, LAS float* scr, int item, int lane, bool headperm = false) {
    const int nblk = ncols / 32, kb = item / nblk, nb = item % nblk, k0 = 64 * kb, n0 = 32 * nb;
    const int d0 = headperm ? ((nb & ~7) + (nb & 1) * 4 + ((nb & 7) >> 1)) * 32 : n0;
#pragma unroll 8
    for (int i = 0; i < 32; ++i) { const int kk = 2 * i + (lane >> 5); float v = W[(size_t)(k0 + kk) * wpitch + n0 + (lane & 31)]; if (kscale) v *= kscale[k0 + kk]; scr[kk * 33 + (lane & 31)] = v; }
    LDS_WAIT(); asm volatile("" ::: "memory");
    const int c = lane & 7;
#pragma unroll
    for (int j = 0; j < 4; ++j) { const int n = (lane >> 3) + 8 * j; const LAS float* s = scr + (8 * c) * 33 + n;
        v4u o; o.x = pk2(s[0 * 33], s[1 * 33]); o.y = pk2(s[2 * 33], s[3 * 33]); o.z = pk2(s[4 * 33], s[5 * 33]); o.w = pk2(s[6 * 33], s[7 * 33]);
        *(v4u*)(WT + (size_t)(row_off + d0 + n) * tpitch + k0 + 8 * c) = o; }
    LDS_WAIT(); asm volatile("" ::: "memory");
}

__device__ __forceinline__ void phase0(const Args& a, LAS unsigned char* lds, int tid, int lane, int wave, int G) {
    unsigned char* ws = a.ws;
    LAS float* scr = (LAS float*)(lds + wave * 16384);
    const int gw = blockIdx.x * NWAVES + wave, NGW = G * NWAVES;
    constexpr int I0 = 16 * 160, I1 = 16 * 64, I2 = 16 * 32, I3 = 16 * 64, I4 = 8 * 32, I5 = 16 * 32, I6 = 16 * 32, I7 = 16 * 32, I8 = 4 * 32;
    constexpr int NITEMS = I0 + I1 + I2 + I3 + I4 + I5 + I6 + I7 + I8;
    for (int it = gw; it < NITEMS; it += NGW) {
        int r = it;
        if (r < I0) { p0_transpose_item(a.w_in, INC, 5120, nullptr, (bf16*)(ws + WS_W1A), 1024, 0, scr, r, lane, true); continue; } r -= I0;
        if (r < I1) { p0_transpose_item(a.w_in + 5120, INC, 2048, nullptr, (bf16*)(ws + WS_W1G), 1024, 0, scr, r, lane); continue; } r -= I1;
        if (r < I2) { p0_transpose_item(a.w_in + 7184, INC, 1024, nullptr, (bf16*)(ws + WS_W1A), 1024, 5120, scr, r, lane, true); continue; } r -= I2;
        if (r < I3) { p0_transpose_item(a.w_in + 8208, INC, 2048, nullptr, (bf16*)(ws + WS_WGT), 1024, 0, scr, r, lane); continue; } r -= I3;
        if (r < I4) { p0_transpose_item(a.w_att, 1024, 1024, nullptr, (bf16*)(ws + WS_WPA), 512, 0, scr, r, lane); continue; } r -= I4;
        if (r < I5) { p0_transpose_item(a.w_gla, 1024, 1024, nullptr, (bf16*)(ws + WS_WPB), 1024, 0, scr, r, lane); continue; } r -= I5;
        if (r < I6) { p0_transpose_item(a.w_out, 1024, 1024, nullptr, (bf16*)(ws + WS_WOUT), 1024, 0, scr, r, lane); continue; } r -= I6;
        if (r < I7) { p0_transpose_item(a.w_pg, 1024, 1024, a.ple_g, (bf16*)(ws + WS_WPG), 1024, 0, scr, r, lane); continue; } r -= I7;
        p0_transpose_item(a.w_ple, 1024, 1024, nullptr, (bf16*)(ws + WS_WPLE), 256, 0, scr, r, lane);
    }
    const int gtid = blockIdx.x * 512 + tid, NT = G * 512;
    for (int i = gtid; i < 16 * 1024; i += NT) { const int k = i >> 4, r = i & 15; ((bf16*)(ws + WS_WGLR))[r * 1024 + k] = (bf16)(pk2(a.w_in[(size_t)k * INC + 7168 + r], 0.f) & 0xffffu); }
    for (int i = gtid; i < T * 8; i += NT) { const int t = i >> 3, j = i & 7;
        const float inv = exp2f(-(float)j * 0.125f * 18.931568569324174f);
        const float ang = (float)a.pos[t] * inv;
        const double ad = (double)ang; const double kq = __builtin_rint(ad * 0.15915494309189535); const float rf = (float)(ad - kq * 6.283185307179586);
        float* rt = (float*)(ws + WS_ROT) + (size_t)t * 16; rt[j] = __cosf(rf); rt[8 + j] = __sinf(rf); }
    bf16* hb = (bf16*)a.out;
    for (int m = gw; m < T; m += NGW) {
        const f32x4* xr = (const f32x4*)(a.x + (size_t)m * D) + lane; const f32x4* gr = (const f32x4*)a.norm_g + lane;
        f32x4 v[4]; float s = 0.f;
#pragma unroll
        for (int j = 0; j < 4; ++j) { v[j] = xr[64 * j]; s += (v[j][0] * v[j][0] + v[j][1] * v[j][1]) + (v[j][2] * v[j][2] + v[j][3] * v[j][3]); }
        const float rstd = rsqrtf(wave_sum(s) * (1.f / D) + EPS);
        v2u* o8 = (v2u*)(hb + (size_t)m * D) + lane;
#pragma unroll
        for (int j = 0; j < 4; ++j) { const f32x4 g = gr[64 * j]; v2u w; w.x = pk2(v[j][0] * rstd * g[0], v[j][1] * rstd * g[1]); w.y = pk2(v[j][2] * rstd * g[2], v[j][3] * rstd * g[3]); o8[64 * j] = w; }
    }
}

__device__ __forceinline__ void glr_step(const Args& a, int lane, int wave, int G) {
    const bf16* hb = (const bf16*)a.out; const bf16* wg = (const bf16*)(a.ws + WS_WGLR); float* glr = (float*)(a.ws + WS_GLR);
    const int l15 = lane & 15, quad = lane >> 4;
    for (int rt = blockIdx.x * NWAVES + wave; rt < T / 16; rt += G * NWAVES) {
        f32x4 acc = {0.f, 0.f, 0.f, 0.f};
        const bf16* ap = hb + (size_t)(rt * 16 + l15) * 1024 + 8 * quad; const bf16* bp = wg + (size_t)l15 * 1024 + 8 * quad;
#pragma unroll 8
        for (int i = 0; i < 32; ++i) acc = mfma16(*(const bf16x8*)(ap + 32 * i), *(const bf16x8*)(bp + 32 * i), acc);
#pragma unroll
        for (int j = 0; j < 4; ++j) glr[(size_t)(rt * 16 + 4 * quad + j) * 16 + l15] = acc[j];
    }
}

constexpr int GL_GLR = 0, GL_CUMX = 4096, GL_QS = 6144, GL_KS = GL_QS + 64 * 272, GL_KT = GL_KS + 64 * 272, GL_VS = GL_KT + 128 * 144, GL_AT = GL_VS + 64 * 528, GL_END = GL_AT + 64 * 144;
static_assert(GL_END <= 131072, "gla lds");
__device__ __forceinline__ void gla_local_phase(const Args& a, LAS unsigned char* lds, int tid, int lane, int wave, int G) {
    asm volatile("" : "+v"(tid), "+v"(lane));
    unsigned char* ws = a.ws;
    const bf16* PROJ = (const bf16*)(ws + WS_PROJG); const float* glr = (const float*)(ws + WS_GLR);
    bf16* Qp = (bf16*)(ws + WS_QP); bf16* OI = (bf16*)(ws + WS_OI); bf16* Lg = (bf16*)(ws + WS_L); float* gamma = (float*)(ws + WS_GAMMA);
    const int d = tid & 127, tg = tid >> 7, l15 = lane & 15, quad = lane >> 4;
    for (int unit = blockIdx.x; unit < 1024; unit += G) {
        const int b = unit >> 8, h = (unit >> 6) & 3, c = unit & 63; const int row0 = b * SEQ + c * 64;
        const bf16* P = PROJ + (size_t)row0 * PG;
#pragma unroll
        for (int i = 0; i < 2; ++i) { const int p = tid + 512 * i, tok = p >> 4, part = p & 15;
            *(LAS v4u*)(lds + GL_QS + tok * 272 + part * 16) = *(const v4u*)(P + (size_t)tok * PG + h * 128 + part * 8);
            *(LAS v4u*)(lds + GL_KS + tok * 272 + part * 16) = *(const v4u*)(P + (size_t)tok * PG + 512 + h * 128 + part * 8); }
        if (tid < 256) ((LAS f32x4*)(lds + GL_GLR))[tid] = ((const f32x4*)(glr + (size_t)row0 * 16))[tid];
#pragma unroll
        for (int i = 0; i < 4; ++i) { const int p = tid + 512 * i, tok = p >> 5, part = p & 31;
            *(LAS v4u*)(lds + GL_VS + tok * 528 + part * 16) = *(const v4u*)(P + (size_t)tok * PG + 1024 + h * 256 + part * 8); }
        float w2r[16];
#pragma unroll
        for (int r = 0; r < 16; ++r) w2r[r] = a.gate_w2[r * 512 + h * 128 + d];
        const float bias = a.gate_b[h * 128 + d];
        __syncthreads();
        float cum[16]; float run = 0.f;
#pragma unroll
        for (int i = 0; i < 16; ++i) { const int t = tg * 16 + i; const LAS f32x4* gp = (const LAS f32x4*)(lds + GL_GLR + t * 64);
            const f32x4 g0 = gp[0], g1 = gp[1], g2 = gp[2], g3 = gp[3];
            float lo = bias;
            lo += g0[0] * w2r[0] + g0[1] * w2r[1] + g0[2] * w2r[2] + g0[3] * w2r[3];
            lo += g1[0] * w2r[4] + g1[1] * w2r[5] + g1[2] * w2r[6] + g1[3] * w2r[7];
            lo += g2[0] * w2r[8] + g2[1] * w2r[9] + g2[2] * w2r[10] + g2[3] * w2r[11];
            lo += g3[0] * w2r[12] + g3[1] * w2r[13] + g3[2] * w2r[14] + g3[3] * w2r[15];
            const float ls = fminf(lo, 0.f) - __logf(1.0f + __expf(-fabsf(lo)));
            run += ls * (1.0f / 16.0f); cum[i] = run; }
        ((LAS float*)(lds + GL_CUMX))[tg * 128 + d] = run;
        __syncthreads();
        float prefix = 0.f, last = 0.f;
#pragma unroll
        for (int g = 0; g < 4; ++g) { const float v = ((LAS float*)(lds + GL_CUMX))[g * 128 + d]; last += v; if (g < tg) prefix += v; }
        unsigned ktp[8];
#pragma unroll
        for (int i = 0; i < 16; ++i) { const int t = tg * 16 + i; const float cm = cum[i] + prefix; const float q = bf2f(*(const LAS unsigned short*)(lds + GL_QS + t * 272 + d * 2)), k = bf2f(*(const LAS unsigned short*)(lds + GL_KS + t * 272 + d * 2));
            const float qp = q * __expf(cm) * 0.08838834764831845f, kp = k * __expf(-cm), kpp = k * __expf(last - cm);
            const unsigned qb = pk2(qp, 0.f) & 0xffffu;
            *(LAS unsigned short*)(lds + GL_QS + t * 272 + d * 2) = (unsigned short)qb;
            *(LAS unsigned short*)(lds + GL_KS + t * 272 + d * 2) = (unsigned short)(pk2(kp, 0.f) & 0xffffu);
            const unsigned kb = pk2(kpp, 0.f) & 0xffffu;
            if (i & 1) ktp[i >> 1] |= kb << 16; else ktp[i >> 1] = kb; }
        { v4u w0, w1; w0.x = ktp[0]; w0.y = ktp[1]; w0.z = ktp[2]; w0.w = ktp[3]; w1.x = ktp[4]; w1.y = ktp[5]; w1.z = ktp[6]; w1.w = ktp[7];
          *(LAS v4u*)(lds + GL_KT + d * 144 + tg * 32) = w0; *(LAS v4u*)(lds + GL_KT + d * 144 + tg * 32 + 16) = w1; }
        if (tg == 0) gamma[(size_t)unit * 128 + d] = __expf(last);
        __syncthreads();
#pragma unroll
        for (int i = 0; i < 2; ++i) { const int p = tid + 512 * i, tok = p >> 4, part = p & 15;
            *(v4u*)(Qp + (size_t)(row0 + tok) * 512 + h * 128 + part * 8) = *(const LAS v4u*)(lds + GL_QS + tok * 272 + part * 16); }
        { const int it = wave >> 1;
#pragma unroll
          for (int jj = 0; jj < 2; ++jj) { const int jt = (wave & 1) * 2 + jj; f32x4 acc = {0.f, 0.f, 0.f, 0.f};
#pragma unroll
            for (int ks = 0; ks < 4; ++ks) { const bf16x8 ka = *(const LAS bf16x8*)(lds + GL_KS + (16 * jt + l15) * 272 + (32 * ks + 8 * quad) * 2);
                const bf16x8 qb = *(const LAS bf16x8*)(lds + GL_QS + (16 * it + l15) * 272 + (32 * ks + 8 * quad) * 2); acc = mfma16(ka, qb, acc); }
            const int i = 16 * it + l15, j0 = 16 * jt + 4 * quad;
            v2u w; w.x = pk2(j0 + 0 <= i ? acc[0] : 0.f, j0 + 1 <= i ? acc[1] : 0.f); w.y = pk2(j0 + 2 <= i ? acc[2] : 0.f, j0 + 3 <= i ? acc[3] : 0.f);
            *(LAS v2u*)(lds + GL_AT + i * 144 + j0 * 2) = w; } }
        __syncthreads();
#pragma unroll 1
        for (int dd = 0; dd < 2; ++dd) { const int dvt = 2 * wave + dd;
            bf16x8 VF[2];
#pragma unroll
            for (int ks = 0; ks < 2; ++ks) { unsigned short e[8];
#pragma unroll
                for (int q = 0; q < 8; ++q) e[q] = *(const LAS unsigned short*)(lds + GL_VS + (32 * ks + 8 * quad + q) * 528 + (16 * dvt + l15) * 2);
                v4u t; t.x = e[0] | ((unsigned)e[1] << 16); t.y = e[2] | ((unsigned)e[3] << 16); t.z = e[4] | ((unsigned)e[5] << 16); t.w = e[6] | ((unsigned)e[7] << 16);
                VF[ks] = __builtin_bit_cast(bf16x8, t); }
#pragma unroll
            for (int it = 0; it < 4; ++it) { f32x4 acc = {0.f, 0.f, 0.f, 0.f};
#pragma unroll
                for (int ks = 0; ks < 2; ++ks) acc = mfma16(VF[ks], *(const LAS bf16x8*)(lds + GL_AT + (16 * it + l15) * 144 + (32 * ks + 8 * quad) * 2), acc);
                v2u w; w.x = pk2(acc[0], acc[1]); w.y = pk2(acc[2], acc[3]);
                *(v2u*)(OI + (size_t)(row0 + 16 * it + l15) * 1024 + h * 256 + 16 * dvt + 4 * quad) = w; }
#pragma unroll
            for (int R = 0; R < 8; ++R) { f32x4 acc = {0.f, 0.f, 0.f, 0.f};
#pragma unroll
                for (int ks = 0; ks < 2; ++ks) acc = mfma16(*(const LAS bf16x8*)(lds + GL_KT + (16 * R + l15) * 144 + (32 * ks + 8 * quad) * 2), VF[ks], acc);
                v2u w; w.x = pk2(acc[0], acc[1]); w.y = pk2(acc[2], acc[3]);
                *(v2u*)(Lg + ((size_t)(unit * 16 + dvt) * 8 + R) * 256 + lane * 4) = w; }
        }
        __syncthreads();
    }
}

constexpr int CH_L = 0, CH_Q = 4096, CH_G = 20480, CH_O = 20992, CH_STAGE = 23040;
struct ChReg { v4u l, q0, q1, q2, q3, x; };
__device__ __forceinline__ void ch_load(ChReg& r, const bf16* Lg, const float* gamma, const bf16* Qp, const bf16* OI, int unit, int dvt, int row0, int h, int lt) {
    r.l = *(const v4u*)(Lg + ((size_t)(unit * 16 + dvt) * 8) * 256 + lt * 8);
    const int rr = lt >> 4, j = (lt & 15) ^ rr;
    const bf16* qb = Qp + (size_t)(row0 + rr) * 512 + h * 128 + j * 8;
    r.q0 = *(const v4u*)(qb); r.q1 = *(const v4u*)(qb + 16 * 512); r.q2 = *(const v4u*)(qb + 32 * 512); r.q3 = *(const v4u*)(qb + 48 * 512);
    if (lt < 32) r.x = *(const v4u*)(gamma + (size_t)unit * 128 + lt * 4);
    else if (lt >= 128) { const int go = lt - 128; r.x = *(const v4u*)(OI + (size_t)(row0 + (go >> 1)) * 1024 + h * 256 + 16 * dvt + (go & 1) * 8); }
}
__device__ __forceinline__ void ch_store(const ChReg& r, LAS unsigned char* st, int lt) {
    *(LAS v4u*)(st + CH_L + lt * 16) = r.l;
    *(LAS v4u*)(st + CH_Q + lt * 16) = r.q0; *(LAS v4u*)(st + CH_Q + (lt + 256) * 16) = r.q1; *(LAS v4u*)(st + CH_Q + (lt + 512) * 16) = r.q2; *(LAS v4u*)(st + CH_Q + (lt + 768) * 16) = r.q3;
    if (lt < 32) *(LAS v4u*)(st + CH_G + lt * 16) = r.x; else if (lt >= 128) *(LAS v4u*)(st + CH_O + (lt - 128) * 16) = r.x;
}
__device__ __forceinline__ void gla_chain_phase(const Args& a, LAS unsigned char* lds, int tid, int lane, int wave, int G, int st_en) {
    asm volatile("" : "+v"(tid), "+v"(lane));
    unsigned char* ws = a.ws;
    const bf16* Qp = (const bf16*)(ws + WS_QP); bf16* OI = (bf16*)(ws + WS_OI); const bf16* Lg = (const bf16*)(ws + WS_L); const float* gamma = (const float*)(ws + WS_GAMMA); float* SS = (float*)(ws + WS_SS);
    const int l15 = lane & 15, quad = lane >> 4, lt = tid - 256, it = wave;
    const int vcu = (G % 8 == 0) ? ((int)blockIdx.x % 8) * (G / 8) + (int)blockIdx.x / 8 : (int)blockIdx.x;
    for (int item = vcu; item < 256; item += G) {
        const int bh = item >> 4, dvt = item & 15, b = bh >> 2, h = bh & 3, unit0 = bh * 64, rowb = b * SEQ;
        if (wave >= 4) {
            ChReg r0, r1, r2, r3, r4, r5, r6, r7;
#define CH_LD(rr, st) ch_load(rr, Lg, gamma, Qp, OI, unit0 + (st), dvt, rowb + (st) * 64, h, lt)
            CH_LD(r0, 0); CH_LD(r1, 1); ch_store(r0, lds, lt); ch_store(r1, lds + CH_STAGE, lt);
            CH_LD(r0, 2); CH_LD(r1, 3); CH_LD(r2, 4); CH_LD(r3, 5); CH_LD(r4, 6); CH_LD(r5, 7); CH_LD(r6, 8); CH_LD(r7, 9);
            __syncthreads();
#pragma unroll 1
            for (int q = 0; q < 8; ++q) {
#pragma unroll
                for (int j = 0; j < 4; ++j) {
                    const int sI = 4 * q + j, c0 = 2 * sI + 2, c1 = 2 * sI + 3;
                    const int n0 = (c0 + 8 < 64) ? c0 + 8 : 63, n1 = (c1 + 8 < 64) ? c1 + 8 : 63;
                    LAS unsigned char* s0 = lds + (c0 & 3) * CH_STAGE; LAS unsigned char* s1 = lds + (c1 & 3) * CH_STAGE;
#define CH_ROT2(ra, rb) do { ch_store(ra, s0, lt); ch_store(rb, s1, lt); CH_LD(ra, n0); CH_LD(rb, n1); } while (0)
                    if (j == 0) CH_ROT2(r0, r1); else if (j == 1) CH_ROT2(r2, r3); else if (j == 2) CH_ROT2(r4, r5); else CH_ROT2(r6, r7);
#undef CH_ROT2
                    __syncthreads();
                }
            }
#undef CH_LD
        } else {
            f32x4 S[8];
#pragma unroll
            for (int R = 0; R < 8; ++R) S[R] = (f32x4){0.f, 0.f, 0.f, 0.f};
            __syncthreads();
#pragma unroll 1
            for (int c2 = 0; c2 < 32; ++c2) {
#pragma unroll
              for (int u2 = 0; u2 < 2; ++u2) { const int c = 2 * c2 + u2;
                const LAS unsigned char* st = lds + (c & 3) * CH_STAGE;
                const int r = 16 * it + l15; const int row = rowb + c * 64 + r;
                f32x4 acc = {0.f, 0.f, 0.f, 0.f};
#pragma unroll
                for (int ks = 0; ks < 4; ++ks) { const int jq = 4 * ks + (quad >> 1), sub = (quad & 1) * 8;
                    const v2u qlo = *(const LAS v2u*)(st + CH_Q + r * 256 + ((jq ^ l15) << 4) + sub), qhi = *(const LAS v2u*)(st + CH_Q + r * 256 + (((jq + 2) ^ l15) << 4) + sub);
                    v4u sa; sa.x = pk2(S[2 * ks][0], S[2 * ks][1]); sa.y = pk2(S[2 * ks][2], S[2 * ks][3]); sa.z = pk2(S[2 * ks + 1][0], S[2 * ks + 1][1]); sa.w = pk2(S[2 * ks + 1][2], S[2 * ks + 1][3]);
                    acc = mfma16(__builtin_bit_cast(bf16x8, sa), mk8(qlo, qhi), acc); }
                const v2u oi = *(const LAS v2u*)(st + CH_O + r * 32 + quad * 8);
                const float o0 = acc[0] + bflo(oi.x), o1 = acc[1] + bfhi(oi.x), o2 = acc[2] + bflo(oi.y), o3 = acc[3] + bfhi(oi.y);
                v2u w; w.x = pk2(o0, o1); w.y = pk2(o2, o3);
                if (st_en) *(v2u*)(OI + (size_t)row * 1024 + h * 256 + 16 * dvt + 4 * quad) = w;
                float s = (o0 * o0 + o1 * o1) + (o2 * o2 + o3 * o3); s += __shfl_xor(s, 16); s += __shfl_xor(s, 32);
                if (quad == 0 && st_en) SS[(size_t)row * 64 + h * 16 + dvt] = s;
#pragma unroll
                for (int R = 0; R < 8; ++R) { const v2u Lr = *(const LAS v2u*)(st + CH_L + R * 512 + lane * 8); const f32x4 gm = *(const LAS f32x4*)(st + CH_G + (16 * R + 4 * quad) * 4);
                    S[R][0] = gm[0] * S[R][0] + bflo(Lr.x); S[R][1] = gm[1] * S[R][1] + bfhi(Lr.x); S[R][2] = gm[2] * S[R][2] + bflo(Lr.y); S[R][3] = gm[3] * S[R][3] + bfhi(Lr.y); }
              }
                __syncthreads();
            }
        }
    }
}

constexpr int ATS_V = 16384, ATS_SLOT = 32768;
struct AtUnit { int b, h, dsh, r, qt; };
__device__ __forceinline__ AtUnit at_decode(int unit) { AtUnit U; const int u = unit & 31, hb = unit >> 5; U.h = hb % 24; U.b = hb / 24; U.dsh = 2 * (U.h >> 3); const int ntc = 32 >> U.dsh; U.r = u / ntc; U.qt = u - U.r * ntc; return U; }
__device__ __forceinline__ const bf16* at_qbase(const bf16* PROJ, const AtUnit& U) { return PROJ + ((size_t)(U.b * 24 + U.h) * 4096 + ((size_t)U.r << (12 - U.dsh))) * 64; }
__device__ __forceinline__ void at_dma_chunk(const bf16* PROJ, const AtUnit& U, int c, LAS unsigned char* slot, int wave, int lane) {
    constexpr size_t WHICH = (size_t)T * 1536;
    const bf16* Pb = at_qbase(PROJ, U) + (size_t)c * 128 * 64;
    const int rl = lane >> 3, j = (lane & 7) ^ rl;
#pragma unroll
    for (int i = 0; i < 2; ++i) { const int rb = wave + 8 * i; const bf16* src = Pb + (size_t)(rb * 8 + rl) * 64 + j * 8;
        __builtin_amdgcn_global_load_lds((const unsigned*)(src + WHICH), (LAS unsigned*)(slot + rb * 1024), 16, 0, 0);
        __builtin_amdgcn_global_load_lds((const unsigned*)(src + 2 * WHICH), (LAS unsigned*)(slot + ATS_V + rb * 1024), 16, 0, 0); }
}
__device__ __forceinline__ void attn_phase(const Args& a, LAS unsigned char* lds, int tid, int lane, int wave, int G) {
    asm volatile("" : "+v"(tid), "+v"(lane));
    unsigned char* ws = a.ws; const bf16* PROJ = (const bf16*)(ws + WS_PROJA);
    bf16* OG = (bf16*)(ws + WS_OG); float* ML = (float*)(ws + WS_ML);
    const int l15 = lane & 15, quad = lane >> 4, w = wave;
    const int vcu = (G % 8 == 0) ? ((int)blockIdx.x % 8) * (G / 8) + (int)blockIdx.x / 8 : (int)blockIdx.x;
    const int tpb = (3072 + G - 1) / G, t0 = vcu * tpb, t1 = (t0 + tpb < 3072) ? t0 + tpb : 3072;
    bf16x8 QB[2];
    if (t0 < t1) { const AtUnit U = at_decode(t0);
        if (U.qt > 0) at_dma_chunk(PROJ, U, U.qt - 1, lds + ((t0 + 2) % 3) * ATS_SLOT, wave, lane);
        at_dma_chunk(PROJ, U, U.qt, lds + (t0 % 3) * ATS_SLOT, wave, lane);
        const bf16* qp = at_qbase(PROJ, U) + (size_t)(128 * U.qt + 16 * w + l15) * 64 + 8 * quad; QB[0] = *(const bf16x8*)qp; QB[1] = *(const bf16x8*)(qp + 32); }
    v2u pend[4]; float pmx = 0.f, pl = 0.f; size_t prow = 0; int ph = 0; bool have = false;
    for (int unit = t0; unit < t1; ++unit) {
        const AtUnit U = at_decode(unit);
        const int sc = unit % 3, sp = (U.qt > 0) ? (unit + 2) % 3 : sc;
        asm volatile("s_waitcnt vmcnt(0)" ::: "memory");
        __syncthreads();
        if (have) {
#pragma unroll
            for (int dt = 0; dt < 4; ++dt) *(v2u*)(OG + prow * 1536 + ph * 64 + 16 * dt + 4 * quad) = pend[dt];
            if (quad == 0) { v2u mlv; mlv.x = __float_as_uint(pmx); mlv.y = __float_as_uint(pl); *(v2u*)(ML + prow * 48 + ph * 2) = mlv; } }
        const bf16x8 q0 = QB[0], q1 = QB[1];
        if (unit + 1 < t1) { const AtUnit Un = at_decode(unit + 1); at_dma_chunk(PROJ, Un, Un.qt, lds + ((unit + 1) % 3) * ATS_SLOT, wave, lane);
            const bf16* qp = at_qbase(PROJ, Un) + (size_t)(128 * Un.qt + 16 * w + l15) * 64 + 8 * quad; QB[0] = *(const bf16x8*)qp; QB[1] = *(const bf16x8*)(qp + 32); }
        {
            const int qt = U.qt;
            const LAS unsigned char* bp = lds + sp * ATS_SLOT; const LAS unsigned char* bc = lds + sc * ATS_SLOT;
            f32x4 ST[9]; float mx = -INFINITY;
#pragma unroll
            for (int Tt = 0; Tt < 9; ++Tt) { f32x4 acc = {0.f, 0.f, 0.f, 0.f}; const int kr = ((16 * (w + Tt)) & 127) + l15; const LAS unsigned char* kb = (w + Tt >= 8) ? bc : bp;
                acc = mfma16(*(const LAS bf16x8*)(kb + kr * 128 + (((0 + quad) ^ (kr & 7)) << 4)), q0, acc);
                acc = mfma16(*(const LAS bf16x8*)(kb + kr * 128 + (((4 + quad) ^ (kr & 7)) << 4)), q1, acc);
#pragma unroll
                for (int e = 0; e < 4; ++e) { const int kk = 4 * quad + e; bool valid = true; if (Tt == 0) valid = kk >= l15; if (Tt == 8) valid = kk <= l15;
                    if (qt == 0) valid = valid && (w + Tt >= 8);
                    acc[e] = valid ? acc[e] : -INFINITY; mx = fmaxf(mx, acc[e]); }
                ST[Tt] = acc; }
            mx = fmaxf(mx, __shfl_xor(mx, 16)); mx = fmaxf(mx, __shfl_xor(mx, 32));
            float l = 0.f;
#pragma unroll
            for (int Tt = 0; Tt < 9; ++Tt)
#pragma unroll
                for (int e = 0; e < 4; ++e) { const float pv = __builtin_amdgcn_exp2f(ST[Tt][e] - mx); ST[Tt][e] = pv; l += pv; }
            l += __shfl_xor(l, 16); l += __shfl_xor(l, 32);
            f32x4 O[4];
#pragma unroll
            for (int dt = 0; dt < 4; ++dt) O[dt] = (f32x4){0.f, 0.f, 0.f, 0.f};
#pragma unroll
            for (int pr = 0; pr < 5; ++pr) { const int T1 = 2 * pr, T2 = (2 * pr + 1 < 9) ? 2 * pr + 1 : 8;
                v4u pf; pf.x = pk2(ST[T1][0], ST[T1][1]); pf.y = pk2(ST[T1][2], ST[T1][3]);
                if (pr < 4) { pf.z = pk2(ST[T2][0], ST[T2][1]); pf.w = pk2(ST[T2][2], ST[T2][3]); } else { pf.z = 0u; pf.w = 0u; }
                const int k1 = ((16 * (w + T1)) & 127) + 4 * quad + (l15 >> 2), k2 = ((16 * (w + T2)) & 127) + 4 * quad + (l15 >> 2);
                const LAS unsigned char* v1 = ((w + T1 >= 8) ? bc : bp) + ATS_V; const LAS unsigned char* v2 = ((w + T2 >= 8) ? bc : bp) + ATS_V;
#pragma unroll
                for (int dt = 0; dt < 4; ++dt) {
                    const int jv = 2 * dt + ((l15 & 3) >> 1), sub = (l15 & 1) * 8;
                    const s16x4 lo = __builtin_amdgcn_ds_read_tr16_b64_v4i16((LAS s16x4*)(v1 + k1 * 128 + ((jv ^ (k1 & 7)) << 4) + sub));
                    const s16x4 hi = (pr < 4) ? __builtin_amdgcn_ds_read_tr16_b64_v4i16((LAS s16x4*)(v2 + k2 * 128 + ((jv ^ (k2 & 7)) << 4) + sub)) : lo;
                    bf16x8 av; av[0] = lo[0]; av[1] = lo[1]; av[2] = lo[2]; av[3] = lo[3]; av[4] = hi[0]; av[5] = hi[1]; av[6] = hi[2]; av[7] = hi[3];
                    O[dt] = mfma16(av, __builtin_bit_cast(bf16x8, pf), O[dt]); } }
            const float inv = 1.0f / l;
            const int tokq = ((128 * qt + 16 * w + l15) << U.dsh) + U.r; const size_t trow = (size_t)U.b * SEQ + tokq;
#pragma unroll
            for (int dt = 0; dt < 4; ++dt) { pend[dt].x = pk2(O[dt][0] * inv, O[dt][1] * inv); pend[dt].y = pk2(O[dt][2] * inv, O[dt][3] * inv); }
            pmx = mx; pl = l; prow = trow; ph = U.h; have = true;
        }
    }
    if (have) {
#pragma unroll
        for (int dt = 0; dt < 4; ++dt) *(v2u*)(OG + prow * 1536 + ph * 64 + 16 * dt + 4 * quad) = pend[dt];
        if (quad == 0) { v2u mlv; mlv.x = __float_as_uint(pmx); mlv.y = __float_as_uint(pl); *(v2u*)(ML + prow * 48 + ph * 2) = mlv; } }
    asm volatile("s_waitcnt vmcnt(0)" ::: "memory"); __syncthreads();
}
__device__ __forceinline__ void prep_a_phase(const Args& a, int tid, int G) {
    asm volatile("" : "+v"(tid));
    unsigned char* ws = a.ws; const bf16* OG = (const bf16*)(ws + WS_OG); const float* ML = (const float*)(ws + WS_ML); const bf16* ZA = (const bf16*)(ws + WS_ZA);
    bf16* AA = (bf16*)(ws + WS_AA);
    for (int p = blockIdx.x * 512 + tid; p < T * 64; p += G * 512) { const int t = p >> 6, col = (p & 63) * 8, s = col >> 6, dc = col & 63;
        v4u o[3]; float m[3], l[3];
#pragma unroll
        for (int g = 0; g < 3; ++g) { const int hh = 8 * g + s; o[g] = *(const v4u*)(OG + (size_t)t * 1536 + hh * 64 + dc); m[g] = ML[(size_t)t * 48 + hh * 2]; l[g] = ML[(size_t)t * 48 + hh * 2 + 1]; }
        const float M = fmaxf(m[0], fmaxf(m[1], m[2]));
        float w0 = l[0] * __builtin_amdgcn_exp2f(m[0] - M), w1 = l[1] * __builtin_amdgcn_exp2f(m[1] - M), w2 = l[2] * __builtin_amdgcn_exp2f(m[2] - M);
        const float iw = 1.0f / (w0 + w1 + w2); w0 *= iw; w1 *= iw; w2 *= iw;
        const v4u z8 = *(const v4u*)(ZA + (size_t)t * 512 + col);
        v4u w;
        w.x = pk2((w0 * bflo(o[0].x) + w1 * bflo(o[1].x) + w2 * bflo(o[2].x)) * siluf_(bflo(z8.x)), (w0 * bfhi(o[0].x) + w1 * bfhi(o[1].x) + w2 * bfhi(o[2].x)) * siluf_(bfhi(z8.x)));
        w.y = pk2((w0 * bflo(o[0].y) + w1 * bflo(o[1].y) + w2 * bflo(o[2].y)) * siluf_(bflo(z8.y)), (w0 * bfhi(o[0].y) + w1 * bfhi(o[1].y) + w2 * bfhi(o[2].y)) * siluf_(bfhi(z8.y)));
        w.z = pk2((w0 * bflo(o[0].z) + w1 * bflo(o[1].z) + w2 * bflo(o[2].z)) * siluf_(bflo(z8.z)), (w0 * bfhi(o[0].z) + w1 * bfhi(o[1].z) + w2 * bfhi(o[2].z)) * siluf_(bfhi(z8.z)));
        w.w = pk2((w0 * bflo(o[0].w) + w1 * bflo(o[1].w) + w2 * bflo(o[2].w)) * siluf_(bflo(z8.w)), (w0 * bfhi(o[0].w) + w1 * bfhi(o[1].w) + w2 * bfhi(o[2].w)) * siluf_(bfhi(z8.w)));
        *(v4u*)(AA + (size_t)t * 512 + col) = w; }
}


#ifndef REP_MASK
#define REP_MASK 0
#endif
#ifndef DBG_STOP
#define DBG_STOP 0
#endif
#if DBG_STOP
__device__ __forceinline__ float dbg_san(float v) { return (fabsf(v) < 1e30f) ? v : 777.0f; }
__device__ __forceinline__ float dbg_sum_bf16(const void* p, size_t bytes, int gtid, int NT) { const unsigned* q = (const unsigned*)p; float s = 0.f; for (size_t i = gtid; i < bytes / 4; i += NT) { const unsigned w = q[i]; s += dbg_san(bflo(w)) + dbg_san(bfhi(w)); } return s; }
__device__ __forceinline__ float dbg_sum_f32(const void* p, size_t bytes, int gtid, int NT) { const float* q = (const float*)p; float s = 0.f; for (size_t i = gtid; i < bytes / 4; i += NT) s += dbg_san(q[i]); return s; }
#define DBG_DUMP(k, NS, ...) if (DBG_STOP == (k)) { const int gtid_ = blockIdx.x * 512 + tid, NT_ = G * 512; float sv_[NS] = { __VA_ARGS__ }; GRID_SYNC(); \
    for (size_t i = gtid_; i < (size_t)T * D; i += NT_) args.out[i] = 0.f; _Pragma("unroll") for (int q_ = 0; q_ < NS; ++q_) args.out[(size_t)q_ * NT_ + gtid_] = sv_[q_]; return; }
#define SB(off, mib) dbg_sum_bf16(ws + (off), (size_t)(mib) * MiB, gtid_, NT_)
#define SF(off, mib) dbg_sum_f32(ws + (off), (size_t)(mib) * MiB, gtid_, NT_)
#else
#define DBG_DUMP(k, NS, ...)
#endif
typedef __attribute__((address_space(1))) unsigned gu32;
#define XB_TMO      128
#define XB_XCNT(j)  (256  + 64 * (j))
#define XB_XSUB(j)  (1280 + 64 * (j))
#define XB_XGEN(j)  (2304 + 64 * (j))
#define XB_TOP      3328
#define XB_TOPGEN   3392
#define XCD_BAR_WORDS 3456
#define XB_SPIN_CAP (1u << 18)

__device__ __forceinline__ unsigned xb_ld(unsigned* p)              { return __hip_atomic_load(p, __ATOMIC_RELAXED, __HIP_MEMORY_SCOPE_AGENT); }
__device__ __forceinline__ unsigned xb_add(unsigned* p, unsigned v) { return __hip_atomic_fetch_add(p, v, __ATOMIC_RELAXED, __HIP_MEMORY_SCOPE_AGENT); }
__device__ __forceinline__ unsigned xb_xcc_id() { return (unsigned)__builtin_amdgcn_s_getreg((3 << 11) | 20) & 0xFu; }
#define XB_SPIN(cond, bar) do { unsigned _sp = 0; while (cond) { __builtin_amdgcn_s_sleep(1); \
    if ((++_sp & 255u) == 0u) { if (xb_ld(&(bar)[XB_TMO])) break; if (_sp > XB_SPIN_CAP) { atomicAdd(&(bar)[XB_TMO], 1u); break; } } } } while (0)

struct XcdBarrier {
    unsigned* bar; unsigned x;
    volatile LAS unsigned* st;
};

__device__ __forceinline__ XcdBarrier xcd_barrier_post(unsigned* bar, volatile LAS unsigned* st) {
    XcdBarrier b; b.bar = bar; b.x = xb_xcc_id(); b.st = st;
    if (threadIdx.x == 0) (void)xb_add(&bar[XB_XCNT(b.x)], 1u);
    return b;
}
__device__ __forceinline__ void xcd_barrier_complete(unsigned* bar, unsigned x, unsigned& nloc, unsigned& nx) {
    const unsigned G = gridDim.x * gridDim.y * gridDim.z;
    unsigned sum, cnt, mine, sp = 0u;
    for (;;) {
        sum = 0u; cnt = 0u; mine = 0u;
#pragma unroll
        for (unsigned j = 0; j < 16; ++j) { const unsigned c = xb_ld(&bar[XB_XCNT(j)]); sum += c; cnt += (c > 0u) ? 1u : 0u; mine = (j == x) ? c : mine; }
        if (sum == G) break;
        __builtin_amdgcn_s_sleep(1);
        if ((++sp & 255u) == 0u) { if (xb_ld(&bar[XB_TMO])) break; if (sp > XB_SPIN_CAP) { atomicAdd(&bar[XB_TMO], 1u); break; } }
    }
    nloc = mine > 0u ? mine : 1u; nx = cnt > 0u ? cnt : 1u;
}

__device__ __forceinline__ void xcd_barrier(const XcdBarrier& b) {
    asm volatile("s_waitcnt vmcnt(0)" ::: "memory");
    __syncthreads();
    if (threadIdx.x == 0) {
        unsigned* bar = b.bar;
        __builtin_amdgcn_s_waitcnt(0);
        unsigned nloc = b.st[0], nx = b.st[1];
        if (nloc == 0u) { xcd_barrier_complete(bar, b.x, nloc, nx); b.st[0] = nloc; b.st[1] = nx; }
        const unsigned old = xb_add(&bar[XB_XSUB(b.x)], 1u);
        const unsigned gen = old / nloc;
        if (old + 1u == (gen + 1u) * nloc) {
            __builtin_amdgcn_fence(__ATOMIC_RELEASE, "agent");
            asm volatile("s_waitcnt vmcnt(0)" ::: "memory");
            const unsigned og = xb_add(&bar[XB_TOP], 1u);
            const unsigned tg = og / nx;
            if (og + 1u == (tg + 1u) * nx) xb_add(&bar[XB_TOPGEN], 1u);
            else XB_SPIN(xb_ld(&bar[XB_TOPGEN]) == tg, bar);
            __builtin_amdgcn_fence(__ATOMIC_ACQUIRE, "agent");
            xb_add(&bar[XB_XGEN(b.x)], 1u);
            asm volatile("s_waitcnt vmcnt(0)" ::: "memory");
        } else {
            XB_SPIN(xb_ld(&bar[XB_XGEN(b.x)]) == gen, bar);
            __builtin_amdgcn_fence(__ATOMIC_ACQUIRE, "agent");
            asm volatile("s_waitcnt vmcnt(0)" ::: "memory");
        }
    }
    __syncthreads();
}


__device__ __forceinline__ void panel_handoff(unsigned* cnt, int pm, unsigned want) {
    asm volatile("s_waitcnt vmcnt(0)" ::: "memory");
    __syncthreads();
    if (threadIdx.x == 0) {
        unsigned* c = cnt + 64 * pm;
        __hip_atomic_fetch_add(c, 1u, __ATOMIC_RELAXED, __HIP_MEMORY_SCOPE_AGENT);
        unsigned sp = 0;
        while (__hip_atomic_load(c, __ATOMIC_RELAXED, __HIP_MEMORY_SCOPE_AGENT) < want) { __builtin_amdgcn_s_sleep(1); if (++sp > (1u << 22)) break; }
        __builtin_amdgcn_fence(__ATOMIC_ACQUIRE, "agent");
        asm volatile("s_waitcnt vmcnt(0)" ::: "memory");
    }
    __syncthreads();
}
#define GRID_SYNC_CG() do { asm volatile("s_waitcnt vmcnt(0) lgkmcnt(0)" ::: "memory"); grid.sync(); __builtin_amdgcn_fence(__ATOMIC_ACQUIRE, "agent"); asm volatile("s_waitcnt vmcnt(0)" ::: "memory"); } while (0)
#define GRID_SYNC() xcd_barrier(xbar)
__global__ void __launch_bounds__(NWAVES * 64, 2) mega_fwd(Args args) {
    extern __shared__ __attribute__((aligned(16))) unsigned char lds_raw[];
    LAS unsigned char* lds = (LAS unsigned char*)lds_raw;
    cg::grid_group grid = cg::this_grid();
    const int tid = threadIdx.x, lane = tid & 63, wave = __builtin_amdgcn_readfirstlane(tid >> 6), G = gridDim.x;
    unsigned char* ws = args.ws;
    if (tid < 32) ((LAS unsigned*)(lds + MISC_OFF))[tid] = 0u;
    __syncthreads();
    const XcdBarrier xbar = xcd_barrier_post((unsigned*)(ws + WS_BAR), (volatile LAS unsigned*)(lds + MISC_OFF) + 8);
    const pg8::bf16_t* hb = (const pg8::bf16_t*)args.out;
    const pg8::bf16_t* AB = (const pg8::bf16_t*)args.out + (size_t)T * 1024;

#if REP_MASK & 32
    for (int q_ = 0; q_ < 10; ++q_) { GRID_SYNC(); }
#endif
    phase0(args, lds, tid, lane, wave, G);
#if REP_MASK & 1
    phase0(args, lds, tid, lane, wave, G);
#endif
    if (args.zero) { GRID_SYNC_CG(); }
    GRID_SYNC();
    glr_step(args, lane, wave, G);
    { pg8::Gemm g{hb, hb, hb, (const pg8::bf16_t*)(ws + WS_W1G), (const pg8::bf16_t*)(ws + WS_W1G), (const pg8::bf16_t*)(ws + WS_W1G), 16, 16, 16, 1024, 1024};
      pg8::SegOrder S; S.init(T, PG, G, (int)blockIdx.x, 1); pg8::EpiBf16 E{(pg8::bf16_t*)(ws + WS_PROJG), PG};
      pg8::gemm_phase<pg8::EpiBf16, pg8::SegOrder, true, true>(lds, g, S, E); }
#if REP_MASK & 128
    { pg8::Gemm g{hb, hb, hb, (const pg8::bf16_t*)(ws + WS_W1G), (const pg8::bf16_t*)(ws + WS_W1G), (const pg8::bf16_t*)(ws + WS_W1G), 16, 16, 16, 1024, 1024};
      pg8::SegOrder S; S.init(T, PG, G, (int)blockIdx.x, 1); pg8::EpiBf16 E{(pg8::bf16_t*)(ws + WS_PROJG), PG};
      pg8::gemm_phase<pg8::EpiBf16, pg8::SegOrder, true, true>(lds, g, S, E); }
#endif
    GRID_SYNC();
    DBG_DUMP(2, 7, SB(WS_W1A, 10), SB(WS_W1G, 6), SB(WS_WGT, 4), SF(WS_ROT, 1), dbg_sum_bf16(args.out, 32 * MiB, gtid_, NT_), SF(WS_GLR, 1), SB(WS_PROJG, 96))
    gla_local_phase(args, lds, tid, lane, wave, G);
#if REP_MASK & 2
    gla_local_phase(args, lds, tid, lane, wave, G);
#endif
    GRID_SYNC();
    DBG_DUMP(3, 4, SB(WS_QP, 16), SB(WS_OI, 32), SB(WS_L, 64), SF(WS_GAMMA, 0.5))
    DBG_DUMP(31, 1, SB(WS_QP, 16))
    DBG_DUMP(32, 1, SB(WS_OI, 32))
    DBG_DUMP(33, 1, SB(WS_L, 64))
    gla_chain_phase(args, lds, tid, lane, wave, G, args.one);
#if REP_MASK & 64
    gla_chain_phase(args, lds, tid, lane, wave, G, args.zero);
#endif
    GRID_SYNC();
    DBG_DUMP(4, 2, SB(WS_OI, 32), SF(WS_SS, 4))
    { pg8::Gemm g{hb, hb, hb, (const pg8::bf16_t*)(ws + WS_W1A), (const pg8::bf16_t*)(ws + WS_W1A), (const pg8::bf16_t*)(ws + WS_W1A), 16, 16, 16, 1024, 1024};
      pg8::SegOrder S; S.init(T, 6144, G, (int)blockIdx.x, 1);
      pg8::EpiQKV E{(pg8::bf16_t*)(ws + WS_PROJA), (pg8::bf16_t*)(ws + WS_ZA), args.gq, args.gk, (const float*)(ws + WS_ROT), EPS, (const pg8::bf16_t*)(ws + WS_OI), (const float*)(ws + WS_SS), args.gla_g, (pg8::bf16_t*)args.out + (size_t)T * 1024};
      pg8::gemm_phase<pg8::EpiQKV, pg8::SegOrder, true, true>(lds, g, S, E); }
#if REP_MASK & 256
    { pg8::Gemm g{hb, hb, hb, (const pg8::bf16_t*)(ws + WS_W1A), (const pg8::bf16_t*)(ws + WS_W1A), (const pg8::bf16_t*)(ws + WS_W1A), 16, 16, 16, 1024, 1024};
      pg8::SegOrder S; S.init(T, 6144, G, (int)blockIdx.x, 1);
      pg8::EpiQKV E{(pg8::bf16_t*)(ws + WS_PROJA), (pg8::bf16_t*)(ws + WS_ZA), args.gq, args.gk, (const float*)(ws + WS_ROT), EPS, (const pg8::bf16_t*)(ws + WS_OI), (const float*)(ws + WS_SS), args.gla_g, (pg8::bf16_t*)args.out + (size_t)T * 1024};
      pg8::gemm_phase<pg8::EpiQKV, pg8::SegOrder, true, true>(lds, g, S, E); }
#endif
    GRID_SYNC();
    attn_phase(args, lds, tid, lane, wave, G);
#if REP_MASK & 8
    attn_phase(args, lds, tid, lane, wave, G);
#endif
    GRID_SYNC();
    prep_a_phase(args, tid, G);
#if REP_MASK & 16
    prep_a_phase(args, tid, G);
#endif
    GRID_SYNC();
    DBG_DUMP(8, 4, SB(WS_PROJA, 160), SB(WS_OG, 48), SF(WS_ML, 3), SB(WS_AA, 16))
    { bf16* pb = (bf16*)(ws + WS_PB);
      for (int i = blockIdx.x * 512 + tid; i < T * 256 / 8; i += G * 512) { const f32x4 v0 = ((const f32x4*)args.p)[2 * i], v1 = ((const f32x4*)args.p)[2 * i + 1];
          v4u w; w.x = pk2(v0[0], v0[1]); w.y = pk2(v0[2], v0[3]); w.z = pk2(v1[0], v1[1]); w.w = pk2(v1[2], v1[3]); ((v4u*)pb)[i] = w; } }
    { const pg8::bf16_t* WGT = (const pg8::bf16_t*)(ws + WS_WGT);
      pg8::Gemm g{hb, hb, hb, WGT, WGT + (size_t)1024 * 1024, WGT, 16, 16, 16, 1024, 1024};
      pg8::SegOrder S; S.init(T, 1024, G, (int)blockIdx.x, 2); pg8::EpiSig2 E{(pg8::bf16_t*)(ws + WS_SGA), (pg8::bf16_t*)(ws + WS_SGB), 1024};
      pg8::gemm_phase<pg8::EpiSig2, pg8::SegOrder, true, true>(lds, g, S, E); }
    { const pg8::bf16_t* AA = (const pg8::bf16_t*)(ws + WS_AA); const pg8::bf16_t* WPA = (const pg8::bf16_t*)(ws + WS_WPA);
      pg8::Gemm g{AA, AA, AA, WPA, WPA, WPA, 8, 8, 8, 512, 512};
      pg8::SegOrder S; S.init(T, 1024, G, (int)blockIdx.x, 1); pg8::EpiGateMul E{(const pg8::bf16_t*)(ws + WS_SGA), (pg8::bf16_t*)(ws + WS_T1), 1024};
      pg8::gemm_phase<pg8::EpiGateMul, pg8::SegOrder, true, true>(lds, g, S, E); }
    { const pg8::bf16_t* WPB = (const pg8::bf16_t*)(ws + WS_WPB);
      pg8::Gemm g{AB, AB, AB, WPB, WPB, WPB, 16, 16, 16, 1024, 1024};
      pg8::SegOrder S; S.init(T, 1024, G, (int)blockIdx.x, 1); pg8::EpiMergeY E{(const pg8::bf16_t*)(ws + WS_SGB), (const pg8::bf16_t*)(ws + WS_T1), (pg8::bf16_t*)(ws + WS_Y), 1024};
      pg8::gemm_phase<pg8::EpiMergeY, pg8::SegOrder, true, true>(lds, g, S, E); }
    GRID_SYNC();
    DBG_DUMP(9, 5, SF(WS_TMP1, 64), SF(WS_TMP2, 64), SB(WS_Y, 32), SB(WS_PB, 8), SB(WS_WPA, 7))
    { const pg8::bf16_t* Y = (const pg8::bf16_t*)(ws + WS_Y); const pg8::bf16_t* W = (const pg8::bf16_t*)(ws + WS_WOUT);
      pg8::Gemm g{Y, Y, Y, W, W, W, 16, 16, 16, 1024, 1024};
      pg8::SegOrder S; S.init(T, 1024, G, (int)blockIdx.x, 1); pg8::EpiResid E{args.x, args.out, (pg8::bf16_t*)(ws + WS_X1B), (float*)(ws + WS_PS), 1024};
      pg8::gemm_phase<pg8::EpiResid, pg8::SegOrder, true, true>(lds, g, S, E); }
#if REP_MASK & 1024
    { const pg8::bf16_t* Y = (const pg8::bf16_t*)(ws + WS_Y); const pg8::bf16_t* W = (const pg8::bf16_t*)(ws + WS_WOUT);
      pg8::Gemm g{Y, Y, Y, W, W, W, 16, 16, 16, 1024, 1024};
      pg8::SegOrder S; S.init(T, 1024, G, (int)blockIdx.x, 1); pg8::EpiResid E{args.x, args.out, (pg8::bf16_t*)(ws + WS_X1B), (float*)(ws + WS_PS), 1024};
      pg8::gemm_phase<pg8::EpiResid, pg8::SegOrder, true, true>(lds, g, S, E); }
#endif
    { pg8::SegOrder S; S.init(T, 1024, G, (int)blockIdx.x, 1); pg8::Unit u0;
      if (S.nwg == G && S.next(0, u0)) panel_handoff((unsigned*)(ws + WS_PCNT), u0.pm, 4u); else { GRID_SYNC(); } }
    DBG_DUMP(10, 3, SB(WS_X1B, 32), SF(WS_PS, 1), dbg_sum_f32(args.out, 64 * MiB, gtid_, NT_))
    { const pg8::bf16_t* X1 = (const pg8::bf16_t*)(ws + WS_X1B); const pg8::bf16_t* W = (const pg8::bf16_t*)(ws + WS_WPG);
      pg8::Gemm g{X1, X1, X1, W, W, W, 16, 16, 16, 1024, 1024};
      pg8::SegOrder S; S.init(T, 1024, G, (int)blockIdx.x, 1); pg8::EpiSigRow E{(const float*)(ws + WS_PS), (pg8::bf16_t*)(ws + WS_SGA), 1024, EPS};
      pg8::gemm_phase<pg8::EpiSigRow, pg8::SegOrder, true, true>(lds, g, S, E); }
    { const pg8::bf16_t* PBm = (const pg8::bf16_t*)(ws + WS_PB); const pg8::bf16_t* W = (const pg8::bf16_t*)(ws + WS_WPLE);
      pg8::Gemm g{PBm, PBm, PBm, W, W, W, 4, 4, 4, 256, 256};
      pg8::SegOrder S; S.init(T, 1024, G, (int)blockIdx.x, 1); pg8::EpiPle2 E{args.out, (const pg8::bf16_t*)(ws + WS_SGA), 1024};
      pg8::gemm_phase<pg8::EpiPle2, pg8::SegOrder, true, true>(lds, g, S, E); }
}

extern "C" void kernel_launch(void* const* d_in, const int* in_sizes, int n_in, void* d_out, int out_size, void* d_ws, size_t ws_size, hipStream_t stream) {
    static int grid = 0;
    if (grid == 0) {
        if (n_in != 16 || out_size != T * D || ws_size < WS_END) { fprintf(stderr, "kernel_launch: unexpected shapes (n_in %d out %d ws %zu)\n", n_in, out_size, ws_size); grid = -1; return; }
        int dev = 0, cus = 0, per_cu = 0;
        (void)hipGetDevice(&dev); (void)hipDeviceGetAttribute(&cus, hipDeviceAttributeMultiprocessorCount, dev);
        (void)hipFuncSetAttribute((const void*)mega_fwd, hipFuncAttributeMaxDynamicSharedMemorySize, LDS_BYTES);
        (void)hipOccupancyMaxActiveBlocksPerMultiprocessor(&per_cu, (const void*)mega_fwd, NWAVES * 64, LDS_BYTES);
        if (per_cu < 1) { fprintf(stderr, "kernel_launch: occupancy query says %d blocks per CU\n", per_cu); per_cu = 1; }
        (void)hipGetLastError();
        grid = cus;
    }
    if (grid < 0) return;
    Args a{};
    a.x = (const float*)d_in[0]; a.p = (const float*)d_in[1]; a.pos = (const int*)d_in[2]; a.norm_g = (const float*)d_in[3]; a.w_in = (const float*)d_in[4];
    a.gq = (const float*)d_in[5]; a.gk = (const float*)d_in[6]; a.gate_w2 = (const float*)d_in[7]; a.gate_b = (const float*)d_in[8]; a.gla_g = (const float*)d_in[9];
    a.w_att = (const float*)d_in[10]; a.w_gla = (const float*)d_in[11]; a.w_out = (const float*)d_in[12]; a.ple_g = (const float*)d_in[13]; a.w_pg = (const float*)d_in[14]; a.w_ple = (const float*)d_in[15];
    a.out = (float*)d_out; a.ws = (unsigned char*)d_ws; a.one = 1; a.zero = 0;
    if (hipMemsetAsync((char*)d_ws + WS_BAR, 0, BAR_BYTES, stream) != hipSuccess) { fprintf(stderr, "kernel_launch: memset of barrier words failed\n"); return; }
    void* kargs[] = {&a};
    hipError_t e = hipLaunchCooperativeKernel((const void*)mega_fwd, dim3(grid), dim3(NWAVES * 64), kargs, LDS_BYTES, stream);
    if (e != hipSuccess) fprintf(stderr, "cooperative launch failed: %s (grid %d)\n", hipGetErrorString(e), grid);
}
```

```cpp
#define REP_MASK 0
#define DBG_STOP 0
#include <hip/hip_runtime.h>
#include <hip/hip_cooperative_groups.h>
#include <cstdio>
#include <cstdint>
namespace cg = cooperative_groups;

namespace pg8 {
#define PG8_LAS __attribute__((address_space(3)))
typedef unsigned short bf16_t;
typedef short bf16x8 __attribute__((ext_vector_type(8)));
typedef float f32x4 __attribute__((ext_vector_type(4)));
typedef unsigned u32x4 __attribute__((ext_vector_type(4)));
typedef unsigned u32x2 __attribute__((ext_vector_type(2)));
constexpr int BM = 256, BK = 64, HALF = 128, HTB = HALF * BK * 2  , STAGE_BYTES = 8 * HTB, NXCD = 8, WGM = 8;

__host__ __device__ __forceinline__ int lds_byte(int r, int c) { const int st = (r >> 4) * 2 + (c >> 5), rr = r & 15, cc = c & 31, ob = rr * 64 + cc * 2; return st * 1024 + (ob ^ (((ob >> 9) & 1) << 5)); }
__host__ __device__ __forceinline__ void stage_rc(int b, int& R, int& C) { const int st = b / 1024, sb = b % 1024, swz = sb ^ (((sb >> 9) & 1) << 5); R = (st >> 1) * 16 + swz / 64; C = (st & 1) * 32 + (swz % 64) / 2; }
__host__ __device__ __forceinline__ int perm32(int rho) { const int n = rho >> 4, i = rho & 15; return 8 * (i >> 2) + 4 * n + (i & 3); }

struct Unit { int pm, pn, seg; };
struct Gemm {
    const bf16_t* A0; const bf16_t* A1; const bf16_t* A2; const bf16_t* B0; const bf16_t* B1; const bf16_t* B2; int nt0, nt1, nt2, lda, ldb;
    __device__ __forceinline__ const bf16_t* selA(int s) const { const bf16_t* a0 = +A0; const bf16_t* a1 = +A1; const bf16_t* a2 = +A2; return s == 0 ? +a0 : (s == 1 ? +a1 : +a2); }
    __device__ __forceinline__ const bf16_t* selB(int s) const { const bf16_t* b0 = +B0; const bf16_t* b1 = +B1; const bf16_t* b2 = +B2; return s == 0 ? +b0 : (s == 1 ? +b1 : +b2); }
    __device__ __forceinline__ int selNt(int s) const { const int n0 = +nt0, n1 = +nt1, n2 = +nt2; return s == 0 ? +n0 : (s == 1 ? +n1 : +n2); }
};
struct SegOrder {
    int nM, nN, nwg, G, c, nseg;
    __device__ void init(int M, int N, int G_, int c_, int nseg_) { nM = M / BM; nN = N / BM; nwg = nM * nN; G = G_; c = c_; nseg = nseg_; }
    __device__ bool next(int i, Unit& u) const {
        const int ti = i / nseg; u.seg = i - ti * nseg;
        const long L = (long)ti * G + c; if (L >= nwg) return false;
        int wgid = (int)L; { const int q = nwg / NXCD, r = nwg % NXCD, xcd = wgid % NXCD, off = wgid / NXCD; wgid = (xcd < r ? xcd * (q + 1) : r * (q + 1) + (xcd - r) * q) + off; }
        const int nig = WGM * nN, gid = wgid / nig, fm = gid * WGM, gsz = (nM - fm) < WGM ? (nM - fm) : WGM;
        u.pm = fm + ((wgid % nig) % gsz); u.pn = (wgid % nig) / gsz; return true;
    }
    __device__ __forceinline__ void a_ready(const Unit&) const {}
    __device__ __forceinline__ void done(const Unit&) const {}
};
typedef __bf16 bf16x2_t __attribute__((ext_vector_type(2)));
typedef float f32x2_t __attribute__((ext_vector_type(2)));
__device__ __forceinline__ unsigned cvt_pk_bf16(float lo, float hi) { f32x2_t f = {lo, hi}; bf16x2_t v = __builtin_convertvector(f, bf16x2_t); return __builtin_bit_cast(unsigned, v); }
__device__ __forceinline__ float sigmoidf_(float x) { return __builtin_amdgcn_rcpf(1.0f + __expf(-x)); }

struct EpiBf16 {
    static constexpr bool PERM = true, AFTER_DRAIN = false;
    bf16_t* O; int ldc;
    __device__ __forceinline__ void operator()(const f32x4 (&acc)[2][2][4][2], const Unit& u, int wr, int wc, int fr, int fq) const {
        const int row0 = u.pm * BM + wr * 64 + fr; const int col0 = u.pn * BM + wc * 32 + 8 * fq;
#pragma unroll
        for (int ai = 0; ai < 2; ++ai)
#pragma unroll
            for (int m = 0; m < 4; ++m) { bf16_t* rowp = O + (size_t)(row0 + ai * HALF + m * 16) * ldc + col0;
#pragma unroll
                for (int bj = 0; bj < 2; ++bj) { const f32x4 v0 = acc[ai][bj][m][0], v1 = acc[ai][bj][m][1];
                    u32x4 w; w.x = cvt_pk_bf16(v0[0], v0[1]); w.y = cvt_pk_bf16(v0[2], v0[3]); w.z = cvt_pk_bf16(v1[0], v1[1]); w.w = cvt_pk_bf16(v1[2], v1[3]);
                    *(u32x4*)(rowp + bj * HALF) = w; } }
    }
};
#define PG8_FOR_ACC(body) \
    _Pragma("unroll") for (int ai = 0; ai < 2; ++ai) _Pragma("unroll") for (int m = 0; m < 4; ++m) { const int row = u.pm * BM + ai * HALF + wr * 64 + m * 16 + fr; \
    _Pragma("unroll") for (int bj = 0; bj < 2; ++bj) _Pragma("unroll") for (int n = 0; n < 2; ++n) { const size_t off = (size_t)row * ldc + (u.pn * BM + bj * HALF + wc * 32 + n * 16 + 4 * fq); const f32x4 a = acc[ai][bj][m][n]; body } }
struct EpiStoreF32 {
    static constexpr bool PERM = false, AFTER_DRAIN = false;
    float* tmp; int ldc;
    __device__ __forceinline__ void operator()(const f32x4 (&acc)[2][2][4][2], const Unit& u, int wr, int wc, int fr, int fq) const {
        PG8_FOR_ACC( *(f32x4*)(tmp + off) = a; )
    }
};
struct EpiMerge {
    static constexpr bool PERM = false, AFTER_DRAIN = false;
    float* tmp1; float* tmp2; bf16_t* y; int ldc;
    __device__ __forceinline__ void operator()(const f32x4 (&acc)[2][2][4][2], const Unit& u, int wr, int wc, int fr, int fq) const {
        if (u.seg == 0) {
            PG8_FOR_ACC( f32x4 t = *(const f32x4*)(tmp1 + off); t[0] *= sigmoidf_(a[0]); t[1] *= sigmoidf_(a[1]); t[2] *= sigmoidf_(a[2]); t[3] *= sigmoidf_(a[3]); *(f32x4*)(tmp1 + off) = t; )
        } else if (u.seg == 1) {
            PG8_FOR_ACC( *(f32x4*)(tmp2 + off) = a; )
        } else {
            PG8_FOR_ACC( const f32x4 t1 = *(const f32x4*)(tmp1 + off); const f32x4 t2 = *(const f32x4*)(tmp2 + off);
                u32x2 w; w.x = cvt_pk_bf16(t1[0] + sigmoidf_(a[0]) * t2[0], t1[1] + sigmoidf_(a[1]) * t2[1]); w.y = cvt_pk_bf16(t1[2] + sigmoidf_(a[2]) * t2[2], t1[3] + sigmoidf_(a[3]) * t2[3]);
                *(u32x2*)(y + off) = w; )
        }
    }
};
__device__ __forceinline__ void st_sc1_16(void* p, u32x4 w) { asm volatile("global_store_dwordx4 %0, %1, off sc1" :: "v"(p), "v"(w) : "memory"); }
struct EpiResid {
    static constexpr bool PERM = true, AFTER_DRAIN = false;
    const float* x; float* out; bf16_t* x1b; float* ps; int ldc;
    __device__ __forceinline__ void operator()(const f32x4 (&acc)[2][2][4][2], const Unit& u, int wr, int wc, int fr, int fq) const {
#pragma unroll
        for (int ai = 0; ai < 2; ++ai)
#pragma unroll
            for (int m = 0; m < 4; ++m) { const int row = u.pm * BM + ai * HALF + wr * 64 + m * 16 + fr; float s = 0.f;
#pragma unroll
                for (int bj = 0; bj < 2; ++bj) { const size_t off = (size_t)row * ldc + (u.pn * BM + bj * HALF + wc * 32 + 8 * fq);
                    const f32x4 v0 = *(const f32x4*)(x + off) + acc[ai][bj][m][0], v1 = *(const f32x4*)(x + off + 4) + acc[ai][bj][m][1];
                    *(f32x4*)(out + off) = v0; *(f32x4*)(out + off + 4) = v1;
                    u32x4 w; w.x = cvt_pk_bf16(v0[0], v0[1]); w.y = cvt_pk_bf16(v0[2], v0[3]); w.z = cvt_pk_bf16(v1[0], v1[1]); w.w = cvt_pk_bf16(v1[2], v1[3]);
                    st_sc1_16(x1b + off, w);
                    s += ((v0[0] * v0[0] + v0[1] * v0[1]) + (v0[2] * v0[2] + v0[3] * v0[3])) + ((v1[0] * v1[0] + v1[1] * v1[1]) + (v1[2] * v1[2] + v1[3] * v1[3])); }
                s += __shfl_xor(s, 16); s += __shfl_xor(s, 32);
                if (fq == 0) __hip_atomic_store(ps + (size_t)row * 16 + u.pn * 4 + wc, s, __ATOMIC_RELAXED, __HIP_MEMORY_SCOPE_AGENT);
                asm volatile("" ::: "memory"); }
    }
};
struct EpiPle {
    static constexpr bool PERM = false, AFTER_DRAIN = false;
    float* out; const float* tmp; const float* ps; int ldc; float eps;
    __device__ __forceinline__ void operator()(const f32x4 (&acc)[2][2][4][2], const Unit& u, int wr, int wc, int fr, int fq) const {
#pragma unroll
        for (int ai = 0; ai < 2; ++ai)
#pragma unroll
            for (int m = 0; m < 4; ++m) { const int row = u.pm * BM + ai * HALF + wr * 64 + m * 16 + fr;
                const f32x4* pp = (const f32x4*)(ps + (size_t)row * 16); const f32x4 p0 = pp[0], p1 = pp[1], p2 = pp[2], p3 = pp[3];
                const float ss = ((p0[0] + p0[1]) + (p0[2] + p0[3])) + ((p1[0] + p1[1]) + (p1[2] + p1[3])) + ((p2[0] + p2[1]) + (p2[2] + p2[3])) + ((p3[0] + p3[1]) + (p3[2] + p3[3]));
                const float rstd = rsqrtf(ss * (1.0f / 1024.0f) + eps);
#pragma unroll
                for (int bj = 0; bj < 2; ++bj)
#pragma unroll
                    for (int n = 0; n < 2; ++n) { const size_t off = (size_t)row * ldc + (u.pn * BM + bj * HALF + wc * 32 + n * 16 + 4 * fq);
                        const f32x4 a = acc[ai][bj][m][n]; const f32x4 t = *(const f32x4*)(tmp + off); f32x4 o = *(const f32x4*)(out + off);
                        o[0] += t[0] * sigmoidf_(rstd * a[0]); o[1] += t[1] * sigmoidf_(rstd * a[1]); o[2] += t[2] * sigmoidf_(rstd * a[2]); o[3] += t[3] * sigmoidf_(rstd * a[3]);
                        *(f32x4*)(out + off) = o; } }
    }
};

__device__ __forceinline__ f32x4 unpack_bf16x4(u32x2 w) { f32x4 r; r[0] = __uint_as_float(w.x << 16); r[1] = __uint_as_float(w.x & 0xffff0000u); r[2] = __uint_as_float(w.y << 16); r[3] = __uint_as_float(w.y & 0xffff0000u); return r; }
struct EpiSig2 {
    static constexpr bool PERM = false, AFTER_DRAIN = false;
    bf16_t* s0; bf16_t* s1; int ldc;
    __device__ __forceinline__ void operator()(const f32x4 (&acc)[2][2][4][2], const Unit& u, int wr, int wc, int fr, int fq) const {
        bf16_t* dst = u.seg == 0 ? s0 : s1;
        PG8_FOR_ACC( u32x2 w; w.x = cvt_pk_bf16(sigmoidf_(a[0]), sigmoidf_(a[1])); w.y = cvt_pk_bf16(sigmoidf_(a[2]), sigmoidf_(a[3])); *(u32x2*)(dst + off) = w; )
    }
};
struct EpiGateMul {
    static constexpr bool PERM = false, AFTER_DRAIN = false;
    const bf16_t* sg; bf16_t* t1; int ldc;
    __device__ __forceinline__ void operator()(const f32x4 (&acc)[2][2][4][2], const Unit& u, int wr, int wc, int fr, int fq) const {
        PG8_FOR_ACC( const f32x4 g = unpack_bf16x4(*(const u32x2*)(sg + off)); u32x2 w; w.x = cvt_pk_bf16(g[0] * a[0], g[1] * a[1]); w.y = cvt_pk_bf16(g[2] * a[2], g[3] * a[3]); *(u32x2*)(t1 + off) = w; )
    }
};
struct EpiMergeY {
    static constexpr bool PERM = false, AFTER_DRAIN = false;
    const bf16_t* sg; const bf16_t* t1; bf16_t* y; int ldc;
    __device__ __forceinline__ void operator()(const f32x4 (&acc)[2][2][4][2], const Unit& u, int wr, int wc, int fr, int fq) const {
        PG8_FOR_ACC( const f32x4 g = unpack_bf16x4(*(const u32x2*)(sg + off)); const f32x4 t = unpack_bf16x4(*(const u32x2*)(t1 + off));
            u32x2 w; w.x = cvt_pk_bf16(t[0] + g[0] * a[0], t[1] + g[1] * a[1]); w.y = cvt_pk_bf16(t[2] + g[2] * a[2], t[3] + g[3] * a[3]); *(u32x2*)(y + off) = w; )
    }
};
struct EpiSigRow {
    static constexpr bool PERM = true, AFTER_DRAIN = false;
    const float* ps; bf16_t* sg; int ldc; float eps;
    __device__ __forceinline__ void operator()(const f32x4 (&acc)[2][2][4][2], const Unit& u, int wr, int wc, int fr, int fq) const {
#pragma unroll
        for (int ai = 0; ai < 2; ++ai)
#pragma unroll
            for (int m = 0; m < 4; ++m) { const int row = u.pm * BM + ai * HALF + wr * 64 + m * 16 + fr;
                const f32x4* pp = (const f32x4*)(ps + (size_t)row * 16); const f32x4 p0 = pp[0], p1 = pp[1], p2 = pp[2], p3 = pp[3];
                const float ss = ((p0[0] + p0[1]) + (p0[2] + p0[3])) + ((p1[0] + p1[1]) + (p1[2] + p1[3])) + ((p2[0] + p2[1]) + (p2[2] + p2[3])) + ((p3[0] + p3[1]) + (p3[2] + p3[3]));
                const float rstd = rsqrtf(ss * (1.0f / 1024.0f) + eps);
#pragma unroll
                for (int bj = 0; bj < 2; ++bj) { const size_t off = (size_t)row * ldc + (u.pn * BM + bj * HALF + wc * 32 + 8 * fq);
                    const f32x4 a0 = acc[ai][bj][m][0], a1 = acc[ai][bj][m][1];
                    u32x4 w; w.x = cvt_pk_bf16(sigmoidf_(rstd * a0[0]), sigmoidf_(rstd * a0[1])); w.y = cvt_pk_bf16(sigmoidf_(rstd * a0[2]), sigmoidf_(rstd * a0[3]));
                    w.z = cvt_pk_bf16(sigmoidf_(rstd * a1[0]), sigmoidf_(rstd * a1[1])); w.w = cvt_pk_bf16(sigmoidf_(rstd * a1[2]), sigmoidf_(rstd * a1[3]));
                    *(u32x4*)(sg + off) = w; } }
    }
};
struct EpiPle2 {
    static constexpr bool PERM = true, AFTER_DRAIN = false;
    float* out; const bf16_t* sg; int ldc;
    __device__ __forceinline__ void operator()(const f32x4 (&acc)[2][2][4][2], const Unit& u, int wr, int wc, int fr, int fq) const {
#pragma unroll
        for (int ai = 0; ai < 2; ++ai)
#pragma unroll
            for (int m = 0; m < 4; ++m) { const int row = u.pm * BM + ai * HALF + wr * 64 + m * 16 + fr;
#pragma unroll
                for (int bj = 0; bj < 2; ++bj) { const size_t off = (size_t)row * ldc + (u.pn * BM + bj * HALF + wc * 32 + 8 * fq);
                    const u32x4 g8 = *(const u32x4*)(sg + off); const f32x4 a0 = acc[ai][bj][m][0], a1 = acc[ai][bj][m][1];
                    f32x4 o0 = *(const f32x4*)(out + off), o1 = *(const f32x4*)(out + off + 4);
                    o0[0] += a0[0] * __uint_as_float(g8.x << 16); o0[1] += a0[1] * __uint_as_float(g8.x & 0xffff0000u); o0[2] += a0[2] * __uint_as_float(g8.y << 16); o0[3] += a0[3] * __uint_as_float(g8.y & 0xffff0000u);
                    o1[0] += a1[0] * __uint_as_float(g8.z << 16); o1[1] += a1[1] * __uint_as_float(g8.z & 0xffff0000u); o1[2] += a1[2] * __uint_as_float(g8.w << 16); o1[3] += a1[3] * __uint_as_float(g8.w & 0xffff0000u);
                    *(f32x4*)(out + off) = o0; *(f32x4*)(out + off + 4) = o1; }
                asm volatile("" ::: "memory"); }
    }
};

struct EpiQKV {
    static constexpr bool PERM = true, AFTER_DRAIN = false;
    bf16_t* QKV; bf16_t* ZA; const float* gq; const float* gk; const float* rot; float eps;
    const bf16_t* OI; const float* SS; const float* gla_g; bf16_t* AB;
    __device__ __forceinline__ void operator()(const f32x4 (&acc)[2][2][4][2], const Unit& u, int wr, int wc, int fr, int fq) const {
        const int row0 = u.pm * BM + wr * 64 + fr; const int cl = u.pn * BM + 64 * wc;
        if (cl >= 5120) {
            const int zc0 = cl - 5120 + 8 * fq, hB = (cl - 5120) >> 8;
            const f32x4 ga0 = *(const f32x4*)(gla_g + (zc0 & 255)), ga1 = *(const f32x4*)(gla_g + (zc0 & 255) + 4), gb0 = *(const f32x4*)(gla_g + ((zc0 + 32) & 255)), gb1 = *(const f32x4*)(gla_g + ((zc0 + 32) & 255) + 4);
#pragma unroll
            for (int ai = 0; ai < 2; ++ai)
#pragma unroll
                for (int m = 0; m < 4; ++m) { const int row = row0 + ai * HALF + m * 16;
                    const f32x4* sp = (const f32x4*)(SS + (size_t)row * 64 + hB * 16); const f32x4 s0 = sp[0], s1 = sp[1], s2 = sp[2], s3 = sp[3];
                    const float ss = ((s0[0] + s0[1]) + (s0[2] + s0[3])) + ((s1[0] + s1[1]) + (s1[2] + s1[3])) + ((s2[0] + s2[1]) + (s2[2] + s2[3])) + ((s3[0] + s3[1]) + (s3[2] + s3[3]));
                    const float rstd = rsqrtf(ss * (1.0f / 256.0f) + eps);
#pragma unroll
                    for (int bj = 0; bj < 2; ++bj) { const size_t off = (size_t)row * 1024 + zc0 + 32 * bj; const u32x4 o8 = *(const u32x4*)(OI + off);
                        const f32x4 z0 = acc[ai][bj][m][0], z1 = acc[ai][bj][m][1]; const f32x4 g0 = bj ? gb0 : ga0, g1 = bj ? gb1 : ga1;
                        u32x4 w;
                        w.x = cvt_pk_bf16(__uint_as_float(o8.x << 16) * rstd * g0[0] * (z0[0] * sigmoidf_(z0[0])), __uint_as_float(o8.x & 0xffff0000u) * rstd * g0[1] * (z0[1] * sigmoidf_(z0[1])));
                        w.y = cvt_pk_bf16(__uint_as_float(o8.y << 16) * rstd * g0[2] * (z0[2] * sigmoidf_(z0[2])), __uint_as_float(o8.y & 0xffff0000u) * rstd * g0[3] * (z0[3] * sigmoidf_(z0[3])));
                        w.z = cvt_pk_bf16(__uint_as_float(o8.z << 16) * rstd * g1[0] * (z1[0] * sigmoidf_(z1[0])), __uint_as_float(o8.z & 0xffff0000u) * rstd * g1[1] * (z1[1] * sigmoidf_(z1[1])));
                        w.w = cvt_pk_bf16(__uint_as_float(o8.w << 16) * rstd * g1[2] * (z1[2] * sigmoidf_(z1[2])), __uint_as_float(o8.w & 0xffff0000u) * rstd * g1[3] * (z1[3] * sigmoidf_(z1[3])));
                        *(u32x4*)(AB + off) = w; } }
            return;
        }
        if (cl >= 4608) {
#pragma unroll
            for (int ai = 0; ai < 2; ++ai)
#pragma unroll
                for (int m = 0; m < 4; ++m) { const int row = row0 + ai * HALF + m * 16;
#pragma unroll
                    for (int bj = 0; bj < 2; ++bj) { const f32x4 v0 = acc[ai][bj][m][0], v1 = acc[ai][bj][m][1];
                        u32x4 w; w.x = cvt_pk_bf16(v0[0], v0[1]); w.y = cvt_pk_bf16(v0[2], v0[3]); w.z = cvt_pk_bf16(v1[0], v1[1]); w.w = cvt_pk_bf16(v1[2], v1[3]);
                        *(u32x4*)(ZA + (size_t)row * 512 + (cl - 4608) + 32 * bj + 8 * fq) = w; } }
            return;
        }
        const int which = cl / 1536, hc = cl - which * 1536, h = hc >> 6, dsh = 2 * (h >> 3);
        bf16_t* base = QKV + (size_t)which * ((size_t)16384 * 1536) + 8 * fq;
        const bool qk = which < 2;
        const float* gp = which == 0 ? gq : gk; const float sc = which == 0 ? 0.125f * 1.4426950408889634f : 1.0f;
        f32x4 g00 = {1.f, 1.f, 1.f, 1.f}, g01 = g00, g10 = g00, g11 = g00;
        if (qk) { g00 = *(const f32x4*)(gp + 8 * fq); g01 = *(const f32x4*)(gp + 8 * fq + 4); g10 = *(const f32x4*)(gp + 32 + 8 * fq); g11 = *(const f32x4*)(gp + 32 + 8 * fq + 4); }
#pragma unroll
        for (int ai = 0; ai < 2; ++ai)
#pragma unroll
            for (int m = 0; m < 4; ++m) { const int row = row0 + ai * HALF + m * 16; const int b = row >> 12, t = row & 4095;
                const int idx = ((t & ((1 << dsh) - 1)) << (12 - dsh)) + (t >> dsh);
                bf16_t* dst = base + ((size_t)(b * 24 + h) * 4096 + idx) * 64;
                f32x4 a0 = acc[ai][0][m][0], a1 = acc[ai][0][m][1], c0 = acc[ai][1][m][0], c1 = acc[ai][1][m][1];
                if (qk) {
                    float ss = ((a0[0] * a0[0] + a0[1] * a0[1]) + (a0[2] * a0[2] + a0[3] * a0[3])) + ((a1[0] * a1[0] + a1[1] * a1[1]) + (a1[2] * a1[2] + a1[3] * a1[3]))
                             + ((c0[0] * c0[0] + c0[1] * c0[1]) + (c0[2] * c0[2] + c0[3] * c0[3])) + ((c1[0] * c1[0] + c1[1] * c1[1]) + (c1[2] * c1[2] + c1[3] * c1[3]));
                    ss += __shfl_xor(ss, 16); ss += __shfl_xor(ss, 32);
                    const float rstd = rsqrtf(ss * (1.0f / 64.0f) + eps);
                    a0 = a0 * rstd * g00; a1 = a1 * rstd * g01; c0 = c0 * rstd * g10; c1 = c1 * rstd * g11;
                    f32x4 p0, p1;
                    p0[0] = __shfl_xor(a0[0], 16); p0[1] = __shfl_xor(a0[1], 16); p0[2] = __shfl_xor(a0[2], 16); p0[3] = __shfl_xor(a0[3], 16);
                    p1[0] = __shfl_xor(a1[0], 16); p1[1] = __shfl_xor(a1[1], 16); p1[2] = __shfl_xor(a1[2], 16); p1[3] = __shfl_xor(a1[3], 16);
                    if (fq < 2) { const float* rp = rot + (size_t)row * 16; const f32x4 cs0 = *(const f32x4*)(rp), cs1 = *(const f32x4*)(rp + 4), sn0 = *(const f32x4*)(rp + 8), sn1 = *(const f32x4*)(rp + 12);
                        const float sg = fq == 0 ? -1.f : 1.f; a0 = a0 * cs0 + (p0 * sn0) * sg; a1 = a1 * cs1 + (p1 * sn1) * sg; }
                    a0 = a0 * sc; a1 = a1 * sc; c0 = c0 * sc; c1 = c1 * sc;
                }
                u32x4 w0, w1; w0.x = cvt_pk_bf16(a0[0], a0[1]); w0.y = cvt_pk_bf16(a0[2], a0[3]); w0.z = cvt_pk_bf16(a1[0], a1[1]); w0.w = cvt_pk_bf16(a1[2], a1[3]);
                w1.x = cvt_pk_bf16(c0[0], c0[1]); w1.y = cvt_pk_bf16(c0[2], c0[3]); w1.z = cvt_pk_bf16(c1[0], c1[1]); w1.w = cvt_pk_bf16(c1[2], c1[3]);
                *(u32x4*)dst = w0; *(u32x4*)(dst + 32) = w1; }
    }
};

template <class Epi, class Sched, bool ALIGN_EPI = false, bool SP2 = false>
__device__ __forceinline__ void gemm_phase(PG8_LAS unsigned char* lds, const Gemm g, const Sched& S, const Epi& E) {
    int tid_ = threadIdx.x; asm volatile("" : "+v"(tid_));
    const int tid = tid_, wid = __builtin_amdgcn_readfirstlane(tid >> 6), lane = tid & 63, wr = wid >> 2, wc = wid & 3, fr = lane & 15, fq = lane >> 4;
    const int lda = g.lda, ldb = g.ldb;
    unsigned voffA[2], voffB[2];
#pragma unroll
    for (int i = 0; i < 2; ++i) { int R, C; stage_rc(tid * 16 + i * 8192, R, C); const int Rb = Epi::PERM ? ((R & ~31) + perm32(R & 31)) : R;
        voffA[i] = (unsigned)(R * lda + C) * 2u; voffB[i] = (unsigned)(Rb * ldb + C) * 2u; }
    const size_t kstep = (size_t)(BK * 2);
    const size_t hstepA = (size_t)HALF * lda * 2, hstepB = (size_t)HALF * ldb * 2;
    const size_t tstepA = 2 * hstepA, tstepB = 2 * hstepB;
    const unsigned ldsw = (unsigned)wid * 1024u;
    const int aoff = lds_byte(wr * 64 + fr, fq * 8), boff = lds_byte(wc * 32 + fr, fq * 8);
#define PG8_SA(b, h) (((b) * 2 + (h)) * HTB)
#define PG8_SB(b, h) ((4 + (b) * 2 + (h)) * HTB)
#define PG8_STAGE(bufoff, gbase, voff) do { _Pragma("unroll") for (int _i = 0; _i < 2; ++_i) \
        __builtin_amdgcn_global_load_lds((const unsigned*)((const char*)(gbase) + (voff)[_i]), (PG8_LAS unsigned*)(lds + (bufoff) + ldsw + _i * 8192), 16, 0, 0); } while (0)
#define PG8_LDA(dst, b, h) do { _Pragma("unroll") for (int m = 0; m < 4; ++m) _Pragma("unroll") for (int k = 0; k < 2; ++k) dst[m][k] = *(const PG8_LAS bf16x8*)(lds + PG8_SA(b, h) + aoff + m * 2048 + k * 1024); } while (0)
#define PG8_LDB(dst, b, h) do { _Pragma("unroll") for (int n = 0; n < 2; ++n) _Pragma("unroll") for (int k = 0; k < 2; ++k) dst[n][k] = *(const PG8_LAS bf16x8*)(lds + PG8_SB(b, h) + boff + n * 2048 + k * 1024); } while (0)
#define PG8_MMA(ai, bj, At, Bt) do { __builtin_amdgcn_s_setprio(1); _Pragma("unroll") for (int m = 0; m < 4; ++m) _Pragma("unroll") for (int n = 0; n < 2; ++n) _Pragma("unroll") for (int k = 0; k < 2; ++k) \
        acc[ai][bj][m][n] = __builtin_amdgcn_mfma_f32_16x16x32_bf16(Bt[n][k], At[m][k], acc[ai][bj][m][n], 0, 0, 0); __builtin_amdgcn_s_setprio(0); } while (0)
#define PG8_WAIT_V(n) asm volatile("s_waitcnt vmcnt(" #n ")" ::: "memory")
#define PG8_WAIT_L(n) asm volatile("s_waitcnt lgkmcnt(" #n ")" ::: "memory")
#define PG8_BAR __builtin_amdgcn_s_barrier()
#define PG8_SCHED __builtin_amdgcn_sched_barrier(0)
    Unit cur, nxt; int ui = 0;
    if (!S.next(0, cur)) return;
    f32x4 acc[2][2][4][2];
#pragma unroll
    for (int a = 0; a < 2; ++a)
#pragma unroll
        for (int b = 0; b < 2; ++b)
#pragma unroll
            for (int m = 0; m < 4; ++m)
#pragma unroll
                for (int n = 0; n < 2; ++n) acc[a][b][m][n] = (f32x4){0.f, 0.f, 0.f, 0.f};
    bf16x8 At[4][2], B0[2][2], B1[2][2];
    const char* cA = (const char*)g.selA(cur.seg) + (size_t)cur.pm * tstepA; const char* cB = (const char*)g.selB(cur.seg) + (size_t)cur.pn * tstepB;
    S.a_ready(cur);
    if constexpr (SP2) {
        PG8_STAGE(PG8_SB(0, 0), cB, voffB); PG8_STAGE(PG8_SB(0, 1), cB + hstepB, voffB); PG8_STAGE(PG8_SA(0, 0), cA, voffA); PG8_STAGE(PG8_SA(0, 1), cA + hstepA, voffA);
        if (wr == 1) PG8_BAR;
        PG8_WAIT_V(2); PG8_BAR;
        PG8_STAGE(PG8_SB(1, 0), cB + kstep, voffB); PG8_STAGE(PG8_SA(1, 0), cA + kstep, voffA); PG8_STAGE(PG8_SB(1, 1), cB + hstepB + kstep, voffB);
        PG8_WAIT_V(6); PG8_BAR;
    } else {
        PG8_STAGE(PG8_SB(0, 0), cB, voffB); PG8_STAGE(PG8_SA(0, 0), cA, voffA); PG8_STAGE(PG8_SB(0, 1), cB + hstepB, voffB); PG8_STAGE(PG8_SA(0, 1), cA + hstepA, voffA);
        if (wr == 1) PG8_BAR;
        PG8_WAIT_V(4); PG8_BAR;
        PG8_STAGE(PG8_SB(1, 0), cB + kstep, voffB); PG8_STAGE(PG8_SA(1, 0), cA + kstep, voffA); PG8_STAGE(PG8_SB(1, 1), cB + hstepB + kstep, voffB);
        PG8_WAIT_V(6); PG8_BAR;
    }
    for (;;) {
        const bool has_next = S.next(ui + 1, nxt);
        const char* nA = has_next ? (const char*)g.selA(nxt.seg) + (size_t)nxt.pm * tstepA : cA; const char* nB = has_next ? (const char*)g.selB(nxt.seg) + (size_t)nxt.pn * tstepB : cB;
        const int nt = g.selNt(cur.seg);
        for (int t = 0; t < nt; t += 2) {
            const bool last = (t == nt - 2);
            const char* a1 = cA + (size_t)(t + 1) * kstep;
            const char* a2 = last ? nA : cA + (size_t)(t + 2) * kstep; const char* b2 = last ? nB : cB + (size_t)(t + 2) * kstep;
            const char* a3 = a2 + kstep; const char* b3 = b2 + kstep;
            if (last && has_next) S.a_ready(nxt);
            if constexpr (SP2) {
            PG8_LDB(B0, 0, 0); PG8_LDB(B1, 0, 1); PG8_SCHED; PG8_LDA(At, 0, 0); PG8_STAGE(PG8_SA(1, 1), a1 + hstepA, voffA);
            PG8_WAIT_V(8); PG8_WAIT_L(0); PG8_BAR; PG8_MMA(0, 0, At, B0); PG8_MMA(0, 1, At, B1); PG8_BAR; PG8_SCHED;
            PG8_LDA(At, 0, 1); PG8_STAGE(PG8_SB(0, 0), b2, voffB); PG8_STAGE(PG8_SB(0, 1), b2 + hstepB, voffB); PG8_STAGE(PG8_SA(0, 0), a2, voffA);
            PG8_WAIT_V(8); PG8_WAIT_L(0); PG8_BAR; PG8_MMA(1, 0, At, B0); PG8_MMA(1, 1, At, B1); PG8_BAR; PG8_SCHED;
            PG8_LDB(B0, 1, 0); PG8_LDB(B1, 1, 1); PG8_SCHED; PG8_LDA(At, 1, 0); PG8_STAGE(PG8_SA(0, 1), a2 + hstepA, voffA);
            PG8_WAIT_V(8); PG8_WAIT_L(0); PG8_BAR; PG8_MMA(0, 0, At, B0); PG8_MMA(0, 1, At, B1); PG8_BAR; PG8_SCHED;
            PG8_LDA(At, 1, 1); PG8_STAGE(PG8_SB(1, 0), b3, voffB); PG8_STAGE(PG8_SB(1, 1), b3 + hstepB, voffB); PG8_STAGE(PG8_SA(1, 0), a3, voffA);
            PG8_WAIT_V(8); PG8_WAIT_L(0); PG8_BAR; PG8_MMA(1, 0, At, B0); PG8_MMA(1, 1, At, B1); PG8_BAR; PG8_SCHED;
            } else {
            PG8_LDB(B0, 0, 0); PG8_SCHED; PG8_LDA(At, 0, 0); PG8_STAGE(PG8_SA(1, 1), a1 + hstepA, voffA);
            PG8_WAIT_L(8); PG8_BAR; PG8_WAIT_L(0); PG8_MMA(0, 0, At, B0); PG8_BAR; PG8_SCHED;
            PG8_LDB(B1, 0, 1); PG8_STAGE(PG8_SB(0, 0), b2, voffB);
            PG8_BAR; PG8_WAIT_L(0); PG8_MMA(0, 1, At, B1); PG8_BAR;
            PG8_LDA(At, 0, 1); PG8_STAGE(PG8_SA(0, 0), a2, voffA);
            PG8_BAR; PG8_WAIT_L(0); PG8_MMA(1, 0, At, B0); PG8_BAR; PG8_SCHED;
            PG8_STAGE(PG8_SB(0, 1), b2 + hstepB, voffB);
            PG8_WAIT_V(6); PG8_BAR; PG8_MMA(1, 1, At, B1); PG8_BAR;
            PG8_LDB(B0, 1, 0); PG8_SCHED; PG8_LDA(At, 1, 0); PG8_STAGE(PG8_SA(0, 1), a2 + hstepA, voffA);
            PG8_WAIT_L(8); PG8_BAR; PG8_WAIT_L(0); PG8_MMA(0, 0, At, B0); PG8_BAR; PG8_SCHED;
            PG8_LDB(B1, 1, 1); PG8_STAGE(PG8_SB(1, 0), b3, voffB);
            PG8_BAR; PG8_WAIT_L(0); PG8_MMA(0, 1, At, B1); PG8_BAR;
            PG8_LDA(At, 1, 1); PG8_STAGE(PG8_SA(1, 0), a3, voffA);
            PG8_BAR; PG8_WAIT_L(0); PG8_MMA(1, 0, At, B0); PG8_BAR; PG8_SCHED;
            PG8_STAGE(PG8_SB(1, 1), b3 + hstepB, voffB);
            PG8_WAIT_V(6); PG8_BAR; PG8_MMA(1, 1, At, B1); PG8_BAR;
            }
        }
        if constexpr (ALIGN_EPI) { if (wr == 0) PG8_BAR; }
        if constexpr (!Epi::AFTER_DRAIN) { E(acc, cur, wr, wc, fr, fq); S.done(cur); }
        if (!has_next) break;
#pragma unroll
        for (int a = 0; a < 2; ++a)
#pragma unroll
            for (int b = 0; b < 2; ++b)
#pragma unroll
                for (int m = 0; m < 4; ++m)
#pragma unroll
                    for (int n = 0; n < 2; ++n) acc[a][b][m][n] = (f32x4){0.f, 0.f, 0.f, 0.f};
        cur = nxt; cA = nA; cB = nB; ++ui;
        if constexpr (ALIGN_EPI) { if (wr == 1) PG8_BAR; }
    }
    PG8_WAIT_V(0);
    if constexpr (!ALIGN_EPI) { if (wr == 0) PG8_BAR; }
    PG8_BAR;
    if constexpr (Epi::AFTER_DRAIN) { E.fused(acc, cur, wr, wc, fr, fq, lds, wid, lane); S.done(cur); }
#undef PG8_SA
#undef PG8_SB
#undef PG8_STAGE
#undef PG8_LDA
#undef PG8_LDB
#undef PG8_MMA
#undef PG8_WAIT_V
#undef PG8_WAIT_L
#undef PG8_BAR
#undef PG8_SCHED
}
}

constexpr int NWAVES = 8;
constexpr int T = 16384, D = 1024, SEQ = 4096, INC = 10256;
constexpr int PA = 5120;
constexpr int PG = 2048;
constexpr float EPS = 1e-6f;
constexpr size_t MiB = 1u << 20;
constexpr size_t WS_W1A = 0, WS_W1G = 12 * MiB, WS_WGT = 16 * MiB, WS_WPA = 20 * MiB, WS_WPB = 21 * MiB, WS_WOUT = 23 * MiB, WS_WPG = 25 * MiB, WS_WPLE = 27 * MiB, WS_WGLR = 27 * MiB + 512 * 1024;
constexpr size_t WS_ROT = 28 * MiB, WS_GLR = 29 * MiB, WS_GAMMA = 30 * MiB, WS_ML = 29 * MiB  , WS_PS = 29 * MiB  ;
constexpr size_t WS_PROJG = 32 * MiB, WS_QP = 96 * MiB, WS_L = 112 * MiB, WS_OI = 192 * MiB, WS_SS = 224 * MiB;
constexpr size_t WS_PROJA = 32 * MiB, WS_ZA = 176 * MiB  , WS_OG = 192 * MiB, WS_AA = 240 * MiB;
constexpr size_t WS_TMP1 = 32 * MiB, WS_TMP2 = 96 * MiB, WS_SGA = 32 * MiB, WS_SGB = 64 * MiB, WS_T1 = 96 * MiB, WS_Y = 160 * MiB, WS_PB = 200 * MiB, WS_X1B = 208 * MiB, WS_END = 256 * MiB;
constexpr int LDS_BYTES = 147456, MISC_OFF = 131072 + 320;
constexpr size_t WS_BAR = 27 * MiB + 512 * 1024 + 65536, WS_PCNT = WS_BAR + 16384, BAR_BYTES = 16384 + 2 * 16384;

#define LAS __attribute__((address_space(3)))
typedef unsigned short bf16;
typedef unsigned v4u __attribute__((ext_vector_type(4)));
typedef unsigned v2u __attribute__((ext_vector_type(2)));
typedef float f32x4 __attribute__((ext_vector_type(4)));
typedef short bf16x8 __attribute__((ext_vector_type(8)));
typedef short s16x4 __attribute__((ext_vector_type(4)));
__device__ __forceinline__ float bflo(unsigned w) { return __uint_as_float(w << 16); }
__device__ __forceinline__ float bfhi(unsigned w) { return __uint_as_float(w & 0xffff0000u); }
__device__ __forceinline__ float bf2f(unsigned short b) { return __uint_as_float(((unsigned)b) << 16); }
__device__ __forceinline__ unsigned pk2(float lo, float hi) { return pg8::cvt_pk_bf16(lo, hi); }
__device__ __forceinline__ bf16x8 mk8(v2u lo, v2u hi) { v4u t; t.x = lo.x; t.y = lo.y; t.z = hi.x; t.w = hi.y; return __builtin_bit_cast(bf16x8, t); }
__device__ __forceinline__ f32x4 mfma16(bf16x8 a, bf16x8 b, f32x4 c) { return __builtin_amdgcn_mfma_f32_16x16x32_bf16(a, b, c, 0, 0, 0); }
__device__ __forceinline__ float siluf_(float x) { return x * pg8::sigmoidf_(x); }
#define LDS_WAIT() asm volatile("s_waitcnt lgkmcnt(0)" ::: "memory")

struct Args {
    const float* x; const float* p; const int* pos; const float* norm_g; const float* w_in; const float* gq; const float* gk; const float* gate_w2; const float* gate_b;
    const float* gla_g; const float* w_att; const float* w_gla; const float* w_out; const float* ple_g; const float* w_pg; const float* w_ple; float* out; unsigned char* ws; int one; int zero;
};

__device__ __forceinline__ float wave_sum(float v) {
#pragma unroll
    for (int o = 1; o < 64; o <<= 1) v += __shfl_xor(v, o);
    return v;
}
__device__ __forceinline__ void p0_transpose_item(const float* W, int wpitch, int ncols, const float* kscale, bf16* WT, int tpitch, int row_off, LAS float* scr, int item, int lane, bool headperm = false) {
    const int nblk = ncols / 32, kb = item / nblk, nb = item % nblk, k0 = 64 * kb, n0 = 32 * nb;
    const int d0 = headperm ? ((nb & ~7) + (nb & 1) * 4 + ((nb & 7) >> 1)) * 32 : n0;
#pragma unroll 8
    for (int i = 0; i < 32; ++i) { const int kk = 2 * i + (lane >> 5); float v = W[(size_t)(k0 + kk) * wpitch + n0 + (lane & 31)]; if (kscale) v *= kscale[k0 + kk]; scr[kk * 33 + (lane & 31)] = v; }
    LDS_WAIT(); asm volatile("" ::: "memory");
    const int c = lane & 7;
#pragma unroll
    for (int j = 0; j < 4; ++j) { const int n = (lane >> 3) + 8 * j; const LAS float* s = scr + (8 * c) * 33 + n;
        v4u o; o.x = pk2(s[0 * 33], s[1 * 33]); o.y = pk2(s[2 * 33], s[3 * 33]); o.z = pk2(s[4 * 33], s[5 * 33]); o.w = pk2(s[6 * 33], s[7 * 33]);
        *(v4u*)(WT + (size_t)(row_off + d0 + n) * tpitch + k0 + 8 * c) = o; }
    LDS_WAIT(); asm volatile("" ::: "memory");
}

__device__ __forceinline__ void phase0(const Args& a, LAS unsigned char* lds, int tid, int lane, int wave, int G) {
    unsigned char* ws = a.ws;
    LAS float* scr = (LAS float*)(lds + wave * 16384);
    const int gw = blockIdx.x * NWAVES + wave, NGW = G * NWAVES;
    constexpr int I0 = 16 * 160, I1 = 16 * 64, I2 = 16 * 32, I3 = 16 * 64, I4 = 8 * 32, I5 = 16 * 32, I6 = 16 * 32, I7 = 16 * 32, I8 = 4 * 32;
    constexpr int NITEMS = I0 + I1 + I2 + I3 + I4 + I5 + I6 + I7 + I8;
    for (int it = gw; it < NITEMS; it += NGW) {
        int r = it;
        if (r < I0) { p0_transpose_item(a.w_in, INC, 5120, nullptr, (bf16*)(ws + WS_W1A), 1024, 0, scr, r, lane, true); continue; } r -= I0;
        if (r < I1) { p0_transpose_item(a.w_in + 5120, INC, 2048, nullptr, (bf16*)(ws + WS_W1G), 1024, 0, scr, r, lane); continue; } r -= I1;
        if (r < I2) { p0_transpose_item(a.w_in + 7184, INC, 1024, nullptr, (bf16*)(ws + WS_W1A), 1024, 5120, scr, r, lane, true); continue; } r -= I2;
        if (r < I3) { p0_transpose_item(a.w_in + 8208, INC, 2048, nullptr, (bf16*)(ws + WS_WGT), 1024, 0, scr, r, lane); continue; } r -= I3;
        if (r < I4) { p0_transpose_item(a.w_att, 1024, 1024, nullptr, (bf16*)(ws + WS_WPA), 512, 0, scr, r, lane); continue; } r -= I4;
        if (r < I5) { p0_transpose_item(a.w_gla, 1024, 1024, nullptr, (bf16*)(ws + WS_WPB), 1024, 0, scr, r, lane); continue; } r -= I5;
        if (r < I6) { p0_transpose_item(a.w_out, 1024, 1024, nullptr, (bf16*)(ws + WS_WOUT), 1024, 0, scr, r, lane); continue; } r -= I6;
        if (r < I7) { p0_transpose_item(a.w_pg, 1024, 1024, a.ple_g, (bf16*)(ws + WS_WPG), 1024, 0, scr, r, lane); continue; } r -= I7;
        p0_transpose_item(a.w_ple, 1024, 1024, nullptr, (bf16*)(ws + WS_WPLE), 256, 0, scr, r, lane);
    }
    const int gtid = blockIdx.x * 512 + tid, NT = G * 512;
    for (int i = gtid; i < 16 * 1024; i += NT) { const int k = i >> 4, r = i & 15; ((bf16*)(ws + WS_WGLR))[r * 1024 + k] = (bf16)(pk2(a.w_in[(size_t)k * INC + 7168 + r], 0.f) & 0xffffu); }
    for (int i = gtid; i < T * 8; i += NT) { const int t = i >> 3, j = i & 7;
        const float inv = exp2f(-(float)j * 0.125f * 18.931568569324174f);
        const float ang = (float)a.pos[t] * inv;
        const double ad = (double)ang; const double kq = __builtin_rint(ad * 0.15915494309189535); const float rf = (float)(ad - kq * 6.283185307179586);
        float* rt = (float*)(ws + WS_ROT) + (size_t)t * 16; rt[j] = __cosf(rf); rt[8 + j] = __sinf(rf); }
    bf16* hb = (bf16*)a.out;
    for (int m = gw; m < T; m += NGW) {
        const f32x4* xr = (const f32x4*)(a.x + (size_t)m * D) + lane; const f32x4* gr = (const f32x4*)a.norm_g + lane;
        f32x4 v[4]; float s = 0.f;
#pragma unroll
        for (int j = 0; j < 4; ++j) { v[j] = xr[64 * j]; s += (v[j][0] * v[j][0] + v[j][1] * v[j][1]) + (v[j][2] * v[j][2] + v[j][3] * v[j][3]); }
        const float rstd = rsqrtf(wave_sum(s) * (1.f / D) + EPS);
        v2u* o8 = (v2u*)(hb + (size_t)m * D) + lane;
#pragma unroll
        for (int j = 0; j < 4; ++j) { const f32x4 g = gr[64 * j]; v2u w; w.x = pk2(v[j][0] * rstd * g[0], v[j][1] * rstd * g[1]); w.y = pk2(v[j][2] * rstd * g[2], v[j][3] * rstd * g[3]); o8[64 * j] = w; }
    }
}

__device__ __forceinline__ void glr_step(const Args& a, int lane, int wave, int G) {
    const bf16* hb = (const bf16*)a.out; const bf16* wg = (const bf16*)(a.ws + WS_WGLR); float* glr = (float*)(a.ws + WS_GLR);
    const int l15 = lane & 15, quad = lane >> 4;
    for (int rt = blockIdx.x * NWAVES + wave; rt < T / 16; rt += G * NWAVES) {
        f32x4 acc = {0.f, 0.f, 0.f, 0.f};
        const bf16* ap = hb + (size_t)(rt * 16 + l15) * 1024 + 8 * quad; const bf16* bp = wg + (size_t)l15 * 1024 + 8 * quad;
#pragma unroll 8
        for (int i = 0; i < 32; ++i) acc = mfma16(*(const bf16x8*)(ap + 32 * i), *(const bf16x8*)(bp + 32 * i), acc);
#pragma unroll
        for (int j = 0; j < 4; ++j) glr[(size_t)(rt * 16 + 4 * quad + j) * 16 + l15] = acc[j];
    }
}

constexpr int GL_GLR = 0, GL_CUMX = 4096, GL_QS = 6144, GL_KS = GL_QS + 64 * 272, GL_KT = GL_KS + 64 * 272, GL_VS = GL_KT + 128 * 144, GL_AT = GL_VS + 64 * 528, GL_END = GL_AT + 64 * 144;
static_assert(GL_END <= 131072, "gla lds");
__device__ __forceinline__ void gla_local_phase(const Args& a, LAS unsigned char* lds, int tid, int lane, int wave, int G) {
    asm volatile("" : "+v"(tid), "+v"(lane));
    unsigned char* ws = a.ws;
    const bf16* PROJ = (const bf16*)(ws + WS_PROJG); const float* glr = (const float*)(ws + WS_GLR);
    bf16* Qp = (bf16*)(ws + WS_QP); bf16* OI = (bf16*)(ws + WS_OI); bf16* Lg = (bf16*)(ws + WS_L); float* gamma = (float*)(ws + WS_GAMMA);
    const int d = tid & 127, tg = tid >> 7, l15 = lane & 15, quad = lane >> 4;
    for (int unit = blockIdx.x; unit < 1024; unit += G) {
        const int b = unit >> 8, h = (unit >> 6) & 3, c = unit & 63; const int row0 = b * SEQ + c * 64;
        const bf16* P = PROJ + (size_t)row0 * PG;
#pragma unroll
        for (int i = 0; i < 2; ++i) { const int p = tid + 512 * i, tok = p >> 4, part = p & 15;
            *(LAS v4u*)(lds + GL_QS + tok * 272 + part * 16) = *(const v4u*)(P + (size_t)tok * PG + h * 128 + part * 8);
            *(LAS v4u*)(lds + GL_KS + tok * 272 + part * 16) = *(const v4u*)(P + (size_t)tok * PG + 512 + h * 128 + part * 8); }
        if (tid < 256) ((LAS f32x4*)(lds + GL_GLR))[tid] = ((const f32x4*)(glr + (size_t)row0 * 16))[tid];
#pragma unroll
        for (int i = 0; i < 4; ++i) { const int p = tid + 512 * i, tok = p >> 5, part = p & 31;
            *(LAS v4u*)(lds + GL_VS + tok * 528 + part * 16) = *(const v4u*)(P + (size_t)tok * PG + 1024 + h * 256 + part * 8); }
        float w2r[16];
#pragma unroll
        for (int r = 0; r < 16; ++r) w2r[r] = a.gate_w2[r * 512 + h * 128 + d];
        const float bias = a.gate_b[h * 128 + d];
        __syncthreads();
        float cum[16]; float run = 0.f;
#pragma unroll
        for (int i = 0; i < 16; ++i) { const int t = tg * 16 + i; const LAS f32x4* gp = (const LAS f32x4*)(lds + GL_GLR + t * 64);
            const f32x4 g0 = gp[0], g1 = gp[1], g2 = gp[2], g3 = gp[3];
            float lo = bias;
            lo += g0[0] * w2r[0] + g0[1] * w2r[1] + g0[2] * w2r[2] + g0[3] * w2r[3];
            lo += g1[0] * w2r[4] + g1[1] * w2r[5] + g1[2] * w2r[6] + g1[3] * w2r[7];
            lo += g2[0] * w2r[8] + g2[1] * w2r[9] + g2[2] * w2r[10] + g2[3] * w2r[11];
            lo += g3[0] * w2r[12] + g3[1] * w2r[13] + g3[2] * w2r[14] + g3[3] * w2r[15];
            const float ls = fminf(lo, 0.f) - __logf(1.0f + __expf(-fabsf(lo)));
            run += ls * (1.0f / 16.0f); cum[i] = run; }
        ((LAS float*)(lds + GL_CUMX))[tg * 128 + d] = run;
        __syncthreads();
        float prefix = 0.f, last = 0.f;
#pragma unroll
        for (int g = 0; g < 4; ++g) { const float v = ((LAS float*)(lds + GL_CUMX))[g * 128 + d]; last += v; if (g < tg) prefix += v; }
        unsigned ktp[8];
#pragma unroll
        for (int i = 0; i < 16; ++i) { const int t = tg * 16 + i; const float cm = cum[i] + prefix; const float q = bf2f(*(const LAS unsigned short*)(lds + GL_QS + t * 272 + d * 2)), k = bf2f(*(const LAS unsigned short*)(lds + GL_KS + t * 272 + d * 2));
            const float qp = q * __expf(cm) * 0.08838834764831845f, kp = k * __expf(-cm), kpp = k * __expf(last - cm);
            const unsigned qb = pk2(qp, 0.f) & 0xffffu;
            *(LAS unsigned short*)(lds + GL_QS + t * 272 + d * 2) = (unsigned short)qb;
            *(LAS unsigned short*)(lds + GL_KS + t * 272 + d * 2) = (unsigned short)(pk2(kp, 0.f) & 0xffffu);
            const unsigned kb = pk2(kpp, 0.f) & 0xffffu;
            if (i & 1) ktp[i >> 1] |= kb << 16; else ktp[i >> 1] = kb; }
        { v4u w0, w1; w0.x = ktp[0]; w0.y = ktp[1]; w0.z = ktp[2]; w0.w = ktp[3]; w1.x = ktp[4]; w1.y = ktp[5]; w1.z = ktp[6]; w1.w = ktp[7];
          *(LAS v4u*)(lds + GL_KT + d * 144 + tg * 32) = w0; *(LAS v4u*)(lds + GL_KT + d * 144 + tg * 32 + 16) = w1; }
        if (tg == 0) gamma[(size_t)unit * 128 + d] = __expf(last);
        __syncthreads();
#pragma unroll
        for (int i = 0; i < 2; ++i) { const int p = tid + 512 * i, tok = p >> 4, part = p & 15;
            *(v4u*)(Qp + (size_t)(row0 + tok) * 512 + h * 128 + part * 8) = *(const LAS v4u*)(lds + GL_QS + tok * 272 + part * 16); }
        { const int it = wave >> 1;
#pragma unroll
          for (int jj = 0; jj < 2; ++jj) { const int jt = (wave & 1) * 2 + jj; f32x4 acc = {0.f, 0.f, 0.f, 0.f};
#pragma unroll
            for (int ks = 0; ks < 4; ++ks) { const bf16x8 ka = *(const LAS bf16x8*)(lds + GL_KS + (16 * jt + l15) * 272 + (32 * ks + 8 * quad) * 2);
                const bf16x8 qb = *(const LAS bf16x8*)(lds + GL_QS + (16 * it + l15) * 272 + (32 * ks + 8 * quad) * 2); acc = mfma16(ka, qb, acc); }
            const int i = 16 * it + l15, j0 = 16 * jt + 4 * quad;
            v2u w; w.x = pk2(j0 + 0 <= i ? acc[0] : 0.f, j0 + 1 <= i ? acc[1] : 0.f); w.y = pk2(j0 + 2 <= i ? acc[2] : 0.f, j0 + 3 <= i ? acc[3] : 0.f);
            *(LAS v2u*)(lds + GL_AT + i * 144 + j0 * 2) = w; } }
        __syncthreads();
#pragma unroll 1
        for (int dd = 0; dd < 2; ++dd) { const int dvt = 2 * wave + dd;
            bf16x8 VF[2];
#pragma unroll
            for (int ks = 0; ks < 2; ++ks) { unsigned short e[8];
#pragma unroll
                for (int q = 0; q < 8; ++q) e[q] = *(const LAS unsigned short*)(lds + GL_VS + (32 * ks + 8 * quad + q) * 528 + (16 * dvt + l15) * 2);
                v4u t; t.x = e[0] | ((unsigned)e[1] << 16); t.y = e[2] | ((unsigned)e[3] << 16); t.z = e[4] | ((unsigned)e[5] << 16); t.w = e[6] | ((unsigned)e[7] << 16);
                VF[ks] = __builtin_bit_cast(bf16x8, t); }
#pragma unroll
            for (int it = 0; it < 4; ++it) { f32x4 acc = {0.f, 0.f, 0.f, 0.f};
#pragma unroll
                for (int ks = 0; ks < 2; ++ks) acc = mfma16(VF[ks], *(const LAS bf16x8*)(lds + GL_AT + (16 * it + l15) * 144 + (32 * ks + 8 * quad) * 2), acc);
                v2u w; w.x = pk2(acc[0], acc[1]); w.y = pk2(acc[2], acc[3]);
                *(v2u*)(OI + (size_t)(row0 + 16 * it + l15) * 1024 + h * 256 + 16 * dvt + 4 * quad) = w; }
#pragma unroll
            for (int R = 0; R < 8; ++R) { f32x4 acc = {0.f, 0.f, 0.f, 0.f};
#pragma unroll
                for (int ks = 0; ks < 2; ++ks) acc = mfma16(*(const LAS bf16x8*)(lds + GL_KT + (16 * R + l15) * 144 + (32 * ks + 8 * quad) * 2), VF[ks], acc);
                v2u w; w.x = pk2(acc[0], acc[1]); w.y = pk2(acc[2], acc[3]);
                *(v2u*)(Lg + ((size_t)(unit * 16 + dvt) * 8 + R) * 256 + lane * 4) = w; }
        }
        __syncthreads();
    }
}

constexpr int CH_L = 0, CH_Q = 4096, CH_G = 20480, CH_O = 20992, CH_STAGE = 23040;
struct ChReg { v4u l, q0, q1, q2, q3, x; };
__device__ __forceinline__ void ch_load(ChReg& r, const bf16* Lg, const float* gamma, const bf16* Qp, const bf16* OI, int unit, int dvt, int row0, int h, int lt) {
    r.l = *(const v4u*)(Lg + ((size_t)(unit * 16 + dvt) * 8) * 256 + lt * 8);
    const int rr = lt >> 4, j = (lt & 15) ^ rr;
    const bf16* qb = Qp + (size_t)(row0 + rr) * 512 + h * 128 + j * 8;
    r.q0 = *(const v4u*)(qb); r.q1 = *(const v4u*)(qb + 16 * 512); r.q2 = *(const v4u*)(qb + 32 * 512); r.q3 = *(const v4u*)(qb + 48 * 512);
    if (lt < 32) r.x = *(const v4u*)(gamma + (size_t)unit * 128 + lt * 4);
    else if (lt >= 128) { const int go = lt - 128; r.x = *(const v4u*)(OI + (size_t)(row0 + (go >> 1)) * 1024 + h * 256 + 16 * dvt + (go & 1) * 8); }
}
__device__ __forceinline__ void ch_store(const ChReg& r, LAS unsigned char* st, int lt) {
    *(LAS v4u*)(st + CH_L + lt * 16) = r.l;
    *(LAS v4u*)(st + CH_Q + lt * 16) = r.q0; *(LAS v4u*)(st + CH_Q + (lt + 256) * 16) = r.q1; *(LAS v4u*)(st + CH_Q + (lt + 512) * 16) = r.q2; *(LAS v4u*)(st + CH_Q + (lt + 768) * 16) = r.q3;
    if (lt < 32) *(LAS v4u*)(st + CH_G + lt * 16) = r.x; else if (lt >= 128) *(LAS v4u*)(st + CH_O + (lt - 128) * 16) = r.x;
}
__device__ __forceinline__ void gla_chain_phase(const Args& a, LAS unsigned char* lds, int tid, int lane, int wave, int G, int st_en) {
    asm volatile("" : "+v"(tid), "+v"(lane));
    unsigned char* ws = a.ws;
    const bf16* Qp = (const bf16*)(ws + WS_QP); bf16* OI = (bf16*)(ws + WS_OI); const bf16* Lg = (const bf16*)(ws + WS_L); const float* gamma = (const float*)(ws + WS_GAMMA); float* SS = (float*)(ws + WS_SS);
    const int l15 = lane & 15, quad = lane >> 4, lt = tid - 256, it = wave;
    const int vcu = (G % 8 == 0) ? ((int)blockIdx.x % 8) * (G / 8) + (int)blockIdx.x / 8 : (int)blockIdx.x;
    for (int item = vcu; item < 256; item += G) {
        const int bh = item >> 4, dvt = item & 15, b = bh >> 2, h = bh & 3, unit0 = bh * 64, rowb = b * SEQ;
        if (wave >= 4) {
            ChReg r0, r1, r2, r3, r4, r5, r6, r7;
#define CH_LD(rr, st) ch_load(rr, Lg, gamma, Qp, OI, unit0 + (st), dvt, rowb + (st) * 64, h, lt)
            CH_LD(r0, 0); CH_LD(r1, 1); ch_store(r0, lds, lt); ch_store(r1, lds + CH_STAGE, lt);
            CH_LD(r0, 2); CH_LD(r1, 3); CH_LD(r2, 4); CH_LD(r3, 5); CH_LD(r4, 6); CH_LD(r5, 7); CH_LD(r6, 8); CH_LD(r7, 9);
            __syncthreads();
#pragma unroll 1
            for (int q = 0; q < 8; ++q) {
#pragma unroll
                for (int j = 0; j < 4; ++j) {
                    const int sI = 4 * q + j, c0 = 2 * sI + 2, c1 = 2 * sI + 3;
                    const int n0 = (c0 + 8 < 64) ? c0 + 8 : 63, n1 = (c1 + 8 < 64) ? c1 + 8 : 63;
                    LAS unsigned char* s0 = lds + (c0 & 3) * CH_STAGE; LAS unsigned char* s1 = lds + (c1 & 3) * CH_STAGE;
#define CH_ROT2(ra, rb) do { ch_store(ra, s0, lt); ch_store(rb, s1, lt); CH_LD(ra, n0); CH_LD(rb, n1); } while (0)
                    if (j == 0) CH_ROT2(r0, r1); else if (j == 1) CH_ROT2(r2, r3); else if (j == 2) CH_ROT2(r4, r5); else CH_ROT2(r6, r7);
#undef CH_ROT2
                    __syncthreads();
                }
            }
#undef CH_LD
        } else {
            f32x4 S[8];
#pragma unroll
            for (int R = 0; R < 8; ++R) S[R] = (f32x4){0.f, 0.f, 0.f, 0.f};
            __syncthreads();
#pragma unroll 1
            for (int c2 = 0; c2 < 32; ++c2) {
#pragma unroll
              for (int u2 = 0; u2 < 2; ++u2) { const int c = 2 * c2 + u2;
                const LAS unsigned char* st = lds + (c & 3) * CH_STAGE;
                const int r = 16 * it + l15; const int row = rowb + c * 64 + r;
                f32x4 acc = {0.f, 0.f, 0.f, 0.f};
#pragma unroll
                for (int ks = 0; ks < 4; ++ks) { const int jq = 4 * ks + (quad >> 1), sub = (quad & 1) * 8;
                    const v2u qlo = *(const LAS v2u*)(st + CH_Q + r * 256 + ((jq ^ l15) << 4) + sub), qhi = *(const LAS v2u*)(st + CH_Q + r * 256 + (((jq + 2) ^ l15) << 4) + sub);
                    v4u sa; sa.x = pk2(S[2 * ks][0], S[2 * ks][1]); sa.y = pk2(S[2 * ks][2], S[2 * ks][3]); sa.z = pk2(S[2 * ks + 1][0], S[2 * ks + 1][1]); sa.w = pk2(S[2 * ks + 1][2], S[2 * ks + 1][3]);
                    acc = mfma16(__builtin_bit_cast(bf16x8, sa), mk8(qlo, qhi), acc); }
                const v2u oi = *(const LAS v2u*)(st + CH_O + r * 32 + quad * 8);
                const float o0 = acc[0] + bflo(oi.x), o1 = acc[1] + bfhi(oi.x), o2 = acc[2] + bflo(oi.y), o3 = acc[3] + bfhi(oi.y);
                v2u w; w.x = pk2(o0, o1); w.y = pk2(o2, o3);
                if (st_en) *(v2u*)(OI + (size_t)row * 1024 + h * 256 + 16 * dvt + 4 * quad) = w;
                float s = (o0 * o0 + o1 * o1) + (o2 * o2 + o3 * o3); s += __shfl_xor(s, 16); s += __shfl_xor(s, 32);
                if (quad == 0 && st_en) SS[(size_t)row * 64 + h * 16 + dvt] = s;
#pragma unroll
                for (int R = 0; R < 8; ++R) { const v2u Lr = *(const LAS v2u*)(st + CH_L + R * 512 + lane * 8); const f32x4 gm = *(const LAS f32x4*)(st + CH_G + (16 * R + 4 * quad) * 4);
                    S[R][0] = gm[0] * S[R][0] + bflo(Lr.x); S[R][1] = gm[1] * S[R][1] + bfhi(Lr.x); S[R][2] = gm[2] * S[R][2] + bflo(Lr.y); S[R][3] = gm[3] * S[R][3] + bfhi(Lr.y); }
              }
                __syncthreads();
            }
        }
    }
}

constexpr int ATS_V = 16384, ATS_SLOT = 32768;
struct AtUnit { int b, h, dsh, r, qt; };
__device__ __forceinline__ AtUnit at_decode(int unit) { AtUnit U; const int u = unit & 31, hb = unit >> 5; U.h = hb % 24; U.b = hb / 24; U.dsh = 2 * (U.h >> 3); const int ntc = 32 >> U.dsh; U.r = u / ntc; U.qt = u - U.r * ntc; return U; }
__device__ __forceinline__ const bf16* at_qbase(const bf16* PROJ, const AtUnit& U) { return PROJ + ((size_t)(U.b * 24 + U.h) * 4096 + ((size_t)U.r << (12 - U.dsh))) * 64; }
__device__ __forceinline__ void at_dma_chunk(const bf16* PROJ, const AtUnit& U, int c, LAS unsigned char* slot, int wave, int lane) {
    constexpr size_t WHICH = (size_t)T * 1536;
    const bf16* Pb = at_qbase(PROJ, U) + (size_t)c * 128 * 64;
    const int rl = lane >> 3, j = (lane & 7) ^ rl;
#pragma unroll
    for (int i = 0; i < 2; ++i) { const int rb = wave + 8 * i; const bf16* src = Pb + (size_t)(rb * 8 + rl) * 64 + j * 8;
        __builtin_amdgcn_global_load_lds((const unsigned*)(src + WHICH), (LAS unsigned*)(slot + rb * 1024), 16, 0, 0);
        __builtin_amdgcn_global_load_lds((const unsigned*)(src + 2 * WHICH), (LAS unsigned*)(slot + ATS_V + rb * 1024), 16, 0, 0); }
}
__device__ __forceinline__ void attn_phase(const Args& a, LAS unsigned char* lds, int tid, int lane, int wave, int G) {
    asm volatile("" : "+v"(tid), "+v"(lane));
    unsigned char* ws = a.ws; const bf16* PROJ = (const bf16*)(ws + WS_PROJA);
    bf16* OG = (bf16*)(ws + WS_OG); float* ML = (float*)(ws + WS_ML);
    const int l15 = lane & 15, quad = lane >> 4, w = wave;
    const int vcu = (G % 8 == 0) ? ((int)blockIdx.x % 8) * (G / 8) + (int)blockIdx.x / 8 : (int)blockIdx.x;
    const int tpb = (3072 + G - 1) / G, t0 = vcu * tpb, t1 = (t0 + tpb < 3072) ? t0 + tpb : 3072;
    bf16x8 QB[2];
    if (t0 < t1) { const AtUnit U = at_decode(t0);
        if (U.qt > 0) at_dma_chunk(PROJ, U, U.qt - 1, lds + ((t0 + 2) % 3) * ATS_SLOT, wave, lane);
        at_dma_chunk(PROJ, U, U.qt, lds + (t0 % 3) * ATS_SLOT, wave, lane);
        const bf16* qp = at_qbase(PROJ, U) + (size_t)(128 * U.qt + 16 * w + l15) * 64 + 8 * quad; QB[0] = *(const bf16x8*)qp; QB[1] = *(const bf16x8*)(qp + 32); }
    v2u pend[4]; float pmx = 0.f, pl = 0.f; size_t prow = 0; int ph = 0; bool have = false;
    for (int unit = t0; unit < t1; ++unit) {
        const AtUnit U = at_decode(unit);
        const int sc = unit % 3, sp = (U.qt > 0) ? (unit + 2) % 3 : sc;
        asm volatile("s_waitcnt vmcnt(0)" ::: "memory");
        __syncthreads();
        if (have) {
#pragma unroll
            for (int dt = 0; dt < 4; ++dt) *(v2u*)(OG + prow * 1536 + ph * 64 + 16 * dt + 4 * quad) = pend[dt];
            if (quad == 0) { v2u mlv; mlv.x = __float_as_uint(pmx); mlv.y = __float_as_uint(pl); *(v2u*)(ML + prow * 48 + ph * 2) = mlv; } }
        const bf16x8 q0 = QB[0], q1 = QB[1];
        if (unit + 1 < t1) { const AtUnit Un = at_decode(unit + 1); at_dma_chunk(PROJ, Un, Un.qt, lds + ((unit + 1) % 3) * ATS_SLOT, wave, lane);
            const bf16* qp = at_qbase(PROJ, Un) + (size_t)(128 * Un.qt + 16 * w + l15) * 64 + 8 * quad; QB[0] = *(const bf16x8*)qp; QB[1] = *(const bf16x8*)(qp + 32); }
        {
            const int qt = U.qt;
            const LAS unsigned char* bp = lds + sp * ATS_SLOT; const LAS unsigned char* bc = lds + sc * ATS_SLOT;
            f32x4 ST[9]; float mx = -INFINITY;
#pragma unroll
            for (int Tt = 0; Tt < 9; ++Tt) { f32x4 acc = {0.f, 0.f, 0.f, 0.f}; const int kr = ((16 * (w + Tt)) & 127) + l15; const LAS unsigned char* kb = (w + Tt >= 8) ? bc : bp;
                acc = mfma16(*(const LAS bf16x8*)(kb + kr * 128 + (((0 + quad) ^ (kr & 7)) << 4)), q0, acc);
                acc = mfma16(*(const LAS bf16x8*)(kb + kr * 128 + (((4 + quad) ^ (kr & 7)) << 4)), q1, acc);
#pragma unroll
                for (int e = 0; e < 4; ++e) { const int kk = 4 * quad + e; bool valid = true; if (Tt == 0) valid = kk >= l15; if (Tt == 8) valid = kk <= l15;
                    if (qt == 0) valid = valid && (w + Tt >= 8);
                    acc[e] = valid ? acc[e] : -INFINITY; mx = fmaxf(mx, acc[e]); }
                ST[Tt] = acc; }
            mx = fmaxf(mx, __shfl_xor(mx, 16)); mx = fmaxf(mx, __shfl_xor(mx, 32));
            float l = 0.f;
#pragma unroll
            for (int Tt = 0; Tt < 9; ++Tt)
#pragma unroll
                for (int e = 0; e < 4; ++e) { const float pv = __builtin_amdgcn_exp2f(ST[Tt][e] - mx); ST[Tt][e] = pv; l += pv; }
            l += __shfl_xor(l, 16); l += __shfl_xor(l, 32);
            f32x4 O[4];
#pragma unroll
            for (int dt = 0; dt < 4; ++dt) O[dt] = (f32x4){0.f, 0.f, 0.f, 0.f};
#pragma unroll
            for (int pr = 0; pr < 5; ++pr) { const int T1 = 2 * pr, T2 = (2 * pr + 1 < 9) ? 2 * pr + 1 : 8;
                v4u pf; pf.x = pk2(ST[T1][0], ST[T1][1]); pf.y = pk2(ST[T1][2], ST[T1][3]);
                if (pr < 4) { pf.z = pk2(ST[T2][0], ST[T2][1]); pf.w = pk2(ST[T2][2], ST[T2][3]); } else { pf.z = 0u; pf.w = 0u; }
                const int k1 = ((16 * (w + T1)) & 127) + 4 * quad + (l15 >> 2), k2 = ((16 * (w + T2)) & 127) + 4 * quad + (l15 >> 2);
                const LAS unsigned char* v1 = ((w + T1 >= 8) ? bc : bp) + ATS_V; const LAS unsigned char* v2 = ((w + T2 >= 8) ? bc : bp) + ATS_V;
#pragma unroll
                for (int dt = 0; dt < 4; ++dt) {
                    const int jv = 2 * dt + ((l15 & 3) >> 1), sub = (l15 & 1) * 8;
                    const s16x4 lo = __builtin_amdgcn_ds_read_tr16_b64_v4i16((LAS s16x4*)(v1 + k1 * 128 + ((jv ^ (k1 & 7)) << 4) + sub));
                    const s16x4 hi = (pr < 4) ? __builtin_amdgcn_ds_read_tr16_b64_v4i16((LAS s16x4*)(v2 + k2 * 128 + ((jv ^ (k2 & 7)) << 4) + sub)) : lo;
                    bf16x8 av; av[0] = lo[0]; av[1] = lo[1]; av[2] = lo[2]; av[3] = lo[3]; av[4] = hi[0]; av[5] = hi[1]; av[6] = hi[2]; av[7] = hi[3];
                    O[dt] = mfma16(av, __builtin_bit_cast(bf16x8, pf), O[dt]); } }
            const float inv = 1.0f / l;
            const int tokq = ((128 * qt + 16 * w + l15) << U.dsh) + U.r; const size_t trow = (size_t)U.b * SEQ + tokq;
#pragma unroll
            for (int dt = 0; dt < 4; ++dt) { pend[dt].x = pk2(O[dt][0] * inv, O[dt][1] * inv); pend[dt].y = pk2(O[dt][2] * inv, O[dt][3] * inv); }
            pmx = mx; pl = l; prow = trow; ph = U.h; have = true;
        }
    }
    if (have) {
#pragma unroll
        for (int dt = 0; dt < 4; ++dt) *(v2u*)(OG + prow * 1536 + ph * 64 + 16 * dt + 4 * quad) = pend[dt];
        if (quad == 0) { v2u mlv; mlv.x = __float_as_uint(pmx); mlv.y = __float_as_uint(pl); *(v2u*)(ML + prow * 48 + ph * 2) = mlv; } }
    asm volatile("s_waitcnt vmcnt(0)" ::: "memory"); __syncthreads();
}
__device__ __forceinline__ void prep_a_phase(const Args& a, int tid, int G) {
    asm volatile("" : "+v"(tid));
    unsigned char* ws = a.ws; const bf16* OG = (const bf16*)(ws + WS_OG); const float* ML = (const float*)(ws + WS_ML); const bf16* ZA = (const bf16*)(ws + WS_ZA);
    bf16* AA = (bf16*)(ws + WS_AA);
    for (int p = blockIdx.x * 512 + tid; p < T * 64; p += G * 512) { const int t = p >> 6, col = (p & 63) * 8, s = col >> 6, dc = col & 63;
        v4u o[3]; float m[3], l[3];
#pragma unroll
        for (int g = 0; g < 3; ++g) { const int hh = 8 * g + s; o[g] = *(const v4u*)(OG + (size_t)t * 1536 + hh * 64 + dc); m[g] = ML[(size_t)t * 48 + hh * 2]; l[g] = ML[(size_t)t * 48 + hh * 2 + 1]; }
        const float M = fmaxf(m[0], fmaxf(m[1], m[2]));
        float w0 = l[0] * __builtin_amdgcn_exp2f(m[0] - M), w1 = l[1] * __builtin_amdgcn_exp2f(m[1] - M), w2 = l[2] * __builtin_amdgcn_exp2f(m[2] - M);
        const float iw = 1.0f / (w0 + w1 + w2); w0 *= iw; w1 *= iw; w2 *= iw;
        const v4u z8 = *(const v4u*)(ZA + (size_t)t * 512 + col);
        v4u w;
        w.x = pk2((w0 * bflo(o[0].x) + w1 * bflo(o[1].x) + w2 * bflo(o[2].x)) * siluf_(bflo(z8.x)), (w0 * bfhi(o[0].x) + w1 * bfhi(o[1].x) + w2 * bfhi(o[2].x)) * siluf_(bfhi(z8.x)));
        w.y = pk2((w0 * bflo(o[0].y) + w1 * bflo(o[1].y) + w2 * bflo(o[2].y)) * siluf_(bflo(z8.y)), (w0 * bfhi(o[0].y) + w1 * bfhi(o[1].y) + w2 * bfhi(o[2].y)) * siluf_(bfhi(z8.y)));
        w.z = pk2((w0 * bflo(o[0].z) + w1 * bflo(o[1].z) + w2 * bflo(o[2].z)) * siluf_(bflo(z8.z)), (w0 * bfhi(o[0].z) + w1 * bfhi(o[1].z) + w2 * bfhi(o[2].z)) * siluf_(bfhi(z8.z)));
        w.w = pk2((w0 * bflo(o[0].w) + w1 * bflo(o[1].w) + w2 * bflo(o[2].w)) * siluf_(bflo(z8.w)), (w0 * bfhi(o[0].w) + w1 * bfhi(o[1].w) + w2 * bfhi(o[2].w)) * siluf_(bfhi(z8.w)));
        *(v4u*)(AA + (size_t)t * 512 + col) = w; }
}


#ifndef REP_MASK
#define REP_MASK 0
#endif
#ifndef DBG_STOP
#define DBG_STOP 0
#endif
#if DBG_STOP
__device__ __forceinline__ float dbg_san(float v) { return (fabsf(v) < 1e30f) ? v : 777.0f; }
__device__ __forceinline__ float dbg_sum_bf16(const void* p, size_t bytes, int gtid, int NT) { const unsigned* q = (const unsigned*)p; float s = 0.f; for (size_t i = gtid; i < bytes / 4; i += NT) { const unsigned w = q[i]; s += dbg_san(bflo(w)) + dbg_san(bfhi(w)); } return s; }
__device__ __forceinline__ float dbg_sum_f32(const void* p, size_t bytes, int gtid, int NT) { const float* q = (const float*)p; float s = 0.f; for (size_t i = gtid; i < bytes / 4; i += NT) s += dbg_san(q[i]); return s; }
#define DBG_DUMP(k, NS, ...) if (DBG_STOP == (k)) { const int gtid_ = blockIdx.x * 512 + tid, NT_ = G * 512; float sv_[NS] = { __VA_ARGS__ }; GRID_SYNC(); \
    for (size_t i = gtid_; i < (size_t)T * D; i += NT_) args.out[i] = 0.f; _Pragma("unroll") for (int q_ = 0; q_ < NS; ++q_) args.out[(size_t)q_ * NT_ + gtid_] = sv_[q_]; return; }
#define SB(off, mib) dbg_sum_bf16(ws + (off), (size_t)(mib) * MiB, gtid_, NT_)
#define SF(off, mib) dbg_sum_f32(ws + (off), (size_t)(mib) * MiB, gtid_, NT_)
#else
#define DBG_DUMP(k, NS, ...)
#endif
typedef __attribute__((address_space(1))) unsigned gu32;
#define XB_TMO      128
#define XB_XCNT(j)  (256  + 64 * (j))
#define XB_XSUB(j)  (1280 + 64 * (j))
#define XB_XGEN(j)  (2304 + 64 * (j))
#define XB_TOP      3328
#define XB_TOPGEN   3392
#define XCD_BAR_WORDS 3456
#define XB_SPIN_CAP (1u << 18)

__device__ __forceinline__ unsigned xb_ld(unsigned* p)              { return __hip_atomic_load(p, __ATOMIC_RELAXED, __HIP_MEMORY_SCOPE_AGENT); }
__device__ __forceinline__ unsigned xb_add(unsigned* p, unsigned v) { return __hip_atomic_fetch_add(p, v, __ATOMIC_RELAXED, __HIP_MEMORY_SCOPE_AGENT); }
__device__ __forceinline__ unsigned xb_xcc_id() { return (unsigned)__builtin_amdgcn_s_getreg((3 << 11) | 20) & 0xFu; }
#define XB_SPIN(cond, bar) do { unsigned _sp = 0; while (cond) { __builtin_amdgcn_s_sleep(1); \
    if ((++_sp & 255u) == 0u) { if (xb_ld(&(bar)[XB_TMO])) break; if (_sp > XB_SPIN_CAP) { atomicAdd(&(bar)[XB_TMO], 1u); break; } } } } while (0)

struct XcdBarrier {
    unsigned* bar; unsigned x;
    volatile LAS unsigned* st;
};

__device__ __forceinline__ XcdBarrier xcd_barrier_post(unsigned* bar, volatile LAS unsigned* st) {
    XcdBarrier b; b.bar = bar; b.x = xb_xcc_id(); b.st = st;
    if (threadIdx.x == 0) (void)xb_add(&bar[XB_XCNT(b.x)], 1u);
    return b;
}
__device__ __forceinline__ void xcd_barrier_complete(unsigned* bar, unsigned x, unsigned& nloc, unsigned& nx) {
    const unsigned G = gridDim.x * gridDim.y * gridDim.z;
    unsigned sum, cnt, mine, sp = 0u;
    for (;;) {
        sum = 0u; cnt = 0u; mine = 0u;
#pragma unroll
        for (unsigned j = 0; j < 16; ++j) { const unsigned c = xb_ld(&bar[XB_XCNT(j)]); sum += c; cnt += (c > 0u) ? 1u : 0u; mine = (j == x) ? c : mine; }
        if (sum == G) break;
        __builtin_amdgcn_s_sleep(1);
        if ((++sp & 255u) == 0u) { if (xb_ld(&bar[XB_TMO])) break; if (sp > XB_SPIN_CAP) { atomicAdd(&bar[XB_TMO], 1u); break; } }
    }
    nloc = mine > 0u ? mine : 1u; nx = cnt > 0u ? cnt : 1u;
}

__device__ __forceinline__ void xcd_barrier(const XcdBarrier& b) {
    asm volatile("s_waitcnt vmcnt(0)" ::: "memory");
    __syncthreads();
    if (threadIdx.x == 0) {
        unsigned* bar = b.bar;
        __builtin_amdgcn_s_waitcnt(0);
        unsigned nloc = b.st[0], nx = b.st[1];
        if (nloc == 0u) { xcd_barrier_complete(bar, b.x, nloc, nx); b.st[0] = nloc; b.st[1] = nx; }
        const unsigned old = xb_add(&bar[XB_XSUB(b.x)], 1u);
        const unsigned gen = old / nloc;
        if (old + 1u == (gen + 1u) * nloc) {
            __builtin_amdgcn_fence(__ATOMIC_RELEASE, "agent");
            asm volatile("s_waitcnt vmcnt(0)" ::: "memory");
            const unsigned og = xb_add(&bar[XB_TOP], 1u);
            const unsigned tg = og / nx;
            if (og + 1u == (tg + 1u) * nx) xb_add(&bar[XB_TOPGEN], 1u);
            else XB_SPIN(xb_ld(&bar[XB_TOPGEN]) == tg, bar);
            __builtin_amdgcn_fence(__ATOMIC_ACQUIRE, "agent");
            xb_add(&bar[XB_XGEN(b.x)], 1u);
            asm volatile("s_waitcnt vmcnt(0)" ::: "memory");
        } else {
            XB_SPIN(xb_ld(&bar[XB_XGEN(b.x)]) == gen, bar);
            __builtin_amdgcn_fence(__ATOMIC_ACQUIRE, "agent");
            asm volatile("s_waitcnt vmcnt(0)" ::: "memory");
        }
    }
    __syncthreads();
}


__device__ __forceinline__ void panel_handoff(unsigned* cnt, int pm, unsigned want) {
    asm volatile("s_waitcnt vmcnt(0)" ::: "memory");
    __syncthreads();
    if (threadIdx.x == 0) {
        unsigned* c = cnt + 64 * pm;
        __hip_atomic_fetch_add(c, 1u, __ATOMIC_RELAXED, __HIP_MEMORY_SCOPE_AGENT);
        unsigned sp = 0;
        while (__hip_atomic_load(c, __ATOMIC_RELAXED, __HIP_MEMORY_SCOPE_AGENT) < want) { __builtin_amdgcn_s_sleep(1); if (++sp > (1u << 22)) break; }
        __builtin_amdgcn_fence(__ATOMIC_ACQUIRE, "agent");
        asm volatile("s_waitcnt vmcnt(0)" ::: "memory");
    }
    __syncthreads();
}
#define GRID_SYNC_CG() do { asm volatile("s_waitcnt vmcnt(0) lgkmcnt(0)" ::: "memory"); grid.sync(); __builtin_amdgcn_fence(__ATOMIC_ACQUIRE, "agent"); asm volatile("s_waitcnt vmcnt(0)" ::: "memory"); } while (0)
#define GRID_SYNC() xcd_barrier(xbar)
__global__ void __launch_bounds__(NWAVES * 64, 2) mega_fwd(Args args) {
    extern __shared__ __attribute__((aligned(16))) unsigned char lds_raw[];
    LAS unsigned char* lds = (LAS unsigned char*)lds_raw;
    cg::grid_group grid = cg::this_grid();
    const int tid = threadIdx.x, lane = tid & 63, wave = __builtin_amdgcn_readfirstlane(tid >> 6), G = gridDim.x;
    unsigned char* ws = args.ws;
    if (tid < 32) ((LAS unsigned*)(lds + MISC_OFF))[tid] = 0u;
    __syncthreads();
    const XcdBarrier xbar = xcd_barrier_post((unsigned*)(ws + WS_BAR), (volatile LAS unsigned*)(lds + MISC_OFF) + 8);
    const pg8::bf16_t* hb = (const pg8::bf16_t*)args.out;
    const pg8::bf16_t* AB = (const pg8::bf16_t*)args.out + (size_t)T * 1024;

#if REP_MASK & 32
    for (int q_ = 0; q_ < 10; ++q_) { GRID_SYNC(); }
#endif
    phase0(args, lds, tid, lane, wave, G);
#if REP_MASK & 1
    phase0(args, lds, tid, lane, wave, G);
#endif
    if (args.zero) { GRID_SYNC_CG(); }
    GRID_SYNC();
    glr_step(args, lane, wave, G);
    { pg8::Gemm g{hb, hb, hb, (const pg8::bf16_t*)(ws + WS_W1G), (const pg8::bf16_t*)(ws + WS_W1G), (const pg8::bf16_t*)(ws + WS_W1G), 16, 16, 16, 1024, 1024};
      pg8::SegOrder S; S.init(T, PG, G, (int)blockIdx.x, 1); pg8::EpiBf16 E{(pg8::bf16_t*)(ws + WS_PROJG), PG};
      pg8::gemm_phase<pg8::EpiBf16, pg8::SegOrder, true, true>(lds, g, S, E); }
#if REP_MASK & 128
    { pg8::Gemm g{hb, hb, hb, (const pg8::bf16_t*)(ws + WS_W1G), (const pg8::bf16_t*)(ws + WS_W1G), (const pg8::bf16_t*)(ws + WS_W1G), 16, 16, 16, 1024, 1024};
      pg8::SegOrder S; S.init(T, PG, G, (int)blockIdx.x, 1); pg8::EpiBf16 E{(pg8::bf16_t*)(ws + WS_PROJG), PG};
      pg8::gemm_phase<pg8::EpiBf16, pg8::SegOrder, true, true>(lds, g, S, E); }
#endif
    GRID_SYNC();
    DBG_DUMP(2, 7, SB(WS_W1A, 10), SB(WS_W1G, 6), SB(WS_WGT, 4), SF(WS_ROT, 1), dbg_sum_bf16(args.out, 32 * MiB, gtid_, NT_), SF(WS_GLR, 1), SB(WS_PROJG, 96))
    gla_local_phase(args, lds, tid, lane, wave, G);
#if REP_MASK & 2
    gla_local_phase(args, lds, tid, lane, wave, G);
#endif
    GRID_SYNC();
    DBG_DUMP(3, 4, SB(WS_QP, 16), SB(WS_OI, 32), SB(WS_L, 64), SF(WS_GAMMA, 0.5))
    DBG_DUMP(31, 1, SB(WS_QP, 16))
    DBG_DUMP(32, 1, SB(WS_OI, 32))
    DBG_DUMP(33, 1, SB(WS_L, 64))
    gla_chain_phase(args, lds, tid, lane, wave, G, args.one);
#if REP_MASK & 64
    gla_chain_phase(args, lds, tid, lane, wave, G, args.zero);
#endif
    GRID_SYNC();
    DBG_DUMP(4, 2, SB(WS_OI, 32), SF(WS_SS, 4))
    { pg8::Gemm g{hb, hb, hb, (const pg8::bf16_t*)(ws + WS_W1A), (const pg8::bf16_t*)(ws + WS_W1A), (const pg8::bf16_t*)(ws + WS_W1A), 16, 16, 16, 1024, 1024};
      pg8::SegOrder S; S.init(T, 6144, G, (int)blockIdx.x, 1);
      pg8::EpiQKV E{(pg8::bf16_t*)(ws + WS_PROJA), (pg8::bf16_t*)(ws + WS_ZA), args.gq, args.gk, (const float*)(ws + WS_ROT), EPS, (const pg8::bf16_t*)(ws + WS_OI), (const float*)(ws + WS_SS), args.gla_g, (pg8::bf16_t*)args.out + (size_t)T * 1024};
      pg8::gemm_phase<pg8::EpiQKV, pg8::SegOrder, true, true>(lds, g, S, E); }
#if REP_MASK & 256
    { pg8::Gemm g{hb, hb, hb, (const pg8::bf16_t*)(ws + WS_W1A), (const pg8::bf16_t*)(ws + WS_W1A), (const pg8::bf16_t*)(ws + WS_W1A), 16, 16, 16, 1024, 1024};
      pg8::SegOrder S; S.init(T, 6144, G, (int)blockIdx.x, 1);
      pg8::EpiQKV E{(pg8::bf16_t*)(ws + WS_PROJA), (pg8::bf16_t*)(ws + WS_ZA), args.gq, args.gk, (const float*)(ws + WS_ROT), EPS, (const pg8::bf16_t*)(ws + WS_OI), (const float*)(ws + WS_SS), args.gla_g, (pg8::bf16_t*)args.out + (size_t)T * 1024};
      pg8::gemm_phase<pg8::EpiQKV, pg8::SegOrder, true, true>(lds, g, S, E); }
#endif
    GRID_SYNC();
    attn_phase(args, lds, tid, lane, wave, G);
#if REP_MASK & 8
    attn_phase(args, lds, tid, lane, wave, G);
#endif
    GRID_SYNC();
    prep_a_phase(args, tid, G);
#if REP_MASK & 16
    prep_a_phase(args, tid, G);
#endif
    GRID_SYNC();
    DBG_DUMP(8, 4, SB(WS_PROJA, 160), SB(WS_OG, 48), SF(WS_ML, 3), SB(WS_AA, 16))
    { bf16* pb = (bf16*)(ws + WS_PB);
      for (int i = blockIdx.x * 512 + tid; i < T * 256 / 8; i += G * 512) { const f32x4 v0 = ((const f32x4*)args.p)[2 * i], v1 = ((const f32x4*)args.p)[2 * i + 1];
          v4u w; w.x = pk2(v0[0], v0[1]); w.y = pk2(v0[2], v0[3]); w.z = pk2(v1[0], v1[1]); w.w = pk2(v1[2], v1[3]); ((v4u*)pb)[i] = w; } }
    { const pg8::bf16_t* WGT = (const pg8::bf16_t*)(ws + WS_WGT);
      pg8::Gemm g{hb, hb, hb, WGT, WGT + (size_t)1024 * 1024, WGT, 16, 16, 16, 1024, 1024};
      pg8::SegOrder S; S.init(T, 1024, G, (int)blockIdx.x, 2); pg8::EpiSig2 E{(pg8::bf16_t*)(ws + WS_SGA), (pg8::bf16_t*)(ws + WS_SGB), 1024};
      pg8::gemm_phase<pg8::EpiSig2, pg8::SegOrder, true, true>(lds, g, S, E); }
    { const pg8::bf16_t* AA = (const pg8::bf16_t*)(ws + WS_AA); const pg8::bf16_t* WPA = (const pg8::bf16_t*)(ws + WS_WPA);
      pg8::Gemm g{AA, AA, AA, WPA, WPA, WPA, 8, 8, 8, 512, 512};
      pg8::SegOrder S; S.init(T, 1024, G, (int)blockIdx.x, 1); pg8::EpiGateMul E{(const pg8::bf16_t*)(ws + WS_SGA), (pg8::bf16_t*)(ws + WS_T1), 1024};
      pg8::gemm_phase<pg8::EpiGateMul, pg8::SegOrder, true, true>(lds, g, S, E); }
    { const pg8::bf16_t* WPB = (const pg8::bf16_t*)(ws + WS_WPB);
      pg8::Gemm g{AB, AB, AB, WPB, WPB, WPB, 16, 16, 16, 1024, 1024};
      pg8::SegOrder S; S.init(T, 1024, G, (int)blockIdx.x, 1); pg8::EpiMergeY E{(const pg8::bf16_t*)(ws + WS_SGB), (const pg8::bf16_t*)(ws + WS_T1), (pg8::bf16_t*)(ws + WS_Y), 1024};
      pg8::gemm_phase<pg8::EpiMergeY, pg8::SegOrder, true, true>(lds, g, S, E); }
#if REP_MASK & 512
    { const pg8::bf16_t* WGT = (const pg8::bf16_t*)(ws + WS_WGT);
      pg8::Gemm g{hb, hb, hb, WGT, WGT + (size_t)1024 * 1024, WGT, 16, 16, 16, 1024, 1024};
      pg8::SegOrder S; S.init(T, 1024, G, (int)blockIdx.x, 2); pg8::EpiSig2 E{(pg8::bf16_t*)(ws + WS_SGA), (pg8::bf16_t*)(ws + WS_SGB), 1024};
      pg8::gemm_phase<pg8::EpiSig2, pg8::SegOrder, true, true>(lds, g, S, E); }
    { const pg8::bf16_t* AA = (const pg8::bf16_t*)(ws + WS_AA); const pg8::bf16_t* WPA = (const pg8::bf16_t*)(ws + WS_WPA);
      pg8::Gemm g{AA, AA, AA, WPA, WPA, WPA, 8, 8, 8, 512, 512};
      pg8::SegOrder S; S.init(T, 1024, G, (int)blockIdx.x, 1); pg8::EpiGateMul E{(const pg8::bf16_t*)(ws + WS_SGA), (pg8::bf16_t*)(ws + WS_T1), 1024};
      pg8::gemm_phase<pg8::EpiGateMul, pg8::SegOrder, true, true>(lds, g, S, E); }
    { const pg8::bf16_t* WPB = (const pg8::bf16_t*)(ws + WS_WPB);
      pg8::Gemm g{AB, AB, AB, WPB, WPB, WPB, 16, 16, 16, 1024, 1024};
      pg8::SegOrder S; S.init(T, 1024, G, (int)blockIdx.x, 1); pg8::EpiMergeY E{(const pg8::bf16_t*)(ws + WS_SGB), (const pg8::bf16_t*)(ws + WS_T1), (pg8::bf16_t*)(ws + WS_Y), 1024};
      pg8::gemm_phase<pg8::EpiMergeY, pg8::SegOrder, true, true>(lds, g, S, E); }
#endif
    GRID_SYNC();
    DBG_DUMP(9, 5, SF(WS_TMP1, 64), SF(WS_TMP2, 64), SB(WS_Y, 32), SB(WS_PB, 8), SB(WS_WPA, 7))
    { const pg8::bf16_t* Y = (const pg8::bf16_t*)(ws + WS_Y); const pg8::bf16_t* W = (const pg8::bf16_t*)(ws + WS_WOUT);
      pg8::Gemm g{Y, Y, Y, W, W, W, 16, 16, 16, 1024, 1024};
      pg8::SegOrder S; S.init(T, 1024, G, (int)blockIdx.x, 1); pg8::EpiResid E{args.x, args.out, (pg8::bf16_t*)(ws + WS_X1B), (float*)(ws + WS_PS), 1024};
      pg8::gemm_phase<pg8::EpiResid, pg8::SegOrder, true, true>(lds, g, S, E); }
#if REP_MASK & 1024
    { const pg8::bf16_t* Y = (const pg8::bf16_t*)(ws + WS_Y); const pg8::bf16_t* W = (const pg8::bf16_t*)(ws + WS_WOUT);
      pg8::Gemm g{Y, Y, Y, W, W, W, 16, 16, 16, 1024, 1024};
      pg8::SegOrder S; S.init(T, 1024, G, (int)blockIdx.x, 1); pg8::EpiResid E{args.x, args.out, (pg8::bf16_t*)(ws + WS_X1B), (float*)(ws + WS_PS), 1024};
      pg8::gemm_phase<pg8::EpiResid, pg8::SegOrder, true, true>(lds, g, S, E); }
#endif
    { pg8::SegOrder S; S.init(T, 1024, G, (int)blockIdx.x, 1); pg8::Unit u0;
      if (S.nwg == G && S.next(0, u0)) panel_handoff((unsigned*)(ws + WS_PCNT), u0.pm, 4u); else { GRID_SYNC(); } }
    DBG_DUMP(10, 3, SB(WS_X1B, 32), SF(WS_PS, 1), dbg_sum_f32(args.out, 64 * MiB, gtid_, NT_))
    { const pg8::bf16_t* X1 = (const pg8::bf16_t*)(ws + WS_X1B); const pg8::bf16_t* W = (const pg8::bf16_t*)(ws + WS_WPG);
      pg8::Gemm g{X1, X1, X1, W, W, W, 16, 16, 16, 1024, 1024};
      pg8::SegOrder S; S.init(T, 1024, G, (int)blockIdx.x, 1); pg8::EpiSigRow E{(const float*)(ws + WS_PS), (pg8::bf16_t*)(ws + WS_SGA), 1024, EPS};
      pg8::gemm_phase<pg8::EpiSigRow, pg8::SegOrder, true, true>(lds, g, S, E); }
#if REP_MASK & 2048
    { const pg8::bf16_t* X1 = (const pg8::bf16_t*)(ws + WS_X1B); const pg8::bf16_t* W = (const pg8::bf16_t*)(ws + WS_WPG);
      pg8::Gemm g{X1, X1, X1, W, W, W, 16, 16, 16, 1024, 1024};
      pg8::SegOrder S; S.init(T, 1024, G, (int)blockIdx.x, 1); pg8::EpiSigRow E{(const float*)(ws + WS_PS), (pg8::bf16_t*)(ws + WS_SGA), 1024, EPS};
      pg8::gemm_phase<pg8::EpiSigRow, pg8::SegOrder, true, true>(lds, g, S, E); }
#endif
    { const pg8::bf16_t* PBm = (const pg8::bf16_t*)(ws + WS_PB); const pg8::bf16_t* W = (const pg8::bf16_t*)(ws + WS_WPLE);
      pg8::Gemm g{PBm, PBm, PBm, W, W, W, 4, 4, 4, 256, 256};
      pg8::SegOrder S; S.init(T, 1024, G, (int)blockIdx.x, 1); pg8::EpiPle2 E{args.out, (const pg8::bf16_t*)(ws + WS_SGA), 1024};
      pg8::gemm_phase<pg8::EpiPle2, pg8::SegOrder, true, true>(lds, g, S, E); }
}

extern "C" void kernel_launch(void* const* d_in, const int* in_sizes, int n_in, void* d_out, int out_size, void* d_ws, size_t ws_size, hipStream_t stream) {
    static int grid = 0;
    if (grid == 0) {
        if (n_in != 16 || out_size != T * D || ws_size < WS_END) { fprintf(stderr, "kernel_launch: unexpected shapes (n_in %d out %d ws %zu)\n", n_in, out_size, ws_size); grid = -1; return; }
        int dev = 0, cus = 0, per_cu = 0;
        (void)hipGetDevice(&dev); (void)hipDeviceGetAttribute(&cus, hipDeviceAttributeMultiprocessorCount, dev);
        (void)hipFuncSetAttribute((const void*)mega_fwd, hipFuncAttributeMaxDynamicSharedMemorySize, LDS_BYTES);
        (void)hipOccupancyMaxActiveBlocksPerMultiprocessor(&per_cu, (const void*)mega_fwd, NWAVES * 64, LDS_BYTES);
        if (per_cu < 1) { fprintf(stderr, "kernel_launch: occupancy query says %d blocks per CU\n", per_cu); per_cu = 1; }
        (void)hipGetLastError();
        grid = cus;
    }
    if (grid < 0) return;
    Args a{};
    a.x = (const float*)d_in[0]; a.p = (const float*)d_in[1]; a.pos = (const int*)d_in[2]; a.norm_g = (const float*)d_in[3]; a.w_in = (const float*)d_in[4];
    a.gq = (const float*)d_in[5]; a.gk = (const float*)d_in[6]; a.gate_w2 = (const float*)d_in[7]; a.gate_b = (const float*)d_in[8]; a.gla_g = (const float*)d_in[9];
    a.w_att = (const float*)d_in[10]; a.w_gla = (const float*)d_in[11]; a.w_out = (const float*)d_in[12]; a.ple_g = (const float*)d_in[13]; a.w_pg = (const float*)d_in[14]; a.w_ple = (const float*)d_in[15];
    a.out = (float*)d_out; a.ws = (unsigned char*)d_ws; a.one = 1; a.zero = 0;
    if (hipMemsetAsync((char*)d_ws + WS_BAR, 0, BAR_BYTES, stream) != hipSuccess) { fprintf(stderr, "kernel_launch: memset of barrier words failed\n"); return; }
    void* kargs[] = {&a};
    hipError_t e = hipLaunchCooperativeKernel((const void*)mega_fwd, dim3(grid), dim3(NWAVES * 64), kargs, LDS_BYTES, stream);
    if (e != hipSuccess) fprintf(stderr, "cooperative launch failed: %s (grid %d)\n", hipGetErrorString(e), grid);
}
```

```cpp
#define REP_MASK 0
#define DBG_STOP 0
#include <hip/hip_runtime.h>
#include <hip/hip_cooperative_groups.h>
#include <cstdio>
#include <cstdint>
namespace cg = cooperative_groups;

namespace pg8 {
#define PG8_LAS __attribute__((address_space(3)))
typedef unsigned short bf16_t;
typedef short bf16x8 __attribute__((ext_vector_type(8)));
typedef float f32x4 __attribute__((ext_vector_type(4)));
typedef unsigned u32x4 __attribute__((ext_vector_type(4)));
typedef unsigned u32x2 __attribute__((ext_vector_type(2)));
constexpr int BM = 256, BK = 64, HALF = 128, HTB = HALF * BK * 2  , STAGE_BYTES = 8 * HTB, NXCD = 8, WGM = 8;

__host__ __device__ __forceinline__ int lds_byte(int r, int c) { const int st = (r >> 4) * 2 + (c >> 5), rr = r & 15, cc = c & 31, ob = rr * 64 + cc * 2; return st * 1024 + (ob ^ (((ob >> 9) & 1) << 5)); }
__host__ __device__ __forceinline__ void stage_rc(int b, int& R, int& C) { const int st = b / 1024, sb = b % 1024, swz = sb ^ (((sb >> 9) & 1) << 5); R = (st >> 1) * 16 + swz / 64; C = (st & 1) * 32 + (swz % 64) / 2; }
__host__ __device__ __forceinline__ int perm32(int rho) { const int n = rho >> 4, i = rho & 15; return 8 * (i >> 2) + 4 * n + (i & 3); }

struct Unit { int pm, pn, seg; };
struct Gemm {
    const bf16_t* A0; const bf16_t* A1; const bf16_t* A2; const bf16_t* B0; const bf16_t* B1; const bf16_t* B2; int nt0, nt1, nt2, lda, ldb;
    __device__ __forceinline__ const bf16_t* selA(int s) const { const bf16_t* a0 = +A0; const bf16_t* a1 = +A1; const bf16_t* a2 = +A2; return s == 0 ? +a0 : (s == 1 ? +a1 : +a2); }
    __device__ __forceinline__ const bf16_t* selB(int s) const { const bf16_t* b0 = +B0; const bf16_t* b1 = +B1; const bf16_t* b2 = +B2; return s == 0 ? +b0 : (s == 1 ? +b1 : +b2); }
    __device__ __forceinline__ int selNt(int s) const { const int n0 = +nt0, n1 = +nt1, n2 = +nt2; return s == 0 ? +n0 : (s == 1 ? +n1 : +n2); }
};
struct SegOrder {
    int nM, nN, nwg, G, c, nseg;
    __device__ void init(int M, int N, int G_, int c_, int nseg_) { nM = M / BM; nN = N / BM; nwg = nM * nN; G = G_; c = c_; nseg = nseg_; }
    __device__ bool next(int i, Unit& u) const {
        const int ti = i / nseg; u.seg = i - ti * nseg;
        const long L = (long)ti * G + c; if (L >= nwg) return false;
        int wgid = (int)L; { const int q = nwg / NXCD, r = nwg % NXCD, xcd = wgid % NXCD, off = wgid / NXCD; wgid = (xcd < r ? xcd * (q + 1) : r * (q + 1) + (xcd - r) * q) + off; }
        const int nig = WGM * nN, gid = wgid / nig, fm = gid * WGM, gsz = (nM - fm) < WGM ? (nM - fm) : WGM;
        u.pm = fm + ((wgid % nig) % gsz); u.pn = (wgid % nig) / gsz; return true;
    }
    __device__ __forceinline__ void a_ready(const Unit&) const {}
    __device__ __forceinline__ void done(const Unit&) const {}
};
typedef __bf16 bf16x2_t __attribute__((ext_vector_type(2)));
typedef float f32x2_t __attribute__((ext_vector_type(2)));
__device__ __forceinline__ unsigned cvt_pk_bf16(float lo, float hi) { f32x2_t f = {lo, hi}; bf16x2_t v = __builtin_convertvector(f, bf16x2_t); return __builtin_bit_cast(unsigned, v); }
__device__ __forceinline__ float sigmoidf_(float x) { return __builtin_amdgcn_rcpf(1.0f + __expf(-x)); }

struct EpiBf16 {
    static constexpr bool PERM = true, AFTER_DRAIN = false;
    bf16_t* O; int ldc;
    __device__ __forceinline__ void operator()(const f32x4 (&acc)[2][2][4][2], const Unit& u, int wr, int wc, int fr, int fq) const {
        const int row0 = u.pm * BM + wr * 64 + fr; const int col0 = u.pn * BM + wc * 32 + 8 * fq;
#pragma unroll
        for (int ai = 0; ai < 2; ++ai)
#pragma unroll
            for (int m = 0; m < 4; ++m) { bf16_t* rowp = O + (size_t)(row0 + ai * HALF + m * 16) * ldc + col0;
#pragma unroll
                for (int bj = 0; bj < 2; ++bj) { const f32x4 v0 = acc[ai][bj][m][0], v1 = acc[ai][bj][m][1];
                    u32x4 w; w.x = cvt_pk_bf16(v0[0], v0[1]); w.y = cvt_pk_bf16(v0[2], v0[3]); w.z = cvt_pk_bf16(v1[0], v1[1]); w.w = cvt_pk_bf16(v1[2], v1[3]);
                    *(u32x4*)(rowp + bj * HALF) = w; } }
    }
};
#define PG8_FOR_ACC(body) \
    _Pragma("unroll") for (int ai = 0; ai < 2; ++ai) _Pragma("unroll") for (int m = 0; m < 4; ++m) { const int row = u.pm * BM + ai * HALF + wr * 64 + m * 16 + fr; \
    _Pragma("unroll") for (int bj = 0; bj < 2; ++bj) _Pragma("unroll") for (int n = 0; n < 2; ++n) { const size_t off = (size_t)row * ldc + (u.pn * BM + bj * HALF + wc * 32 + n * 16 + 4 * fq); const f32x4 a = acc[ai][bj][m][n]; body } }
struct EpiStoreF32 {
    static constexpr bool PERM = false, AFTER_DRAIN = false;
    float* tmp; int ldc;
    __device__ __forceinline__ void operator()(const f32x4 (&acc)[2][2][4][2], const Unit& u, int wr, int wc, int fr, int fq) const {
        PG8_FOR_ACC( *(f32x4*)(tmp + off) = a; )
    }
};
struct EpiMerge {
    static constexpr bool PERM = false, AFTER_DRAIN = false;
    float* tmp1; float* tmp2; bf16_t* y; int ldc;
    __device__ __forceinline__ void operator()(const f32x4 (&acc)[2][2][4][2], const Unit& u, int wr, int wc, int fr, int fq) const {
        if (u.seg == 0) {
            PG8_FOR_ACC( f32x4 t = *(const f32x4*)(tmp1 + off); t[0] *= sigmoidf_(a[0]); t[1] *= sigmoidf_(a[1]); t[2] *= sigmoidf_(a[2]); t[3] *= sigmoidf_(a[3]); *(f32x4*)(tmp1 + off) = t; )
        } else if (u.seg == 1) {
            PG8_FOR_ACC( *(f32x4*)(tmp2 + off) = a; )
        } else {
            PG8_FOR_ACC( const f32x4 t1 = *(const f32x4*)(tmp1 + off); const f32x4 t2 = *(const f32x4*)(tmp2 + off);
                u32x2 w; w.x = cvt_pk_bf16(t1[0] + sigmoidf_(a[0]) * t2[0], t1[1] + sigmoidf_(a[1]) * t2[1]); w.y = cvt_pk_bf16(t1[2] + sigmoidf_(a[2]) * t2[2], t1[3] + sigmoidf_(a[3]) * t2[3]);
                *(u32x2*)(y + off) = w; )
        }
    }
};
__device__ __forceinline__ void st_sc1_16(void* p, u32x4 w) { asm volatile("global_store_dwordx4 %0, %1, off sc1" :: "v"(p), "v"(w) : "memory"); }
struct EpiResid {
    static constexpr bool PERM = true, AFTER_DRAIN = false;
    const float* x; float* out; bf16_t* x1b; float* ps; int ldc;
    __device__ __forceinline__ void operator()(const f32x4 (&acc)[2][2][4][2], const Unit& u, int wr, int wc, int fr, int fq) const {
#pragma unroll
        for (int ai = 0; ai < 2; ++ai)
#pragma unroll
            for (int m = 0; m < 4; ++m) { const int row = u.pm * BM + ai * HALF + wr * 64 + m * 16 + fr; float s = 0.f;
#pragma unroll
                for (int bj = 0; bj < 2; ++bj) { const size_t off = (size_t)row * ldc + (u.pn * BM + bj * HALF + wc * 32 + 8 * fq);
                    const f32x4 v0 = *(const f32x4*)(x + off) + acc[ai][bj][m][0], v1 = *(const f32x4*)(x + off + 4) + acc[ai][bj][m][1];
                    *(f32x4*)(out + off) = v0; *(f32x4*)(out + off + 4) = v1;
                    u32x4 w; w.x = cvt_pk_bf16(v0[0], v0[1]); w.y = cvt_pk_bf16(v0[2], v0[3]); w.z = cvt_pk_bf16(v1[0], v1[1]); w.w = cvt_pk_bf16(v1[2], v1[3]);
                    st_sc1_16(x1b + off, w);
                    s += ((v0[0] * v0[0] + v0[1] * v0[1]) + (v0[2] * v0[2] + v0[3] * v0[3])) + ((v1[0] * v1[0] + v1[1] * v1[1]) + (v1[2] * v1[2] + v1[3] * v1[3])); }
                s += __shfl_xor(s, 16); s += __shfl_xor(s, 32);
                if (fq == 0) __hip_atomic_store(ps + (size_t)row * 16 + u.pn * 4 + wc, s, __ATOMIC_RELAXED, __HIP_MEMORY_SCOPE_AGENT);
                asm volatile("" ::: "memory"); }
    }
};
struct EpiPle {
    static constexpr bool PERM = false, AFTER_DRAIN = false;
    float* out; const float* tmp; const float* ps; int ldc; float eps;
    __device__ __forceinline__ void operator()(const f32x4 (&acc)[2][2][4][2], const Unit& u, int wr, int wc, int fr, int fq) const {
#pragma unroll
        for (int ai = 0; ai < 2; ++ai)
#pragma unroll
            for (int m = 0; m < 4; ++m) { const int row = u.pm * BM + ai * HALF + wr * 64 + m * 16 + fr;
                const f32x4* pp = (const f32x4*)(ps + (size_t)row * 16); const f32x4 p0 = pp[0], p1 = pp[1], p2 = pp[2], p3 = pp[3];
                const float ss = ((p0[0] + p0[1]) + (p0[2] + p0[3])) + ((p1[0] + p1[1]) + (p1[2] + p1[3])) + ((p2[0] + p2[1]) + (p2[2] + p2[3])) + ((p3[0] + p3[1]) + (p3[2] + p3[3]));
                const float rstd = rsqrtf(ss * (1.0f / 1024.0f) + eps);
#pragma unroll
                for (int bj = 0; bj < 2; ++bj)
#pragma unroll
                    for (int n = 0; n < 2; ++n) { const size_t off = (size_t)row * ldc + (u.pn * BM + bj * HALF + wc * 32 + n * 16 + 4 * fq);
                        const f32x4 a = acc[ai][bj][m][n]; const f32x4 t = *(const f32x4*)(tmp + off); f32x4 o = *(const f32x4*)(out + off);
                        o[0] += t[0] * sigmoidf_(rstd * a[0]); o[1] += t[1] * sigmoidf_(rstd * a[1]); o[2] += t[2] * sigmoidf_(rstd * a[2]); o[3] += t[3] * sigmoidf_(rstd * a[3]);
                        *(f32x4*)(out + off) = o; } }
    }
};

__device__ __forceinline__ f32x4 unpack_bf16x4(u32x2 w) { f32x4 r; r[0] = __uint_as_float(w.x << 16); r[1] = __uint_as_float(w.x & 0xffff0000u); r[2] = __uint_as_float(w.y << 16); r[3] = __uint_as_float(w.y & 0xffff0000u); return r; }
struct EpiSig2 {
    static constexpr bool PERM = false, AFTER_DRAIN = false;
    bf16_t* s0; bf16_t* s1; int ldc;
    __device__ __forceinline__ void operator()(const f32x4 (&acc)[2][2][4][2], const Unit& u, int wr, int wc, int fr, int fq) const {
        bf16_t* dst = u.seg == 0 ? s0 : s1;
        PG8_FOR_ACC( u32x2 w; w.x = cvt_pk_bf16(sigmoidf_(a[0]), sigmoidf_(a[1])); w.y = cvt_pk_bf16(sigmoidf_(a[2]), sigmoidf_(a[3])); *(u32x2*)(dst + off) = w; )
    }
};
struct EpiGateMul {
    static constexpr bool PERM = false, AFTER_DRAIN = false;
    const bf16_t* sg; bf16_t* t1; int ldc;
    __device__ __forceinline__ void operator()(const f32x4 (&acc)[2][2][4][2], const Unit& u, int wr, int wc, int fr, int fq) const {
        PG8_FOR_ACC( const f32x4 g = unpack_bf16x4(*(const u32x2*)(sg + off)); u32x2 w; w.x = cvt_pk_bf16(g[0] * a[0], g[1] * a[1]); w.y = cvt_pk_bf16(g[2] * a[2], g[3] * a[3]); *(u32x2*)(t1 + off) = w; )
    }
};
struct EpiMergeY {
    static constexpr bool PERM = false, AFTER_DRAIN = false;
    const bf16_t* sg; const bf16_t* t1; bf16_t* y; int ldc;
    __device__ __forceinline__ void operator()(const f32x4 (&acc)[2][2][4][2], const Unit& u, int wr, int wc, int fr, int fq) const {
        PG8_FOR_ACC( const f32x4 g = unpack_bf16x4(*(const u32x2*)(sg + off)); const f32x4 t = unpack_bf16x4(*(const u32x2*)(t1 + off));
            u32x2 w; w.x = cvt_pk_bf16(t[0] + g[0] * a[0], t[1] + g[1] * a[1]); w.y = cvt_pk_bf16(t[2] + g[2] * a[2], t[3] + g[3] * a[3]); *(u32x2*)(y + off) = w; )
    }
};
struct EpiSigRow {
    static constexpr bool PERM = true, AFTER_DRAIN = false;
    const float* ps; bf16_t* sg; int ldc; float eps;
    __device__ __forceinline__ void operator()(const f32x4 (&acc)[2][2][4][2], const Unit& u, int wr, int wc, int fr, int fq) const {
#pragma unroll
        for (int ai = 0; ai < 2; ++ai)
#pragma unroll
            for (int m = 0; m < 4; ++m) { const int row = u.pm * BM + ai * HALF + wr * 64 + m * 16 + fr;
                const f32x4* pp = (const f32x4*)(ps + (size_t)row * 16); const f32x4 p0 = pp[0], p1 = pp[1], p2 = pp[2], p3 = pp[3];
                const float ss = ((p0[0] + p0[1]) + (p0[2] + p0[3])) + ((p1[0] + p1[1]) + (p1[2] + p1[3])) + ((p2[0] + p2[1]) + (p2[2] + p2[3])) + ((p3[0] + p3[1]) + (p3[2] + p3[3]));
                const float rstd = rsqrtf(ss * (1.0f / 1024.0f) + eps);
#pragma unroll
                for (int bj = 0; bj < 2; ++bj) { const size_t off = (size_t)row * ldc + (u.pn * BM + bj * HALF + wc * 32 + 8 * fq);
                    const f32x4 a0 = acc[ai][bj][m][0], a1 = acc[ai][bj][m][1];
                    u32x4 w; w.x = cvt_pk_bf16(sigmoidf_(rstd * a0[0]), sigmoidf_(rstd * a0[1])); w.y = cvt_pk_bf16(sigmoidf_(rstd * a0[2]), sigmoidf_(rstd * a0[3]));
                    w.z = cvt_pk_bf16(sigmoidf_(rstd * a1[0]), sigmoidf_(rstd * a1[1])); w.w = cvt_pk_bf16(sigmoidf_(rstd * a1[2]), sigmoidf_(rstd * a1[3]));
                    *(u32x4*)(sg + off) = w; } }
    }
};
struct EpiPle2 {
    static constexpr bool PERM = true, AFTER_DRAIN = false;
    float* out; const bf16_t* sg; int ldc;
    __device__ __forceinline__ void operator()(const f32x4 (&acc)[2][2][4][2], const Unit& u, int wr, int wc, int fr, int fq) const {
#pragma unroll
        for (int ai = 0; ai < 2; ++ai)
#pragma unroll
            for (int m = 0; m < 4; ++m) { const int row = u.pm * BM + ai * HALF + wr * 64 + m * 16 + fr;
#pragma unroll
                for (int bj = 0; bj < 2; ++bj) { const size_t off = (size_t)row * ldc + (u.pn * BM + bj * HALF + wc * 32 + 8 * fq);
                    const u32x4 g8 = *(const u32x4*)(sg + off); const f32x4 a0 = acc[ai][bj][m][0], a1 = acc[ai][bj][m][1];
                    f32x4 o0 = *(const f32x4*)(out + off), o1 = *(const f32x4*)(out + off + 4);
                    o0[0] += a0[0] * __uint_as_float(g8.x << 16); o0[1] += a0[1] * __uint_as_float(g8.x & 0xffff0000u); o0[2] += a0[2] * __uint_as_float(g8.y << 16); o0[3] += a0[3] * __uint_as_float(g8.y & 0xffff0000u);
                    o1[0] += a1[0] * __uint_as_float(g8.z << 16); o1[1] += a1[1] * __uint_as_float(g8.z & 0xffff0000u); o1[2] += a1[2] * __uint_as_float(g8.w << 16); o1[3] += a1[3] * __uint_as_float(g8.w & 0xffff0000u);
                    *(f32x4*)(out + off) = o0; *(f32x4*)(out + off + 4) = o1; }
                asm volatile("" ::: "memory"); }
    }
};

struct EpiQKV {
    static constexpr bool PERM = true, AFTER_DRAIN = false;
    bf16_t* QKV; bf16_t* ZA; const float* gq; const float* gk; const float* rot; float eps;
    const bf16_t* OI; const float* SS; const float* gla_g; bf16_t* AB;
    __device__ __forceinline__ void operator()(const f32x4 (&acc)[2][2][4][2], const Unit& u, int wr, int wc, int fr, int fq) const {
        const int row0 = u.pm * BM + wr * 64 + fr; const int cl = u.pn * BM + 64 * wc;
        if (cl >= 5120) {
            const int zc0 = cl - 5120 + 8 * fq, hB = (cl - 5120) >> 8;
            const f32x4 ga0 = *(const f32x4*)(gla_g + (zc0 & 255)), ga1 = *(const f32x4*)(gla_g + (zc0 & 255) + 4), gb0 = *(const f32x4*)(gla_g + ((zc0 + 32) & 255)), gb1 = *(const f32x4*)(gla_g + ((zc0 + 32) & 255) + 4);
#pragma unroll
            for (int ai = 0; ai < 2; ++ai)
#pragma unroll
                for (int m = 0; m < 4; ++m) { const int row = row0 + ai * HALF + m * 16;
                    const f32x4* sp = (const f32x4*)(SS + (size_t)row * 64 + hB * 16); const f32x4 s0 = sp[0], s1 = sp[1], s2 = sp[2], s3 = sp[3];
                    const float ss = ((s0[0] + s0[1]) + (s0[2] + s0[3])) + ((s1[0] + s1[1]) + (s1[2] + s1[3])) + ((s2[0] + s2[1]) + (s2[2] + s2[3])) + ((s3[0] + s3[1]) + (s3[2] + s3[3]));
                    const float rstd = rsqrtf(ss * (1.0f / 256.0f) + eps);
#pragma unroll
                    for (int bj = 0; bj < 2; ++bj) { const size_t off = (size_t)row * 1024 + zc0 + 32 * bj; const u32x4 o8 = *(const u32x4*)(OI + off);
                        const f32x4 z0 = acc[ai][bj][m][0], z1 = acc[ai][bj][m][1]; const f32x4 g0 = bj ? gb0 : ga0, g1 = bj ? gb1 : ga1;
                        u32x4 w;
                        w.x = cvt_pk_bf16(__uint_as_float(o8.x << 16) * rstd * g0[0] * (z0[0] * sigmoidf_(z0[0])), __uint_as_float(o8.x & 0xffff0000u) * rstd * g0[1] * (z0[1] * sigmoidf_(z0[1])));
                        w.y = cvt_pk_bf16(__uint_as_float(o8.y << 16) * rstd * g0[2] * (z0[2] * sigmoidf_(z0[2])), __uint_as_float(o8.y & 0xffff0000u) * rstd * g0[3] * (z0[3] * sigmoidf_(z0[3])));
                        w.z = cvt_pk_bf16(__uint_as_float(o8.z << 16) * rstd * g1[0] * (z1[0] * sigmoidf_(z1[0])), __uint_as_float(o8.z & 0xffff0000u) * rstd * g1[1] * (z1[1] * sigmoidf_(z1[1])));
                        w.w = cvt_pk_bf16(__uint_as_float(o8.w << 16) * rstd * g1[2] * (z1[2] * sigmoidf_(z1[2])), __uint_as_float(o8.w & 0xffff0000u) * rstd * g1[3] * (z1[3] * sigmoidf_(z1[3])));
                        *(u32x4*)(AB + off) = w; } }
            return;
        }
        if (cl >= 4608) {
#pragma unroll
            for (int ai = 0; ai < 2; ++ai)
#pragma unroll
                for (int m = 0; m < 4; ++m) { const int row = row0 + ai * HALF + m * 16;
#pragma unroll
                    for (int bj = 0; bj < 2; ++bj) { const f32x4 v0 = acc[ai][bj][m][0], v1 = acc[ai][bj][m][1];
                        u32x4 w; w.x = cvt_pk_bf16(v0[0], v0[1]); w.y = cvt_pk_bf16(v0[2], v0[3]); w.z = cvt_pk_bf16(v1[0], v1[1]); w.w = cvt_pk_bf16(v1[2], v1[3]);
                        *(u32x4*)(ZA + (size_t)row * 512 + (cl - 4608) + 32 * bj + 8 * fq) = w; } }
            return;
        }
        const int which = cl / 1536, hc = cl - which * 1536, h = hc >> 6, dsh = 2 * (h >> 3);
        bf16_t* base = QKV + (size_t)which * ((size_t)16384 * 1536) + 8 * fq;
        const bool qk = which < 2;
        const float* gp = which == 0 ? gq : gk; const float sc = which == 0 ? 0.125f * 1.4426950408889634f : 1.0f;
        f32x4 g00 = {1.f, 1.f, 1.f, 1.f}, g01 = g00, g10 = g00, g11 = g00;
        if (qk) { g00 = *(const f32x4*)(gp + 8 * fq); g01 = *(const f32x4*)(gp + 8 * fq + 4); g10 = *(const f32x4*)(gp + 32 + 8 * fq); g11 = *(const f32x4*)(gp + 32 + 8 * fq + 4); }
#pragma unroll
        for (int ai = 0; ai < 2; ++ai)
#pragma unroll
            for (int m = 0; m < 4; ++m) { const int row = row0 + ai * HALF + m * 16; const int b = row >> 12, t = row & 4095;
                const int idx = ((t & ((1 << dsh) - 1)) << (12 - dsh)) + (t >> dsh);
                bf16_t* dst = base + ((size_t)(b * 24 + h) * 4096 + idx) * 64;
                f32x4 a0 = acc[ai][0][m][0], a1 = acc[ai][0][m][1], c0 = acc[ai][1][m][0], c1 = acc[ai][1][m][1];
                if (qk) {
                    float ss = ((a0[0] * a0[0] + a0[1] * a0[1]) + (a0[2] * a0[2] + a0[3] * a0[3])) + ((a1[0] * a1[0] + a1[1] * a1[1]) + (a1[2] * a1[2] + a1[3] * a1[3]))
                             + ((c0[0] * c0[0] + c0[1] * c0[1]) + (c0[2] * c0[2] + c0[3] * c0[3])) + ((c1[0] * c1[0] + c1[1] * c1[1]) + (c1[2] * c1[2] + c1[3] * c1[3]));
                    ss += __shfl_xor(ss, 16); ss += __shfl_xor(ss, 32);
                    const float rstd = rsqrtf(ss * (1.0f / 64.0f) + eps);
                    a0 = a0 * rstd * g00; a1 = a1 * rstd * g01; c0 = c0 * rstd * g10; c1 = c1 * rstd * g11;
                    f32x4 p0, p1;
                    p0[0] = __shfl_xor(a0[0], 16); p0[1] = __shfl_xor(a0[1], 16); p0[2] = __shfl_xor(a0[2], 16); p0[3] = __shfl_xor(a0[3], 16);
                    p1[0] = __shfl_xor(a1[0], 16); p1[1] = __shfl_xor(a1[1], 16); p1[2] = __shfl_xor(a1[2], 16); p1[3] = __shfl_xor(a1[3], 16);
                    if (fq < 2) { const float* rp = rot + (size_t)row * 16; const f32x4 cs0 = *(const f32x4*)(rp), cs1 = *(const f32x4*)(rp + 4), sn0 = *(const f32x4*)(rp + 8), sn1 = *(const f32x4*)(rp + 12);
                        const float sg = fq == 0 ? -1.f : 1.f; a0 = a0 * cs0 + (p0 * sn0) * sg; a1 = a1 * cs1 + (p1 * sn1) * sg; }
                    a0 = a0 * sc; a1 = a1 * sc; c0 = c0 * sc; c1 = c1 * sc;
                }
                u32x4 w0, w1; w0.x = cvt_pk_bf16(a0[0], a0[1]); w0.y = cvt_pk_bf16(a0[2], a0[3]); w0.z = cvt_pk_bf16(a1[0], a1[1]); w0.w = cvt_pk_bf16(a1[2], a1[3]);
                w1.x = cvt_pk_bf16(c0[0], c0[1]); w1.y = cvt_pk_bf16(c0[2], c0[3]); w1.z = cvt_pk_bf16(c1[0], c1[1]); w1.w = cvt_pk_bf16(c1[2], c1[3]);
                *(u32x4*)dst = w0; *(u32x4*)(dst + 32) = w1; }
    }
};

template <class Epi, class Sched, bool ALIGN_EPI = false, bool SP2 = false>
__device__ __forceinline__ void gemm_phase(PG8_LAS unsigned char* lds, const Gemm g, const Sched& S, const Epi& E) {
    int tid_ = threadIdx.x; asm volatile("" : "+v"(tid_));
    const int tid = tid_, wid = __builtin_amdgcn_readfirstlane(tid >> 6), lane = tid & 63, wr = wid >> 2, wc = wid & 3, fr = lane & 15, fq = lane >> 4;
    const int lda = g.lda, ldb = g.ldb;
    unsigned voffA[2], voffB[2];
#pragma unroll
    for (int i = 0; i < 2; ++i) { int R, C; stage_rc(tid * 16 + i * 8192, R, C); const int Rb = Epi::PERM ? ((R & ~31) + perm32(R & 31)) : R;
        voffA[i] = (unsigned)(R * lda + C) * 2u; voffB[i] = (unsigned)(Rb * ldb + C) * 2u; }
    const size_t kstep = (size_t)(BK * 2);
    const size_t hstepA = (size_t)HALF * lda * 2, hstepB = (size_t)HALF * ldb * 2;
    const size_t tstepA = 2 * hstepA, tstepB = 2 * hstepB;
    const unsigned ldsw = (unsigned)wid * 1024u;
    const int aoff = lds_byte(wr * 64 + fr, fq * 8), boff = lds_byte(wc * 32 + fr, fq * 8);
#define PG8_SA(b, h) (((b) * 2 + (h)) * HTB)
#define PG8_SB(b, h) ((4 + (b) * 2 + (h)) * HTB)
#define PG8_STAGE(bufoff, gbase, voff) do { _Pragma("unroll") for (int _i = 0; _i < 2; ++_i) \
        __builtin_amdgcn_global_load_lds((const unsigned*)((const char*)(gbase) + (voff)[_i]), (PG8_LAS unsigned*)(lds + (bufoff) + ldsw + _i * 8192), 16, 0, 0); } while (0)
#define PG8_LDA(dst, b, h) do { _Pragma("unroll") for (int m = 0; m < 4; ++m) _Pragma("unroll") for (int k = 0; k < 2; ++k) dst[m][k] = *(const PG8_LAS bf16x8*)(lds + PG8_SA(b, h) + aoff + m * 2048 + k * 1024); } while (0)
#define PG8_LDB(dst, b, h) do { _Pragma("unroll") for (int n = 0; n < 2; ++n) _Pragma("unroll") for (int k = 0; k < 2; ++k) dst[n][k] = *(const PG8_LAS bf16x8*)(lds + PG8_SB(b, h) + boff + n * 2048 + k * 1024); } while (0)
#define PG8_MMA(ai, bj, At, Bt) do { __builtin_amdgcn_s_setprio(1); _Pragma("unroll") for (int m = 0; m < 4; ++m) _Pragma("unroll") for (int n = 0; n < 2; ++n) _Pragma("unroll") for (int k = 0; k < 2; ++k) \
        acc[ai][bj][m][n] = __builtin_amdgcn_mfma_f32_16x16x32_bf16(Bt[n][k], At[m][k], acc[ai][bj][m][n], 0, 0, 0); __builtin_amdgcn_s_setprio(0); } while (0)
#define PG8_WAIT_V(n) asm volatile("s_waitcnt vmcnt(" #n ")" ::: "memory")
#define PG8_WAIT_L(n) asm volatile("s_waitcnt lgkmcnt(" #n ")" ::: "memory")
#define PG8_BAR __builtin_amdgcn_s_barrier()
#define PG8_SCHED __builtin_amdgcn_sched_barrier(0)
    Unit cur, nxt; int ui = 0;
    if (!S.next(0, cur)) return;
    f32x4 acc[2][2][4][2];
#pragma unroll
    for (int a = 0; a < 2; ++a)
#pragma unroll
        for (int b = 0; b < 2; ++b)
#pragma unroll
            for (int m = 0; m < 4; ++m)
#pragma unroll
                for (int n = 0; n < 2; ++n) acc[a][b][m][n] = (f32x4){0.f, 0.f, 0.f, 0.f};
    bf16x8 At[4][2], B0[2][2], B1[2][2];
    const char* cA = (const char*)g.selA(cur.seg) + (size_t)cur.pm * tstepA; const char* cB = (const char*)g.selB(cur.seg) + (size_t)cur.pn * tstepB;
    S.a_ready(cur);
    if constexpr (SP2) {
        PG8_STAGE(PG8_SB(0, 0), cB, voffB); PG8_STAGE(PG8_SB(0, 1), cB + hstepB, voffB); PG8_STAGE(PG8_SA(0, 0), cA, voffA); PG8_STAGE(PG8_SA(0, 1), cA + hstepA, voffA);
        if (wr == 1) PG8_BAR;
        PG8_WAIT_V(2); PG8_BAR;
        PG8_STAGE(PG8_SB(1, 0), cB + kstep, voffB); PG8_STAGE(PG8_SA(1, 0), cA + kstep, voffA); PG8_STAGE(PG8_SB(1, 1), cB + hstepB + kstep, voffB);
        PG8_WAIT_V(6); PG8_BAR;
    } else {
        PG8_STAGE(PG8_SB(0, 0), cB, voffB); PG8_STAGE(PG8_SA(0, 0), cA, voffA); PG8_STAGE(PG8_SB(0, 1), cB + hstepB, voffB); PG8_STAGE(PG8_SA(0, 1), cA + hstepA, voffA);
        if (wr == 1) PG8_BAR;
        PG8_WAIT_V(4); PG8_BAR;
        PG8_STAGE(PG8_SB(1, 0), cB + kstep, voffB); PG8_STAGE(PG8_SA(1, 0), cA + kstep, voffA); PG8_STAGE(PG8_SB(1, 1), cB + hstepB + kstep, voffB);
        PG8_WAIT_V(6); PG8_BAR;
    }
    for (;;) {
        const bool has_next = S.next(ui + 1, nxt);
        const char* nA = has_next ? (const char*)g.selA(nxt.seg) + (size_t)nxt.pm * tstepA : cA; const char* nB = has_next ? (const char*)g.selB(nxt.seg) + (size_t)nxt.pn * tstepB : cB;
        const int nt = g.selNt(cur.seg);
        for (int t = 0; t < nt; t += 2) {
            const bool last = (t == nt - 2);
            const char* a1 = cA + (size_t)(t + 1) * kstep;
            const char* a2 = last ? nA : cA + (size_t)(t + 2) * kstep; const char* b2 = last ? nB : cB + (size_t)(t + 2) * kstep;
            const char* a3 = a2 + kstep; const char* b3 = b2 + kstep;
            if (last && has_next) S.a_ready(nxt);
            if constexpr (SP2) {
            PG8_LDB(B0, 0, 0); PG8_LDB(B1, 0, 1); PG8_SCHED; PG8_LDA(At, 0, 0); PG8_STAGE(PG8_SA(1, 1), a1 + hstepA, voffA);
            PG8_WAIT_V(8); PG8_WAIT_L(0); PG8_BAR; PG8_MMA(0, 0, At, B0); PG8_MMA(0, 1, At, B1); PG8_BAR; PG8_SCHED;
            PG8_LDA(At, 0, 1); PG8_STAGE(PG8_SB(0, 0), b2, voffB); PG8_STAGE(PG8_SB(0, 1), b2 + hstepB, voffB); PG8_STAGE(PG8_SA(0, 0), a2, voffA);
            PG8_WAIT_V(8); PG8_WAIT_L(0); PG8_BAR; PG8_MMA(1, 0, At, B0); PG8_MMA(1, 1, At, B1); PG8_BAR; PG8_SCHED;
            PG8_LDB(B0, 1, 0); PG8_LDB(B1, 1, 1); PG8_SCHED; PG8_LDA(At, 1, 0); PG8_STAGE(PG8_SA(0, 1), a2 + hstepA, voffA);
            PG8_WAIT_V(8); PG8_WAIT_L(0); PG8_BAR; PG8_MMA(0, 0, At, B0); PG8_MMA(0, 1, At, B1); PG8_BAR; PG8_SCHED;
            PG8_LDA(At, 1, 1); PG8_STAGE(PG8_SB(1, 0), b3, voffB); PG8_STAGE(PG8_SB(1, 1), b3 + hstepB, voffB); PG8_STAGE(PG8_SA(1, 0), a3, voffA);
            PG8_WAIT_V(8); PG8_WAIT_L(0); PG8_BAR; PG8_MMA(1, 0, At, B0); PG8_MMA(1, 1, At, B1); PG8_BAR; PG8_SCHED;
            } else {
            PG8_LDB(B0, 0, 0); PG8_SCHED; PG8_LDA(At, 0, 0); PG8_STAGE(PG8_SA(1, 1), a1 + hstepA, voffA);
            PG8_WAIT_L(8); PG8_BAR; PG8_WAIT_L(0); PG8_MMA(0, 0, At, B0); PG8_BAR; PG8_SCHED;
            PG8_LDB(B1, 0, 1); PG8_STAGE(PG8_SB(0, 0), b2, voffB);
            PG8_BAR; PG8_WAIT_L(0); PG8_MMA(0, 1, At, B1); PG8_BAR;
            PG8_LDA(At, 0, 1); PG8_STAGE(PG8_SA(0, 0), a2, voffA);
            PG8_BAR; PG8_WAIT_L(0); PG8_MMA(1, 0, At, B0); PG8_BAR; PG8_SCHED;
            PG8_STAGE(PG8_SB(0, 1), b2 + hstepB, voffB);
            PG8_WAIT_V(6); PG8_BAR; PG8_MMA(1, 1, At, B1); PG8_BAR;
            PG8_LDB(B0, 1, 0); PG8_SCHED; PG8_LDA(At, 1, 0); PG8_STAGE(PG8_SA(0, 1), a2 + hstepA, voffA);
            PG8_WAIT_L(8); PG8_BAR; PG8_WAIT_L(0); PG8_MMA(0, 0, At, B0); PG8_BAR; PG8_SCHED;
            PG8_LDB(B1, 1, 1); PG8_STAGE(PG8_SB(1, 0), b3, voffB);
            PG8_BAR; PG8_WAIT_L(0); PG8_MMA(0, 1, At, B1); PG8_BAR;
            PG8_LDA(At, 1, 1); PG8_STAGE(PG8_SA(1, 0), a3, voffA);
            PG8_BAR; PG8_WAIT_L(0); PG8_MMA(1, 0, At, B0); PG8_BAR; PG8_SCHED;
            PG8_STAGE(PG8_SB(1, 1), b3 + hstepB, voffB);
            PG8_WAIT_V(6); PG8_BAR; PG8_MMA(1, 1, At, B1); PG8_BAR;
            }
        }
        if constexpr (ALIGN_EPI) { if (wr == 0) PG8_BAR; }
        if constexpr (!Epi::AFTER_DRAIN) { E(acc, cur, wr, wc, fr, fq); S.done(cur); }
        if (!has_next) break;
#pragma unroll
        for (int a = 0; a < 2; ++a)
#pragma unroll
            for (int b = 0; b < 2; ++b)
#pragma unroll
                for (int m = 0; m < 4; ++m)
#pragma unroll
                    for (int n = 0; n < 2; ++n) acc[a][b][m][n] = (f32x4){0.f, 0.f, 0.f, 0.f};
        cur = nxt; cA = nA; cB = nB; ++ui;
        if constexpr (ALIGN_EPI) { if (wr == 1) PG8_BAR; }
    }
    PG8_WAIT_V(0);
    if constexpr (!ALIGN_EPI) { if (wr == 0) PG8_BAR; }
    PG8_BAR;
    if constexpr (Epi::AFTER_DRAIN) { E.fused(acc, cur, wr, wc, fr, fq, lds, wid, lane); S.done(cur); }
#undef PG8_SA
#undef PG8_SB
#undef PG8_STAGE
#undef PG8_LDA
#undef PG8_LDB
#undef PG8_MMA
#undef PG8_WAIT_V
#undef PG8_WAIT_L
#undef PG8_BAR
#undef PG8_SCHED
}
}

constexpr int NWAVES = 8;
constexpr int T = 16384, D = 1024, SEQ = 4096, INC = 10256;
constexpr int PA = 5120;
constexpr int PG = 2048;
constexpr float EPS = 1e-6f;
constexpr size_t MiB = 1u << 20;
constexpr size_t WS_W1A = 0, WS_W1G = 12 * MiB, WS_WGT = 16 * MiB, WS_WPA = 20 * MiB, WS_WPB = 21 * MiB, WS_WOUT = 23 * MiB, WS_WPG = 25 * MiB, WS_WPLE = 27 * MiB, WS_WGLR = 27 * MiB + 512 * 1024;
constexpr size_t WS_ROT = 28 * MiB, WS_GLR = 29 * MiB, WS_GAMMA = 30 * MiB, WS_ML = 29 * MiB  , WS_PS = 29 * MiB  ;
constexpr size_t WS_PROJG = 32 * MiB, WS_QP = 96 * MiB, WS_L = 112 * MiB, WS_OI = 192 * MiB, WS_SS = 224 * MiB;
constexpr size_t WS_PROJA = 32 * MiB, WS_ZA = 176 * MiB  , WS_OG = 192 * MiB, WS_AA = 240 * MiB;
constexpr size_t WS_TMP1 = 32 * MiB, WS_TMP2 = 96 * MiB, WS_SGA = 32 * MiB, WS_SGB = 64 * MiB, WS_T1 = 96 * MiB, WS_Y = 136 * MiB, WS_PB = 128 * MiB, WS_X1B = 208 * MiB, WS_END = 256 * MiB;
constexpr int LDS_BYTES = 147456, MISC_OFF = 131072 + 320;
constexpr size_t WS_BAR = 27 * MiB + 512 * 1024 + 65536, WS_PCNT = WS_BAR + 16384, BAR_BYTES = 16384 + 2 * 16384;

#define LAS __attribute__((address_space(3)))
typedef unsigned short bf16;
typedef unsigned v4u __attribute__((ext_vector_type(4)));
typedef unsigned v2u __attribute__((ext_vector_type(2)));
typedef float f32x4 __attribute__((ext_vector_type(4)));
typedef short bf16x8 __attribute__((ext_vector_type(8)));
typedef short s16x4 __attribute__((ext_vector_type(4)));
__device__ __forceinline__ float bflo(unsigned w) { return __uint_as_float(w << 16); }
__device__ __forceinline__ float bfhi(unsigned w) { return __uint_as_float(w & 0xffff0000u); }
__device__ __forceinline__ float bf2f(unsigned short b) { return __uint_as_float(((unsigned)b) << 16); }
__device__ __forceinline__ unsigned pk2(float lo, float hi) { return pg8::cvt_pk_bf16(lo, hi); }
__device__ __forceinline__ bf16x8 mk8(v2u lo, v2u hi) { v4u t; t.x = lo.x; t.y = lo.y; t.z = hi.x; t.w = hi.y; return __builtin_bit_cast(bf16x8, t); }
__device__ __forceinline__ f32x4 mfma16(bf16x8 a, bf16x8 b, f32x4 c) { return __builtin_amdgcn_mfma_f32_16x16x32_bf16(a, b, c, 0, 0, 0); }
__device__ __forceinline__ float siluf_(float x) { return x * pg8::sigmoidf_(x); }
#define LDS_WAIT() asm volatile("s_waitcnt lgkmcnt(0)" ::: "memory")

struct Args {
    const float* x; const float* p; const int* pos; const float* norm_g; const float* w_in; const float* gq; const float* gk; const float* gate_w2; const float* gate_b;
    const float* gla_g; const float* w_att; const float* w_gla; const float* w_out; const float* ple_g; const float* w_pg; const float* w_ple; float* out; unsigned char* ws; int one; int zero;
};

__device__ __forceinline__ float wave_sum(float v) {
#pragma unroll
    for (int o = 1; o < 64; o <<= 1) v += __shfl_xor(v, o);
    return v;
}
__device__ __forceinline__ void p0_transpose_item(const float* W, int wpitch, int ncols, const float* kscale, bf16* WT, int tpitch, int row_off, LAS float* scr, int item, int lane, bool headperm = false) {
    const int nblk = ncols / 32, kb = item / nblk, nb = item % nblk, k0 = 64 * kb, n0 = 32 * nb;
    const int d0 = headperm ? ((nb & ~7) + (nb & 1) * 4 + ((nb & 7) >> 1)) * 32 : n0;
#pragma unroll 8
    for (int i = 0; i < 32; ++i) { const int kk = 2 * i + (lane >> 5); float v = W[(size_t)(k0 + kk) * wpitch + n0 + (lane & 31)]; if (kscale) v *= kscale[k0 + kk]; scr[kk * 33 + (lane & 31)] = v; }
    LDS_WAIT(); asm volatile("" ::: "memory");
    const int c = lane & 7;
#pragma unroll
    for (int j = 0; j < 4; ++j) { const int n = (lane >> 3) + 8 * j; const LAS float* s = scr + (8 * c) * 33 + n;
        v4u o; o.x = pk2(s[0 * 33], s[1 * 33]); o.y = pk2(s[2 * 33], s[3 * 33]); o.z = pk2(s[4 * 33], s[5 * 33]); o.w = pk2(s[6 * 33], s[7 * 33]);
        *(v4u*)(WT + (size_t)(row_off + d0 + n) * tpitch + k0 + 8 * c) = o; }
    LDS_WAIT(); asm volatile("" ::: "memory");
}

__device__ __forceinline__ void phase0(const Args& a, LAS unsigned char* lds, int tid, int lane, int wave, int G) {
    unsigned char* ws = a.ws;
    LAS float* scr = (LAS float*)(lds + wave * 16384);
    const int gw = blockIdx.x * NWAVES + wave, NGW = G * NWAVES;
    constexpr int I0 = 16 * 160, I1 = 16 * 64, I2 = 16 * 32, I3 = 16 * 64, I4 = 8 * 32, I5 = 16 * 32, I6 = 16 * 32, I7 = 16 * 32, I8 = 4 * 32;
    constexpr int NITEMS = I0 + I1 + I2 + I3 + I4 + I5 + I6 + I7 + I8;
    for (int it = gw; it < NITEMS; it += NGW) {
        int r = it;
        if (r < I0) { p0_transpose_item(a.w_in, INC, 5120, nullptr, (bf16*)(ws + WS_W1A), 1024, 0, scr, r, lane, true); continue; } r -= I0;
        if (r < I1) { p0_transpose_item(a.w_in + 5120, INC, 2048, nullptr, (bf16*)(ws + WS_W1G), 1024, 0, scr, r, lane); continue; } r -= I1;
        if (r < I2) { p0_transpose_item(a.w_in + 7184, INC, 1024, nullptr, (bf16*)(ws + WS_W1A), 1024, 5120, scr, r, lane, true); continue; } r -= I2;
        if (r < I3) { p0_transpose_item(a.w_in + 8208, INC, 2048, nullptr, (bf16*)(ws + WS_WGT), 1024, 0, scr, r, lane); continue; } r -= I3;
        if (r < I4) { p0_transpose_item(a.w_att, 1024, 1024, nullptr, (bf16*)(ws + WS_WPA), 512, 0, scr, r, lane); continue; } r -= I4;
        if (r < I5) { p0_transpose_item(a.w_gla, 1024, 1024, nullptr, (bf16*)(ws + WS_WPB), 1024, 0, scr, r, lane); continue; } r -= I5;
        if (r < I6) { p0_transpose_item(a.w_out, 1024, 1024, nullptr, (bf16*)(ws + WS_WOUT), 1024, 0, scr, r, lane); continue; } r -= I6;
        if (r < I7) { p0_transpose_item(a.w_pg, 1024, 1024, a.ple_g, (bf16*)(ws + WS_WPG), 1024, 0, scr, r, lane); continue; } r -= I7;
        p0_transpose_item(a.w_ple, 1024, 1024, nullptr, (bf16*)(ws + WS_WPLE), 256, 0, scr, r, lane);
    }
    const int gtid = blockIdx.x * 512 + tid, NT = G * 512;
    for (int i = gtid; i < 16 * 1024; i += NT) { const int k = i >> 4, r = i & 15; ((bf16*)(ws + WS_WGLR))[r * 1024 + k] = (bf16)(pk2(a.w_in[(size_t)k * INC + 7168 + r], 0.f) & 0xffffu); }
    for (int i = gtid; i < T * 8; i += NT) { const int t = i >> 3, j = i & 7;
        const float inv = exp2f(-(float)j * 0.125f * 18.931568569324174f);
        const float ang = (float)a.pos[t] * inv;
        const double ad = (double)ang; const double kq = __builtin_rint(ad * 0.15915494309189535); const float rf = (float)(ad - kq * 6.283185307179586);
        float* rt = (float*)(ws + WS_ROT) + (size_t)t * 16; rt[j] = __cosf(rf); rt[8 + j] = __sinf(rf); }
    bf16* hb = (bf16*)a.out;
    for (int m = gw; m < T; m += NGW) {
        const f32x4* xr = (const f32x4*)(a.x + (size_t)m * D) + lane; const f32x4* gr = (const f32x4*)a.norm_g + lane;
        f32x4 v[4]; float s = 0.f;
#pragma unroll
        for (int j = 0; j < 4; ++j) { v[j] = xr[64 * j]; s += (v[j][0] * v[j][0] + v[j][1] * v[j][1]) + (v[j][2] * v[j][2] + v[j][3] * v[j][3]); }
        const float rstd = rsqrtf(wave_sum(s) * (1.f / D) + EPS);
        v2u* o8 = (v2u*)(hb + (size_t)m * D) + lane;
#pragma unroll
        for (int j = 0; j < 4; ++j) { const f32x4 g = gr[64 * j]; v2u w; w.x = pk2(v[j][0] * rstd * g[0], v[j][1] * rstd * g[1]); w.y = pk2(v[j][2] * rstd * g[2], v[j][3] * rstd * g[3]); o8[64 * j] = w; }
    }
}

__device__ __forceinline__ void glr_step(const Args& a, int lane, int wave, int G) {
    const bf16* hb = (const bf16*)a.out; const bf16* wg = (const bf16*)(a.ws + WS_WGLR); float* glr = (float*)(a.ws + WS_GLR);
    const int l15 = lane & 15, quad = lane >> 4;
    for (int rt = blockIdx.x * NWAVES + wave; rt < T / 16; rt += G * NWAVES) {
        f32x4 acc = {0.f, 0.f, 0.f, 0.f};
        const bf16* ap = hb + (size_t)(rt * 16 + l15) * 1024 + 8 * quad; const bf16* bp = wg + (size_t)l15 * 1024 + 8 * quad;
#pragma unroll 8
        for (int i = 0; i < 32; ++i) acc = mfma16(*(const bf16x8*)(ap + 32 * i), *(const bf16x8*)(bp + 32 * i), acc);
#pragma unroll
        for (int j = 0; j < 4; ++j) glr[(size_t)(rt * 16 + 4 * quad + j) * 16 + l15] = acc[j];
    }
}

constexpr int GL_GLR = 0, GL_CUMX = 4096, GL_QS = 6144, GL_KS = GL_QS + 64 * 272, GL_KT = GL_KS + 64 * 272, GL_VS = GL_KT + 128 * 144, GL_AT = GL_VS + 64 * 528, GL_END = GL_AT + 64 * 144;
static_assert(GL_END <= 131072, "gla lds");
__device__ __forceinline__ void gla_local_phase(const Args& a, LAS unsigned char* lds, int tid, int lane, int wave, int G) {
    asm volatile("" : "+v"(tid), "+v"(lane));
    unsigned char* ws = a.ws;
    const bf16* PROJ = (const bf16*)(ws + WS_PROJG); const float* glr = (const float*)(ws + WS_GLR);
    bf16* Qp = (bf16*)(ws + WS_QP); bf16* OI = (bf16*)(ws + WS_OI); bf16* Lg = (bf16*)(ws + WS_L); float* gamma = (float*)(ws + WS_GAMMA);
    const int d = tid & 127, tg = tid >> 7, l15 = lane & 15, quad = lane >> 4;
    for (int unit = blockIdx.x; unit < 1024; unit += G) {
        const int b = unit >> 8, h = (unit >> 6) & 3, c = unit & 63; const int row0 = b * SEQ + c * 64;
        const bf16* P = PROJ + (size_t)row0 * PG;
#pragma unroll
        for (int i = 0; i < 2; ++i) { const int p = tid + 512 * i, tok = p >> 4, part = p & 15;
            *(LAS v4u*)(lds + GL_QS + tok * 272 + part * 16) = *(const v4u*)(P + (size_t)tok * PG + h * 128 + part * 8);
            *(LAS v4u*)(lds + GL_KS + tok * 272 + part * 16) = *(const v4u*)(P + (size_t)tok * PG + 512 + h * 128 + part * 8); }
        if (tid < 256) ((LAS f32x4*)(lds + GL_GLR))[tid] = ((const f32x4*)(glr + (size_t)row0 * 16))[tid];
#pragma unroll
        for (int i = 0; i < 4; ++i) { const int p = tid + 512 * i, tok = p >> 5, part = p & 31;
            *(LAS v4u*)(lds + GL_VS + tok * 528 + part * 16) = *(const v4u*)(P + (size_t)tok * PG + 1024 + h * 256 + part * 8); }
        float w2r[16];
#pragma unroll
        for (int r = 0; r < 16; ++r) w2r[r] = a.gate_w2[r * 512 + h * 128 + d];
        const float bias = a.gate_b[h * 128 + d];
        __syncthreads();
        float cum[16]; float run = 0.f;
#pragma unroll
        for (int i = 0; i < 16; ++i) { const int t = tg * 16 + i; const LAS f32x4* gp = (const LAS f32x4*)(lds + GL_GLR + t * 64);
            const f32x4 g0 = gp[0], g1 = gp[1], g2 = gp[2], g3 = gp[3];
            float lo = bias;
            lo += g0[0] * w2r[0] + g0[1] * w2r[1] + g0[2] * w2r[2] + g0[3] * w2r[3];
            lo += g1[0] * w2r[4] + g1[1] * w2r[5] + g1[2] * w2r[6] + g1[3] * w2r[7];
            lo += g2[0] * w2r[8] + g2[1] * w2r[9] + g2[2] * w2r[10] + g2[3] * w2r[11];
            lo += g3[0] * w2r[12] + g3[1] * w2r[13] + g3[2] * w2r[14] + g3[3] * w2r[15];
            const float ls = fminf(lo, 0.f) - __logf(1.0f + __expf(-fabsf(lo)));
            run += ls * (1.0f / 16.0f); cum[i] = run; }
        ((LAS float*)(lds + GL_CUMX))[tg * 128 + d] = run;
        __syncthreads();
        float prefix = 0.f, last = 0.f;
#pragma unroll
        for (int g = 0; g < 4; ++g) { const float v = ((LAS float*)(lds + GL_CUMX))[g * 128 + d]; last += v; if (g < tg) prefix += v; }
        unsigned ktp[8];
#pragma unroll
        for (int i = 0; i < 16; ++i) { const int t = tg * 16 + i; const float cm = cum[i] + prefix; const float q = bf2f(*(const LAS unsigned short*)(lds + GL_QS + t * 272 + d * 2)), k = bf2f(*(const LAS unsigned short*)(lds + GL_KS + t * 272 + d * 2));
            const float qp = q * __expf(cm) * 0.08838834764831845f, kp = k * __expf(-cm), kpp = k * __expf(last - cm);
            const unsigned qb = pk2(qp, 0.f) & 0xffffu;
            *(LAS unsigned short*)(lds + GL_QS + t * 272 + d * 2) = (unsigned short)qb;
            *(LAS unsigned short*)(lds + GL_KS + t * 272 + d * 2) = (unsigned short)(pk2(kp, 0.f) & 0xffffu);
            const unsigned kb = pk2(kpp, 0.f) & 0xffffu;
            if (i & 1) ktp[i >> 1] |= kb << 16; else ktp[i >> 1] = kb; }
        { v4u w0, w1; w0.x = ktp[0]; w0.y = ktp[1]; w0.z = ktp[2]; w0.w = ktp[3]; w1.x = ktp[4]; w1.y = ktp[5]; w1.z = ktp[6]; w1.w = ktp[7];
          *(LAS v4u*)(lds + GL_KT + d * 144 + tg * 32) = w0; *(LAS v4u*)(lds + GL_KT + d * 144 + tg * 32 + 16) = w1; }
        if (tg == 0) gamma[(size_t)unit * 128 + d] = __expf(last);
        __syncthreads();
#pragma unroll
        for (int i = 0; i < 2; ++i) { const int p = tid + 512 * i, tok = p >> 4, part = p & 15;
            *(v4u*)(Qp + (size_t)(row0 + tok) * 512 + h * 128 + part * 8) = *(const LAS v4u*)(lds + GL_QS + tok * 272 + part * 16); }
        { const int it = wave >> 1;
#pragma unroll
          for (int jj = 0; jj < 2; ++jj) { const int jt = (wave & 1) * 2 + jj; f32x4 acc = {0.f, 0.f, 0.f, 0.f};
#pragma unroll
            for (int ks = 0; ks < 4; ++ks) { const bf16x8 ka = *(const LAS bf16x8*)(lds + GL_KS + (16 * jt + l15) * 272 + (32 * ks + 8 * quad) * 2);
                const bf16x8 qb = *(const LAS bf16x8*)(lds + GL_QS + (16 * it + l15) * 272 + (32 * ks + 8 * quad) * 2); acc = mfma16(ka, qb, acc); }
            const int i = 16 * it + l15, j0 = 16 * jt + 4 * quad;
            v2u w; w.x = pk2(j0 + 0 <= i ? acc[0] : 0.f, j0 + 1 <= i ? acc[1] : 0.f); w.y = pk2(j0 + 2 <= i ? acc[2] : 0.f, j0 + 3 <= i ? acc[3] : 0.f);
            *(LAS v2u*)(lds + GL_AT + i * 144 + j0 * 2) = w; } }
        __syncthreads();
#pragma unroll 1
        for (int dd = 0; dd < 2; ++dd) { const int dvt = 2 * wave + dd;
            bf16x8 VF[2];
#pragma unroll
            for (int ks = 0; ks < 2; ++ks) { unsigned short e[8];
#pragma unroll
                for (int q = 0; q < 8; ++q) e[q] = *(const LAS unsigned short*)(lds + GL_VS + (32 * ks + 8 * quad + q) * 528 + (16 * dvt + l15) * 2);
                v4u t; t.x = e[0] | ((unsigned)e[1] << 16); t.y = e[2] | ((unsigned)e[3] << 16); t.z = e[4] | ((unsigned)e[5] << 16); t.w = e[6] | ((unsigned)e[7] << 16);
                VF[ks] = __builtin_bit_cast(bf16x8, t); }
#pragma unroll
            for (int it = 0; it < 4; ++it) { f32x4 acc = {0.f, 0.f, 0.f, 0.f};
#pragma unroll
                for (int ks = 0; ks < 2; ++ks) acc = mfma16(VF[ks], *(const LAS bf16x8*)(lds + GL_AT + (16 * it + l15) * 144 + (32 * ks + 8 * quad) * 2), acc);
                v2u w; w.x = pk2(acc[0], acc[1]); w.y = pk2(acc[2], acc[3]);
                *(v2u*)(OI + (size_t)(row0 + 16 * it + l15) * 1024 + h * 256 + 16 * dvt + 4 * quad) = w; }
#pragma unroll
            for (int R = 0; R < 8; ++R) { f32x4 acc = {0.f, 0.f, 0.f, 0.f};
#pragma unroll
                for (int ks = 0; ks < 2; ++ks) acc = mfma16(*(const LAS bf16x8*)(lds + GL_KT + (16 * R + l15) * 144 + (32 * ks + 8 * quad) * 2), VF[ks], acc);
                v2u w; w.x = pk2(acc[0], acc[1]); w.y = pk2(acc[2], acc[3]);
                *(v2u*)(Lg + ((size_t)(unit * 16 + dvt) * 8 + R) * 256 + lane * 4) = w; }
        }
        __syncthreads();
    }
}

constexpr int CH_L = 0, CH_Q = 4096, CH_G = 20480, CH_O = 20992, CH_STAGE = 23040;
struct ChReg { v4u l, q0, q1, q2, q3, x; };
__device__ __forceinline__ void ch_load(ChReg& r, const bf16* Lg, const float* gamma, const bf16* Qp, const bf16* OI, int unit, int dvt, int row0, int h, int lt) {
    r.l = *(const v4u*)(Lg + ((size_t)(unit * 16 + dvt) * 8) * 256 + lt * 8);
    const int rr = lt >> 4, j = (lt & 15) ^ rr;
    const bf16* qb = Qp + (size_t)(row0 + rr) * 512 + h * 128 + j * 8;
    r.q0 = *(const v4u*)(qb); r.q1 = *(const v4u*)(qb + 16 * 512); r.q2 = *(const v4u*)(qb + 32 * 512); r.q3 = *(const v4u*)(qb + 48 * 512);
    if (lt < 32) r.x = *(const v4u*)(gamma + (size_t)unit * 128 + lt * 4);
    else if (lt >= 128) { const int go = lt - 128; r.x = *(const v4u*)(OI + (size_t)(row0 + (go >> 1)) * 1024 + h * 256 + 16 * dvt + (go & 1) * 8); }
}
__device__ __forceinline__ void ch_store(const ChReg& r, LAS unsigned char* st, int lt) {
    *(LAS v4u*)(st + CH_L + lt * 16) = r.l;
    *(LAS v4u*)(st + CH_Q + lt * 16) = r.q0; *(LAS v4u*)(st + CH_Q + (lt + 256) * 16) = r.q1; *(LAS v4u*)(st + CH_Q + (lt + 512) * 16) = r.q2; *(LAS v4u*)(st + CH_Q + (lt + 768) * 16) = r.q3;
    if (lt < 32) *(LAS v4u*)(st + CH_G + lt * 16) = r.x; else if (lt >= 128) *(LAS v4u*)(st + CH_O + (lt - 128) * 16) = r.x;
}
__device__ __forceinline__ void gla_chain_phase(const Args& a, LAS unsigned char* lds, int tid, int lane, int wave, int G, int st_en) {
    asm volatile("" : "+v"(tid), "+v"(lane));
    unsigned char* ws = a.ws;
    const bf16* Qp = (const bf16*)(ws + WS_QP); bf16* OI = (bf16*)(ws + WS_OI); const bf16* Lg = (const bf16*)(ws + WS_L); const float* gamma = (const float*)(ws + WS_GAMMA); float* SS = (float*)(ws + WS_SS);
    const int l15 = lane & 15, quad = lane >> 4, lt = tid - 256, it = wave;
    const int vcu = (G % 8 == 0) ? ((int)blockIdx.x % 8) * (G / 8) + (int)blockIdx.x / 8 : (int)blockIdx.x;
    for (int item = vcu; item < 256; item += G) {
        const int bh = item >> 4, dvt = item & 15, b = bh >> 2, h = bh & 3, unit0 = bh * 64, rowb = b * SEQ;
        if (wave >= 4) {
            ChReg r0, r1, r2, r3, r4, r5, r6, r7;
#define CH_LD(rr, st) ch_load(rr, Lg, gamma, Qp, OI, unit0 + (st), dvt, rowb + (st) * 64, h, lt)
            CH_LD(r0, 0); CH_LD(r1, 1); ch_store(r0, lds, lt); ch_store(r1, lds + CH_STAGE, lt);
            CH_LD(r0, 2); CH_LD(r1, 3); CH_LD(r2, 4); CH_LD(r3, 5); CH_LD(r4, 6); CH_LD(r5, 7); CH_LD(r6, 8); CH_LD(r7, 9);
            __syncthreads();
#pragma unroll 1
            for (int q = 0; q < 8; ++q) {
#pragma unroll
                for (int j = 0; j < 4; ++j) {
                    const int sI = 4 * q + j, c0 = 2 * sI + 2, c1 = 2 * sI + 3;
                    const int n0 = (c0 + 8 < 64) ? c0 + 8 : 63, n1 = (c1 + 8 < 64) ? c1 + 8 : 63;
                    LAS unsigned char* s0 = lds + (c0 & 3) * CH_STAGE; LAS unsigned char* s1 = lds + (c1 & 3) * CH_STAGE;
#define CH_ROT2(ra, rb) do { ch_store(ra, s0, lt); ch_store(rb, s1, lt); CH_LD(ra, n0); CH_LD(rb, n1); } while (0)
                    if (j == 0) CH_ROT2(r0, r1); else if (j == 1) CH_ROT2(r2, r3); else if (j == 2) CH_ROT2(r4, r5); else CH_ROT2(r6, r7);
#undef CH_ROT2
                    __syncthreads();
                }
            }
#undef CH_LD
        } else {
            f32x4 S[8];
#pragma unroll
            for (int R = 0; R < 8; ++R) S[R] = (f32x4){0.f, 0.f, 0.f, 0.f};
            __syncthreads();
#pragma unroll 1
            for (int c2 = 0; c2 < 32; ++c2) {
#pragma unroll
              for (int u2 = 0; u2 < 2; ++u2) { const int c = 2 * c2 + u2;
                const LAS unsigned char* st = lds + (c & 3) * CH_STAGE;
                const int r = 16 * it + l15; const int row = rowb + c * 64 + r;
                f32x4 acc = {0.f, 0.f, 0.f, 0.f};
#pragma unroll
                for (int ks = 0; ks < 4; ++ks) { const int jq = 4 * ks + (quad >> 1), sub = (quad & 1) * 8;
                    const v2u qlo = *(const LAS v2u*)(st + CH_Q + r * 256 + ((jq ^ l15) << 4) + sub), qhi = *(const LAS v2u*)(st + CH_Q + r * 256 + (((jq + 2) ^ l15) << 4) + sub);
                    v4u sa; sa.x = pk2(S[2 * ks][0], S[2 * ks][1]); sa.y = pk2(S[2 * ks][2], S[2 * ks][3]); sa.z = pk2(S[2 * ks + 1][0], S[2 * ks + 1][1]); sa.w = pk2(S[2 * ks + 1][2], S[2 * ks + 1][3]);
                    acc = mfma16(__builtin_bit_cast(bf16x8, sa), mk8(qlo, qhi), acc); }
                const v2u oi = *(const LAS v2u*)(st + CH_O + r * 32 + quad * 8);
                const float o0 = acc[0] + bflo(oi.x), o1 = acc[1] + bfhi(oi.x), o2 = acc[2] + bflo(oi.y), o3 = acc[3] + bfhi(oi.y);
                v2u w; w.x = pk2(o0, o1); w.y = pk2(o2, o3);
                if (st_en) *(v2u*)(OI + (size_t)row * 1024 + h * 256 + 16 * dvt + 4 * quad) = w;
                float s = (o0 * o0 + o1 * o1) + (o2 * o2 + o3 * o3); s += __shfl_xor(s, 16); s += __shfl_xor(s, 32);
                if (quad == 0 && st_en) SS[(size_t)row * 64 + h * 16 + dvt] = s;
#pragma unroll
                for (int R = 0; R < 8; ++R) { const v2u Lr = *(const LAS v2u*)(st + CH_L + R * 512 + lane * 8); const f32x4 gm = *(const LAS f32x4*)(st + CH_G + (16 * R + 4 * quad) * 4);
                    S[R][0] = gm[0] * S[R][0] + bflo(Lr.x); S[R][1] = gm[1] * S[R][1] + bfhi(Lr.x); S[R][2] = gm[2] * S[R][2] + bflo(Lr.y); S[R][3] = gm[3] * S[R][3] + bfhi(Lr.y); }
              }
                __syncthreads();
            }
        }
    }
}

constexpr int ATS_V = 16384, ATS_SLOT = 32768;
struct AtUnit { int b, h, dsh, r, qt; };
__device__ __forceinline__ AtUnit at_decode(int unit) { AtUnit U; const int u = unit & 31, hb = unit >> 5; U.h = hb % 24; U.b = hb / 24; U.dsh = 2 * (U.h >> 3); const int ntc = 32 >> U.dsh; U.r = u / ntc; U.qt = u - U.r * ntc; return U; }
__device__ __forceinline__ const bf16* at_qbase(const bf16* PROJ, const AtUnit& U) { return PROJ + ((size_t)(U.b * 24 + U.h) * 4096 + ((size_t)U.r << (12 - U.dsh))) * 64; }
__device__ __forceinline__ void at_dma_chunk(const bf16* PROJ, const AtUnit& U, int c, LAS unsigned char* slot, int wave, int lane) {
    constexpr size_t WHICH = (size_t)T * 1536;
    const bf16* Pb = at_qbase(PROJ, U) + (size_t)c * 128 * 64;
    const int rl = lane >> 3, j = (lane & 7) ^ rl;
#pragma unroll
    for (int i = 0; i < 2; ++i) { const int rb = wave + 8 * i; const bf16* src = Pb + (size_t)(rb * 8 + rl) * 64 + j * 8;
        __builtin_amdgcn_global_load_lds((const unsigned*)(src + WHICH), (LAS unsigned*)(slot + rb * 1024), 16, 0, 0);
        __builtin_amdgcn_global_load_lds((const unsigned*)(src + 2 * WHICH), (LAS unsigned*)(slot + ATS_V + rb * 1024), 16, 0, 0); }
}
__device__ __forceinline__ void attn_phase(const Args& a, LAS unsigned char* lds, int tid, int lane, int wave, int G) {
    asm volatile("" : "+v"(tid), "+v"(lane));
    unsigned char* ws = a.ws; const bf16* PROJ = (const bf16*)(ws + WS_PROJA);
    bf16* OG = (bf16*)(ws + WS_OG); float* ML = (float*)(ws + WS_ML);
    const int l15 = lane & 15, quad = lane >> 4, w = wave;
    const int vcu = (G % 8 == 0) ? ((int)blockIdx.x % 8) * (G / 8) + (int)blockIdx.x / 8 : (int)blockIdx.x;
    const int tpb = (3072 + G - 1) / G, t0 = vcu * tpb, t1 = (t0 + tpb < 3072) ? t0 + tpb : 3072;
    bf16x8 QB[2];
    if (t0 < t1) { const AtUnit U = at_decode(t0);
        if (U.qt > 0) at_dma_chunk(PROJ, U, U.qt - 1, lds + ((t0 + 2) % 3) * ATS_SLOT, wave, lane);
        at_dma_chunk(PROJ, U, U.qt, lds + (t0 % 3) * ATS_SLOT, wave, lane);
        const bf16* qp = at_qbase(PROJ, U) + (size_t)(128 * U.qt + 16 * w + l15) * 64 + 8 * quad; QB[0] = *(const bf16x8*)qp; QB[1] = *(const bf16x8*)(qp + 32); }
    v2u pend[4]; float pmx = 0.f, pl = 0.f; size_t prow = 0; int ph = 0; bool have = false;
    for (int unit = t0; unit < t1; ++unit) {
        const AtUnit U = at_decode(unit);
        const int sc = unit % 3, sp = (U.qt > 0) ? (unit + 2) % 3 : sc;
        asm volatile("s_waitcnt vmcnt(0)" ::: "memory");
        __syncthreads();
        if (have) {
#pragma unroll
            for (int dt = 0; dt < 4; ++dt) *(v2u*)(OG + prow * 1536 + ph * 64 + 16 * dt + 4 * quad) = pend[dt];
            if (quad == 0) { v2u mlv; mlv.x = __float_as_uint(pmx); mlv.y = __float_as_uint(pl); *(v2u*)(ML + prow * 48 + ph * 2) = mlv; } }
        const bf16x8 q0 = QB[0], q1 = QB[1];
        if (unit + 1 < t1) { const AtUnit Un = at_decode(unit + 1); at_dma_chunk(PROJ, Un, Un.qt, lds + ((unit + 1) % 3) * ATS_SLOT, wave, lane);
            const bf16* qp = at_qbase(PROJ, Un) + (size_t)(128 * Un.qt + 16 * w + l15) * 64 + 8 * quad; QB[0] = *(const bf16x8*)qp; QB[1] = *(const bf16x8*)(qp + 32); }
        {
            const int qt = U.qt;
            const LAS unsigned char* bp = lds + sp * ATS_SLOT; const LAS unsigned char* bc = lds + sc * ATS_SLOT;
            f32x4 ST[9]; float mx = -INFINITY;
#pragma unroll
            for (int Tt = 0; Tt < 9; ++Tt) { f32x4 acc = {0.f, 0.f, 0.f, 0.f}; const int kr = ((16 * (w + Tt)) & 127) + l15; const LAS unsigned char* kb = (w + Tt >= 8) ? bc : bp;
                acc = mfma16(*(const LAS bf16x8*)(kb + kr * 128 + (((0 + quad) ^ (kr & 7)) << 4)), q0, acc);
                acc = mfma16(*(const LAS bf16x8*)(kb + kr * 128 + (((4 + quad) ^ (kr & 7)) << 4)), q1, acc);
#pragma unroll
                for (int e = 0; e < 4; ++e) { const int kk = 4 * quad + e; bool valid = true; if (Tt == 0) valid = kk >= l15; if (Tt == 8) valid = kk <= l15;
                    if (qt == 0) valid = valid && (w + Tt >= 8);
                    acc[e] = valid ? acc[e] : -INFINITY; mx = fmaxf(mx, acc[e]); }
                ST[Tt] = acc; }
            mx = fmaxf(mx, __shfl_xor(mx, 16)); mx = fmaxf(mx, __shfl_xor(mx, 32));
            float l = 0.f;
#pragma unroll
            for (int Tt = 0; Tt < 9; ++Tt)
#pragma unroll
                for (int e = 0; e < 4; ++e) { const float pv = __builtin_amdgcn_exp2f(ST[Tt][e] - mx); ST[Tt][e] = pv; l += pv; }
            l += __shfl_xor(l, 16); l += __shfl_xor(l, 32);
            f32x4 O[4];
#pragma unroll
            for (int dt = 0; dt < 4; ++dt) O[dt] = (f32x4){0.f, 0.f, 0.f, 0.f};
#pragma unroll
            for (int pr = 0; pr < 5; ++pr) { const int T1 = 2 * pr, T2 = (2 * pr + 1 < 9) ? 2 * pr + 1 : 8;
                v4u pf; pf.x = pk2(ST[T1][0], ST[T1][1]); pf.y = pk2(ST[T1][2], ST[T1][3]);
                if (pr < 4) { pf.z = pk2(ST[T2][0], ST[T2][1]); pf.w = pk2(ST[T2][2], ST[T2][3]); } else { pf.z = 0u; pf.w = 0u; }
                const int k1 = ((16 * (w + T1)) & 127) + 4 * quad + (l15 >> 2), k2 = ((16 * (w + T2)) & 127) + 4 * quad + (l15 >> 2);
                const LAS unsigned char* v1 = ((w + T1 >= 8) ? bc : bp) + ATS_V; const LAS unsigned char* v2 = ((w + T2 >= 8) ? bc : bp) + ATS_V;
#pragma unroll
                for (int dt = 0; dt < 4; ++dt) {
                    const int jv = 2 * dt + ((l15 & 3) >> 1), sub = (l15 & 1) * 8;
                    const s16x4 lo = __builtin_amdgcn_ds_read_tr16_b64_v4i16((LAS s16x4*)(v1 + k1 * 128 + ((jv ^ (k1 & 7)) << 4) + sub));
                    const s16x4 hi = (pr < 4) ? __builtin_amdgcn_ds_read_tr16_b64_v4i16((LAS s16x4*)(v2 + k2 * 128 + ((jv ^ (k2 & 7)) << 4) + sub)) : lo;
                    bf16x8 av; av[0] = lo[0]; av[1] = lo[1]; av[2] = lo[2]; av[3] = lo[3]; av[4] = hi[0]; av[5] = hi[1]; av[6] = hi[2]; av[7] = hi[3];
                    O[dt] = mfma16(av, __builtin_bit_cast(bf16x8, pf), O[dt]); } }
            const float inv = 1.0f / l;
            const int tokq = ((128 * qt + 16 * w + l15) << U.dsh) + U.r; const size_t trow = (size_t)U.b * SEQ + tokq;
#pragma unroll
            for (int dt = 0; dt < 4; ++dt) { pend[dt].x = pk2(O[dt][0] * inv, O[dt][1] * inv); pend[dt].y = pk2(O[dt][2] * inv, O[dt][3] * inv); }
            pmx = mx; pl = l; prow = trow; ph = U.h; have = true;
        }
    }
    if (have) {
#pragma unroll
        for (int dt = 0; dt < 4; ++dt) *(v2u*)(OG + prow * 1536 + ph * 64 + 16 * dt + 4 * quad) = pend[dt];
        if (quad == 0) { v2u mlv; mlv.x = __float_as_uint(pmx); mlv.y = __float_as_uint(pl); *(v2u*)(ML + prow * 48 + ph * 2) = mlv; } }
    asm volatile("s_waitcnt vmcnt(0)" ::: "memory"); __syncthreads();
}
__device__ __forceinline__ void prep_a_phase(const Args& a, int tid, int G, int row_base, int nrows, int row_stride) {
    asm volatile("" : "+v"(tid));
    unsigned char* ws = a.ws; const bf16* OG = (const bf16*)(ws + WS_OG); const float* ML = (const float*)(ws + WS_ML); const bf16* ZA = (const bf16*)(ws + WS_ZA);
    bf16* AA = (bf16*)(ws + WS_AA);
    for (int rb = row_base; rb < T; rb += row_stride)
    for (int p = tid; p < nrows * 64; p += 512) { const int t = rb + (p >> 6), col = (p & 63) * 8, s = col >> 6, dc = col & 63;
        v4u o[3]; float m[3], l[3];
#pragma unroll
        for (int g = 0; g < 3; ++g) { const int hh = 8 * g + s; o[g] = *(const v4u*)(OG + (size_t)t * 1536 + hh * 64 + dc); m[g] = ML[(size_t)t * 48 + hh * 2]; l[g] = ML[(size_t)t * 48 + hh * 2 + 1]; }
        const float M = fmaxf(m[0], fmaxf(m[1], m[2]));
        float w0 = l[0] * __builtin_amdgcn_exp2f(m[0] - M), w1 = l[1] * __builtin_amdgcn_exp2f(m[1] - M), w2 = l[2] * __builtin_amdgcn_exp2f(m[2] - M);
        const float iw = 1.0f / (w0 + w1 + w2); w0 *= iw; w1 *= iw; w2 *= iw;
        const v4u z8 = *(const v4u*)(ZA + (size_t)t * 512 + col);
        v4u w;
        w.x = pk2((w0 * bflo(o[0].x) + w1 * bflo(o[1].x) + w2 * bflo(o[2].x)) * siluf_(bflo(z8.x)), (w0 * bfhi(o[0].x) + w1 * bfhi(o[1].x) + w2 * bfhi(o[2].x)) * siluf_(bfhi(z8.x)));
        w.y = pk2((w0 * bflo(o[0].y) + w1 * bflo(o[1].y) + w2 * bflo(o[2].y)) * siluf_(bflo(z8.y)), (w0 * bfhi(o[0].y) + w1 * bfhi(o[1].y) + w2 * bfhi(o[2].y)) * siluf_(bfhi(z8.y)));
        w.z = pk2((w0 * bflo(o[0].z) + w1 * bflo(o[1].z) + w2 * bflo(o[2].z)) * siluf_(bflo(z8.z)), (w0 * bfhi(o[0].z) + w1 * bfhi(o[1].z) + w2 * bfhi(o[2].z)) * siluf_(bfhi(z8.z)));
        w.w = pk2((w0 * bflo(o[0].w) + w1 * bflo(o[1].w) + w2 * bflo(o[2].w)) * siluf_(bflo(z8.w)), (w0 * bfhi(o[0].w) + w1 * bfhi(o[1].w) + w2 * bfhi(o[2].w)) * siluf_(bfhi(z8.w)));
        pg8::st_sc1_16(AA + (size_t)t * 512 + col, w); }
}

#ifndef REP_MASK
#define REP_MASK 0
#endif
#ifndef DBG_STOP
#define DBG_STOP 0
#endif
#if DBG_STOP
__device__ __forceinline__ float dbg_san(float v) { return (fabsf(v) < 1e30f) ? v : 777.0f; }
__device__ __forceinline__ float dbg_sum_bf16(const void* p, size_t bytes, int gtid, int NT) { const unsigned* q = (const unsigned*)p; float s = 0.f; for (size_t i = gtid; i < bytes / 4; i += NT) { const unsigned w = q[i]; s += dbg_san(bflo(w)) + dbg_san(bfhi(w)); } return s; }
__device__ __forceinline__ float dbg_sum_f32(const void* p, size_t bytes, int gtid, int NT) { const float* q = (const float*)p; float s = 0.f; for (size_t i = gtid; i < bytes / 4; i += NT) s += dbg_san(q[i]); return s; }
#define DBG_DUMP(k, NS, ...) if (DBG_STOP == (k)) { const int gtid_ = blockIdx.x * 512 + tid, NT_ = G * 512; float sv_[NS] = { __VA_ARGS__ }; GRID_SYNC(); \
    for (size_t i = gtid_; i < (size_t)T * D; i += NT_) args.out[i] = 0.f; _Pragma("unroll") for (int q_ = 0; q_ < NS; ++q_) args.out[(size_t)q_ * NT_ + gtid_] = sv_[q_]; return; }
#define SB(off, mib) dbg_sum_bf16(ws + (off), (size_t)(mib) * MiB, gtid_, NT_)
#define SF(off, mib) dbg_sum_f32(ws + (off), (size_t)(mib) * MiB, gtid_, NT_)
#else
#define DBG_DUMP(k, NS, ...)
#endif
typedef __attribute__((address_space(1))) unsigned gu32;
#define XB_TMO      128
#define XB_XCNT(j)  (256  + 64 * (j))
#define XB_XSUB(j)  (1280 + 64 * (j))
#define XB_XGEN(j)  (2304 + 64 * (j))
#define XB_TOP      3328
#define XB_TOPGEN   3392
#define XCD_BAR_WORDS 3456
#define XB_SPIN_CAP (1u << 18)

__device__ __forceinline__ unsigned xb_ld(unsigned* p)              { return __hip_atomic_load(p, __ATOMIC_RELAXED, __HIP_MEMORY_SCOPE_AGENT); }
__device__ __forceinline__ unsigned xb_add(unsigned* p, unsigned v) { return __hip_atomic_fetch_add(p, v, __ATOMIC_RELAXED, __HIP_MEMORY_SCOPE_AGENT); }
__device__ __forceinline__ unsigned xb_xcc_id() { return (unsigned)__builtin_amdgcn_s_getreg((3 << 11) | 20) & 0xFu; }
#define XB_SPIN(cond, bar) do { unsigned _sp = 0; while (cond) { __builtin_amdgcn_s_sleep(1); \
    if ((++_sp & 255u) == 0u) { if (xb_ld(&(bar)[XB_TMO])) break; if (_sp > XB_SPIN_CAP) { atomicAdd(&(bar)[XB_TMO], 1u); break; } } } } while (0)

struct XcdBarrier {
    unsigned* bar; unsigned x;
    volatile LAS unsigned* st;
};

__device__ __forceinline__ XcdBarrier xcd_barrier_post(unsigned* bar, volatile LAS unsigned* st) {
    XcdBarrier b; b.bar = bar; b.x = xb_xcc_id(); b.st = st;
    if (threadIdx.x == 0) (void)xb_add(&bar[XB_XCNT(b.x)], 1u);
    return b;
}
__device__ __forceinline__ void xcd_barrier_complete(unsigned* bar, unsigned x, unsigned& nloc, unsigned& nx) {
    const unsigned G = gridDim.x * gridDim.y * gridDim.z;
    unsigned sum, cnt, mine, sp = 0u;
    for (;;) {
        sum = 0u; cnt = 0u; mine = 0u;
#pragma unroll
        for (unsigned j = 0; j < 16; ++j) { const unsigned c = xb_ld(&bar[XB_XCNT(j)]); sum += c; cnt += (c > 0u) ? 1u : 0u; mine = (j == x) ? c : mine; }
        if (sum == G) break;
        __builtin_amdgcn_s_sleep(1);
        if ((++sp & 255u) == 0u) { if (xb_ld(&bar[XB_TMO])) break; if (sp > XB_SPIN_CAP) { atomicAdd(&bar[XB_TMO], 1u); break; } }
    }
    nloc = mine > 0u ? mine : 1u; nx = cnt > 0u ? cnt : 1u;
}

__device__ __forceinline__ void xcd_barrier(const XcdBarrier& b) {
    asm volatile("s_waitcnt vmcnt(0)" ::: "memory");
    __syncthreads();
    if (threadIdx.x == 0) {
        unsigned* bar = b.bar;
        __builtin_amdgcn_s_waitcnt(0);
        unsigned nloc = b.st[0], nx = b.st[1];
        if (nloc == 0u) { xcd_barrier_complete(bar, b.x, nloc, nx); b.st[0] = nloc; b.st[1] = nx; }
        const unsigned old = xb_add(&bar[XB_XSUB(b.x)], 1u);
        const unsigned gen = old / nloc;
        if (old + 1u == (gen + 1u) * nloc) {
            __builtin_amdgcn_fence(__ATOMIC_RELEASE, "agent");
            asm volatile("s_waitcnt vmcnt(0)" ::: "memory");
            const unsigned og = xb_add(&bar[XB_TOP], 1u);
            const unsigned tg = og / nx;
            if (og + 1u == (tg + 1u) * nx) xb_add(&bar[XB_TOPGEN], 1u);
            else XB_SPIN(xb_ld(&bar[XB_TOPGEN]) == tg, bar);
            __builtin_amdgcn_fence(__ATOMIC_ACQUIRE, "agent");
            xb_add(&bar[XB_XGEN(b.x)], 1u);
            asm volatile("s_waitcnt vmcnt(0)" ::: "memory");
        } else {
            XB_SPIN(xb_ld(&bar[XB_XGEN(b.x)]) == gen, bar);
            __builtin_amdgcn_fence(__ATOMIC_ACQUIRE, "agent");
            asm volatile("s_waitcnt vmcnt(0)" ::: "memory");
        }
    }
    __syncthreads();
}


__device__ __forceinline__ void panel_handoff(unsigned* cnt, int pm, unsigned want) {
    asm volatile("s_waitcnt vmcnt(0)" ::: "memory");
    __syncthreads();
    if (threadIdx.x == 0) {
        unsigned* c = cnt + 64 * pm;
        __hip_atomic_fetch_add(c, 1u, __ATOMIC_RELAXED, __HIP_MEMORY_SCOPE_AGENT);
        unsigned sp = 0;
        while (__hip_atomic_load(c, __ATOMIC_RELAXED, __HIP_MEMORY_SCOPE_AGENT) < want) { __builtin_amdgcn_s_sleep(1); if (++sp > (1u << 22)) break; }
        __builtin_amdgcn_fence(__ATOMIC_ACQUIRE, "agent");
        asm volatile("s_waitcnt vmcnt(0)" ::: "memory");
    }
    __syncthreads();
}
#define GRID_SYNC_CG() do { asm volatile("s_waitcnt vmcnt(0) lgkmcnt(0)" ::: "memory"); grid.sync(); __builtin_amdgcn_fence(__ATOMIC_ACQUIRE, "agent"); asm volatile("s_waitcnt vmcnt(0)" ::: "memory"); } while (0)
#define GRID_SYNC() xcd_barrier(xbar)
__global__ void __launch_bounds__(NWAVES * 64, 2) mega_fwd(Args args) {
    extern __shared__ __attribute__((aligned(16))) unsigned char lds_raw[];
    LAS unsigned char* lds = (LAS unsigned char*)lds_raw;
    cg::grid_group grid = cg::this_grid();
    const int tid = threadIdx.x, lane = tid & 63, wave = __builtin_amdgcn_readfirstlane(tid >> 6), G = gridDim.x;
    unsigned char* ws = args.ws;
    if (tid < 32) ((LAS unsigned*)(lds + MISC_OFF))[tid] = 0u;
    __syncthreads();
    const XcdBarrier xbar = xcd_barrier_post((unsigned*)(ws + WS_BAR), (volatile LAS unsigned*)(lds + MISC_OFF) + 8);
    const pg8::bf16_t* hb = (const pg8::bf16_t*)args.out;
    const pg8::bf16_t* AB = (const pg8::bf16_t*)args.out + (size_t)T * 1024;

#if REP_MASK & 32
    for (int q_ = 0; q_ < 10; ++q_) { GRID_SYNC(); }
#endif
    phase0(args, lds, tid, lane, wave, G);
#if REP_MASK & 1
    phase0(args, lds, tid, lane, wave, G);
#endif
    if (args.zero) { GRID_SYNC_CG(); }
    GRID_SYNC();
    glr_step(args, lane, wave, G);
    { pg8::Gemm g{hb, hb, hb, (const pg8::bf16_t*)(ws + WS_W1G), (const pg8::bf16_t*)(ws + WS_W1G), (const pg8::bf16_t*)(ws + WS_W1G), 16, 16, 16, 1024, 1024};
      pg8::SegOrder S; S.init(T, PG, G, (int)blockIdx.x, 1); pg8::EpiBf16 E{(pg8::bf16_t*)(ws + WS_PROJG), PG};
      pg8::gemm_phase<pg8::EpiBf16, pg8::SegOrder, true, true>(lds, g, S, E); }
#if REP_MASK & 128
    { pg8::Gemm g{hb, hb, hb, (const pg8::bf16_t*)(ws + WS_W1G), (const pg8::bf16_t*)(ws + WS_W1G), (const pg8::bf16_t*)(ws + WS_W1G), 16, 16, 16, 1024, 1024};
      pg8::SegOrder S; S.init(T, PG, G, (int)blockIdx.x, 1); pg8::EpiBf16 E{(pg8::bf16_t*)(ws + WS_PROJG), PG};
      pg8::gemm_phase<pg8::EpiBf16, pg8::SegOrder, true, true>(lds, g, S, E); }
#endif
    GRID_SYNC();
    DBG_DUMP(2, 7, SB(WS_W1A, 10), SB(WS_W1G, 6), SB(WS_WGT, 4), SF(WS_ROT, 1), dbg_sum_bf16(args.out, 32 * MiB, gtid_, NT_), SF(WS_GLR, 1), SB(WS_PROJG, 96))
    gla_local_phase(args, lds, tid, lane, wave, G);
#if REP_MASK & 2
    gla_local_phase(args, lds, tid, lane, wave, G);
#endif
    GRID_SYNC();
    DBG_DUMP(3, 4, SB(WS_QP, 16), SB(WS_OI, 32), SB(WS_L, 64), SF(WS_GAMMA, 0.5))
    DBG_DUMP(31, 1, SB(WS_QP, 16))
    DBG_DUMP(32, 1, SB(WS_OI, 32))
    DBG_DUMP(33, 1, SB(WS_L, 64))
    gla_chain_phase(args, lds, tid, lane, wave, G, args.one);
#if REP_MASK & 64
    gla_chain_phase(args, lds, tid, lane, wave, G, args.zero);
#endif
    GRID_SYNC();
    DBG_DUMP(4, 2, SB(WS_OI, 32), SF(WS_SS, 4))
    { pg8::Gemm g{hb, hb, hb, (const pg8::bf16_t*)(ws + WS_W1A), (const pg8::bf16_t*)(ws + WS_W1A), (const pg8::bf16_t*)(ws + WS_W1A), 16, 16, 16, 1024, 1024};
      pg8::SegOrder S; S.init(T, 6144, G, (int)blockIdx.x, 1);
      pg8::EpiQKV E{(pg8::bf16_t*)(ws + WS_PROJA), (pg8::bf16_t*)(ws + WS_ZA), args.gq, args.gk, (const float*)(ws + WS_ROT), EPS, (const pg8::bf16_t*)(ws + WS_OI), (const float*)(ws + WS_SS), args.gla_g, (pg8::bf16_t*)args.out + (size_t)T * 1024};
      pg8::gemm_phase<pg8::EpiQKV, pg8::SegOrder, true, true>(lds, g, S, E); }
#if REP_MASK & 256
    { pg8::Gemm g{hb, hb, hb, (const pg8::bf16_t*)(ws + WS_W1A), (const pg8::bf16_t*)(ws + WS_W1A), (const pg8::bf16_t*)(ws + WS_W1A), 16, 16, 16, 1024, 1024};
      pg8::SegOrder S; S.init(T, 6144, G, (int)blockIdx.x, 1);
      pg8::EpiQKV E{(pg8::bf16_t*)(ws + WS_PROJA), (pg8::bf16_t*)(ws + WS_ZA), args.gq, args.gk, (const float*)(ws + WS_ROT), EPS, (const pg8::bf16_t*)(ws + WS_OI), (const float*)(ws + WS_SS), args.gla_g, (pg8::bf16_t*)args.out + (size_t)T * 1024};
      pg8::gemm_phase<pg8::EpiQKV, pg8::SegOrder, true, true>(lds, g, S, E); }
#endif
    GRID_SYNC();
    attn_phase(args, lds, tid, lane, wave, G);
#if REP_MASK & 8
    attn_phase(args, lds, tid, lane, wave, G);
#endif
    GRID_SYNC();
    pg8::SegOrder SP; SP.init(T, 1024, G, (int)blockIdx.x, 1); pg8::Unit up; const bool panel_mode = (SP.nwg == G) && SP.next(0, up);
    if (panel_mode) prep_a_phase(args, tid, G, up.pm * 256 + up.pn * 64, 64, T);
    else { prep_a_phase(args, tid, G, (int)blockIdx.x * 64, 64, G * 64); GRID_SYNC(); }
    { bf16* pb = (bf16*)(ws + WS_PB);
      for (int i = blockIdx.x * 512 + tid; i < T * 256 / 8; i += G * 512) { const f32x4 v0 = ((const f32x4*)args.p)[2 * i], v1 = ((const f32x4*)args.p)[2 * i + 1];
          v4u w; w.x = pk2(v0[0], v0[1]); w.y = pk2(v0[2], v0[3]); w.z = pk2(v1[0], v1[1]); w.w = pk2(v1[2], v1[3]); ((v4u*)pb)[i] = w; } }
    { const pg8::bf16_t* WGT = (const pg8::bf16_t*)(ws + WS_WGT);
      pg8::Gemm g{hb, hb, hb, WGT, WGT + (size_t)1024 * 1024, WGT, 16, 16, 16, 1024, 1024};
      pg8::SegOrder S; S.init(T, 1024, G, (int)blockIdx.x, 2); pg8::EpiSig2 E{(pg8::bf16_t*)(ws + WS_SGA), (pg8::bf16_t*)(ws + WS_SGB), 1024};
      pg8::gemm_phase<pg8::EpiSig2, pg8::SegOrder, true, true>(lds, g, S, E); }
    if (panel_mode) panel_handoff((unsigned*)(ws + WS_PCNT) + 4096, up.pm, 4u);
    { const pg8::bf16_t* AA = (const pg8::bf16_t*)(ws + WS_AA); const pg8::bf16_t* WPA = (const pg8::bf16_t*)(ws + WS_WPA);
      pg8::Gemm g{AA, AA, AA, WPA, WPA, WPA, 8, 8, 8, 512, 512};
      pg8::SegOrder S; S.init(T, 1024, G, (int)blockIdx.x, 1); pg8::EpiGateMul E{(const pg8::bf16_t*)(ws + WS_SGA), (pg8::bf16_t*)(ws + WS_T1), 1024};
      pg8::gemm_phase<pg8::EpiGateMul, pg8::SegOrder, true, true>(lds, g, S, E); }
    { const pg8::bf16_t* WPB = (const pg8::bf16_t*)(ws + WS_WPB);
      pg8::Gemm g{AB, AB, AB, WPB, WPB, WPB, 16, 16, 16, 1024, 1024};
      pg8::SegOrder S; S.init(T, 1024, G, (int)blockIdx.x, 1); pg8::EpiMergeY E{(const pg8::bf16_t*)(ws + WS_SGB), (const pg8::bf16_t*)(ws + WS_T1), (pg8::bf16_t*)(ws + WS_Y), 1024};
      pg8::gemm_phase<pg8::EpiMergeY, pg8::SegOrder, true, true>(lds, g, S, E); }
#if REP_MASK & 512
    { const pg8::bf16_t* WGT = (const pg8::bf16_t*)(ws + WS_WGT);
      pg8::Gemm g{hb, hb, hb, WGT, WGT + (size_t)1024 * 1024, WGT, 16, 16, 16, 1024, 1024};
      pg8::SegOrder S; S.init(T, 1024, G, (int)blockIdx.x, 2); pg8::EpiSig2 E{(pg8::bf16_t*)(ws + WS_SGA), (pg8::bf16_t*)(ws + WS_SGB), 1024};
      pg8::gemm_phase<pg8::EpiSig2, pg8::SegOrder, true, true>(lds, g, S, E); }
    { const pg8::bf16_t* AA = (const pg8::bf16_t*)(ws + WS_AA); const pg8::bf16_t* WPA = (const pg8::bf16_t*)(ws + WS_WPA);
      pg8::Gemm g{AA, AA, AA, WPA, WPA, WPA, 8, 8, 8, 512, 512};
      pg8::SegOrder S; S.init(T, 1024, G, (int)blockIdx.x, 1); pg8::EpiGateMul E{(const pg8::bf16_t*)(ws + WS_SGA), (pg8::bf16_t*)(ws + WS_T1), 1024};
      pg8::gemm_phase<pg8::EpiGateMul, pg8::SegOrder, true, true>(lds, g, S, E); }
    { const pg8::bf16_t* WPB = (const pg8::bf16_t*)(ws + WS_WPB);
      pg8::Gemm g{AB, AB, AB, WPB, WPB, WPB, 16, 16, 16, 1024, 1024};
      pg8::SegOrder S; S.init(T, 1024, G, (int)blockIdx.x, 1); pg8::EpiMergeY E{(const pg8::bf16_t*)(ws + WS_SGB), (const pg8::bf16_t*)(ws + WS_T1), (pg8::bf16_t*)(ws + WS_Y), 1024};
      pg8::gemm_phase<pg8::EpiMergeY, pg8::SegOrder, true, true>(lds, g, S, E); }
#endif
    GRID_SYNC();
    DBG_DUMP(9, 5, SF(WS_TMP1, 64), SF(WS_TMP2, 64), SB(WS_Y, 32), SB(WS_PB, 8), SB(WS_WPA, 7))
    { const pg8::bf16_t* Y = (const pg8::bf16_t*)(ws + WS_Y); const pg8::bf16_t* W = (const pg8::bf16_t*)(ws + WS_WOUT);
      pg8::Gemm g{Y, Y, Y, W, W, W, 16, 16, 16, 1024, 1024};
      pg8::SegOrder S; S.init(T, 1024, G, (int)blockIdx.x, 1); pg8::EpiResid E{args.x, args.out, (pg8::bf16_t*)(ws + WS_X1B), (float*)(ws + WS_PS), 1024};
      pg8::gemm_phase<pg8::EpiResid, pg8::SegOrder, true, true>(lds, g, S, E); }
#if REP_MASK & 1024
    { const pg8::bf16_t* Y = (const pg8::bf16_t*)(ws + WS_Y); const pg8::bf16_t* W = (const pg8::bf16_t*)(ws + WS_WOUT);
      pg8::Gemm g{Y, Y, Y, W, W, W, 16, 16, 16, 1024, 1024};
      pg8::SegOrder S; S.init(T, 1024, G, (int)blockIdx.x, 1); pg8::EpiResid E{args.x, args.out, (pg8::bf16_t*)(ws + WS_X1B), (float*)(ws + WS_PS), 1024};
      pg8::gemm_phase<pg8::EpiResid, pg8::SegOrder, true, true>(lds, g, S, E); }
#endif
    { pg8::SegOrder S; S.init(T, 1024, G, (int)blockIdx.x, 1); pg8::Unit u0;
      if (S.nwg == G && S.next(0, u0)) panel_handoff((unsigned*)(ws + WS_PCNT), u0.pm, 4u); else { GRID_SYNC(); } }
    DBG_DUMP(10, 3, SB(WS_X1B, 32), SF(WS_PS, 1), dbg_sum_f32(args.out, 64 * MiB, gtid_, NT_))
    { const pg8::bf16_t* X1 = (const pg8::bf16_t*)(ws + WS_X1B); const pg8::bf16_t* W = (const pg8::bf16_t*)(ws + WS_WPG);
      pg8::Gemm g{X1, X1, X1, W, W, W, 16, 16, 16, 1024, 1024};
      pg8::SegOrder S; S.init(T, 1024, G, (int)blockIdx.x, 1); pg8::EpiSigRow E{(const float*)(ws + WS_PS), (pg8::bf16_t*)(ws + WS_SGA), 1024, EPS};
      pg8::gemm_phase<pg8::EpiSigRow, pg8::SegOrder, true, true>(lds, g, S, E); }
#if REP_MASK & 2048
    { const pg8::bf16_t* X1 = (const pg8::bf16_t*)(ws + WS_X1B); const pg8::bf16_t* W = (const pg8::bf16_t*)(ws + WS_WPG);
      pg8::Gemm g{X1, X1, X1, W, W, W, 16, 16, 16, 1024, 1024};
      pg8::SegOrder S; S.init(T, 1024, G, (int)blockIdx.x, 1); pg8::EpiSigRow E{(const float*)(ws + WS_PS), (pg8::bf16_t*)(ws + WS_SGA), 1024, EPS};
      pg8::gemm_phase<pg8::EpiSigRow, pg8::SegOrder, true, true>(lds, g, S, E); }
#endif
    { const pg8::bf16_t* PBm = (const pg8::bf16_t*)(ws + WS_PB); const pg8::bf16_t* W = (const pg8::bf16_t*)(ws + WS_WPLE);
      pg8::Gemm g{PBm, PBm, PBm, W, W, W, 4, 4, 4, 256, 256};
      pg8::SegOrder S; S.init(T, 1024, G, (int)blockIdx.x, 1); pg8::EpiPle2 E{args.out, (const pg8::bf16_t*)(ws + WS_SGA), 1024};
      pg8::gemm_phase<pg8::EpiPle2, pg8::SegOrder, true, true>(lds, g, S, E); }
}

extern "C" void kernel_launch(void* const* d_in, const int* in_sizes, int n_in, void* d_out, int out_size, void* d_ws, size_t ws_size, hipStream_t stream) {
    static int grid = 0;
    if (grid == 0) {
        if (n_in != 16 || out_size != T * D || ws_size < WS_END) { fprintf(stderr, "kernel_launch: unexpected shapes (n_in %d out %d ws %zu)\n", n_in, out_size, ws_size); grid = -1; return; }
        int dev = 0, cus = 0, per_cu = 0;
        (void)hipGetDevice(&dev); (void)hipDeviceGetAttribute(&cus, hipDeviceAttributeMultiprocessorCount, dev);
        (void)hipFuncSetAttribute((const void*)mega_fwd, hipFuncAttributeMaxDynamicSharedMemorySize, LDS_BYTES);
        (void)hipOccupancyMaxActiveBlocksPerMultiprocessor(&per_cu, (const void*)mega_fwd, NWAVES * 64, LDS_BYTES);
        if (per_cu < 1) { fprintf(stderr, "kernel_launch: occupancy query says %d blocks per CU\n", per_cu); per_cu = 1; }
        (void)hipGetLastError();
        grid = cus;
    }
    if (grid < 0) return;
    Args a{};
    a.x = (const float*)d_in[0]; a.p = (const float*)d_in[1]; a.pos = (const int*)d_in[2]; a.norm_g = (const float*)d_in[3]; a.w_in = (const float*)d_in[4];
    a.gq = (const float*)d_in[5]; a.gk = (const float*)d_in[6]; a.gate_w2 = (const float*)d_in[7]; a.gate_b = (const float*)d_in[8]; a.gla_g = (const float*)d_in[9];
    a.w_att = (const float*)d_in[10]; a.w_gla = (const float*)d_in[11]; a.w_out = (const float*)d_in[12]; a.ple_g = (const float*)d_in[13]; a.w_pg = (const float*)d_in[14]; a.w_ple = (const float*)d_in[15];
    a.out = (float*)d_out; a.ws = (unsigned char*)d_ws; a.one = 1; a.zero = 0;
    if (hipMemsetAsync((char*)d_ws + WS_BAR, 0, BAR_BYTES, stream) != hipSuccess) { fprintf(stderr, "kernel_launch: memset of barrier words failed\n"); return; }
    void* kargs[] = {&a};
    hipError_t e = hipLaunchCooperativeKernel((const void*)mega_fwd, dim3(grid), dim3(NWAVES * 64), kargs, LDS_BYTES, stream);
    if (e != hipSuccess) fprintf(stderr, "cooperative launch failed: %s (grid %d)\n", hipGetErrorString(e), grid);
}
```

```cpp
#define REP_MASK 0
#define DBG_STOP 0
#include <hip/hip_runtime.h>
#include <hip/hip_cooperative_groups.h>
#include <cstdio>
#include <cstdint>
namespace cg = cooperative_groups;

namespace pg8 {
#define PG8_LAS __attribute__((address_space(3)))
typedef unsigned short bf16_t;
typedef short bf16x8 __attribute__((ext_vector_type(8)));
typedef float f32x4 __attribute__((ext_vector_type(4)));
typedef unsigned u32x4 __attribute__((ext_vector_type(4)));
typedef unsigned u32x2 __attribute__((ext_vector_type(2)));
constexpr int BM = 256, BK = 64, HALF = 128, HTB = HALF * BK * 2  , STAGE_BYTES = 8 * HTB, NXCD = 8, WGM = 8;

__host__ __device__ __forceinline__ int lds_byte(int r, int c) { const int st = (r >> 4) * 2 + (c >> 5), rr = r & 15, cc = c & 31, ob = rr * 64 + cc * 2; return st * 1024 + (ob ^ (((ob >> 9) & 1) << 5)); }
__host__ __device__ __forceinline__ void stage_rc(int b, int& R, int& C) { const int st = b / 1024, sb = b % 1024, swz = sb ^ (((sb >> 9) & 1) << 5); R = (st >> 1) * 16 + swz / 64; C = (st & 1) * 32 + (swz % 64) / 2; }
__host__ __device__ __forceinline__ int perm32(int rho) { const int n = rho >> 4, i = rho & 15; return 8 * (i >> 2) + 4 * n + (i & 3); }

struct Unit { int pm, pn, seg; };
struct Gemm {
    const bf16_t* A0; const bf16_t* A1; const bf16_t* A2; const bf16_t* B0; const bf16_t* B1; const bf16_t* B2; int nt0, nt1, nt2, lda, ldb;
    __device__ __forceinline__ const bf16_t* selA(int s) const { const bf16_t* a0 = +A0; const bf16_t* a1 = +A1; const bf16_t* a2 = +A2; return s == 0 ? +a0 : (s == 1 ? +a1 : +a2); }
    __device__ __forceinline__ const bf16_t* selB(int s) const { const bf16_t* b0 = +B0; const bf16_t* b1 = +B1; const bf16_t* b2 = +B2; return s == 0 ? +b0 : (s == 1 ? +b1 : +b2); }
    __device__ __forceinline__ int selNt(int s) const { const int n0 = +nt0, n1 = +nt1, n2 = +nt2; return s == 0 ? +n0 : (s == 1 ? +n1 : +n2); }
};
struct SegOrder {
    int nM, nN, nwg, G, c, nseg;
    __device__ void init(int M, int N, int G_, int c_, int nseg_) { nM = M / BM; nN = N / BM; nwg = nM * nN; G = G_; c = c_; nseg = nseg_; }
    __device__ bool next(int i, Unit& u) const {
        const int ti = i / nseg; u.seg = i - ti * nseg;
        const long L = (long)ti * G + c; if (L >= nwg) return false;
        int wgid = (int)L; { const int q = nwg / NXCD, r = nwg % NXCD, xcd = wgid % NXCD, off = wgid / NXCD; wgid = (xcd < r ? xcd * (q + 1) : r * (q + 1) + (xcd - r) * q) + off; }
        const int nig = WGM * nN, gid = wgid / nig, fm = gid * WGM, gsz = (nM - fm) < WGM ? (nM - fm) : WGM;
        u.pm = fm + ((wgid % nig) % gsz); u.pn = (wgid % nig) / gsz; return true;
    }
    __device__ __forceinline__ void a_ready(const Unit&) const {}
    __device__ __forceinline__ void done(const Unit&) const {}
};
typedef __bf16 bf16x2_t __attribute__((ext_vector_type(2)));
typedef float f32x2_t __attribute__((ext_vector_type(2)));
__device__ __forceinline__ unsigned cvt_pk_bf16(float lo, float hi) { f32x2_t f = {lo, hi}; bf16x2_t v = __builtin_convertvector(f, bf16x2_t); return __builtin_bit_cast(unsigned, v); }
__device__ __forceinline__ float sigmoidf_(float x) { return __builtin_amdgcn_rcpf(1.0f + __expf(-x)); }

struct EpiBf16 {
    static constexpr bool PERM = true, AFTER_DRAIN = false;
    bf16_t* O; int ldc;
    __device__ __forceinline__ void operator()(const f32x4 (&acc)[2][2][4][2], const Unit& u, int wr, int wc, int fr, int fq) const {
        const int row0 = u.pm * BM + wr * 64 + fr; const int col0 = u.pn * BM + wc * 32 + 8 * fq;
#pragma unroll
        for (int ai = 0; ai < 2; ++ai)
#pragma unroll
            for (int m = 0; m < 4; ++m) { bf16_t* rowp = O + (size_t)(row0 + ai * HALF + m * 16) * ldc + col0;
#pragma unroll
                for (int bj = 0; bj < 2; ++bj) { const f32x4 v0 = acc[ai][bj][m][0], v1 = acc[ai][bj][m][1];
                    u32x4 w; w.x = cvt_pk_bf16(v0[0], v0[1]); w.y = cvt_pk_bf16(v0[2], v0[3]); w.z = cvt_pk_bf16(v1[0], v1[1]); w.w = cvt_pk_bf16(v1[2], v1[3]);
                    *(u32x4*)(rowp + bj * HALF) = w; } }
    }
};
#define PG8_FOR_ACC(body) \
    _Pragma("unroll") for (int ai = 0; ai < 2; ++ai) _Pragma("unroll") for (int m = 0; m < 4; ++m) { const int row = u.pm * BM + ai * HALF + wr * 64 + m * 16 + fr; \
    _Pragma("unroll") for (int bj = 0; bj < 2; ++bj) _Pragma("unroll") for (int n = 0; n < 2; ++n) { const size_t off = (size_t)row * ldc + (u.pn * BM + bj * HALF + wc * 32 + n * 16 + 4 * fq); const f32x4 a = acc[ai][bj][m][n]; body } }
struct EpiStoreF32 {
    static constexpr bool PERM = false, AFTER_DRAIN = false;
    float* tmp; int ldc;
    __device__ __forceinline__ void operator()(const f32x4 (&acc)[2][2][4][2], const Unit& u, int wr, int wc, int fr, int fq) const {
        PG8_FOR_ACC( *(f32x4*)(tmp + off) = a; )
    }
};
struct EpiMerge {
    static constexpr bool PERM = false, AFTER_DRAIN = false;
    float* tmp1; float* tmp2; bf16_t* y; int ldc;
    __device__ __forceinline__ void operator()(const f32x4 (&acc)[2][2][4][2], const Unit& u, int wr, int wc, int fr, int fq) const {
        if (u.seg == 0) {
            PG8_FOR_ACC( f32x4 t = *(const f32x4*)(tmp1 + off); t[0] *= sigmoidf_(a[0]); t[1] *= sigmoidf_(a[1]); t[2] *= sigmoidf_(a[2]); t[3] *= sigmoidf_(a[3]); *(f32x4*)(tmp1 + off) = t; )
        } else if (u.seg == 1) {
            PG8_FOR_ACC( *(f32x4*)(tmp2 + off) = a; )
        } else {
            PG8_FOR_ACC( const f32x4 t1 = *(const f32x4*)(tmp1 + off); const f32x4 t2 = *(const f32x4*)(tmp2 + off);
                u32x2 w; w.x = cvt_pk_bf16(t1[0] + sigmoidf_(a[0]) * t2[0], t1[1] + sigmoidf_(a[1]) * t2[1]); w.y = cvt_pk_bf16(t1[2] + sigmoidf_(a[2]) * t2[2], t1[3] + sigmoidf_(a[3]) * t2[3]);
                *(u32x2*)(y + off) = w; )
        }
    }
};
__device__ __forceinline__ void st_sc1_16(void* p, u32x4 w) { asm volatile("global_store_dwordx4 %0, %1, off sc1" :: "v"(p), "v"(w) : "memory"); }
struct EpiResid {
    static constexpr bool PERM = true, AFTER_DRAIN = false;
    const float* x; float* out; bf16_t* x1b; float* ps; int ldc;
    __device__ __forceinline__ void operator()(const f32x4 (&acc)[2][2][4][2], const Unit& u, int wr, int wc, int fr, int fq) const {
#pragma unroll
        for (int ai = 0; ai < 2; ++ai)
#pragma unroll
            for (int m = 0; m < 4; ++m) { const int row = u.pm * BM + ai * HALF + wr * 64 + m * 16 + fr; float s = 0.f;
#pragma unroll
                for (int bj = 0; bj < 2; ++bj) { const size_t off = (size_t)row * ldc + (u.pn * BM + bj * HALF + wc * 32 + 8 * fq);
                    const f32x4 v0 = *(const f32x4*)(x + off) + acc[ai][bj][m][0], v1 = *(const f32x4*)(x + off + 4) + acc[ai][bj][m][1];
                    *(f32x4*)(out + off) = v0; *(f32x4*)(out + off + 4) = v1;
                    u32x4 w; w.x = cvt_pk_bf16(v0[0], v0[1]); w.y = cvt_pk_bf16(v0[2], v0[3]); w.z = cvt_pk_bf16(v1[0], v1[1]); w.w = cvt_pk_bf16(v1[2], v1[3]);
                    st_sc1_16(x1b + off, w);
                    s += ((v0[0] * v0[0] + v0[1] * v0[1]) + (v0[2] * v0[2] + v0[3] * v0[3])) + ((v1[0] * v1[0] + v1[1] * v1[1]) + (v1[2] * v1[2] + v1[3] * v1[3])); }
                s += __shfl_xor(s, 16); s += __shfl_xor(s, 32);
                if (fq == 0) __hip_atomic_store(ps + (size_t)row * 16 + u.pn * 4 + wc, s, __ATOMIC_RELAXED, __HIP_MEMORY_SCOPE_AGENT);
                asm volatile("" ::: "memory"); }
    }
};
struct EpiPle {
    static constexpr bool PERM = false, AFTER_DRAIN = false;
    float* out; const float* tmp; const float* ps; int ldc; float eps;
    __device__ __forceinline__ void operator()(const f32x4 (&acc)[2][2][4][2], const Unit& u, int wr, int wc, int fr, int fq) const {
#pragma unroll
        for (int ai = 0; ai < 2; ++ai)
#pragma unroll
            for (int m = 0; m < 4; ++m) { const int row = u.pm * BM + ai * HALF + wr * 64 + m * 16 + fr;
                const f32x4* pp = (const f32x4*)(ps + (size_t)row * 16); const f32x4 p0 = pp[0], p1 = pp[1], p2 = pp[2], p3 = pp[3];
                const float ss = ((p0[0] + p0[1]) + (p0[2] + p0[3])) + ((p1[0] + p1[1]) + (p1[2] + p1[3])) + ((p2[0] + p2[1]) + (p2[2] + p2[3])) + ((p3[0] + p3[1]) + (p3[2] + p3[3]));
                const float rstd = rsqrtf(ss * (1.0f / 1024.0f) + eps);
#pragma unroll
                for (int bj = 0; bj < 2; ++bj)
#pragma unroll
                    for (int n = 0; n < 2; ++n) { const size_t off = (size_t)row * ldc + (u.pn * BM + bj * HALF + wc * 32 + n * 16 + 4 * fq);
                        const f32x4 a = acc[ai][bj][m][n]; const f32x4 t = *(const f32x4*)(tmp + off); f32x4 o = *(const f32x4*)(out + off);
                        o[0] += t[0] * sigmoidf_(rstd * a[0]); o[1] += t[1] * sigmoidf_(rstd * a[1]); o[2] += t[2] * sigmoidf_(rstd * a[2]); o[3] += t[3] * sigmoidf_(rstd * a[3]);
                        *(f32x4*)(out + off) = o; } }
    }
};

__device__ __forceinline__ f32x4 unpack_bf16x4(u32x2 w) { f32x4 r; r[0] = __uint_as_float(w.x << 16); r[1] = __uint_as_float(w.x & 0xffff0000u); r[2] = __uint_as_float(w.y << 16); r[3] = __uint_as_float(w.y & 0xffff0000u); return r; }
#define PG8_FOR_ACC8(...) \
    _Pragma("unroll") for (int ai = 0; ai < 2; ++ai) _Pragma("unroll") for (int m = 0; m < 4; ++m) { const int row = u.pm * BM + ai * HALF + wr * 64 + m * 16 + fr; \
    _Pragma("unroll") for (int bj = 0; bj < 2; ++bj) { const size_t off = (size_t)row * ldc + (u.pn * BM + bj * HALF + wc * 32 + 8 * fq); const f32x4 a0 = acc[ai][bj][m][0], a1 = acc[ai][bj][m][1]; __VA_ARGS__ } }
__device__ __forceinline__ void unpack_bf16x8(u32x4 w, f32x4& lo, f32x4& hi) { lo[0] = __uint_as_float(w.x << 16); lo[1] = __uint_as_float(w.x & 0xffff0000u); lo[2] = __uint_as_float(w.y << 16); lo[3] = __uint_as_float(w.y & 0xffff0000u);
    hi[0] = __uint_as_float(w.z << 16); hi[1] = __uint_as_float(w.z & 0xffff0000u); hi[2] = __uint_as_float(w.w << 16); hi[3] = __uint_as_float(w.w & 0xffff0000u); }
__device__ __forceinline__ u32x4 pack_bf16x8(f32x4 lo, f32x4 hi) { u32x4 w; w.x = cvt_pk_bf16(lo[0], lo[1]); w.y = cvt_pk_bf16(lo[2], lo[3]); w.z = cvt_pk_bf16(hi[0], hi[1]); w.w = cvt_pk_bf16(hi[2], hi[3]); return w; }
__device__ __forceinline__ f32x4 sig4(f32x4 a) { f32x4 r; r[0] = sigmoidf_(a[0]); r[1] = sigmoidf_(a[1]); r[2] = sigmoidf_(a[2]); r[3] = sigmoidf_(a[3]); return r; }
struct EpiSig2 {
    static constexpr bool PERM = true, AFTER_DRAIN = false;
    bf16_t* s0; bf16_t* s1; int ldc;
    __device__ __forceinline__ void operator()(const f32x4 (&acc)[2][2][4][2], const Unit& u, int wr, int wc, int fr, int fq) const {
        bf16_t* dst = u.seg == 0 ? s0 : s1;
        PG8_FOR_ACC8( *(u32x4*)(dst + off) = pack_bf16x8(sig4(a0), sig4(a1)); )
    }
};
struct EpiGateMul {
    static constexpr bool PERM = true, AFTER_DRAIN = false;
    const bf16_t* sg; bf16_t* t1; int ldc;
    __device__ __forceinline__ void operator()(const f32x4 (&acc)[2][2][4][2], const Unit& u, int wr, int wc, int fr, int fq) const {
        PG8_FOR_ACC8( f32x4 g0, g1; unpack_bf16x8(*(const u32x4*)(sg + off), g0, g1); *(u32x4*)(t1 + off) = pack_bf16x8(g0 * a0, g1 * a1); )
    }
};
struct EpiMergeY {
    static constexpr bool PERM = true, AFTER_DRAIN = false;
    const bf16_t* sg; const bf16_t* t1; bf16_t* y; int ldc;
    __device__ __forceinline__ void operator()(const f32x4 (&acc)[2][2][4][2], const Unit& u, int wr, int wc, int fr, int fq) const {
        PG8_FOR_ACC8( f32x4 g0, g1, t0, t1v; unpack_bf16x8(*(const u32x4*)(sg + off), g0, g1); unpack_bf16x8(*(const u32x4*)(t1 + off), t0, t1v);
            *(u32x4*)(y + off) = pack_bf16x8(t0 + g0 * a0, t1v + g1 * a1); )
    }
};
struct EpiSigRow {
    static constexpr bool PERM = true, AFTER_DRAIN = false;
    const float* ps; bf16_t* sg; int ldc; float eps;
    __device__ __forceinline__ void operator()(const f32x4 (&acc)[2][2][4][2], const Unit& u, int wr, int wc, int fr, int fq) const {
#pragma unroll
        for (int ai = 0; ai < 2; ++ai)
#pragma unroll
            for (int m = 0; m < 4; ++m) { const int row = u.pm * BM + ai * HALF + wr * 64 + m * 16 + fr;
                const f32x4* pp = (const f32x4*)(ps + (size_t)row * 16); const f32x4 p0 = pp[0], p1 = pp[1], p2 = pp[2], p3 = pp[3];
                const float ss = ((p0[0] + p0[1]) + (p0[2] + p0[3])) + ((p1[0] + p1[1]) + (p1[2] + p1[3])) + ((p2[0] + p2[1]) + (p2[2] + p2[3])) + ((p3[0] + p3[1]) + (p3[2] + p3[3]));
                const float rstd = rsqrtf(ss * (1.0f / 1024.0f) + eps);
#pragma unroll
                for (int bj = 0; bj < 2; ++bj) { const size_t off = (size_t)row * ldc + (u.pn * BM + bj * HALF + wc * 32 + 8 * fq);
                    const f32x4 a0 = acc[ai][bj][m][0], a1 = acc[ai][bj][m][1];
                    u32x4 w; w.x = cvt_pk_bf16(sigmoidf_(rstd * a0[0]), sigmoidf_(rstd * a0[1])); w.y = cvt_pk_bf16(sigmoidf_(rstd * a0[2]), sigmoidf_(rstd * a0[3]));
                    w.z = cvt_pk_bf16(sigmoidf_(rstd * a1[0]), sigmoidf_(rstd * a1[1])); w.w = cvt_pk_bf16(sigmoidf_(rstd * a1[2]), sigmoidf_(rstd * a1[3]));
                    *(u32x4*)(sg + off) = w; } }
    }
};
struct EpiPle2 {
    static constexpr bool PERM = true, AFTER_DRAIN = false;
    float* out; const bf16_t* sg; int ldc;
    __device__ __forceinline__ void operator()(const f32x4 (&acc)[2][2][4][2], const Unit& u, int wr, int wc, int fr, int fq) const {
#pragma unroll
        for (int ai = 0; ai < 2; ++ai)
#pragma unroll
            for (int m = 0; m < 4; ++m) { const int row = u.pm * BM + ai * HALF + wr * 64 + m * 16 + fr;
#pragma unroll
                for (int bj = 0; bj < 2; ++bj) { const size_t off = (size_t)row * ldc + (u.pn * BM + bj * HALF + wc * 32 + 8 * fq);
                    const u32x4 g8 = *(const u32x4*)(sg + off); const f32x4 a0 = acc[ai][bj][m][0], a1 = acc[ai][bj][m][1];
                    f32x4 o0 = *(const f32x4*)(out + off), o1 = *(const f32x4*)(out + off + 4);
                    o0[0] += a0[0] * __uint_as_float(g8.x << 16); o0[1] += a0[1] * __uint_as_float(g8.x & 0xffff0000u); o0[2] += a0[2] * __uint_as_float(g8.y << 16); o0[3] += a0[3] * __uint_as_float(g8.y & 0xffff0000u);
                    o1[0] += a1[0] * __uint_as_float(g8.z << 16); o1[1] += a1[1] * __uint_as_float(g8.z & 0xffff0000u); o1[2] += a1[2] * __uint_as_float(g8.w << 16); o1[3] += a1[3] * __uint_as_float(g8.w & 0xffff0000u);
                    *(f32x4*)(out + off) = o0; *(f32x4*)(out + off + 4) = o1; }
                asm volatile("" ::: "memory"); }
    }
};

struct EpiQKV {
    static constexpr bool PERM = true, AFTER_DRAIN = false;
    bf16_t* QKV; bf16_t* ZA; const float* gq; const float* gk; const float* rot; float eps;
    const bf16_t* OI; const float* SS; const float* gla_g; bf16_t* AB;
    __device__ __forceinline__ void operator()(const f32x4 (&acc)[2][2][4][2], const Unit& u, int wr, int wc, int fr, int fq) const {
        const int row0 = u.pm * BM + wr * 64 + fr; const int cl = u.pn * BM + 64 * wc;
        if (cl >= 5120) {
            const int zc0 = cl - 5120 + 8 * fq, hB = (cl - 5120) >> 8;
            const f32x4 ga0 = *(const f32x4*)(gla_g + (zc0 & 255)), ga1 = *(const f32x4*)(gla_g + (zc0 & 255) + 4), gb0 = *(const f32x4*)(gla_g + ((zc0 + 32) & 255)), gb1 = *(const f32x4*)(gla_g + ((zc0 + 32) & 255) + 4);
#pragma unroll
            for (int ai = 0; ai < 2; ++ai)
#pragma unroll
                for (int m = 0; m < 4; ++m) { const int row = row0 + ai * HALF + m * 16;
                    const f32x4* sp = (const f32x4*)(SS + (size_t)row * 64 + hB * 16); const f32x4 s0 = sp[0], s1 = sp[1], s2 = sp[2], s3 = sp[3];
                    const float ss = ((s0[0] + s0[1]) + (s0[2] + s0[3])) + ((s1[0] + s1[1]) + (s1[2] + s1[3])) + ((s2[0] + s2[1]) + (s2[2] + s2[3])) + ((s3[0] + s3[1]) + (s3[2] + s3[3]));
                    const float rstd = rsqrtf(ss * (1.0f / 256.0f) + eps);
#pragma unroll
                    for (int bj = 0; bj < 2; ++bj) { const size_t off = (size_t)row * 1024 + zc0 + 32 * bj; const u32x4 o8 = *(const u32x4*)(OI + off);
                        const f32x4 z0 = acc[ai][bj][m][0], z1 = acc[ai][bj][m][1]; const f32x4 g0 = bj ? gb0 : ga0, g1 = bj ? gb1 : ga1;
                        u32x4 w;
                        w.x = cvt_pk_bf16(__uint_as_float(o8.x << 16) * rstd * g0[0] * (z0[0] * sigmoidf_(z0[0])), __uint_as_float(o8.x & 0xffff0000u) * rstd * g0[1] * (z0[1] * sigmoidf_(z0[1])));
                        w.y = cvt_pk_bf16(__uint_as_float(o8.y << 16) * rstd * g0[2] * (z0[2] * sigmoidf_(z0[2])), __uint_as_float(o8.y & 0xffff0000u) * rstd * g0[3] * (z0[3] * sigmoidf_(z0[3])));
                        w.z = cvt_pk_bf16(__uint_as_float(o8.z << 16) * rstd * g1[0] * (z1[0] * sigmoidf_(z1[0])), __uint_as_float(o8.z & 0xffff0000u) * rstd * g1[1] * (z1[1] * sigmoidf_(z1[1])));
                        w.w = cvt_pk_bf16(__uint_as_float(o8.w << 16) * rstd * g1[2] * (z1[2] * sigmoidf_(z1[2])), __uint_as_float(o8.w & 0xffff0000u) * rstd * g1[3] * (z1[3] * sigmoidf_(z1[3])));
                        *(u32x4*)(AB + off) = w; } }
            return;
        }
        if (cl >= 4608) {
#pragma unroll
            for (int ai = 0; ai < 2; ++ai)
#pragma unroll
                for (int m = 0; m < 4; ++m) { const int row = row0 + ai * HALF + m * 16;
#pragma unroll
                    for (int bj = 0; bj < 2; ++bj) { const f32x4 v0 = acc[ai][bj][m][0], v1 = acc[ai][bj][m][1];
                        u32x4 w; w.x = cvt_pk_bf16(v0[0], v0[1]); w.y = cvt_pk_bf16(v0[2], v0[3]); w.z = cvt_pk_bf16(v1[0], v1[1]); w.w = cvt_pk_bf16(v1[2], v1[3]);
                        *(u32x4*)(ZA + (size_t)row * 512 + (cl - 4608) + 32 * bj + 8 * fq) = w; } }
            return;
        }
        const int which = cl / 1536, hc = cl - which * 1536, h = hc >> 6, dsh = 2 * (h >> 3);
        bf16_t* base = QKV + (size_t)which * ((size_t)16384 * 1536) + 8 * fq;
        const bool qk = which < 2;
        const float* gp = which == 0 ? gq : gk; const float sc = which == 0 ? 0.125f * 1.4426950408889634f : 1.0f;
        f32x4 g00 = {1.f, 1.f, 1.f, 1.f}, g01 = g00, g10 = g00, g11 = g00;
        if (qk) { g00 = *(const f32x4*)(gp + 8 * fq); g01 = *(const f32x4*)(gp + 8 * fq + 4); g10 = *(const f32x4*)(gp + 32 + 8 * fq); g11 = *(const f32x4*)(gp + 32 + 8 * fq + 4); }
#pragma unroll
        for (int ai = 0; ai < 2; ++ai)
#pragma unroll
            for (int m = 0; m < 4; ++m) { const int row = row0 + ai * HALF + m * 16; const int b = row >> 12, t = row & 4095;
                const int idx = ((t & ((1 << dsh) - 1)) << (12 - dsh)) + (t >> dsh);
                bf16_t* dst = base + ((size_t)(b * 24 + h) * 4096 + idx) * 64;
                f32x4 a0 = acc[ai][0][m][0], a1 = acc[ai][0][m][1], c0 = acc[ai][1][m][0], c1 = acc[ai][1][m][1];
                if (qk) {
                    float ss = ((a0[0] * a0[0] + a0[1] * a0[1]) + (a0[2] * a0[2] + a0[3] * a0[3])) + ((a1[0] * a1[0] + a1[1] * a1[1]) + (a1[2] * a1[2] + a1[3] * a1[3]))
                             + ((c0[0] * c0[0] + c0[1] * c0[1]) + (c0[2] * c0[2] + c0[3] * c0[3])) + ((c1[0] * c1[0] + c1[1] * c1[1]) + (c1[2] * c1[2] + c1[3] * c1[3]));
                    ss += __shfl_xor(ss, 16); ss += __shfl_xor(ss, 32);
                    const float rstd = rsqrtf(ss * (1.0f / 64.0f) + eps);
                    a0 = a0 * rstd * g00; a1 = a1 * rstd * g01; c0 = c0 * rstd * g10; c1 = c1 * rstd * g11;
                    f32x4 p0, p1;
                    p0[0] = __shfl_xor(a0[0], 16); p0[1] = __shfl_xor(a0[1], 16); p0[2] = __shfl_xor(a0[2], 16); p0[3] = __shfl_xor(a0[3], 16);
                    p1[0] = __shfl_xor(a1[0], 16); p1[1] = __shfl_xor(a1[1], 16); p1[2] = __shfl_xor(a1[2], 16); p1[3] = __shfl_xor(a1[3], 16);
                    if (fq < 2) { const float* rp = rot + (size_t)row * 16; const f32x4 cs0 = *(const f32x4*)(rp), cs1 = *(const f32x4*)(rp + 4), sn0 = *(const f32x4*)(rp + 8), sn1 = *(const f32x4*)(rp + 12);
                        const float sg = fq == 0 ? -1.f : 1.f; a0 = a0 * cs0 + (p0 * sn0) * sg; a1 = a1 * cs1 + (p1 * sn1) * sg; }
                    a0 = a0 * sc; a1 = a1 * sc; c0 = c0 * sc; c1 = c1 * sc;
                }
                u32x4 w0, w1; w0.x = cvt_pk_bf16(a0[0], a0[1]); w0.y = cvt_pk_bf16(a0[2], a0[3]); w0.z = cvt_pk_bf16(a1[0], a1[1]); w0.w = cvt_pk_bf16(a1[2], a1[3]);
                w1.x = cvt_pk_bf16(c0[0], c0[1]); w1.y = cvt_pk_bf16(c0[2], c0[3]); w1.z = cvt_pk_bf16(c1[0], c1[1]); w1.w = cvt_pk_bf16(c1[2], c1[3]);
                *(u32x4*)dst = w0; *(u32x4*)(dst + 32) = w1; }
    }
};

template <class Epi, class Sched, bool ALIGN_EPI = false, bool SP2 = false>
__device__ __forceinline__ void gemm_phase(PG8_LAS unsigned char* lds, const Gemm g, const Sched& S, const Epi& E) {
    int tid_ = threadIdx.x; asm volatile("" : "+v"(tid_));
    const int tid = tid_, wid = __builtin_amdgcn_readfirstlane(tid >> 6), lane = tid & 63, wr = wid >> 2, wc = wid & 3, fr = lane & 15, fq = lane >> 4;
    const int lda = g.lda, ldb = g.ldb;
    unsigned voffA[2], voffB[2];
#pragma unroll
    for (int i = 0; i < 2; ++i) { int R, C; stage_rc(tid * 16 + i * 8192, R, C); const int Rb = Epi::PERM ? ((R & ~31) + perm32(R & 31)) : R;
        voffA[i] = (unsigned)(R * lda + C) * 2u; voffB[i] = (unsigned)(Rb * ldb + C) * 2u; }
    const size_t kstep = (size_t)(BK * 2);
    const size_t hstepA = (size_t)HALF * lda * 2, hstepB = (size_t)HALF * ldb * 2;
    const size_t tstepA = 2 * hstepA, tstepB = 2 * hstepB;
    const unsigned ldsw = (unsigned)wid * 1024u;
    const int aoff = lds_byte(wr * 64 + fr, fq * 8), boff = lds_byte(wc * 32 + fr, fq * 8);
#define PG8_SA(b, h) (((b) * 2 + (h)) * HTB)
#define PG8_SB(b, h) ((4 + (b) * 2 + (h)) * HTB)
#define PG8_STAGE(bufoff, gbase, voff) do { _Pragma("unroll") for (int _i = 0; _i < 2; ++_i) \
        __builtin_amdgcn_global_load_lds((const unsigned*)((const char*)(gbase) + (voff)[_i]), (PG8_LAS unsigned*)(lds + (bufoff) + ldsw + _i * 8192), 16, 0, 0); } while (0)
#define PG8_LDA(dst, b, h) do { _Pragma("unroll") for (int m = 0; m < 4; ++m) _Pragma("unroll") for (int k = 0; k < 2; ++k) dst[m][k] = *(const PG8_LAS bf16x8*)(lds + PG8_SA(b, h) + aoff + m * 2048 + k * 1024); } while (0)
#define PG8_LDB(dst, b, h) do { _Pragma("unroll") for (int n = 0; n < 2; ++n) _Pragma("unroll") for (int k = 0; k < 2; ++k) dst[n][k] = *(const PG8_LAS bf16x8*)(lds + PG8_SB(b, h) + boff + n * 2048 + k * 1024); } while (0)
#define PG8_MMA(ai, bj, At, Bt) do { __builtin_amdgcn_s_setprio(1); _Pragma("unroll") for (int m = 0; m < 4; ++m) _Pragma("unroll") for (int n = 0; n < 2; ++n) _Pragma("unroll") for (int k = 0; k < 2; ++k) \
        acc[ai][bj][m][n] = __builtin_amdgcn_mfma_f32_16x16x32_bf16(Bt[n][k], At[m][k], acc[ai][bj][m][n], 0, 0, 0); __builtin_amdgcn_s_setprio(0); } while (0)
#define PG8_WAIT_V(n) asm volatile("s_waitcnt vmcnt(" #n ")" ::: "memory")
#define PG8_WAIT_L(n) asm volatile("s_waitcnt lgkmcnt(" #n ")" ::: "memory")
#define PG8_BAR __builtin_amdgcn_s_barrier()
#define PG8_SCHED __builtin_amdgcn_sched_barrier(0)
    Unit cur, nxt; int ui = 0;
    if (!S.next(0, cur)) return;
    f32x4 acc[2][2][4][2];
#pragma unroll
    for (int a = 0; a < 2; ++a)
#pragma unroll
        for (int b = 0; b < 2; ++b)
#pragma unroll
            for (int m = 0; m < 4; ++m)
#pragma unroll
                for (int n = 0; n < 2; ++n) acc[a][b][m][n] = (f32x4){0.f, 0.f, 0.f, 0.f};
    bf16x8 At[4][2], B0[2][2], B1[2][2];
    const char* cA = (const char*)g.selA(cur.seg) + (size_t)cur.pm * tstepA; const char* cB = (const char*)g.selB(cur.seg) + (size_t)cur.pn * tstepB;
    S.a_ready(cur);
    if constexpr (SP2) {
        PG8_STAGE(PG8_SB(0, 0), cB, voffB); PG8_STAGE(PG8_SB(0, 1), cB + hstepB, voffB); PG8_STAGE(PG8_SA(0, 0), cA, voffA); PG8_STAGE(PG8_SA(0, 1), cA + hstepA, voffA);
        if (wr == 1) PG8_BAR;
        PG8_WAIT_V(2); PG8_BAR;
        PG8_STAGE(PG8_SB(1, 0), cB + kstep, voffB); PG8_STAGE(PG8_SA(1, 0), cA + kstep, voffA); PG8_STAGE(PG8_SB(1, 1), cB + hstepB + kstep, voffB);
        PG8_WAIT_V(6); PG8_BAR;
    } else {
        PG8_STAGE(PG8_SB(0, 0), cB, voffB); PG8_STAGE(PG8_SA(0, 0), cA, voffA); PG8_STAGE(PG8_SB(0, 1), cB + hstepB, voffB); PG8_STAGE(PG8_SA(0, 1), cA + hstepA, voffA);
        if (wr == 1) PG8_BAR;
        PG8_WAIT_V(4); PG8_BAR;
        PG8_STAGE(PG8_SB(1, 0), cB + kstep, voffB); PG8_STAGE(PG8_SA(1, 0), cA + kstep, voffA); PG8_STAGE(PG8_SB(1, 1), cB + hstepB + kstep, voffB);
        PG8_WAIT_V(6); PG8_BAR;
    }
    for (;;) {
        const bool has_next = S.next(ui + 1, nxt);
        const char* nA = has_next ? (const char*)g.selA(nxt.seg) + (size_t)nxt.pm * tstepA : cA; const char* nB = has_next ? (const char*)g.selB(nxt.seg) + (size_t)nxt.pn * tstepB : cB;
        const int nt = g.selNt(cur.seg);
        for (int t = 0; t < nt; t += 2) {
            const bool last = (t == nt - 2);
            const char* a1 = cA + (size_t)(t + 1) * kstep;
            const char* a2 = last ? nA : cA + (size_t)(t + 2) * kstep; const char* b2 = last ? nB : cB + (size_t)(t + 2) * kstep;
            const char* a3 = a2 + kstep; const char* b3 = b2 + kstep;
            if (last && has_next) S.a_ready(nxt);
            if constexpr (SP2) {
            PG8_LDB(B0, 0, 0); PG8_LDB(B1, 0, 1); PG8_SCHED; PG8_LDA(At, 0, 0); PG8_STAGE(PG8_SA(1, 1), a1 + hstepA, voffA);
            PG8_WAIT_V(8); PG8_WAIT_L(0); PG8_BAR; PG8_MMA(0, 0, At, B0); PG8_MMA(0, 1, At, B1); PG8_BAR; PG8_SCHED;
            PG8_LDA(At, 0, 1); PG8_STAGE(PG8_SB(0, 0), b2, voffB); PG8_STAGE(PG8_SB(0, 1), b2 + hstepB, voffB); PG8_STAGE(PG8_SA(0, 0), a2, voffA);
            PG8_WAIT_V(8); PG8_WAIT_L(0); PG8_BAR; PG8_MMA(1, 0, At, B0); PG8_MMA(1, 1, At, B1); PG8_BAR; PG8_SCHED;
            PG8_LDB(B0, 1, 0); PG8_LDB(B1, 1, 1); PG8_SCHED; PG8_LDA(At, 1, 0); PG8_STAGE(PG8_SA(0, 1), a2 + hstepA, voffA);
            PG8_WAIT_V(8); PG8_WAIT_L(0); PG8_BAR; PG8_MMA(0, 0, At, B0); PG8_MMA(0, 1, At, B1); PG8_BAR; PG8_SCHED;
            PG8_LDA(At, 1, 1); PG8_STAGE(PG8_SB(1, 0), b3, voffB); PG8_STAGE(PG8_SB(1, 1), b3 + hstepB, voffB); PG8_STAGE(PG8_SA(1, 0), a3, voffA);
            PG8_WAIT_V(8); PG8_WAIT_L(0); PG8_BAR; PG8_MMA(1, 0, At, B0); PG8_MMA(1, 1, At, B1); PG8_BAR; PG8_SCHED;
            } else {
            PG8_LDB(B0, 0, 0); PG8_SCHED; PG8_LDA(At, 0, 0); PG8_STAGE(PG8_SA(1, 1), a1 + hstepA, voffA);
            PG8_WAIT_L(8); PG8_BAR; PG8_WAIT_L(0); PG8_MMA(0, 0, At, B0); PG8_BAR; PG8_SCHED;
            PG8_LDB(B1, 0, 1); PG8_STAGE(PG8_SB(0, 0), b2, voffB);
            PG8_BAR; PG8_WAIT_L(0); PG8_MMA(0, 1, At, B1); PG8_BAR;
            PG8_LDA(At, 0, 1); PG8_STAGE(PG8_SA(0, 0), a2, voffA);
            PG8_BAR; PG8_WAIT_L(0); PG8_MMA(1, 0, At, B0); PG8_BAR; PG8_SCHED;
            PG8_STAGE(PG8_SB(0, 1), b2 + hstepB, voffB);
            PG8_WAIT_V(6); PG8_BAR; PG8_MMA(1, 1, At, B1); PG8_BAR;
            PG8_LDB(B0, 1, 0); PG8_SCHED; PG8_LDA(At, 1, 0); PG8_STAGE(PG8_SA(0, 1), a2 + hstepA, voffA);
            PG8_WAIT_L(8); PG8_BAR; PG8_WAIT_L(0); PG8_MMA(0, 0, At, B0); PG8_BAR; PG8_SCHED;
            PG8_LDB(B1, 1, 1); PG8_STAGE(PG8_SB(1, 0), b3, voffB);
            PG8_BAR; PG8_WAIT_L(0); PG8_MMA(0, 1, At, B1); PG8_BAR;
            PG8_LDA(At, 1, 1); PG8_STAGE(PG8_SA(1, 0), a3, voffA);
            PG8_BAR; PG8_WAIT_L(0); PG8_MMA(1, 0, At, B0); PG8_BAR; PG8_SCHED;
            PG8_STAGE(PG8_SB(1, 1), b3 + hstepB, voffB);
            PG8_WAIT_V(6); PG8_BAR; PG8_MMA(1, 1, At, B1); PG8_BAR;
            }
        }
        if constexpr (ALIGN_EPI) { if (wr == 0) PG8_BAR; }
        if constexpr (!Epi::AFTER_DRAIN) { E(acc, cur, wr, wc, fr, fq); S.done(cur); }
        if (!has_next) break;
#pragma unroll
        for (int a = 0; a < 2; ++a)
#pragma unroll
            for (int b = 0; b < 2; ++b)
#pragma unroll
                for (int m = 0; m < 4; ++m)
#pragma unroll
                    for (int n = 0; n < 2; ++n) acc[a][b][m][n] = (f32x4){0.f, 0.f, 0.f, 0.f};
        cur = nxt; cA = nA; cB = nB; ++ui;
        if constexpr (ALIGN_EPI) { if (wr == 1) PG8_BAR; }
    }
    PG8_WAIT_V(0);
    if constexpr (!ALIGN_EPI) { if (wr == 0) PG8_BAR; }
    PG8_BAR;
    if constexpr (Epi::AFTER_DRAIN) { E.fused(acc, cur, wr, wc, fr, fq, lds, wid, lane); S.done(cur); }
#undef PG8_SA
#undef PG8_SB
#undef PG8_STAGE
#undef PG8_LDA
#undef PG8_LDB
#undef PG8_MMA
#undef PG8_WAIT_V
#undef PG8_WAIT_L
#undef PG8_BAR
#undef PG8_SCHED
}
}

constexpr int NWAVES = 8;
constexpr int T = 16384, D = 1024, SEQ = 4096, INC = 10256;
constexpr int PA = 5120;
constexpr int PG = 2048;
constexpr float EPS = 1e-6f;
constexpr size_t MiB = 1u << 20;
constexpr size_t WS_W1A = 0, WS_W1G = 12 * MiB, WS_WGT = 16 * MiB, WS_WPA = 20 * MiB, WS_WPB = 21 * MiB, WS_WOUT = 23 * MiB, WS_WPG = 25 * MiB, WS_WPLE = 27 * MiB, WS_WGLR = 27 * MiB + 512 * 1024;
constexpr size_t WS_ROT = 28 * MiB, WS_GLR = 29 * MiB, WS_GAMMA = 30 * MiB, WS_ML = 29 * MiB  , WS_PS = 29 * MiB  ;
constexpr size_t WS_PROJG = 32 * MiB, WS_QP = 96 * MiB, WS_L = 112 * MiB, WS_OI = 192 * MiB, WS_SS = 224 * MiB;
constexpr size_t WS_PROJA = 32 * MiB, WS_ZA = 176 * MiB  , WS_OG = 192 * MiB, WS_AA = 240 * MiB;
constexpr size_t WS_TMP1 = 32 * MiB, WS_TMP2 = 96 * MiB, WS_SGA = 32 * MiB, WS_SGB = 64 * MiB, WS_T1 = 96 * MiB, WS_Y = 136 * MiB, WS_PB = 128 * MiB, WS_X1B = 208 * MiB, WS_END = 256 * MiB;
constexpr int LDS_BYTES = 147456, MISC_OFF = 131072 + 320;
constexpr size_t WS_BAR = 27 * MiB + 512 * 1024 + 65536, WS_PCNT = WS_BAR + 16384, BAR_BYTES = 16384 + 2 * 16384;

#define LAS __attribute__((address_space(3)))
typedef unsigned short bf16;
typedef unsigned v4u __attribute__((ext_vector_type(4)));
typedef unsigned v2u __attribute__((ext_vector_type(2)));
typedef float f32x4 __attribute__((ext_vector_type(4)));
typedef short bf16x8 __attribute__((ext_vector_type(8)));
typedef short s16x4 __attribute__((ext_vector_type(4)));
__device__ __forceinline__ float bflo(unsigned w) { return __uint_as_float(w << 16); }
__device__ __forceinline__ float bfhi(unsigned w) { return __uint_as_float(w & 0xffff0000u); }
__device__ __forceinline__ float bf2f(unsigned short b) { return __uint_as_float(((unsigned)b) << 16); }
__device__ __forceinline__ unsigned pk2(float lo, float hi) { return pg8::cvt_pk_bf16(lo, hi); }
__device__ __forceinline__ bf16x8 mk8(v2u lo, v2u hi) { v4u t; t.x = lo.x; t.y = lo.y; t.z = hi.x; t.w = hi.y; return __builtin_bit_cast(bf16x8, t); }
__device__ __forceinline__ f32x4 mfma16(bf16x8 a, bf16x8 b, f32x4 c) { return __builtin_amdgcn_mfma_f32_16x16x32_bf16(a, b, c, 0, 0, 0); }
__device__ __forceinline__ float siluf_(float x) { return x * pg8::sigmoidf_(x); }
#define LDS_WAIT() asm volatile("s_waitcnt lgkmcnt(0)" ::: "memory")

struct Args {
    const float* x; const float* p; const int* pos; const float* norm_g; const float* w_in; const float* gq; const float* gk; const float* gate_w2; const float* gate_b;
    const float* gla_g; const float* w_att; const float* w_gla; const float* w_out; const float* ple_g; const float* w_pg; const float* w_ple; float* out; unsigned char* ws; int one; int zero;
};

__device__ __forceinline__ float wave_sum(float v) {
#pragma unroll
    for (int o = 1; o < 64; o <<= 1) v += __shfl_xor(v, o);
    return v;
}
__device__ __forceinline__ void p0_transpose_item(const float* W, int wpitch, int ncols, const float* kscale, bf16* WT, int tpitch, int row_off, LAS float* scr, int item, int lane, bool headperm = false) {
    const int nblk = ncols / 32, kb = item / nblk, nb = item % nblk, k0 = 64 * kb, n0 = 32 * nb;
    const int d0 = headperm ? ((nb & ~7) + (nb & 1) * 4 + ((nb & 7) >> 1)) * 32 : n0;
#pragma unroll 8
    for (int i = 0; i < 32; ++i) { const int kk = 2 * i + (lane >> 5); float v = W[(size_t)(k0 + kk) * wpitch + n0 + (lane & 31)]; if (kscale) v *= kscale[k0 + kk]; scr[kk * 33 + (lane & 31)] = v; }
    LDS_WAIT(); asm volatile("" ::: "memory");
    const int c = lane & 7;
#pragma unroll
    for (int j = 0; j < 4; ++j) { const int n = (lane >> 3) + 8 * j; const LAS float* s = scr + (8 * c) * 33 + n;
        v4u o; o.x = pk2(s[0 * 33], s[1 * 33]); o.y = pk2(s[2 * 33], s[3 * 33]); o.z = pk2(s[4 * 33], s[5 * 33]); o.w = pk2(s[6 * 33], s[7 * 33]);
        *(v4u*)(WT + (size_t)(row_off + d0 + n) * tpitch + k0 + 8 * c) = o; }
    LDS_WAIT(); asm volatile("" ::: "memory");
}

__device__ __forceinline__ void phase0(const Args& a, LAS unsigned char* lds, int tid, int lane, int wave, int G) {
    unsigned char* ws = a.ws;
    LAS float* scr = (LAS float*)(lds + wave * 16384);
    const int gw = blockIdx.x * NWAVES + wave, NGW = G * NWAVES;
    constexpr int I0 = 16 * 160, I1 = 16 * 64, I2 = 16 * 32, I3 = 16 * 64, I4 = 8 * 32, I5 = 16 * 32, I6 = 16 * 32, I7 = 16 * 32, I8 = 4 * 32;
    constexpr int NITEMS = I0 + I1 + I2 + I3 + I4 + I5 + I6 + I7 + I8;
    for (int it = gw; it < NITEMS; it += NGW) {
        int r = it;
        if (r < I0) { p0_transpose_item(a.w_in, INC, 5120, nullptr, (bf16*)(ws + WS_W1A), 1024, 0, scr, r, lane, true); continue; } r -= I0;
        if (r < I1) { p0_transpose_item(a.w_in + 5120, INC, 2048, nullptr, (bf16*)(ws + WS_W1G), 1024, 0, scr, r, lane); continue; } r -= I1;
        if (r < I2) { p0_transpose_item(a.w_in + 7184, INC, 1024, nullptr, (bf16*)(ws + WS_W1A), 1024, 5120, scr, r, lane, true); continue; } r -= I2;
        if (r < I3) { p0_transpose_item(a.w_in + 8208, INC, 2048, nullptr, (bf16*)(ws + WS_WGT), 1024, 0, scr, r, lane); continue; } r -= I3;
        if (r < I4) { p0_transpose_item(a.w_att, 1024, 1024, nullptr, (bf16*)(ws + WS_WPA), 512, 0, scr, r, lane); continue; } r -= I4;
        if (r < I5) { p0_transpose_item(a.w_gla, 1024, 1024, nullptr, (bf16*)(ws + WS_WPB), 1024, 0, scr, r, lane); continue; } r -= I5;
        if (r < I6) { p0_transpose_item(a.w_out, 1024, 1024, nullptr, (bf16*)(ws + WS_WOUT), 1024, 0, scr, r, lane); continue; } r -= I6;
        if (r < I7) { p0_transpose_item(a.w_pg, 1024, 1024, a.ple_g, (bf16*)(ws + WS_WPG), 1024, 0, scr, r, lane); continue; } r -= I7;
        p0_transpose_item(a.w_ple, 1024, 1024, nullptr, (bf16*)(ws + WS_WPLE), 256, 0, scr, r, lane);
    }
    const int gtid = blockIdx.x * 512 + tid, NT = G * 512;
    for (int i = gtid; i < 16 * 1024; i += NT) { const int k = i >> 4, r = i & 15; ((bf16*)(ws + WS_WGLR))[r * 1024 + k] = (bf16)(pk2(a.w_in[(size_t)k * INC + 7168 + r], 0.f) & 0xffffu); }
    for (int i = gtid; i < T * 8; i += NT) { const int t = i >> 3, j = i & 7;
        const float inv = exp2f(-(float)j * 0.125f * 18.931568569324174f);
        const float ang = (float)a.pos[t] * inv;
        const double ad = (double)ang; const double kq = __builtin_rint(ad * 0.15915494309189535); const float rf = (float)(ad - kq * 6.283185307179586);
        float* rt = (float*)(ws + WS_ROT) + (size_t)t * 16; rt[j] = __cosf(rf); rt[8 + j] = __sinf(rf); }
    bf16* hb = (bf16*)a.out;
    for (int m = gw; m < T; m += NGW) {
        const f32x4* xr = (const f32x4*)(a.x + (size_t)m * D) + lane; const f32x4* gr = (const f32x4*)a.norm_g + lane;
        f32x4 v[4]; float s = 0.f;
#pragma unroll
        for (int j = 0; j < 4; ++j) { v[j] = xr[64 * j]; s += (v[j][0] * v[j][0] + v[j][1] * v[j][1]) + (v[j][2] * v[j][2] + v[j][3] * v[j][3]); }
        const float rstd = rsqrtf(wave_sum(s) * (1.f / D) + EPS);
        v2u* o8 = (v2u*)(hb + (size_t)m * D) + lane;
#pragma unroll
        for (int j = 0; j < 4; ++j) { const f32x4 g = gr[64 * j]; v2u w; w.x = pk2(v[j][0] * rstd * g[0], v[j][1] * rstd * g[1]); w.y = pk2(v[j][2] * rstd * g[2], v[j][3] * rstd * g[3]); o8[64 * j] = w; }
    }
}

__device__ __forceinline__ void glr_step(const Args& a, int lane, int wave, int G) {
    const bf16* hb = (const bf16*)a.out; const bf16* wg = (const bf16*)(a.ws + WS_WGLR); float* glr = (float*)(a.ws + WS_GLR);
    const int l15 = lane & 15, quad = lane >> 4;
    for (int rt = blockIdx.x * NWAVES + wave; rt < T / 16; rt += G * NWAVES) {
        f32x4 acc = {0.f, 0.f, 0.f, 0.f};
        const bf16* ap = hb + (size_t)(rt * 16 + l15) * 1024 + 8 * quad; const bf16* bp = wg + (size_t)l15 * 1024 + 8 * quad;
#pragma unroll 8
        for (int i = 0; i < 32; ++i) acc = mfma16(*(const bf16x8*)(ap + 32 * i), *(const bf16x8*)(bp + 32 * i), acc);
#pragma unroll
        for (int j = 0; j < 4; ++j) glr[(size_t)(rt * 16 + 4 * quad + j) * 16 + l15] = acc[j];
    }
}

constexpr int GL_GLR = 0, GL_CUMX = 4096, GL_QS = 6144, GL_KS = GL_QS + 64 * 272, GL_KT = GL_KS + 64 * 272, GL_VS = GL_KT + 128 * 144, GL_AT = GL_VS + 64 * 528, GL_END = GL_AT + 64 * 144;
static_assert(GL_END <= 131072, "gla lds");
__device__ __forceinline__ void gla_local_phase(const Args& a, LAS unsigned char* lds, int tid, int lane, int wave, int G) {
    asm volatile("" : "+v"(tid), "+v"(lane));
    unsigned char* ws = a.ws;
    const bf16* PROJ = (const bf16*)(ws + WS_PROJG); const float* glr = (const float*)(ws + WS_GLR);
    bf16* Qp = (bf16*)(ws + WS_QP); bf16* OI = (bf16*)(ws + WS_OI); bf16* Lg = (bf16*)(ws + WS_L); float* gamma = (float*)(ws + WS_GAMMA);
    const int d = tid & 127, tg = tid >> 7, l15 = lane & 15, quad = lane >> 4;
    for (int unit = blockIdx.x; unit < 1024; unit += G) {
        const int b = unit >> 8, h = (unit >> 6) & 3, c = unit & 63; const int row0 = b * SEQ + c * 64;
        const bf16* P = PROJ + (size_t)row0 * PG;
#pragma unroll
        for (int i = 0; i < 2; ++i) { const int p = tid + 512 * i, tok = p >> 4, part = p & 15;
            *(LAS v4u*)(lds + GL_QS + tok * 272 + part * 16) = *(const v4u*)(P + (size_t)tok * PG + h * 128 + part * 8);
            *(LAS v4u*)(lds + GL_KS + tok * 272 + part * 16) = *(const v4u*)(P + (size_t)tok * PG + 512 + h * 128 + part * 8); }
        if (tid < 256) ((LAS f32x4*)(lds + GL_GLR))[tid] = ((const f32x4*)(glr + (size_t)row0 * 16))[tid];
#pragma unroll
        for (int i = 0; i < 4; ++i) { const int p = tid + 512 * i, tok = p >> 5, part = p & 31;
            *(LAS v4u*)(lds + GL_VS + tok * 528 + part * 16) = *(const v4u*)(P + (size_t)tok * PG + 1024 + h * 256 + part * 8); }
        float w2r[16];
#pragma unroll
        for (int r = 0; r < 16; ++r) w2r[r] = a.gate_w2[r * 512 + h * 128 + d];
        const float bias = a.gate_b[h * 128 + d];
        __syncthreads();
        float cum[16]; float run = 0.f;
#pragma unroll
        for (int i = 0; i < 16; ++i) { const int t = tg * 16 + i; const LAS f32x4* gp = (const LAS f32x4*)(lds + GL_GLR + t * 64);
            const f32x4 g0 = gp[0], g1 = gp[1], g2 = gp[2], g3 = gp[3];
            float lo = bias;
            lo += g0[0] * w2r[0] + g0[1] * w2r[1] + g0[2] * w2r[2] + g0[3] * w2r[3];
            lo += g1[0] * w2r[4] + g1[1] * w2r[5] + g1[2] * w2r[6] + g1[3] * w2r[7];
            lo += g2[0] * w2r[8] + g2[1] * w2r[9] + g2[2] * w2r[10] + g2[3] * w2r[11];
            lo += g3[0] * w2r[12] + g3[1] * w2r[13] + g3[2] * w2r[14] + g3[3] * w2r[15];
            const float ls = fminf(lo, 0.f) - __logf(1.0f + __expf(-fabsf(lo)));
            run += ls * (1.0f / 16.0f); cum[i] = run; }
        ((LAS float*)(lds + GL_CUMX))[tg * 128 + d] = run;
        __syncthreads();
        float prefix = 0.f, last = 0.f;
#pragma unroll
        for (int g = 0; g < 4; ++g) { const float v = ((LAS float*)(lds + GL_CUMX))[g * 128 + d]; last += v; if (g < tg) prefix += v; }
        unsigned ktp[8];
#pragma unroll
        for (int i = 0; i < 16; ++i) { const int t = tg * 16 + i; const float cm = cum[i] + prefix; const float q = bf2f(*(const LAS unsigned short*)(lds + GL_QS + t * 272 + d * 2)), k = bf2f(*(const LAS unsigned short*)(lds + GL_KS + t * 272 + d * 2));
            const float qp = q * __expf(cm) * 0.08838834764831845f, kp = k * __expf(-cm), kpp = k * __expf(last - cm);
            const unsigned qb = pk2(qp, 0.f) & 0xffffu;
            *(LAS unsigned short*)(lds + GL_QS + t * 272 + d * 2) = (unsigned short)qb;
            *(LAS unsigned short*)(lds + GL_KS + t * 272 + d * 2) = (unsigned short)(pk2(kp, 0.f) & 0xffffu);
            const unsigned kb = pk2(kpp, 0.f) & 0xffffu;
            if (i & 1) ktp[i >> 1] |= kb << 16; else ktp[i >> 1] = kb; }
        { v4u w0, w1; w0.x = ktp[0]; w0.y = ktp[1]; w0.z = ktp[2]; w0.w = ktp[3]; w1.x = ktp[4]; w1.y = ktp[5]; w1.z = ktp[6]; w1.w = ktp[7];
          *(LAS v4u*)(lds + GL_KT + d * 144 + tg * 32) = w0; *(LAS v4u*)(lds + GL_KT + d * 144 + tg * 32 + 16) = w1; }
        if (tg == 0) gamma[(size_t)unit * 128 + d] = __expf(last);
        __syncthreads();
#pragma unroll
        for (int i = 0; i < 2; ++i) { const int p = tid + 512 * i, tok = p >> 4, part = p & 15;
            *(v4u*)(Qp + (size_t)(row0 + tok) * 512 + h * 128 + part * 8) = *(const LAS v4u*)(lds + GL_QS + tok * 272 + part * 16); }
        { const int it = wave >> 1;
#pragma unroll
          for (int jj = 0; jj < 2; ++jj) { const int jt = (wave & 1) * 2 + jj; f32x4 acc = {0.f, 0.f, 0.f, 0.f};
#pragma unroll
            for (int ks = 0; ks < 4; ++ks) { const bf16x8 ka = *(const LAS bf16x8*)(lds + GL_KS + (16 * jt + l15) * 272 + (32 * ks + 8 * quad) * 2);
                const bf16x8 qb = *(const LAS bf16x8*)(lds + GL_QS + (16 * it + l15) * 272 + (32 * ks + 8 * quad) * 2); acc = mfma16(ka, qb, acc); }
            const int i = 16 * it + l15, j0 = 16 * jt + 4 * quad;
            v2u w; w.x = pk2(j0 + 0 <= i ? acc[0] : 0.f, j0 + 1 <= i ? acc[1] : 0.f); w.y = pk2(j0 + 2 <= i ? acc[2] : 0.f, j0 + 3 <= i ? acc[3] : 0.f);
            *(LAS v2u*)(lds + GL_AT + i * 144 + j0 * 2) = w; } }
        __syncthreads();
#pragma unroll 1
        for (int dd = 0; dd < 2; ++dd) { const int dvt = 2 * wave + dd;
            bf16x8 VF[2];
#pragma unroll
            for (int ks = 0; ks < 2; ++ks) { unsigned short e[8];
#pragma unroll
                for (int q = 0; q < 8; ++q) e[q] = *(const LAS unsigned short*)(lds + GL_VS + (32 * ks + 8 * quad + q) * 528 + (16 * dvt + l15) * 2);
                v4u t; t.x = e[0] | ((unsigned)e[1] << 16); t.y = e[2] | ((unsigned)e[3] << 16); t.z = e[4] | ((unsigned)e[5] << 16); t.w = e[6] | ((unsigned)e[7] << 16);
                VF[ks] = __builtin_bit_cast(bf16x8, t); }
#pragma unroll
            for (int it = 0; it < 4; ++it) { f32x4 acc = {0.f, 0.f, 0.f, 0.f};
#pragma unroll
                for (int ks = 0; ks < 2; ++ks) acc = mfma16(VF[ks], *(const LAS bf16x8*)(lds + GL_AT + (16 * it + l15) * 144 + (32 * ks + 8 * quad) * 2), acc);
                v2u w; w.x = pk2(acc[0], acc[1]); w.y = pk2(acc[2], acc[3]);
                *(v2u*)(OI + (size_t)(row0 + 16 * it + l15) * 1024 + h * 256 + 16 * dvt + 4 * quad) = w; }
#pragma unroll
            for (int R = 0; R < 8; ++R) { f32x4 acc = {0.f, 0.f, 0.f, 0.f};
#pragma unroll
                for (int ks = 0; ks < 2; ++ks) acc = mfma16(*(const LAS bf16x8*)(lds + GL_KT + (16 * R + l15) * 144 + (32 * ks + 8 * quad) * 2), VF[ks], acc);
                v2u w; w.x = pk2(acc[0], acc[1]); w.y = pk2(acc[2], acc[3]);
                *(v2u*)(Lg + ((size_t)(unit * 16 + dvt) * 8 + R) * 256 + lane * 4) = w; }
        }
        __syncthreads();
    }
}

constexpr int CH_L = 0, CH_Q = 4096, CH_G = 20480, CH_O = 20992, CH_STAGE = 23040;
struct ChReg { v4u l, q0, q1, q2, q3, x; };
__device__ __forceinline__ void ch_load(ChReg& r, const bf16* Lg, const float* gamma, const bf16* Qp, const bf16* OI, int unit, int dvt, int row0, int h, int lt) {
    r.l = *(const v4u*)(Lg + ((size_t)(unit * 16 + dvt) * 8) * 256 + lt * 8);
    const int rr = lt >> 4, j = (lt & 15) ^ rr;
    const bf16* qb = Qp + (size_t)(row0 + rr) * 512 + h * 128 + j * 8;
    r.q0 = *(const v4u*)(qb); r.q1 = *(const v4u*)(qb + 16 * 512); r.q2 = *(const v4u*)(qb + 32 * 512); r.q3 = *(const v4u*)(qb + 48 * 512);
    if (lt < 32) r.x = *(const v4u*)(gamma + (size_t)unit * 128 + lt * 4);
    else if (lt >= 128) { const int go = lt - 128; r.x = *(const v4u*)(OI + (size_t)(row0 + (go >> 1)) * 1024 + h * 256 + 16 * dvt + (go & 1) * 8); }
}
__device__ __forceinline__ void ch_store(const ChReg& r, LAS unsigned char* st, int lt) {
    *(LAS v4u*)(st + CH_L + lt * 16) = r.l;
    *(LAS v4u*)(st + CH_Q + lt * 16) = r.q0; *(LAS v4u*)(st + CH_Q + (lt + 256) * 16) = r.q1; *(LAS v4u*)(st + CH_Q + (lt + 512) * 16) = r.q2; *(LAS v4u*)(st + CH_Q + (lt + 768) * 16) = r.q3;
    if (lt < 32) *(LAS v4u*)(st + CH_G + lt * 16) = r.x; else if (lt >= 128) *(LAS v4u*)(st + CH_O + (lt - 128) * 16) = r.x;
}
__device__ __forceinline__ void gla_chain_phase(const Args& a, LAS unsigned char* lds, int tid, int lane, int wave, int G, int st_en) {
    asm volatile("" : "+v"(tid), "+v"(lane));
    unsigned char* ws = a.ws;
    const bf16* Qp = (const bf16*)(ws + WS_QP); bf16* OI = (bf16*)(ws + WS_OI); const bf16* Lg = (const bf16*)(ws + WS_L); const float* gamma = (const float*)(ws + WS_GAMMA); float* SS = (float*)(ws + WS_SS);
    const int l15 = lane & 15, quad = lane >> 4, lt = tid - 256, it = wave;
    const int vcu = (G % 8 == 0) ? ((int)blockIdx.x % 8) * (G / 8) + (int)blockIdx.x / 8 : (int)blockIdx.x;
    for (int item = vcu; item < 256; item += G) {
        const int bh = item >> 4, dvt = item & 15, b = bh >> 2, h = bh & 3, unit0 = bh * 64, rowb = b * SEQ;
        if (wave >= 4) {
            ChReg r0, r1, r2, r3, r4, r5, r6, r7;
#define CH_LD(rr, st) ch_load(rr, Lg, gamma, Qp, OI, unit0 + (st), dvt, rowb + (st) * 64, h, lt)
            CH_LD(r0, 0); CH_LD(r1, 1); ch_store(r0, lds, lt); ch_store(r1, lds + CH_STAGE, lt);
            CH_LD(r0, 2); CH_LD(r1, 3); CH_LD(r2, 4); CH_LD(r3, 5); CH_LD(r4, 6); CH_LD(r5, 7); CH_LD(r6, 8); CH_LD(r7, 9);
            __syncthreads();
#pragma unroll 1
            for (int q = 0; q < 8; ++q) {
#pragma unroll
                for (int j = 0; j < 4; ++j) {
                    const int sI = 4 * q + j, c0 = 2 * sI + 2, c1 = 2 * sI + 3;
                    const int n0 = (c0 + 8 < 64) ? c0 + 8 : 63, n1 = (c1 + 8 < 64) ? c1 + 8 : 63;
                    LAS unsigned char* s0 = lds + (c0 & 3) * CH_STAGE; LAS unsigned char* s1 = lds + (c1 & 3) * CH_STAGE;
#define CH_ROT2(ra, rb) do { ch_store(ra, s0, lt); ch_store(rb, s1, lt); CH_LD(ra, n0); CH_LD(rb, n1); } while (0)
                    if (j == 0) CH_ROT2(r0, r1); else if (j == 1) CH_ROT2(r2, r3); else if (j == 2) CH_ROT2(r4, r5); else CH_ROT2(r6, r7);
#undef CH_ROT2
                    __syncthreads();
                }
            }
#undef CH_LD
        } else {
            f32x4 S[8];
#pragma unroll
            for (int R = 0; R < 8; ++R) S[R] = (f32x4){0.f, 0.f, 0.f, 0.f};
            __syncthreads();
#pragma unroll 1
            for (int c2 = 0; c2 < 32; ++c2) {
#pragma unroll
              for (int u2 = 0; u2 < 2; ++u2) { const int c = 2 * c2 + u2;
                const LAS unsigned char* st = lds + (c & 3) * CH_STAGE;
                const int r = 16 * it + l15; const int row = rowb + c * 64 + r;
                f32x4 acc = {0.f, 0.f, 0.f, 0.f};
#pragma unroll
                for (int ks = 0; ks < 4; ++ks) { const int jq = 4 * ks + (quad >> 1), sub = (quad & 1) * 8;
                    const v2u qlo = *(const LAS v2u*)(st + CH_Q + r * 256 + ((jq ^ l15) << 4) + sub), qhi = *(const LAS v2u*)(st + CH_Q + r * 256 + (((jq + 2) ^ l15) << 4) + sub);
                    v4u sa; sa.x = pk2(S[2 * ks][0], S[2 * ks][1]); sa.y = pk2(S[2 * ks][2], S[2 * ks][3]); sa.z = pk2(S[2 * ks + 1][0], S[2 * ks + 1][1]); sa.w = pk2(S[2 * ks + 1][2], S[2 * ks + 1][3]);
                    acc = mfma16(__builtin_bit_cast(bf16x8, sa), mk8(qlo, qhi), acc); }
                const v2u oi = *(const LAS v2u*)(st + CH_O + r * 32 + quad * 8);
                const float o0 = acc[0] + bflo(oi.x), o1 = acc[1] + bfhi(oi.x), o2 = acc[2] + bflo(oi.y), o3 = acc[3] + bfhi(oi.y);
                v2u w; w.x = pk2(o0, o1); w.y = pk2(o2, o3);
                if (st_en) *(v2u*)(OI + (size_t)row * 1024 + h * 256 + 16 * dvt + 4 * quad) = w;
                float s = (o0 * o0 + o1 * o1) + (o2 * o2 + o3 * o3); s += __shfl_xor(s, 16); s += __shfl_xor(s, 32);
                if (quad == 0 && st_en) SS[(size_t)row * 64 + h * 16 + dvt] = s;
#pragma unroll
                for (int R = 0; R < 8; ++R) { const v2u Lr = *(const LAS v2u*)(st + CH_L + R * 512 + lane * 8); const f32x4 gm = *(const LAS f32x4*)(st + CH_G + (16 * R + 4 * quad) * 4);
                    S[R][0] = gm[0] * S[R][0] + bflo(Lr.x); S[R][1] = gm[1] * S[R][1] + bfhi(Lr.x); S[R][2] = gm[2] * S[R][2] + bflo(Lr.y); S[R][3] = gm[3] * S[R][3] + bfhi(Lr.y); }
              }
                __syncthreads();
            }
        }
    }
}

constexpr int ATS_V = 16384, ATS_SLOT = 32768;
struct AtUnit { int b, h, dsh, r, qt; };
__device__ __forceinline__ AtUnit at_decode(int unit) { AtUnit U; const int u = unit & 31, hb = unit >> 5; U.h = hb % 24; U.b = hb / 24; U.dsh = 2 * (U.h >> 3); const int ntc = 32 >> U.dsh; U.r = u / ntc; U.qt = u - U.r * ntc; return U; }
__device__ __forceinline__ const bf16* at_qbase(const bf16* PROJ, const AtUnit& U) { return PROJ + ((size_t)(U.b * 24 + U.h) * 4096 + ((size_t)U.r << (12 - U.dsh))) * 64; }
__device__ __forceinline__ void at_dma_chunk(const bf16* PROJ, const AtUnit& U, int c, LAS unsigned char* slot, int wave, int lane) {
    constexpr size_t WHICH = (size_t)T * 1536;
    const bf16* Pb = at_qbase(PROJ, U) + (size_t)c * 128 * 64;
    const int rl = lane >> 3, j = (lane & 7) ^ rl;
#pragma unroll
    for (int i = 0; i < 2; ++i) { const int rb = wave + 8 * i; const bf16* src = Pb + (size_t)(rb * 8 + rl) * 64 + j * 8;
        __builtin_amdgcn_global_load_lds((const unsigned*)(src + WHICH), (LAS unsigned*)(slot + rb * 1024), 16, 0, 0);
        __builtin_amdgcn_global_load_lds((const unsigned*)(src + 2 * WHICH), (LAS unsigned*)(slot + ATS_V + rb * 1024), 16, 0, 0); }
}
__device__ __forceinline__ void attn_phase(const Args& a, LAS unsigned char* lds, int tid, int lane, int wave, int G) {
    asm volatile("" : "+v"(tid), "+v"(lane));
    unsigned char* ws = a.ws; const bf16* PROJ = (const bf16*)(ws + WS_PROJA);
    bf16* OG = (bf16*)(ws + WS_OG); float* ML = (float*)(ws + WS_ML);
    const int l15 = lane & 15, quad = lane >> 4, w = wave;
    const int vcu = (G % 8 == 0) ? ((int)blockIdx.x % 8) * (G / 8) + (int)blockIdx.x / 8 : (int)blockIdx.x;
    const int tpb = (3072 + G - 1) / G, t0 = vcu * tpb, t1 = (t0 + tpb < 3072) ? t0 + tpb : 3072;
    bf16x8 QB[2];
    if (t0 < t1) { const AtUnit U = at_decode(t0);
        if (U.qt > 0) at_dma_chunk(PROJ, U, U.qt - 1, lds + ((t0 + 2) % 3) * ATS_SLOT, wave, lane);
        at_dma_chunk(PROJ, U, U.qt, lds + (t0 % 3) * ATS_SLOT, wave, lane);
        const bf16* qp = at_qbase(PROJ, U) + (size_t)(128 * U.qt + 16 * w + l15) * 64 + 8 * quad; QB[0] = *(const bf16x8*)qp; QB[1] = *(const bf16x8*)(qp + 32); }
    v2u pend[4]; float pmx = 0.f, pl = 0.f; size_t prow = 0; int ph = 0; bool have = false;
    for (int unit = t0; unit < t1; ++unit) {
        const AtUnit U = at_decode(unit);
        const int sc = unit % 3, sp = (U.qt > 0) ? (unit + 2) % 3 : sc;
        asm volatile("s_waitcnt vmcnt(0)" ::: "memory");
        __syncthreads();
        if (have) {
#pragma unroll
            for (int dt = 0; dt < 4; ++dt) *(v2u*)(OG + prow * 1536 + ph * 64 + 16 * dt + 4 * quad) = pend[dt];
            if (quad == 0) { v2u mlv; mlv.x = __float_as_uint(pmx); mlv.y = __float_as_uint(pl); *(v2u*)(ML + prow * 48 + ph * 2) = mlv; } }
        const bf16x8 q0 = QB[0], q1 = QB[1];
        if (unit + 1 < t1) { const AtUnit Un = at_decode(unit + 1); at_dma_chunk(PROJ, Un, Un.qt, lds + ((unit + 1) % 3) * ATS_SLOT, wave, lane);
            const bf16* qp = at_qbase(PROJ, Un) + (size_t)(128 * Un.qt + 16 * w + l15) * 64 + 8 * quad; QB[0] = *(const bf16x8*)qp; QB[1] = *(const bf16x8*)(qp + 32); }
        {
            const int qt = U.qt;
            const LAS unsigned char* bp = lds + sp * ATS_SLOT; const LAS unsigned char* bc = lds + sc * ATS_SLOT;
            f32x4 ST[9]; float mx = -INFINITY;
#pragma unroll
            for (int Tt = 0; Tt < 9; ++Tt) { f32x4 acc = {0.f, 0.f, 0.f, 0.f}; const int kr = ((16 * (w + Tt)) & 127) + l15; const LAS unsigned char* kb = (w + Tt >= 8) ? bc : bp;
                acc = mfma16(*(const LAS bf16x8*)(kb + kr * 128 + (((0 + quad) ^ (kr & 7)) << 4)), q0, acc);
                acc = mfma16(*(const LAS bf16x8*)(kb + kr * 128 + (((4 + quad) ^ (kr & 7)) << 4)), q1, acc);
#pragma unroll
                for (int e = 0; e < 4; ++e) { const int kk = 4 * quad + e; bool valid = true; if (Tt == 0) valid = kk >= l15; if (Tt == 8) valid = kk <= l15;
                    if (qt == 0) valid = valid && (w + Tt >= 8);
                    acc[e] = valid ? acc[e] : -INFINITY; mx = fmaxf(mx, acc[e]); }
                ST[Tt] = acc; }
            mx = fmaxf(mx, __shfl_xor(mx, 16)); mx = fmaxf(mx, __shfl_xor(mx, 32));
            float l = 0.f;
#pragma unroll
            for (int Tt = 0; Tt < 9; ++Tt)
#pragma unroll
                for (int e = 0; e < 4; ++e) { const float pv = __builtin_amdgcn_exp2f(ST[Tt][e] - mx); ST[Tt][e] = pv; l += pv; }
            l += __shfl_xor(l, 16); l += __shfl_xor(l, 32);
            f32x4 O[4];
#pragma unroll
            for (int dt = 0; dt < 4; ++dt) O[dt] = (f32x4){0.f, 0.f, 0.f, 0.f};
#pragma unroll
            for (int pr = 0; pr < 5; ++pr) { const int T1 = 2 * pr, T2 = (2 * pr + 1 < 9) ? 2 * pr + 1 : 8;
                v4u pf; pf.x = pk2(ST[T1][0], ST[T1][1]); pf.y = pk2(ST[T1][2], ST[T1][3]);
                if (pr < 4) { pf.z = pk2(ST[T2][0], ST[T2][1]); pf.w = pk2(ST[T2][2], ST[T2][3]); } else { pf.z = 0u; pf.w = 0u; }
                const int k1 = ((16 * (w + T1)) & 127) + 4 * quad + (l15 >> 2), k2 = ((16 * (w + T2)) & 127) + 4 * quad + (l15 >> 2);
                const LAS unsigned char* v1 = ((w + T1 >= 8) ? bc : bp) + ATS_V; const LAS unsigned char* v2 = ((w + T2 >= 8) ? bc : bp) + ATS_V;
#pragma unroll
                for (int dt = 0; dt < 4; ++dt) {
                    const int jv = 2 * dt + ((l15 & 3) >> 1), sub = (l15 & 1) * 8;
                    const s16x4 lo = __builtin_amdgcn_ds_read_tr16_b64_v4i16((LAS s16x4*)(v1 + k1 * 128 + ((jv ^ (k1 & 7)) << 4) + sub));
                    const s16x4 hi = (pr < 4) ? __builtin_amdgcn_ds_read_tr16_b64_v4i16((LAS s16x4*)(v2 + k2 * 128 + ((jv ^ (k2 & 7)) << 4) + sub)) : lo;
                    bf16x8 av; av[0] = lo[0]; av[1] = lo[1]; av[2] = lo[2]; av[3] = lo[3]; av[4] = hi[0]; av[5] = hi[1]; av[6] = hi[2]; av[7] = hi[3];
                    O[dt] = mfma16(av, __builtin_bit_cast(bf16x8, pf), O[dt]); } }
            const float inv = 1.0f / l;
            const int tokq = ((128 * qt + 16 * w + l15) << U.dsh) + U.r; const size_t trow = (size_t)U.b * SEQ + tokq;
#pragma unroll
            for (int dt = 0; dt < 4; ++dt) { pend[dt].x = pk2(O[dt][0] * inv, O[dt][1] * inv); pend[dt].y = pk2(O[dt][2] * inv, O[dt][3] * inv); }
            pmx = mx; pl = l; prow = trow; ph = U.h; have = true;
        }
    }
    if (have) {
#pragma unroll
        for (int dt = 0; dt < 4; ++dt) *(v2u*)(OG + prow * 1536 + ph * 64 + 16 * dt + 4 * quad) = pend[dt];
        if (quad == 0) { v2u mlv; mlv.x = __float_as_uint(pmx); mlv.y = __float_as_uint(pl); *(v2u*)(ML + prow * 48 + ph * 2) = mlv; } }
    asm volatile("s_waitcnt vmcnt(0)" ::: "memory"); __syncthreads();
}
__device__ __forceinline__ void prep_a_phase(const Args& a, int tid, int G, int row_base, int nrows, int row_stride) {
    asm volatile("" : "+v"(tid));
    unsigned char* ws = a.ws; const bf16* OG = (const bf16*)(ws + WS_OG); const float* ML = (const float*)(ws + WS_ML); const bf16* ZA = (const bf16*)(ws + WS_ZA);
    bf16* AA = (bf16*)(ws + WS_AA);
    for (int rb = row_base; rb < T; rb += row_stride)
    for (int p = tid; p < nrows * 64; p += 512) { const int t = rb + (p >> 6), col = (p & 63) * 8, s = col >> 6, dc = col & 63;
        v4u o[3]; float m[3], l[3];
#pragma unroll
        for (int g = 0; g < 3; ++g) { const int hh = 8 * g + s; o[g] = *(const v4u*)(OG + (size_t)t * 1536 + hh * 64 + dc); m[g] = ML[(size_t)t * 48 + hh * 2]; l[g] = ML[(size_t)t * 48 + hh * 2 + 1]; }
        const float M = fmaxf(m[0], fmaxf(m[1], m[2]));
        float w0 = l[0] * __builtin_amdgcn_exp2f(m[0] - M), w1 = l[1] * __builtin_amdgcn_exp2f(m[1] - M), w2 = l[2] * __builtin_amdgcn_exp2f(m[2] - M);
        const float iw = 1.0f / (w0 + w1 + w2); w0 *= iw; w1 *= iw; w2 *= iw;
        const v4u z8 = *(const v4u*)(ZA + (size_t)t * 512 + col);
        v4u w;
        w.x = pk2((w0 * bflo(o[0].x) + w1 * bflo(o[1].x) + w2 * bflo(o[2].x)) * siluf_(bflo(z8.x)), (w0 * bfhi(o[0].x) + w1 * bfhi(o[1].x) + w2 * bfhi(o[2].x)) * siluf_(bfhi(z8.x)));
        w.y = pk2((w0 * bflo(o[0].y) + w1 * bflo(o[1].y) + w2 * bflo(o[2].y)) * siluf_(bflo(z8.y)), (w0 * bfhi(o[0].y) + w1 * bfhi(o[1].y) + w2 * bfhi(o[2].y)) * siluf_(bfhi(z8.y)));
        w.z = pk2((w0 * bflo(o[0].z) + w1 * bflo(o[1].z) + w2 * bflo(o[2].z)) * siluf_(bflo(z8.z)), (w0 * bfhi(o[0].z) + w1 * bfhi(o[1].z) + w2 * bfhi(o[2].z)) * siluf_(bfhi(z8.z)));
        w.w = pk2((w0 * bflo(o[0].w) + w1 * bflo(o[1].w) + w2 * bflo(o[2].w)) * siluf_(bflo(z8.w)), (w0 * bfhi(o[0].w) + w1 * bfhi(o[1].w) + w2 * bfhi(o[2].w)) * siluf_(bfhi(z8.w)));
        pg8::st_sc1_16(AA + (size_t)t * 512 + col, w); }
}

#ifndef REP_MASK
#define REP_MASK 0
#endif
#ifndef DBG_STOP
#define DBG_STOP 0
#endif
#if DBG_STOP
__device__ __forceinline__ float dbg_san(float v) { return (fabsf(v) < 1e30f) ? v : 777.0f; }
__device__ __forceinline__ float dbg_sum_bf16(const void* p, size_t bytes, int gtid, int NT) { const unsigned* q = (const unsigned*)p; float s = 0.f; for (size_t i = gtid; i < bytes / 4; i += NT) { const unsigned w = q[i]; s += dbg_san(bflo(w)) + dbg_san(bfhi(w)); } return s; }
__device__ __forceinline__ float dbg_sum_f32(const void* p, size_t bytes, int gtid, int NT) { const float* q = (const float*)p; float s = 0.f; for (size_t i = gtid; i < bytes / 4; i += NT) s += dbg_san(q[i]); return s; }
#define DBG_DUMP(k, NS, ...) if (DBG_STOP == (k)) { const int gtid_ = blockIdx.x * 512 + tid, NT_ = G * 512; float sv_[NS] = { __VA_ARGS__ }; GRID_SYNC(); \
    for (size_t i = gtid_; i < (size_t)T * D; i += NT_) args.out[i] = 0.f; _Pragma("unroll") for (int q_ = 0; q_ < NS; ++q_) args.out[(size_t)q_ * NT_ + gtid_] = sv_[q_]; return; }
#define SB(off, mib) dbg_sum_bf16(ws + (off), (size_t)(mib) * MiB, gtid_, NT_)
#define SF(off, mib) dbg_sum_f32(ws + (off), (size_t)(mib) * MiB, gtid_, NT_)
#else
#define DBG_DUMP(k, NS, ...)
#endif
typedef __attribute__((address_space(1))) unsigned gu32;
#define XB_TMO      128
#define XB_XCNT(j)  (256  + 64 * (j))
#define XB_XSUB(j)  (1280 + 64 * (j))
#define XB_XGEN(j)  (2304 + 64 * (j))
#define XB_TOP      3328
#define XB_TOPGEN   3392
#define XCD_BAR_WORDS 3456
#define XB_SPIN_CAP (1u << 18)

__device__ __forceinline__ unsigned xb_ld(unsigned* p)              { return __hip_atomic_load(p, __ATOMIC_RELAXED, __HIP_MEMORY_SCOPE_AGENT); }
__device__ __forceinline__ unsigned xb_add(unsigned* p, unsigned v) { return __hip_atomic_fetch_add(p, v, __ATOMIC_RELAXED, __HIP_MEMORY_SCOPE_AGENT); }
__device__ __forceinline__ unsigned xb_xcc_id() { return (unsigned)__builtin_amdgcn_s_getreg((3 << 11) | 20) & 0xFu; }
#define XB_SPIN(cond, bar) do { unsigned _sp = 0; while (cond) { __builtin_amdgcn_s_sleep(1); \
    if ((++_sp & 255u) == 0u) { if (xb_ld(&(bar)[XB_TMO])) break; if (_sp > XB_SPIN_CAP) { atomicAdd(&(bar)[XB_TMO], 1u); break; } } } } while (0)

struct XcdBarrier {
    unsigned* bar; unsigned x;
    volatile LAS unsigned* st;
};

__device__ __forceinline__ XcdBarrier xcd_barrier_post(unsigned* bar, volatile LAS unsigned* st) {
    XcdBarrier b; b.bar = bar; b.x = xb_xcc_id(); b.st = st;
    if (threadIdx.x == 0) (void)xb_add(&bar[XB_XCNT(b.x)], 1u);
    return b;
}
__device__ __forceinline__ void xcd_barrier_complete(unsigned* bar, unsigned x, unsigned& nloc, unsigned& nx) {
    const unsigned G = gridDim.x * gridDim.y * gridDim.z;
    unsigned sum, cnt, mine, sp = 0u;
    for (;;) {
        sum = 0u; cnt = 0u; mine = 0u;
#pragma unroll
        for (unsigned j = 0; j < 16; ++j) { const unsigned c = xb_ld(&bar[XB_XCNT(j)]); sum += c; cnt += (c > 0u) ? 1u : 0u; mine = (j == x) ? c : mine; }
        if (sum == G) break;
        __builtin_amdgcn_s_sleep(1);
        if ((++sp & 255u) == 0u) { if (xb_ld(&bar[XB_TMO])) break; if (sp > XB_SPIN_CAP) { atomicAdd(&bar[XB_TMO], 1u); break; } }
    }
    nloc = mine > 0u ? mine : 1u; nx = cnt > 0u ? cnt : 1u;
}

__device__ __forceinline__ void xcd_barrier(const XcdBarrier& b) {
    asm volatile("s_waitcnt vmcnt(0)" ::: "memory");
    __syncthreads();
    if (threadIdx.x == 0) {
        unsigned* bar = b.bar;
        __builtin_amdgcn_s_waitcnt(0);
        unsigned nloc = b.st[0], nx = b.st[1];
        if (nloc == 0u) { xcd_barrier_complete(bar, b.x, nloc, nx); b.st[0] = nloc; b.st[1] = nx; }
        const unsigned old = xb_add(&bar[XB_XSUB(b.x)], 1u);
        const unsigned gen = old / nloc;
        if (old + 1u == (gen + 1u) * nloc) {
            __builtin_amdgcn_fence(__ATOMIC_RELEASE, "agent");
            asm volatile("s_waitcnt vmcnt(0)" ::: "memory");
            const unsigned og = xb_add(&bar[XB_TOP], 1u);
            const unsigned tg = og / nx;
            if (og + 1u == (tg + 1u) * nx) xb_add(&bar[XB_TOPGEN], 1u);
            else XB_SPIN(xb_ld(&bar[XB_TOPGEN]) == tg, bar);
            __builtin_amdgcn_fence(__ATOMIC_ACQUIRE, "agent");
            xb_add(&bar[XB_XGEN(b.x)], 1u);
            asm volatile("s_waitcnt vmcnt(0)" ::: "memory");
        } else {
            XB_SPIN(xb_ld(&bar[XB_XGEN(b.x)]) == gen, bar);
            __builtin_amdgcn_fence(__ATOMIC_ACQUIRE, "agent");
            asm volatile("s_waitcnt vmcnt(0)" ::: "memory");
        }
    }
    __syncthreads();
}


__device__ __forceinline__ void panel_handoff(unsigned* cnt, int pm, unsigned want) {
    asm volatile("s_waitcnt vmcnt(0)" ::: "memory");
    __syncthreads();
    if (threadIdx.x == 0) {
        unsigned* c = cnt + 64 * pm;
        __hip_atomic_fetch_add(c, 1u, __ATOMIC_RELAXED, __HIP_MEMORY_SCOPE_AGENT);
        unsigned sp = 0;
        while (__hip_atomic_load(c, __ATOMIC_RELAXED, __HIP_MEMORY_SCOPE_AGENT) < want) { __builtin_amdgcn_s_sleep(1); if (++sp > (1u << 22)) break; }
        __builtin_amdgcn_fence(__ATOMIC_ACQUIRE, "agent");
        asm volatile("s_waitcnt vmcnt(0)" ::: "memory");
    }
    __syncthreads();
}
#define GRID_SYNC_CG() do { asm volatile("s_waitcnt vmcnt(0) lgkmcnt(0)" ::: "memory"); grid.sync(); __builtin_amdgcn_fence(__ATOMIC_ACQUIRE, "agent"); asm volatile("s_waitcnt vmcnt(0)" ::: "memory"); } while (0)
#define GRID_SYNC() xcd_barrier(xbar)
__global__ void __launch_bounds__(NWAVES * 64, 2) mega_fwd(Args args) {
    extern __shared__ __attribute__((aligned(16))) unsigned char lds_raw[];
    LAS unsigned char* lds = (LAS unsigned char*)lds_raw;
    cg::grid_group grid = cg::this_grid();
    const int tid = threadIdx.x, lane = tid & 63, wave = __builtin_amdgcn_readfirstlane(tid >> 6), G = gridDim.x;
    unsigned char* ws = args.ws;
    if (tid < 32) ((LAS unsigned*)(lds + MISC_OFF))[tid] = 0u;
    __syncthreads();
    const XcdBarrier xbar = xcd_barrier_post((unsigned*)(ws + WS_BAR), (volatile LAS unsigned*)(lds + MISC_OFF) + 8);
    const pg8::bf16_t* hb = (const pg8::bf16_t*)args.out;
    const pg8::bf16_t* AB = (const pg8::bf16_t*)args.out + (size_t)T * 1024;

#if REP_MASK & 32
    for (int q_ = 0; q_ < 10; ++q_) { GRID_SYNC(); }
#endif
    phase0(args, lds, tid, lane, wave, G);
#if REP_MASK & 1
    phase0(args, lds, tid, lane, wave, G);
#endif
    if (args.zero) { GRID_SYNC_CG(); }
    GRID_SYNC();
    glr_step(args, lane, wave, G);
    { pg8::Gemm g{hb, hb, hb, (const pg8::bf16_t*)(ws + WS_W1G), (const pg8::bf16_t*)(ws + WS_W1G), (const pg8::bf16_t*)(ws + WS_W1G), 16, 16, 16, 1024, 1024};
      pg8::SegOrder S; S.init(T, PG, G, (int)blockIdx.x, 1); pg8::EpiBf16 E{(pg8::bf16_t*)(ws + WS_PROJG), PG};
      pg8::gemm_phase<pg8::EpiBf16, pg8::SegOrder, true, true>(lds, g, S, E); }
#if REP_MASK & 128
    { pg8::Gemm g{hb, hb, hb, (const pg8::bf16_t*)(ws + WS_W1G), (const pg8::bf16_t*)(ws + WS_W1G), (const pg8::bf16_t*)(ws + WS_W1G), 16, 16, 16, 1024, 1024};
      pg8::SegOrder S; S.init(T, PG, G, (int)blockIdx.x, 1); pg8::EpiBf16 E{(pg8::bf16_t*)(ws + WS_PROJG), PG};
      pg8::gemm_phase<pg8::EpiBf16, pg8::SegOrder, true, true>(lds, g, S, E); }
#endif
    GRID_SYNC();
    DBG_DUMP(2, 7, SB(WS_W1A, 10), SB(WS_W1G, 6), SB(WS_WGT, 4), SF(WS_ROT, 1), dbg_sum_bf16(args.out, 32 * MiB, gtid_, NT_), SF(WS_GLR, 1), SB(WS_PROJG, 96))
    gla_local_phase(args, lds, tid, lane, wave, G);
#if REP_MASK & 2
    gla_local_phase(args, lds, tid, lane, wave, G);
#endif
    GRID_SYNC();
    DBG_DUMP(3, 4, SB(WS_QP, 16), SB(WS_OI, 32), SB(WS_L, 64), SF(WS_GAMMA, 0.5))
    DBG_DUMP(31, 1, SB(WS_QP, 16))
    DBG_DUMP(32, 1, SB(WS_OI, 32))
    DBG_DUMP(33, 1, SB(WS_L, 64))
    gla_chain_phase(args, lds, tid, lane, wave, G, args.one);
#if REP_MASK & 64
    gla_chain_phase(args, lds, tid, lane, wave, G, args.zero);
#endif
    GRID_SYNC();
    DBG_DUMP(4, 2, SB(WS_OI, 32), SF(WS_SS, 4))
    { pg8::Gemm g{hb, hb, hb, (const pg8::bf16_t*)(ws + WS_W1A), (const pg8::bf16_t*)(ws + WS_W1A), (const pg8::bf16_t*)(ws + WS_W1A), 16, 16, 16, 1024, 1024};
      pg8::SegOrder S; S.init(T, 6144, G, (int)blockIdx.x, 1);
      pg8::EpiQKV E{(pg8::bf16_t*)(ws + WS_PROJA), (pg8::bf16_t*)(ws + WS_ZA), args.gq, args.gk, (const float*)(ws + WS_ROT), EPS, (const pg8::bf16_t*)(ws + WS_OI), (const float*)(ws + WS_SS), args.gla_g, (pg8::bf16_t*)args.out + (size_t)T * 1024};
      pg8::gemm_phase<pg8::EpiQKV, pg8::SegOrder, true, true>(lds, g, S, E); }
#if REP_MASK & 256
    { pg8::Gemm g{hb, hb, hb, (const pg8::bf16_t*)(ws + WS_W1A), (const pg8::bf16_t*)(ws + WS_W1A), (const pg8::bf16_t*)(ws + WS_W1A), 16, 16, 16, 1024, 1024};
      pg8::SegOrder S; S.init(T, 6144, G, (int)blockIdx.x, 1);
      pg8::EpiQKV E{(pg8::bf16_t*)(ws + WS_PROJA), (pg8::bf16_t*)(ws + WS_ZA), args.gq, args.gk, (const float*)(ws + WS_ROT), EPS, (const pg8::bf16_t*)(ws + WS_OI), (const float*)(ws + WS_SS), args.gla_g, (pg8::bf16_t*)args.out + (size_t)T * 1024};
      pg8::gemm_phase<pg8::EpiQKV, pg8::SegOrder, true, true>(lds, g, S, E); }
#endif
    GRID_SYNC();
    attn_phase(args, lds, tid, lane, wave, G);
#if REP_MASK & 8
    attn_phase(args, lds, tid, lane, wave, G);
#endif
    GRID_SYNC();
    pg8::SegOrder SP; SP.init(T, 1024, G, (int)blockIdx.x, 1); pg8::Unit up; const bool panel_mode = (SP.nwg == G) && SP.next(0, up);
    if (panel_mode) prep_a_phase(args, tid, G, up.pm * 256 + up.pn * 64, 64, T);
    else { prep_a_phase(args, tid, G, (int)blockIdx.x * 64, 64, G * 64); GRID_SYNC(); }
    { bf16* pb = (bf16*)(ws + WS_PB);
      for (int i = blockIdx.x * 512 + tid; i < T * 256 / 8; i += G * 512) { const f32x4 v0 = ((const f32x4*)args.p)[2 * i], v1 = ((const f32x4*)args.p)[2 * i + 1];
          v4u w; w.x = pk2(v0[0], v0[1]); w.y = pk2(v0[2], v0[3]); w.z = pk2(v1[0], v1[1]); w.w = pk2(v1[2], v1[3]); ((v4u*)pb)[i] = w; } }
    { const pg8::bf16_t* WGT = (const pg8::bf16_t*)(ws + WS_WGT);
      pg8::Gemm g{hb, hb, hb, WGT, WGT + (size_t)1024 * 1024, WGT, 16, 16, 16, 1024, 1024};
      pg8::SegOrder S; S.init(T, 1024, G, (int)blockIdx.x, 2); pg8::EpiSig2 E{(pg8::bf16_t*)(ws + WS_SGA), (pg8::bf16_t*)(ws + WS_SGB), 1024};
      pg8::gemm_phase<pg8::EpiSig2, pg8::SegOrder, true, true>(lds, g, S, E); }
    if (panel_mode) panel_handoff((unsigned*)(ws + WS_PCNT) + 4096, up.pm, 4u);
    { const pg8::bf16_t* AA = (const pg8::bf16_t*)(ws + WS_AA); const pg8::bf16_t* WPA = (const pg8::bf16_t*)(ws + WS_WPA);
      pg8::Gemm g{AA, AA, AA, WPA, WPA, WPA, 8, 8, 8, 512, 512};
      pg8::SegOrder S; S.init(T, 1024, G, (int)blockIdx.x, 1); pg8::EpiGateMul E{(const pg8::bf16_t*)(ws + WS_SGA), (pg8::bf16_t*)(ws + WS_T1), 1024};
      pg8::gemm_phase<pg8::EpiGateMul, pg8::SegOrder, true, true>(lds, g, S, E); }
    { const pg8::bf16_t* WPB = (const pg8::bf16_t*)(ws + WS_WPB);
      pg8::Gemm g{AB, AB, AB, WPB, WPB, WPB, 16, 16, 16, 1024, 1024};
      pg8::SegOrder S; S.init(T, 1024, G, (int)blockIdx.x, 1); pg8::EpiMergeY E{(const pg8::bf16_t*)(ws + WS_SGB), (const pg8::bf16_t*)(ws + WS_T1), (pg8::bf16_t*)(ws + WS_Y), 1024};
      pg8::gemm_phase<pg8::EpiMergeY, pg8::SegOrder, true, true>(lds, g, S, E); }
#if REP_MASK & 512
    { const pg8::bf16_t* WGT = (const pg8::bf16_t*)(ws + WS_WGT);
      pg8::Gemm g{hb, hb, hb, WGT, WGT + (size_t)1024 * 1024, WGT, 16, 16, 16, 1024, 1024};
      pg8::SegOrder S; S.init(T, 1024, G, (int)blockIdx.x, 2); pg8::EpiSig2 E{(pg8::bf16_t*)(ws + WS_SGA), (pg8::bf16_t*)(ws + WS_SGB), 1024};
      pg8::gemm_phase<pg8::EpiSig2, pg8::SegOrder, true, true>(lds, g, S, E); }
    { const pg8::bf16_t* AA = (const pg8::bf16_t*)(ws + WS_AA); const pg8::bf16_t* WPA = (const pg8::bf16_t*)(ws + WS_WPA);
      pg8::Gemm g{AA, AA, AA, WPA, WPA, WPA, 8, 8, 8, 512, 512};
      pg8::SegOrder S; S.init(T, 1024, G, (int)blockIdx.x, 1); pg8::EpiGateMul E{(const pg8::bf16_t*)(ws + WS_SGA), (pg8::bf16_t*)(ws + WS_T1), 1024};
      pg8::gemm_phase<pg8::EpiGateMul, pg8::SegOrder, true, true>(lds, g, S, E); }
    { const pg8::bf16_t* WPB = (const pg8::bf16_t*)(ws + WS_WPB);
      pg8::Gemm g{AB, AB, AB, WPB, WPB, WPB, 16, 16, 16, 1024, 1024};
      pg8::SegOrder S; S.init(T, 1024, G, (int)blockIdx.x, 1); pg8::EpiMergeY E{(const pg8::bf16_t*)(ws + WS_SGB), (const pg8::bf16_t*)(ws + WS_T1), (pg8::bf16_t*)(ws + WS_Y), 1024};
      pg8::gemm_phase<pg8::EpiMergeY, pg8::SegOrder, true, true>(lds, g, S, E); }
#endif
    GRID_SYNC();
    DBG_DUMP(9, 5, SF(WS_TMP1, 64), SF(WS_TMP2, 64), SB(WS_Y, 32), SB(WS_PB, 8), SB(WS_WPA, 7))
    { const pg8::bf16_t* Y = (const pg8::bf16_t*)(ws + WS_Y); const pg8::bf16_t* W = (const pg8::bf16_t*)(ws + WS_WOUT);
      pg8::Gemm g{Y, Y, Y, W, W, W, 16, 16, 16, 1024, 1024};
      pg8::SegOrder S; S.init(T, 1024, G, (int)blockIdx.x, 1); pg8::EpiResid E{args.x, args.out, (pg8::bf16_t*)(ws + WS_X1B), (float*)(ws + WS_PS), 1024};
      pg8::gemm_phase<pg8::EpiResid, pg8::SegOrder, true, true>(lds, g, S, E); }
#if REP_MASK & 1024
    { const pg8::bf16_t* Y = (const pg8::bf16_t*)(ws + WS_Y); const pg8::bf16_t* W = (const pg8::bf16_t*)(ws + WS_WOUT);
      pg8::Gemm g{Y, Y, Y, W, W, W, 16, 16, 16, 1024, 1024};
      pg8::SegOrder S; S.init(T, 1024, G, (int)blockIdx.x, 1); pg8::EpiResid E{args.x, args.out, (pg8::bf16_t*)(ws + WS_X1B), (float*)(ws + WS_PS), 1024};
      pg8::gemm_phase<pg8::EpiResid, pg8::SegOrder, true, true>(lds, g, S, E); }
#endif
    { pg8::SegOrder S; S.init(T, 1024, G, (int)blockIdx.x, 1); pg8::Unit u0;
      if (S.nwg == G && S.next(0, u0)) panel_handoff((unsigned*)(ws + WS_PCNT), u0.pm, 4u); else { GRID_SYNC(); } }
    DBG_DUMP(10, 3, SB(WS_X1B, 32), SF(WS_PS, 1), dbg_sum_f32(args.out, 64 * MiB, gtid_, NT_))
    { const pg8::bf16_t* X1 = (const pg8::bf16_t*)(ws + WS_X1B); const pg8::bf16_t* W = (const pg8::bf16_t*)(ws + WS_WPG);
      pg8::Gemm g{X1, X1, X1, W, W, W, 16, 16, 16, 1024, 1024};
      pg8::SegOrder S; S.init(T, 1024, G, (int)blockIdx.x, 1); pg8::EpiSigRow E{(const float*)(ws + WS_PS), (pg8::bf16_t*)(ws + WS_SGA), 1024, EPS};
      pg8::gemm_phase<pg8::EpiSigRow, pg8::SegOrder, true, true>(lds, g, S, E); }
#if REP_MASK & 2048
    { const pg8::bf16_t* X1 = (const pg8::bf16_t*)(ws + WS_X1B); const pg8::bf16_t* W = (const pg8::bf16_t*)(ws + WS_WPG);
      pg8::Gemm g{X1, X1, X1, W, W, W, 16, 16, 16, 1024, 1024};
      pg8::SegOrder S; S.init(T, 1024, G, (int)blockIdx.x, 1); pg8::EpiSigRow E{(const float*)(ws + WS_PS), (pg8::bf16_t*)(ws + WS_SGA), 1024, EPS};
      pg8::gemm_phase<pg8::EpiSigRow, pg8::SegOrder, true, true>(lds, g, S, E); }
#endif
    { const pg8::bf16_t* PBm = (const pg8::bf16_t*)(ws + WS_PB); const pg8::bf16_t* W = (const pg8::bf16_t*)(ws + WS_WPLE);
      pg8::Gemm g{PBm, PBm, PBm, W, W, W, 4, 4, 4, 256, 256};
      pg8::SegOrder S; S.init(T, 1024, G, (int)blockIdx.x, 1); pg8::EpiPle2 E{args.out, (const pg8::bf16_t*)(ws + WS_SGA), 1024};
      pg8::gemm_phase<pg8::EpiPle2, pg8::SegOrder, true, true>(lds, g, S, E); }
}

extern "C" void kernel_launch(void* const* d_in, const int* in_sizes, int n_in, void* d_out, int out_size, void* d_ws, size_t ws_size, hipStream_t stream) {
    static int grid = 0;
    if (grid == 0) {
        if (n_in != 16 || out_size != T * D || ws_size < WS_END) { fprintf(stderr, "kernel_launch: unexpected shapes (n_in %d out %d ws %zu)\n", n_in, out_size, ws_size); grid = -1; return; }
        int dev = 0, cus = 0, per_cu = 0;
        (void)hipGetDevice(&dev); (void)hipDeviceGetAttribute(&cus, hipDeviceAttributeMultiprocessorCount, dev);
        (void)hipFuncSetAttribute((const void*)mega_fwd, hipFuncAttributeMaxDynamicSharedMemorySize, LDS_BYTES);
        (void)hipOccupancyMaxActiveBlocksPerMultiprocessor(&per_cu, (const void*)mega_fwd, NWAVES * 64, LDS_BYTES);
        if (per_cu < 1) { fprintf(stderr, "kernel_launch: occupancy query says %d blocks per CU\n", per_cu); per_cu = 1; }
        (void)hipGetLastError();
        grid = cus;
    }
    if (grid < 0) return;
    Args a{};
    a.x = (const float*)d_in[0]; a.p = (const float*)d_in[1]; a.pos = (const int*)d_in[2]; a.norm_g = (const float*)d_in[3]; a.w_in = (const float*)d_in[4];
    a.gq = (const float*)d_in[5]; a.gk = (const float*)d_in[6]; a.gate_w2 = (const float*)d_in[7]; a.gate_b = (const float*)d_in[8]; a.gla_g = (const float*)d_in[9];
    a.w_att = (const float*)d_in[10]; a.w_gla = (const float*)d_in[11]; a.w_out = (const float*)d_in[12]; a.ple_g = (const float*)d_in[13]; a.w_pg = (const float*)d_in[14]; a.w_ple = (const float*)d_in[15];
    a.out = (float*)d_out; a.ws = (unsigned char*)d_ws; a.one = 1; a.zero = 0;
    if (hipMemsetAsync((char*)d_ws + WS_BAR, 0, BAR_BYTES, stream) != hipSuccess) { fprintf(stderr, "kernel_launch: memset of barrier words failed\n"); return; }
    void* kargs[] = {&a};
    hipError_t e = hipLaunchCooperativeKernel((const void*)mega_fwd, dim3(grid), dim3(NWAVES * 64), kargs, LDS_BYTES, stream);
    if (e != hipSuccess) fprintf(stderr, "cooperative launch failed: %s (grid %d)\n", hipGetErrorString(e), grid);
}
```

```cpp
#define REP_MASK 0
#define DBG_STOP 0
#include <hip/hip_runtime.h>
#include <hip/hip_cooperative_groups.h>
#include <cstdio>
#include <cstdint>
namespace cg = cooperative_groups;

namespace pg8 {
#define PG8_LAS __attribute__((address_space(3)))
typedef unsigned short bf16_t;
typedef short bf16x8 __attribute__((ext_vector_type(8)));
typedef float f32x4 __attribute__((ext_vector_type(4)));
typedef unsigned u32x4 __attribute__((ext_vector_type(4)));
typedef unsigned u32x2 __attribute__((ext_vector_type(2)));
constexpr int BM = 256, BK = 64, HALF = 128, HTB = HALF * BK * 2  , STAGE_BYTES = 8 * HTB, NXCD = 8, WGM = 8;

__host__ __device__ __forceinline__ int lds_byte(int r, int c) { const int st = (r >> 4) * 2 + (c >> 5), rr = r & 15, cc = c & 31, ob = rr * 64 + cc * 2; return st * 1024 + (ob ^ (((ob >> 9) & 1) << 5)); }
__host__ __device__ __forceinline__ void stage_rc(int b, int& R, int& C) { const int st = b / 1024, sb = b % 1024, swz = sb ^ (((sb >> 9) & 1) << 5); R = (st >> 1) * 16 + swz / 64; C = (st & 1) * 32 + (swz % 64) / 2; }
__host__ __device__ __forceinline__ int perm32(int rho) { const int n = rho >> 4, i = rho & 15; return 8 * (i >> 2) + 4 * n + (i & 3); }

struct Unit { int pm, pn, seg; };
struct Gemm {
    const bf16_t* A0; const bf16_t* A1; const bf16_t* A2; const bf16_t* B0; const bf16_t* B1; const bf16_t* B2; int nt0, nt1, nt2, lda, ldb;
    __device__ __forceinline__ const bf16_t* selA(int s) const { const bf16_t* a0 = +A0; const bf16_t* a1 = +A1; const bf16_t* a2 = +A2; return s == 0 ? +a0 : (s == 1 ? +a1 : +a2); }
    __device__ __forceinline__ const bf16_t* selB(int s) const { const bf16_t* b0 = +B0; const bf16_t* b1 = +B1; const bf16_t* b2 = +B2; return s == 0 ? +b0 : (s == 1 ? +b1 : +b2); }
    __device__ __forceinline__ int selNt(int s) const { const int n0 = +nt0, n1 = +nt1, n2 = +nt2; return s == 0 ? +n0 : (s == 1 ? +n1 : +n2); }
};
struct SegOrder {
    int nM, nN, nwg, G, c, nseg;
    __device__ void init(int M, int N, int G_, int c_, int nseg_) { nM = M / BM; nN = N / BM; nwg = nM * nN; G = G_; c = c_; nseg = nseg_; }
    __device__ bool next(int i, Unit& u) const {
        const int ti = i / nseg; u.seg = i - ti * nseg;
        const long L = (long)ti * G + c; if (L >= nwg) return false;
        int wgid = (int)L; { const int q = nwg / NXCD, r = nwg % NXCD, xcd = wgid % NXCD, off = wgid / NXCD; wgid = (xcd < r ? xcd * (q + 1) : r * (q + 1) + (xcd - r) * q) + off; }
        const int nig = WGM * nN, gid = wgid / nig, fm = gid * WGM, gsz = (nM - fm) < WGM ? (nM - fm) : WGM;
        u.pm = fm + ((wgid % nig) % gsz); u.pn = (wgid % nig) / gsz; return true;
    }
    __device__ __forceinline__ void a_ready(const Unit&) const {}
    __device__ __forceinline__ void done(const Unit&) const {}
};
typedef __bf16 bf16x2_t __attribute__((ext_vector_type(2)));
typedef float f32x2_t __attribute__((ext_vector_type(2)));
__device__ __forceinline__ unsigned cvt_pk_bf16(float lo, float hi) { f32x2_t f = {lo, hi}; bf16x2_t v = __builtin_convertvector(f, bf16x2_t); return __builtin_bit_cast(unsigned, v); }
__device__ __forceinline__ float sigmoidf_(float x) { return __builtin_amdgcn_rcpf(1.0f + __expf(-x)); }

struct EpiBf16 {
    static constexpr bool PERM = true, AFTER_DRAIN = false;
    bf16_t* O; int ldc;
    __device__ __forceinline__ void operator()(const f32x4 (&acc)[2][2][4][2], const Unit& u, int wr, int wc, int fr, int fq) const {
        const int row0 = u.pm * BM + wr * 64 + fr; const int col0 = u.pn * BM + wc * 32 + 8 * fq;
#pragma unroll
        for (int ai = 0; ai < 2; ++ai)
#pragma unroll
            for (int m = 0; m < 4; ++m) { bf16_t* rowp = O + (size_t)(row0 + ai * HALF + m * 16) * ldc + col0;
#pragma unroll
                for (int bj = 0; bj < 2; ++bj) { const f32x4 v0 = acc[ai][bj][m][0], v1 = acc[ai][bj][m][1];
                    u32x4 w; w.x = cvt_pk_bf16(v0[0], v0[1]); w.y = cvt_pk_bf16(v0[2], v0[3]); w.z = cvt_pk_bf16(v1[0], v1[1]); w.w = cvt_pk_bf16(v1[2], v1[3]);
                    *(u32x4*)(rowp + bj * HALF) = w; } }
    }
};
#define PG8_FOR_ACC(body) \
    _Pragma("unroll") for (int ai = 0; ai < 2; ++ai) _Pragma("unroll") for (int m = 0; m < 4; ++m) { const int row = u.pm * BM + ai * HALF + wr * 64 + m * 16 + fr; \
    _Pragma("unroll") for (int bj = 0; bj < 2; ++bj) _Pragma("unroll") for (int n = 0; n < 2; ++n) { const size_t off = (size_t)row * ldc + (u.pn * BM + bj * HALF + wc * 32 + n * 16 + 4 * fq); const f32x4 a = acc[ai][bj][m][n]; body } }
struct EpiStoreF32 {
    static constexpr bool PERM = false, AFTER_DRAIN = false;
    float* tmp; int ldc;
    __device__ __forceinline__ void operator()(const f32x4 (&acc)[2][2][4][2], const Unit& u, int wr, int wc, int fr, int fq) const {
        PG8_FOR_ACC( *(f32x4*)(tmp + off) = a; )
    }
};
struct EpiMerge {
    static constexpr bool PERM = false, AFTER_DRAIN = false;
    float* tmp1; float* tmp2; bf16_t* y; int ldc;
    __device__ __forceinline__ void operator()(const f32x4 (&acc)[2][2][4][2], const Unit& u, int wr, int wc, int fr, int fq) const {
        if (u.seg == 0) {
            PG8_FOR_ACC( f32x4 t = *(const f32x4*)(tmp1 + off); t[0] *= sigmoidf_(a[0]); t[1] *= sigmoidf_(a[1]); t[2] *= sigmoidf_(a[2]); t[3] *= sigmoidf_(a[3]); *(f32x4*)(tmp1 + off) = t; )
        } else if (u.seg == 1) {
            PG8_FOR_ACC( *(f32x4*)(tmp2 + off) = a; )
        } else {
            PG8_FOR_ACC( const f32x4 t1 = *(const f32x4*)(tmp1 + off); const f32x4 t2 = *(const f32x4*)(tmp2 + off);
                u32x2 w; w.x = cvt_pk_bf16(t1[0] + sigmoidf_(a[0]) * t2[0], t1[1] + sigmoidf_(a[1]) * t2[1]); w.y = cvt_pk_bf16(t1[2] + sigmoidf_(a[2]) * t2[2], t1[3] + sigmoidf_(a[3]) * t2[3]);
                *(u32x2*)(y + off) = w; )
        }
    }
};
__device__ __forceinline__ void st_sc1_16(void* p, u32x4 w) { asm volatile("global_store_dwordx4 %0, %1, off sc1" :: "v"(p), "v"(w) : "memory"); }
struct EpiResid {
    static constexpr bool PERM = true, AFTER_DRAIN = false;
    const float* x; float* out; bf16_t* x1b; float* ps; int ldc;
    __device__ __forceinline__ void operator()(const f32x4 (&acc)[2][2][4][2], const Unit& u, int wr, int wc, int fr, int fq) const {
#pragma unroll
        for (int ai = 0; ai < 2; ++ai)
#pragma unroll
            for (int m = 0; m < 4; ++m) { const int row = u.pm * BM + ai * HALF + wr * 64 + m * 16 + fr; float s = 0.f;
#pragma unroll
                for (int bj = 0; bj < 2; ++bj) { const size_t off = (size_t)row * ldc + (u.pn * BM + bj * HALF + wc * 32 + 8 * fq);
                    const f32x4 v0 = *(const f32x4*)(x + off) + acc[ai][bj][m][0], v1 = *(const f32x4*)(x + off + 4) + acc[ai][bj][m][1];
                    *(f32x4*)(out + off) = v0; *(f32x4*)(out + off + 4) = v1;
                    u32x4 w; w.x = cvt_pk_bf16(v0[0], v0[1]); w.y = cvt_pk_bf16(v0[2], v0[3]); w.z = cvt_pk_bf16(v1[0], v1[1]); w.w = cvt_pk_bf16(v1[2], v1[3]);
                    st_sc1_16(x1b + off, w);
                    s += ((v0[0] * v0[0] + v0[1] * v0[1]) + (v0[2] * v0[2] + v0[3] * v0[3])) + ((v1[0] * v1[0] + v1[1] * v1[1]) + (v1[2] * v1[2] + v1[3] * v1[3])); }
                s += __shfl_xor(s, 16); s += __shfl_xor(s, 32);
                if (fq == 0) __hip_atomic_store(ps + (size_t)row * 16 + u.pn * 4 + wc, s, __ATOMIC_RELAXED, __HIP_MEMORY_SCOPE_AGENT);
                asm volatile("" ::: "memory"); }
    }
};
struct EpiPle {
    static constexpr bool PERM = false, AFTER_DRAIN = false;
    float* out; const float* tmp; const float* ps; int ldc; float eps;
    __device__ __forceinline__ void operator()(const f32x4 (&acc)[2][2][4][2], const Unit& u, int wr, int wc, int fr, int fq) const {
#pragma unroll
        for (int ai = 0; ai < 2; ++ai)
#pragma unroll
            for (int m = 0; m < 4; ++m) { const int row = u.pm * BM + ai * HALF + wr * 64 + m * 16 + fr;
                const f32x4* pp = (const f32x4*)(ps + (size_t)row * 16); const f32x4 p0 = pp[0], p1 = pp[1], p2 = pp[2], p3 = pp[3];
                const float ss = ((p0[0] + p0[1]) + (p0[2] + p0[3])) + ((p1[0] + p1[1]) + (p1[2] + p1[3])) + ((p2[0] + p2[1]) + (p2[2] + p2[3])) + ((p3[0] + p3[1]) + (p3[2] + p3[3]));
                const float rstd = rsqrtf(ss * (1.0f / 1024.0f) + eps);
#pragma unroll
                for (int bj = 0; bj < 2; ++bj)
#pragma unroll
                    for (int n = 0; n < 2; ++n) { const size_t off = (size_t)row * ldc + (u.pn * BM + bj * HALF + wc * 32 + n * 16 + 4 * fq);
                        const f32x4 a = acc[ai][bj][m][n]; const f32x4 t = *(const f32x4*)(tmp + off); f32x4 o = *(const f32x4*)(out + off);
                        o[0] += t[0] * sigmoidf_(rstd * a[0]); o[1] += t[1] * sigmoidf_(rstd * a[1]); o[2] += t[2] * sigmoidf_(rstd * a[2]); o[3] += t[3] * sigmoidf_(rstd * a[3]);
                        *(f32x4*)(out + off) = o; } }
    }
};

__device__ __forceinline__ f32x4 unpack_bf16x4(u32x2 w) { f32x4 r; r[0] = __uint_as_float(w.x << 16); r[1] = __uint_as_float(w.x & 0xffff0000u); r[2] = __uint_as_float(w.y << 16); r[3] = __uint_as_float(w.y & 0xffff0000u); return r; }
#define PG8_FOR_ACC8(...) \
    _Pragma("unroll") for (int ai = 0; ai < 2; ++ai) _Pragma("unroll") for (int m = 0; m < 4; ++m) { const int row = u.pm * BM + ai * HALF + wr * 64 + m * 16 + fr; \
    _Pragma("unroll") for (int bj = 0; bj < 2; ++bj) { const size_t off = (size_t)row * ldc + (u.pn * BM + bj * HALF + wc * 32 + 8 * fq); const f32x4 a0 = acc[ai][bj][m][0], a1 = acc[ai][bj][m][1]; __VA_ARGS__ } }
__device__ __forceinline__ void unpack_bf16x8(u32x4 w, f32x4& lo, f32x4& hi) { lo[0] = __uint_as_float(w.x << 16); lo[1] = __uint_as_float(w.x & 0xffff0000u); lo[2] = __uint_as_float(w.y << 16); lo[3] = __uint_as_float(w.y & 0xffff0000u);
    hi[0] = __uint_as_float(w.z << 16); hi[1] = __uint_as_float(w.z & 0xffff0000u); hi[2] = __uint_as_float(w.w << 16); hi[3] = __uint_as_float(w.w & 0xffff0000u); }
__device__ __forceinline__ u32x4 pack_bf16x8(f32x4 lo, f32x4 hi) { u32x4 w; w.x = cvt_pk_bf16(lo[0], lo[1]); w.y = cvt_pk_bf16(lo[2], lo[3]); w.z = cvt_pk_bf16(hi[0], hi[1]); w.w = cvt_pk_bf16(hi[2], hi[3]); return w; }
__device__ __forceinline__ f32x4 sig4(f32x4 a) { f32x4 r; r[0] = sigmoidf_(a[0]); r[1] = sigmoidf_(a[1]); r[2] = sigmoidf_(a[2]); r[3] = sigmoidf_(a[3]); return r; }
struct EpiSig2 {
    static constexpr bool PERM = true, AFTER_DRAIN = false;
    bf16_t* s0; bf16_t* s1; int ldc;
    __device__ __forceinline__ void operator()(const f32x4 (&acc)[2][2][4][2], const Unit& u, int wr, int wc, int fr, int fq) const {
        bf16_t* dst = u.seg == 0 ? s0 : s1;
        PG8_FOR_ACC8( *(u32x4*)(dst + off) = pack_bf16x8(sig4(a0), sig4(a1)); )
    }
};
struct EpiGateMul {
    static constexpr bool PERM = true, AFTER_DRAIN = false;
    const bf16_t* sg; bf16_t* t1; int ldc;
    __device__ __forceinline__ void operator()(const f32x4 (&acc)[2][2][4][2], const Unit& u, int wr, int wc, int fr, int fq) const {
        PG8_FOR_ACC8( f32x4 g0, g1; unpack_bf16x8(*(const u32x4*)(sg + off), g0, g1); *(u32x4*)(t1 + off) = pack_bf16x8(g0 * a0, g1 * a1); )
    }
};
struct EpiMergeY {
    static constexpr bool PERM = true, AFTER_DRAIN = false;
    const bf16_t* sg; const bf16_t* t1; bf16_t* y; int ldc;
    __device__ __forceinline__ void operator()(const f32x4 (&acc)[2][2][4][2], const Unit& u, int wr, int wc, int fr, int fq) const {
        PG8_FOR_ACC8( f32x4 g0, g1, t0, t1v; unpack_bf16x8(*(const u32x4*)(sg + off), g0, g1); unpack_bf16x8(*(const u32x4*)(t1 + off), t0, t1v);
            *(u32x4*)(y + off) = pack_bf16x8(t0 + g0 * a0, t1v + g1 * a1); )
    }
};
struct EpiSigRow {
    static constexpr bool PERM = true, AFTER_DRAIN = false;
    const float* ps; bf16_t* sg; int ldc; float eps;
    __device__ __forceinline__ void operator()(const f32x4 (&acc)[2][2][4][2], const Unit& u, int wr, int wc, int fr, int fq) const {
#pragma unroll
        for (int ai = 0; ai < 2; ++ai)
#pragma unroll
            for (int m = 0; m < 4; ++m) { const int row = u.pm * BM + ai * HALF + wr * 64 + m * 16 + fr;
                const f32x4* pp = (const f32x4*)(ps + (size_t)row * 16); const f32x4 p0 = pp[0], p1 = pp[1], p2 = pp[2], p3 = pp[3];
                const float ss = ((p0[0] + p0[1]) + (p0[2] + p0[3])) + ((p1[0] + p1[1]) + (p1[2] + p1[3])) + ((p2[0] + p2[1]) + (p2[2] + p2[3])) + ((p3[0] + p3[1]) + (p3[2] + p3[3]));
                const float rstd = rsqrtf(ss * (1.0f / 1024.0f) + eps);
#pragma unroll
                for (int bj = 0; bj < 2; ++bj) { const size_t off = (size_t)row * ldc + (u.pn * BM + bj * HALF + wc * 32 + 8 * fq);
                    const f32x4 a0 = acc[ai][bj][m][0], a1 = acc[ai][bj][m][1];
                    u32x4 w; w.x = cvt_pk_bf16(sigmoidf_(rstd * a0[0]), sigmoidf_(rstd * a0[1])); w.y = cvt_pk_bf16(sigmoidf_(rstd * a0[2]), sigmoidf_(rstd * a0[3]));
                    w.z = cvt_pk_bf16(sigmoidf_(rstd * a1[0]), sigmoidf_(rstd * a1[1])); w.w = cvt_pk_bf16(sigmoidf_(rstd * a1[2]), sigmoidf_(rstd * a1[3]));
                    *(u32x4*)(sg + off) = w; } }
    }
};
struct EpiPle2 {
    static constexpr bool PERM = true, AFTER_DRAIN = false;
    float* out; const bf16_t* sg; int ldc;
    __device__ __forceinline__ void operator()(const f32x4 (&acc)[2][2][4][2], const Unit& u, int wr, int wc, int fr, int fq) const {
#pragma unroll
        for (int ai = 0; ai < 2; ++ai)
#pragma unroll
            for (int m = 0; m < 4; ++m) { const int row = u.pm * BM + ai * HALF + wr * 64 + m * 16 + fr;
#pragma unroll
                for (int bj = 0; bj < 2; ++bj) { const size_t off = (size_t)row * ldc + (u.pn * BM + bj * HALF + wc * 32 + 8 * fq);
                    const u32x4 g8 = *(const u32x4*)(sg + off); const f32x4 a0 = acc[ai][bj][m][0], a1 = acc[ai][bj][m][1];
                    f32x4 o0 = *(const f32x4*)(out + off), o1 = *(const f32x4*)(out + off + 4);
                    o0[0] += a0[0] * __uint_as_float(g8.x << 16); o0[1] += a0[1] * __uint_as_float(g8.x & 0xffff0000u); o0[2] += a0[2] * __uint_as_float(g8.y << 16); o0[3] += a0[3] * __uint_as_float(g8.y & 0xffff0000u);
                    o1[0] += a1[0] * __uint_as_float(g8.z << 16); o1[1] += a1[1] * __uint_as_float(g8.z & 0xffff0000u); o1[2] += a1[2] * __uint_as_float(g8.w << 16); o1[3] += a1[3] * __uint_as_float(g8.w & 0xffff0000u);
                    *(f32x4*)(out + off) = o0; *(f32x4*)(out + off + 4) = o1; }
                asm volatile("" ::: "memory"); }
    }
};

struct EpiQKV {
    static constexpr bool PERM = true, AFTER_DRAIN = false;
    bf16_t* QKV; bf16_t* ZA; const float* gq; const float* gk; const float* rot; float eps;
    const bf16_t* OI; const float* SS; const float* gla_g; bf16_t* AB;
    __device__ __forceinline__ void operator()(const f32x4 (&acc)[2][2][4][2], const Unit& u, int wr, int wc, int fr, int fq) const {
        const int row0 = u.pm * BM + wr * 64 + fr; const int cl = u.pn * BM + 64 * wc;
        if (cl >= 5120) {
            const int zc0 = cl - 5120 + 8 * fq, hB = (cl - 5120) >> 8;
            const f32x4 ga0 = *(const f32x4*)(gla_g + (zc0 & 255)), ga1 = *(const f32x4*)(gla_g + (zc0 & 255) + 4), gb0 = *(const f32x4*)(gla_g + ((zc0 + 32) & 255)), gb1 = *(const f32x4*)(gla_g + ((zc0 + 32) & 255) + 4);
#pragma unroll
            for (int ai = 0; ai < 2; ++ai)
#pragma unroll
                for (int m = 0; m < 4; ++m) { const int row = row0 + ai * HALF + m * 16;
                    const f32x4* sp = (const f32x4*)(SS + (size_t)row * 64 + hB * 16); const f32x4 s0 = sp[0], s1 = sp[1], s2 = sp[2], s3 = sp[3];
                    const float ss = ((s0[0] + s0[1]) + (s0[2] + s0[3])) + ((s1[0] + s1[1]) + (s1[2] + s1[3])) + ((s2[0] + s2[1]) + (s2[2] + s2[3])) + ((s3[0] + s3[1]) + (s3[2] + s3[3]));
                    const float rstd = rsqrtf(ss * (1.0f / 256.0f) + eps);
#pragma unroll
                    for (int bj = 0; bj < 2; ++bj) { const size_t off = (size_t)row * 1024 + zc0 + 32 * bj; const u32x4 o8 = *(const u32x4*)(OI + off);
                        const f32x4 z0 = acc[ai][bj][m][0], z1 = acc[ai][bj][m][1]; const f32x4 g0 = bj ? gb0 : ga0, g1 = bj ? gb1 : ga1;
                        u32x4 w;
                        w.x = cvt_pk_bf16(__uint_as_float(o8.x << 16) * rstd * g0[0] * (z0[0] * sigmoidf_(z0[0])), __uint_as_float(o8.x & 0xffff0000u) * rstd * g0[1] * (z0[1] * sigmoidf_(z0[1])));
                        w.y = cvt_pk_bf16(__uint_as_float(o8.y << 16) * rstd * g0[2] * (z0[2] * sigmoidf_(z0[2])), __uint_as_float(o8.y & 0xffff0000u) * rstd * g0[3] * (z0[3] * sigmoidf_(z0[3])));
                        w.z = cvt_pk_bf16(__uint_as_float(o8.z << 16) * rstd * g1[0] * (z1[0] * sigmoidf_(z1[0])), __uint_as_float(o8.z & 0xffff0000u) * rstd * g1[1] * (z1[1] * sigmoidf_(z1[1])));
                        w.w = cvt_pk_bf16(__uint_as_float(o8.w << 16) * rstd * g1[2] * (z1[2] * sigmoidf_(z1[2])), __uint_as_float(o8.w & 0xffff0000u) * rstd * g1[3] * (z1[3] * sigmoidf_(z1[3])));
                        *(u32x4*)(AB + off) = w; } }
            return;
        }
        if (cl >= 4608) {
#pragma unroll
            for (int ai = 0; ai < 2; ++ai)
#pragma unroll
                for (int m = 0; m < 4; ++m) { const int row = row0 + ai * HALF + m * 16;
#pragma unroll
                    for (int bj = 0; bj < 2; ++bj) { const f32x4 v0 = acc[ai][bj][m][0], v1 = acc[ai][bj][m][1];
                        u32x4 w; w.x = cvt_pk_bf16(v0[0], v0[1]); w.y = cvt_pk_bf16(v0[2], v0[3]); w.z = cvt_pk_bf16(v1[0], v1[1]); w.w = cvt_pk_bf16(v1[2], v1[3]);
                        *(u32x4*)(ZA + (size_t)row * 512 + (cl - 4608) + 32 * bj + 8 * fq) = w; } }
            return;
        }
        const int which = cl / 1536, hc = cl - which * 1536, h = hc >> 6, dsh = 2 * (h >> 3);
        bf16_t* base = QKV + (size_t)which * ((size_t)16384 * 1536) + 8 * fq;
        const bool qk = which < 2;
        const float* gp = which == 0 ? gq : gk; const float sc = which == 0 ? 0.125f * 1.4426950408889634f : 1.0f;
        f32x4 g00 = {1.f, 1.f, 1.f, 1.f}, g01 = g00, g10 = g00, g11 = g00;
        if (qk) { g00 = *(const f32x4*)(gp + 8 * fq); g01 = *(const f32x4*)(gp + 8 * fq + 4); g10 = *(const f32x4*)(gp + 32 + 8 * fq); g11 = *(const f32x4*)(gp + 32 + 8 * fq + 4); }
#pragma unroll
        for (int ai = 0; ai < 2; ++ai)
#pragma unroll
            for (int m = 0; m < 4; ++m) { const int row = row0 + ai * HALF + m * 16; const int b = row >> 12, t = row & 4095;
                const int idx = ((t & ((1 << dsh) - 1)) << (12 - dsh)) + (t >> dsh);
                bf16_t* dst = base + ((size_t)(b * 24 + h) * 4096 + idx) * 64;
                f32x4 a0 = acc[ai][0][m][0], a1 = acc[ai][0][m][1], c0 = acc[ai][1][m][0], c1 = acc[ai][1][m][1];
                if (qk) {
                    float ss = ((a0[0] * a0[0] + a0[1] * a0[1]) + (a0[2] * a0[2] + a0[3] * a0[3])) + ((a1[0] * a1[0] + a1[1] * a1[1]) + (a1[2] * a1[2] + a1[3] * a1[3]))
                             + ((c0[0] * c0[0] + c0[1] * c0[1]) + (c0[2] * c0[2] + c0[3] * c0[3])) + ((c1[0] * c1[0] + c1[1] * c1[1]) + (c1[2] * c1[2] + c1[3] * c1[3]));
                    ss += __shfl_xor(ss, 16); ss += __shfl_xor(ss, 32);
                    const float rstd = rsqrtf(ss * (1.0f / 64.0f) + eps);
                    a0 = a0 * rstd * g00; a1 = a1 * rstd * g01; c0 = c0 * rstd * g10; c1 = c1 * rstd * g11;
                    f32x4 p0, p1;
                    p0[0] = __shfl_xor(a0[0], 16); p0[1] = __shfl_xor(a0[1], 16); p0[2] = __shfl_xor(a0[2], 16); p0[3] = __shfl_xor(a0[3], 16);
                    p1[0] = __shfl_xor(a1[0], 16); p1[1] = __shfl_xor(a1[1], 16); p1[2] = __shfl_xor(a1[2], 16); p1[3] = __shfl_xor(a1[3], 16);
                    if (fq < 2) { const float* rp = rot + (size_t)row * 16; const f32x4 cs0 = *(const f32x4*)(rp), cs1 = *(const f32x4*)(rp + 4), sn0 = *(const f32x4*)(rp + 8), sn1 = *(const f32x4*)(rp + 12);
                        const float sg = fq == 0 ? -1.f : 1.f; a0 = a0 * cs0 + (p0 * sn0) * sg; a1 = a1 * cs1 + (p1 * sn1) * sg; }
                    a0 = a0 * sc; a1 = a1 * sc; c0 = c0 * sc; c1 = c1 * sc;
                }
                u32x4 w0, w1; w0.x = cvt_pk_bf16(a0[0], a0[1]); w0.y = cvt_pk_bf16(a0[2], a0[3]); w0.z = cvt_pk_bf16(a1[0], a1[1]); w0.w = cvt_pk_bf16(a1[2], a1[3]);
                w1.x = cvt_pk_bf16(c0[0], c0[1]); w1.y = cvt_pk_bf16(c0[2], c0[3]); w1.z = cvt_pk_bf16(c1[0], c1[1]); w1.w = cvt_pk_bf16(c1[2], c1[3]);
                *(u32x4*)dst = w0; *(u32x4*)(dst + 32) = w1; }
    }
};

template <class Epi, class Sched, bool ALIGN_EPI = false, bool SP2 = false>
__device__ __forceinline__ void gemm_phase(PG8_LAS unsigned char* lds, const Gemm g, const Sched& S, const Epi& E) {
    int tid_ = threadIdx.x; asm volatile("" : "+v"(tid_));
    const int tid = tid_, wid = __builtin_amdgcn_readfirstlane(tid >> 6), lane = tid & 63, wr = wid >> 2, wc = wid & 3, fr = lane & 15, fq = lane >> 4;
    const int lda = g.lda, ldb = g.ldb;
    unsigned voffA[2], voffB[2];
#pragma unroll
    for (int i = 0; i < 2; ++i) { int R, C; stage_rc(tid * 16 + i * 8192, R, C); const int Rb = Epi::PERM ? ((R & ~31) + perm32(R & 31)) : R;
        voffA[i] = (unsigned)(R * lda + C) * 2u; voffB[i] = (unsigned)(Rb * ldb + C) * 2u; }
    const size_t kstep = (size_t)(BK * 2);
    const size_t hstepA = (size_t)HALF * lda * 2, hstepB = (size_t)HALF * ldb * 2;
    const size_t tstepA = 2 * hstepA, tstepB = 2 * hstepB;
    const unsigned ldsw = (unsigned)wid * 1024u;
    const int aoff = lds_byte(wr * 64 + fr, fq * 8), boff = lds_byte(wc * 32 + fr, fq * 8);
#define PG8_SA(b, h) (((b) * 2 + (h)) * HTB)
#define PG8_SB(b, h) ((4 + (b) * 2 + (h)) * HTB)
#define PG8_STAGE(bufoff, gbase, voff) do { _Pragma("unroll") for (int _i = 0; _i < 2; ++_i) \
        __builtin_amdgcn_global_load_lds((const unsigned*)((const char*)(gbase) + (voff)[_i]), (PG8_LAS unsigned*)(lds + (bufoff) + ldsw + _i * 8192), 16, 0, 0); } while (0)
#define PG8_LDA(dst, b, h) do { _Pragma("unroll") for (int m = 0; m < 4; ++m) _Pragma("unroll") for (int k = 0; k < 2; ++k) dst[m][k] = *(const PG8_LAS bf16x8*)(lds + PG8_SA(b, h) + aoff + m * 2048 + k * 1024); } while (0)
#define PG8_LDB(dst, b, h) do { _Pragma("unroll") for (int n = 0; n < 2; ++n) _Pragma("unroll") for (int k = 0; k < 2; ++k) dst[n][k] = *(const PG8_LAS bf16x8*)(lds + PG8_SB(b, h) + boff + n * 2048 + k * 1024); } while (0)
#define PG8_MMA(ai, bj, At, Bt) do { __builtin_amdgcn_s_setprio(1); _Pragma("unroll") for (int m = 0; m < 4; ++m) _Pragma("unroll") for (int n = 0; n < 2; ++n) _Pragma("unroll") for (int k = 0; k < 2; ++k) \
        acc[ai][bj][m][n] = __builtin_amdgcn_mfma_f32_16x16x32_bf16(Bt[n][k], At[m][k], acc[ai][bj][m][n], 0, 0, 0); __builtin_amdgcn_s_setprio(0); } while (0)
#define PG8_WAIT_V(n) asm volatile("s_waitcnt vmcnt(" #n ")" ::: "memory")
#define PG8_WAIT_L(n) asm volatile("s_waitcnt lgkmcnt(" #n ")" ::: "memory")
#define PG8_BAR __builtin_amdgcn_s_barrier()
#define PG8_SCHED __builtin_amdgcn_sched_barrier(0)
    Unit cur, nxt; int ui = 0;
    if (!S.next(0, cur)) return;
    f32x4 acc[2][2][4][2];
#pragma unroll
    for (int a = 0; a < 2; ++a)
#pragma unroll
        for (int b = 0; b < 2; ++b)
#pragma unroll
            for (int m = 0; m < 4; ++m)
#pragma unroll
                for (int n = 0; n < 2; ++n) acc[a][b][m][n] = (f32x4){0.f, 0.f, 0.f, 0.f};
    bf16x8 At[4][2], B0[2][2], B1[2][2];
    const char* cA = (const char*)g.selA(cur.seg) + (size_t)cur.pm * tstepA; const char* cB = (const char*)g.selB(cur.seg) + (size_t)cur.pn * tstepB;
    S.a_ready(cur);
    if constexpr (SP2) {
        PG8_STAGE(PG8_SB(0, 0), cB, voffB); PG8_STAGE(PG8_SB(0, 1), cB + hstepB, voffB); PG8_STAGE(PG8_SA(0, 0), cA, voffA); PG8_STAGE(PG8_SA(0, 1), cA + hstepA, voffA);
        if (wr == 1) PG8_BAR;
        PG8_WAIT_V(2); PG8_BAR;
        PG8_STAGE(PG8_SB(1, 0), cB + kstep, voffB); PG8_STAGE(PG8_SA(1, 0), cA + kstep, voffA); PG8_STAGE(PG8_SB(1, 1), cB + hstepB + kstep, voffB);
        PG8_WAIT_V(6); PG8_BAR;
    } else {
        PG8_STAGE(PG8_SB(0, 0), cB, voffB); PG8_STAGE(PG8_SA(0, 0), cA, voffA); PG8_STAGE(PG8_SB(0, 1), cB + hstepB, voffB); PG8_STAGE(PG8_SA(0, 1), cA + hstepA, voffA);
        if (wr == 1) PG8_BAR;
        PG8_WAIT_V(4); PG8_BAR;
        PG8_STAGE(PG8_SB(1, 0), cB + kstep, voffB); PG8_STAGE(PG8_SA(1, 0), cA + kstep, voffA); PG8_STAGE(PG8_SB(1, 1), cB + hstepB + kstep, voffB);
        PG8_WAIT_V(6); PG8_BAR;
    }
    for (;;) {
        const bool has_next = S.next(ui + 1, nxt);
        const char* nA = has_next ? (const char*)g.selA(nxt.seg) + (size_t)nxt.pm * tstepA : cA; const char* nB = has_next ? (const char*)g.selB(nxt.seg) + (size_t)nxt.pn * tstepB : cB;
        const int nt = g.selNt(cur.seg);
        for (int t = 0; t < nt; t += 2) {
            const bool last = (t == nt - 2);
            const char* a1 = cA + (size_t)(t + 1) * kstep;
            const char* a2 = last ? nA : cA + (size_t)(t + 2) * kstep; const char* b2 = last ? nB : cB + (size_t)(t + 2) * kstep;
            const char* a3 = a2 + kstep; const char* b3 = b2 + kstep;
            if (last && has_next) S.a_ready(nxt);
            if constexpr (SP2) {
            PG8_LDB(B0, 0, 0); PG8_LDB(B1, 0, 1); PG8_SCHED; PG8_LDA(At, 0, 0); PG8_STAGE(PG8_SA(1, 1), a1 + hstepA, voffA);
            PG8_WAIT_V(8); PG8_WAIT_L(0); PG8_BAR; PG8_MMA(0, 0, At, B0); PG8_MMA(0, 1, At, B1); PG8_BAR; PG8_SCHED;
            PG8_LDA(At, 0, 1); PG8_STAGE(PG8_SB(0, 0), b2, voffB); PG8_STAGE(PG8_SB(0, 1), b2 + hstepB, voffB); PG8_STAGE(PG8_SA(0, 0), a2, voffA);
            PG8_WAIT_V(8); PG8_WAIT_L(0); PG8_BAR; PG8_MMA(1, 0, At, B0); PG8_MMA(1, 1, At, B1); PG8_BAR; PG8_SCHED;
            PG8_LDB(B0, 1, 0); PG8_LDB(B1, 1, 1); PG8_SCHED; PG8_LDA(At, 1, 0); PG8_STAGE(PG8_SA(0, 1), a2 + hstepA, voffA);
            PG8_WAIT_V(8); PG8_WAIT_L(0); PG8_BAR; PG8_MMA(0, 0, At, B0); PG8_MMA(0, 1, At, B1); PG8_BAR; PG8_SCHED;
            PG8_LDA(At, 1, 1); PG8_STAGE(PG8_SB(1, 0), b3, voffB); PG8_STAGE(PG8_SB(1, 1), b3 + hstepB, voffB); PG8_STAGE(PG8_SA(1, 0), a3, voffA);
            PG8_WAIT_V(8); PG8_WAIT_L(0); PG8_BAR; PG8_MMA(1, 0, At, B0); PG8_MMA(1, 1, At, B1); PG8_BAR; PG8_SCHED;
            } else {
            PG8_LDB(B0, 0, 0); PG8_SCHED; PG8_LDA(At, 0, 0); PG8_STAGE(PG8_SA(1, 1), a1 + hstepA, voffA);
            PG8_WAIT_L(8); PG8_BAR; PG8_WAIT_L(0); PG8_MMA(0, 0, At, B0); PG8_BAR; PG8_SCHED;
            PG8_LDB(B1, 0, 1); PG8_STAGE(PG8_SB(0, 0), b2, voffB);
            PG8_BAR; PG8_WAIT_L(0); PG8_MMA(0, 1, At, B1); PG8_BAR;
            PG8_LDA(At, 0, 1); PG8_STAGE(PG8_SA(0, 0), a2, voffA);
            PG8_BAR; PG8_WAIT_L(0); PG8_MMA(1, 0, At, B0); PG8_BAR; PG8_SCHED;
            PG8_STAGE(PG8_SB(0, 1), b2 + hstepB, voffB);
            PG8_WAIT_V(6); PG8_BAR; PG8_MMA(1, 1, At, B1); PG8_BAR;
            PG8_LDB(B0, 1, 0); PG8_SCHED; PG8_LDA(At, 1, 0); PG8_STAGE(PG8_SA(0, 1), a2 + hstepA, voffA);
            PG8_WAIT_L(8); PG8_BAR; PG8_WAIT_L(0); PG8_MMA(0, 0, At, B0); PG8_BAR; PG8_SCHED;
            PG8_LDB(B1, 1, 1); PG8_STAGE(PG8_SB(1, 0), b3, voffB);
            PG8_BAR; PG8_WAIT_L(0); PG8_MMA(0, 1, At, B1); PG8_BAR;
            PG8_LDA(At, 1, 1); PG8_STAGE(PG8_SA(1, 0), a3, voffA);
            PG8_BAR; PG8_WAIT_L(0); PG8_MMA(1, 0, At, B0); PG8_BAR; PG8_SCHED;
            PG8_STAGE(PG8_SB(1, 1), b3 + hstepB, voffB);
            PG8_WAIT_V(6); PG8_BAR; PG8_MMA(1, 1, At, B1); PG8_BAR;
            }
        }
        if constexpr (ALIGN_EPI) { if (wr == 0) PG8_BAR; }
        if constexpr (!Epi::AFTER_DRAIN) { E(acc, cur, wr, wc, fr, fq); S.done(cur); }
        if (!has_next) break;
#pragma unroll
        for (int a = 0; a < 2; ++a)
#pragma unroll
            for (int b = 0; b < 2; ++b)
#pragma unroll
                for (int m = 0; m < 4; ++m)
#pragma unroll
                    for (int n = 0; n < 2; ++n) acc[a][b][m][n] = (f32x4){0.f, 0.f, 0.f, 0.f};
        cur = nxt; cA = nA; cB = nB; ++ui;
        if constexpr (ALIGN_EPI) { if (wr == 1) PG8_BAR; }
    }
    PG8_WAIT_V(0);
    if constexpr (!ALIGN_EPI) { if (wr == 0) PG8_BAR; }
    PG8_BAR;
    if constexpr (Epi::AFTER_DRAIN) { E.fused(acc, cur, wr, wc, fr, fq, lds, wid, lane); S.done(cur); }
#undef PG8_SA
#undef PG8_SB
#undef PG8_STAGE
#undef PG8_LDA
#undef PG8_LDB
#undef PG8_MMA
#undef PG8_WAIT_V
#undef PG8_WAIT_L
#undef PG8_BAR
#undef PG8_SCHED
}
}

constexpr int NWAVES = 8;
constexpr int T = 16384, D = 1024, SEQ = 4096, INC = 10256;
constexpr int PA = 5120;
constexpr int PG = 2048;
constexpr float EPS = 1e-6f;
constexpr size_t MiB = 1u << 20;
constexpr size_t WS_W1A = 0, WS_W1G = 12 * MiB, WS_WGT = 16 * MiB, WS_WPA = 20 * MiB, WS_WPB = 21 * MiB, WS_WOUT = 23 * MiB, WS_WPG = 25 * MiB, WS_WPLE = 27 * MiB, WS_WGLR = 27 * MiB + 512 * 1024;
constexpr size_t WS_ROT = 28 * MiB, WS_GLR = 29 * MiB, WS_GAMMA = 30 * MiB, WS_ML = 29 * MiB  , WS_PS = 29 * MiB  ;
constexpr size_t WS_PROJG = 32 * MiB, WS_QP = 96 * MiB, WS_L = 112 * MiB, WS_OI = 192 * MiB, WS_SS = 224 * MiB;
constexpr size_t WS_PROJA = 32 * MiB, WS_ZA = 176 * MiB  , WS_OG = 192 * MiB, WS_AA = 240 * MiB;
constexpr size_t WS_TMP1 = 32 * MiB, WS_TMP2 = 96 * MiB, WS_SGA = 32 * MiB, WS_SGB = 64 * MiB, WS_T1 = 96 * MiB, WS_Y = 136 * MiB, WS_PB = 128 * MiB, WS_X1B = 208 * MiB, WS_END = 256 * MiB;
constexpr int LDS_BYTES = 147456, MISC_OFF = 131072 + 320;
constexpr size_t WS_BAR = 27 * MiB + 512 * 1024 + 65536, WS_PCNT = WS_BAR + 16384, BAR_BYTES = 16384 + 2 * 16384;

#define LAS __attribute__((address_space(3)))
typedef unsigned short bf16;
typedef unsigned v4u __attribute__((ext_vector_type(4)));
typedef unsigned v2u __attribute__((ext_vector_type(2)));
typedef float f32x4 __attribute__((ext_vector_type(4)));
typedef short bf16x8 __attribute__((ext_vector_type(8)));
typedef short s16x4 __attribute__((ext_vector_type(4)));
__device__ __forceinline__ float bflo(unsigned w) { return __uint_as_float(w << 16); }
__device__ __forceinline__ float bfhi(unsigned w) { return __uint_as_float(w & 0xffff0000u); }
__device__ __forceinline__ float bf2f(unsigned short b) { return __uint_as_float(((unsigned)b) << 16); }
__device__ __forceinline__ unsigned pk2(float lo, float hi) { return pg8::cvt_pk_bf16(lo, hi); }
__device__ __forceinline__ bf16x8 mk8(v2u lo, v2u hi) { v4u t; t.x = lo.x; t.y = lo.y; t.z = hi.x; t.w = hi.y; return __builtin_bit_cast(bf16x8, t); }
__device__ __forceinline__ f32x4 mfma16(bf16x8 a, bf16x8 b, f32x4 c) { return __builtin_amdgcn_mfma_f32_16x16x32_bf16(a, b, c, 0, 0, 0); }
__device__ __forceinline__ float siluf_(float x) { return x * pg8::sigmoidf_(x); }
#define LDS_WAIT() asm volatile("s_waitcnt lgkmcnt(0)" ::: "memory")

struct Args {
    const float* x; const float* p; const int* pos; const float* norm_g; const float* w_in; const float* gq; const float* gk; const float* gate_w2; const float* gate_b;
    const float* gla_g; const float* w_att; const float* w_gla; const float* w_out; const float* ple_g; const float* w_pg; const float* w_ple; float* out; unsigned char* ws; int one; int zero;
};

__device__ __forceinline__ float wave_sum(float v) {
#pragma unroll
    for (int o = 1; o < 64; o <<= 1) v += __shfl_xor(v, o);
    return v;
}
__device__ __forceinline__ void p0_transpose_item(const float* W, int wpitch, int ncols, const float* kscale, bf16* WT, int tpitch, int row_off, LAS float* scr, int item, int lane, bool headperm = false) {
    const int nblk = ncols / 32, kb = item / nblk, nb = item % nblk, k0 = 64 * kb, n0 = 32 * nb;
    const int d0 = headperm ? ((nb & ~7) + (nb & 1) * 4 + ((nb & 7) >> 1)) * 32 : n0;
#pragma unroll
    for (int i = 0; i < 8; ++i) { const int kk = 8 * i + (lane >> 3), c4 = 4 * (lane & 7);
        f32x4 v = *(const f32x4*)(W + (size_t)(k0 + kk) * wpitch + n0 + c4); if (kscale) v = v * kscale[k0 + kk];
        scr[kk * 33 + c4] = v[0]; scr[kk * 33 + c4 + 1] = v[1]; scr[kk * 33 + c4 + 2] = v[2]; scr[kk * 33 + c4 + 3] = v[3]; }
    LDS_WAIT(); asm volatile("" ::: "memory");
    const int c = lane & 7;
#pragma unroll
    for (int j = 0; j < 4; ++j) { const int n = (lane >> 3) + 8 * j; const LAS float* s = scr + (8 * c) * 33 + n;
        v4u o; o.x = pk2(s[0 * 33], s[1 * 33]); o.y = pk2(s[2 * 33], s[3 * 33]); o.z = pk2(s[4 * 33], s[5 * 33]); o.w = pk2(s[6 * 33], s[7 * 33]);
        *(v4u*)(WT + (size_t)(row_off + d0 + n) * tpitch + k0 + 8 * c) = o; }
    LDS_WAIT(); asm volatile("" ::: "memory");
}

__device__ __forceinline__ void phase0(const Args& a, LAS unsigned char* lds, int tid, int lane, int wave, int G) {
    unsigned char* ws = a.ws;
    LAS float* scr = (LAS float*)(lds + wave * 16384);
    const int gw = blockIdx.x * NWAVES + wave, NGW = G * NWAVES;
    constexpr int I0 = 16 * 160, I1 = 16 * 64, I2 = 16 * 32, I3 = 16 * 64, I4 = 8 * 32, I5 = 16 * 32, I6 = 16 * 32, I7 = 16 * 32, I8 = 4 * 32;
    constexpr int NITEMS = I0 + I1 + I2 + I3 + I4 + I5 + I6 + I7 + I8;
    for (int it = gw; it < NITEMS; it += NGW) {
        int r = it;
        if (r < I0) { p0_transpose_item(a.w_in, INC, 5120, nullptr, (bf16*)(ws + WS_W1A), 1024, 0, scr, r, lane, true); continue; } r -= I0;
        if (r < I1) { p0_transpose_item(a.w_in + 5120, INC, 2048, nullptr, (bf16*)(ws + WS_W1G), 1024, 0, scr, r, lane); continue; } r -= I1;
        if (r < I2) { p0_transpose_item(a.w_in + 7184, INC, 1024, nullptr, (bf16*)(ws + WS_W1A), 1024, 5120, scr, r, lane, true); continue; } r -= I2;
        if (r < I3) { p0_transpose_item(a.w_in + 8208, INC, 2048, nullptr, (bf16*)(ws + WS_WGT), 1024, 0, scr, r, lane); continue; } r -= I3;
        if (r < I4) { p0_transpose_item(a.w_att, 1024, 1024, nullptr, (bf16*)(ws + WS_WPA), 512, 0, scr, r, lane); continue; } r -= I4;
        if (r < I5) { p0_transpose_item(a.w_gla, 1024, 1024, nullptr, (bf16*)(ws + WS_WPB), 1024, 0, scr, r, lane); continue; } r -= I5;
        if (r < I6) { p0_transpose_item(a.w_out, 1024, 1024, nullptr, (bf16*)(ws + WS_WOUT), 1024, 0, scr, r, lane); continue; } r -= I6;
        if (r < I7) { p0_transpose_item(a.w_pg, 1024, 1024, a.ple_g, (bf16*)(ws + WS_WPG), 1024, 0, scr, r, lane); continue; } r -= I7;
        p0_transpose_item(a.w_ple, 1024, 1024, nullptr, (bf16*)(ws + WS_WPLE), 256, 0, scr, r, lane);
    }
    const int gtid = blockIdx.x * 512 + tid, NT = G * 512;
    for (int i = gtid; i < 16 * 1024; i += NT) { const int k = i >> 4, r = i & 15; ((bf16*)(ws + WS_WGLR))[r * 1024 + k] = (bf16)(pk2(a.w_in[(size_t)k * INC + 7168 + r], 0.f) & 0xffffu); }
    for (int i = gtid; i < T * 8; i += NT) { const int t = i >> 3, j = i & 7;
        const float inv = exp2f(-(float)j * 0.125f * 18.931568569324174f);
        const float ang = (float)a.pos[t] * inv;
        const double ad = (double)ang; const double kq = __builtin_rint(ad * 0.15915494309189535); const float rf = (float)(ad - kq * 6.283185307179586);
        float* rt = (float*)(ws + WS_ROT) + (size_t)t * 16; rt[j] = __cosf(rf); rt[8 + j] = __sinf(rf); }
    bf16* hb = (bf16*)a.out;
    for (int m = gw; m < T; m += NGW) {
        const f32x4* xr = (const f32x4*)(a.x + (size_t)m * D) + lane; const f32x4* gr = (const f32x4*)a.norm_g + lane;
        f32x4 v[4]; float s = 0.f;
#pragma unroll
        for (int j = 0; j < 4; ++j) { v[j] = xr[64 * j]; s += (v[j][0] * v[j][0] + v[j][1] * v[j][1]) + (v[j][2] * v[j][2] + v[j][3] * v[j][3]); }
        const float rstd = rsqrtf(wave_sum(s) * (1.f / D) + EPS);
        v2u* o8 = (v2u*)(hb + (size_t)m * D) + lane;
#pragma unroll
        for (int j = 0; j < 4; ++j) { const f32x4 g = gr[64 * j]; v2u w; w.x = pk2(v[j][0] * rstd * g[0], v[j][1] * rstd * g[1]); w.y = pk2(v[j][2] * rstd * g[2], v[j][3] * rstd * g[3]); o8[64 * j] = w; }
    }
}

__device__ __forceinline__ void glr_step(const Args& a, int lane, int wave, int G) {
    const bf16* hb = (const bf16*)a.out; const bf16* wg = (const bf16*)(a.ws + WS_WGLR); float* glr = (float*)(a.ws + WS_GLR);
    const int l15 = lane & 15, quad = lane >> 4;
    for (int rt = blockIdx.x * NWAVES + wave; rt < T / 16; rt += G * NWAVES) {
        f32x4 acc = {0.f, 0.f, 0.f, 0.f};
        const bf16* ap = hb + (size_t)(rt * 16 + l15) * 1024 + 8 * quad; const bf16* bp = wg + (size_t)l15 * 1024 + 8 * quad;
#pragma unroll 8
        for (int i = 0; i < 32; ++i) acc = mfma16(*(const bf16x8*)(ap + 32 * i), *(const bf16x8*)(bp + 32 * i), acc);
#pragma unroll
        for (int j = 0; j < 4; ++j) glr[(size_t)(rt * 16 + 4 * quad + j) * 16 + l15] = acc[j];
    }
}

constexpr int GL_GLR = 0, GL_CUMX = 4096, GL_QS = 6144, GL_KS = GL_QS + 64 * 272, GL_KT = GL_KS + 64 * 272, GL_VS = GL_KT + 128 * 144, GL_AT = GL_VS + 64 * 528, GL_END = GL_AT + 64 * 144;
static_assert(GL_END <= 131072, "gla lds");
__device__ __forceinline__ void gla_local_phase(const Args& a, LAS unsigned char* lds, int tid, int lane, int wave, int G) {
    asm volatile("" : "+v"(tid), "+v"(lane));
    unsigned char* ws = a.ws;
    const bf16* PROJ = (const bf16*)(ws + WS_PROJG); const float* glr = (const float*)(ws + WS_GLR);
    bf16* Qp = (bf16*)(ws + WS_QP); bf16* OI = (bf16*)(ws + WS_OI); bf16* Lg = (bf16*)(ws + WS_L); float* gamma = (float*)(ws + WS_GAMMA);
    const int d = tid & 127, tg = tid >> 7, l15 = lane & 15, quad = lane >> 4;
    for (int unit = blockIdx.x; unit < 1024; unit += G) {
        const int b = unit >> 8, h = (unit >> 6) & 3, c = unit & 63; const int row0 = b * SEQ + c * 64;
        const bf16* P = PROJ + (size_t)row0 * PG;
#pragma unroll
        for (int i = 0; i < 2; ++i) { const int p = tid + 512 * i, tok = p >> 4, part = p & 15;
            *(LAS v4u*)(lds + GL_QS + tok * 272 + part * 16) = *(const v4u*)(P + (size_t)tok * PG + h * 128 + part * 8);
            *(LAS v4u*)(lds + GL_KS + tok * 272 + part * 16) = *(const v4u*)(P + (size_t)tok * PG + 512 + h * 128 + part * 8); }
        if (tid < 256) ((LAS f32x4*)(lds + GL_GLR))[tid] = ((const f32x4*)(glr + (size_t)row0 * 16))[tid];
#pragma unroll
        for (int i = 0; i < 4; ++i) { const int p = tid + 512 * i, tok = p >> 5, part = p & 31;
            *(LAS v4u*)(lds + GL_VS + tok * 528 + part * 16) = *(const v4u*)(P + (size_t)tok * PG + 1024 + h * 256 + part * 8); }
        float w2r[16];
#pragma unroll
        for (int r = 0; r < 16; ++r) w2r[r] = a.gate_w2[r * 512 + h * 128 + d];
        const float bias = a.gate_b[h * 128 + d];
        __syncthreads();
        float cum[16]; float run = 0.f;
#pragma unroll
        for (int i = 0; i < 16; ++i) { const int t = tg * 16 + i; const LAS f32x4* gp = (const LAS f32x4*)(lds + GL_GLR + t * 64);
            const f32x4 g0 = gp[0], g1 = gp[1], g2 = gp[2], g3 = gp[3];
            float lo = bias;
            lo += g0[0] * w2r[0] + g0[1] * w2r[1] + g0[2] * w2r[2] + g0[3] * w2r[3];
            lo += g1[0] * w2r[4] + g1[1] * w2r[5] + g1[2] * w2r[6] + g1[3] * w2r[7];
            lo += g2[0] * w2r[8] + g2[1] * w2r[9] + g2[2] * w2r[10] + g2[3] * w2r[11];
            lo += g3[0] * w2r[12] + g3[1] * w2r[13] + g3[2] * w2r[14] + g3[3] * w2r[15];
            const float ls = fminf(lo, 0.f) - __logf(1.0f + __expf(-fabsf(lo)));
            run += ls * (1.0f / 16.0f); cum[i] = run; }
        ((LAS float*)(lds + GL_CUMX))[tg * 128 + d] = run;
        __syncthreads();
        float prefix = 0.f, last = 0.f;
#pragma unroll
        for (int g = 0; g < 4; ++g) { const float v = ((LAS float*)(lds + GL_CUMX))[g * 128 + d]; last += v; if (g < tg) prefix += v; }
        unsigned ktp[8];
#pragma unroll
        for (int i = 0; i < 16; ++i) { const int t = tg * 16 + i; const float cm = cum[i] + prefix; const float q = bf2f(*(const LAS unsigned short*)(lds + GL_QS + t * 272 + d * 2)), k = bf2f(*(const LAS unsigned short*)(lds + GL_KS + t * 272 + d * 2));
            const float qp = q * __expf(cm) * 0.08838834764831845f, kp = k * __expf(-cm), kpp = k * __expf(last - cm);
            const unsigned qb = pk2(qp, 0.f) & 0xffffu;
            *(LAS unsigned short*)(lds + GL_QS + t * 272 + d * 2) = (unsigned short)qb;
            *(LAS unsigned short*)(lds + GL_KS + t * 272 + d * 2) = (unsigned short)(pk2(kp, 0.f) & 0xffffu);
            const unsigned kb = pk2(kpp, 0.f) & 0xffffu;
            if (i & 1) ktp[i >> 1] |= kb << 16; else ktp[i >> 1] = kb; }
        { v4u w0, w1; w0.x = ktp[0]; w0.y = ktp[1]; w0.z = ktp[2]; w0.w = ktp[3]; w1.x = ktp[4]; w1.y = ktp[5]; w1.z = ktp[6]; w1.w = ktp[7];
          *(LAS v4u*)(lds + GL_KT + d * 144 + tg * 32) = w0; *(LAS v4u*)(lds + GL_KT + d * 144 + tg * 32 + 16) = w1; }
        if (tg == 0) gamma[(size_t)unit * 128 + d] = __expf(last);
        __syncthreads();
#pragma unroll
        for (int i = 0; i < 2; ++i) { const int p = tid + 512 * i, tok = p >> 4, part = p & 15;
            *(v4u*)(Qp + (size_t)(row0 + tok) * 512 + h * 128 + part * 8) = *(const LAS v4u*)(lds + GL_QS + tok * 272 + part * 16); }
        { const int it = wave >> 1;
#pragma unroll
          for (int jj = 0; jj < 2; ++jj) { const int jt = (wave & 1) * 2 + jj; f32x4 acc = {0.f, 0.f, 0.f, 0.f};
#pragma unroll
            for (int ks = 0; ks < 4; ++ks) { const bf16x8 ka = *(const LAS bf16x8*)(lds + GL_KS + (16 * jt + l15) * 272 + (32 * ks + 8 * quad) * 2);
                const bf16x8 qb = *(const LAS bf16x8*)(lds + GL_QS + (16 * it + l15) * 272 + (32 * ks + 8 * quad) * 2); acc = mfma16(ka, qb, acc); }
            const int i = 16 * it + l15, j0 = 16 * jt + 4 * quad;
            v2u w; w.x = pk2(j0 + 0 <= i ? acc[0] : 0.f, j0 + 1 <= i ? acc[1] : 0.f); w.y = pk2(j0 + 2 <= i ? acc[2] : 0.f, j0 + 3 <= i ? acc[3] : 0.f);
            *(LAS v2u*)(lds + GL_AT + i * 144 + j0 * 2) = w; } }
        __syncthreads();
#pragma unroll 1
        for (int dd = 0; dd < 2; ++dd) { const int dvt = 2 * wave + dd;
            bf16x8 VF[2];
#pragma unroll
            for (int ks = 0; ks < 2; ++ks) { unsigned short e[8];
#pragma unroll
                for (int q = 0; q < 8; ++q) e[q] = *(const LAS unsigned short*)(lds + GL_VS + (32 * ks + 8 * quad + q) * 528 + (16 * dvt + l15) * 2);
                v4u t; t.x = e[0] | ((unsigned)e[1] << 16); t.y = e[2] | ((unsigned)e[3] << 16); t.z = e[4] | ((unsigned)e[5] << 16); t.w = e[6] | ((unsigned)e[7] << 16);
                VF[ks] = __builtin_bit_cast(bf16x8, t); }
#pragma unroll
            for (int it = 0; it < 4; ++it) { f32x4 acc = {0.f, 0.f, 0.f, 0.f};
#pragma unroll
                for (int ks = 0; ks < 2; ++ks) acc = mfma16(VF[ks], *(const LAS bf16x8*)(lds + GL_AT + (16 * it + l15) * 144 + (32 * ks + 8 * quad) * 2), acc);
                v2u w; w.x = pk2(acc[0], acc[1]); w.y = pk2(acc[2], acc[3]);
                *(v2u*)(OI + (size_t)(row0 + 16 * it + l15) * 1024 + h * 256 + 16 * dvt + 4 * quad) = w; }
#pragma unroll
            for (int R = 0; R < 8; ++R) { f32x4 acc = {0.f, 0.f, 0.f, 0.f};
#pragma unroll
                for (int ks = 0; ks < 2; ++ks) acc = mfma16(*(const LAS bf16x8*)(lds + GL_KT + (16 * R + l15) * 144 + (32 * ks + 8 * quad) * 2), VF[ks], acc);
                v2u w; w.x = pk2(acc[0], acc[1]); w.y = pk2(acc[2], acc[3]);
                *(v2u*)(Lg + ((size_t)(unit * 16 + dvt) * 8 + R) * 256 + lane * 4) = w; }
        }
        __syncthreads();
    }
}

constexpr int CH_L = 0, CH_Q = 4096, CH_G = 20480, CH_O = 20992, CH_STAGE = 23040;
struct ChReg { v4u l, q0, q1, q2, q3, x; };
__device__ __forceinline__ void ch_load(ChReg& r, const bf16* Lg, const float* gamma, const bf16* Qp, const bf16* OI, int unit, int dvt, int row0, int h, int lt) {
    r.l = *(const v4u*)(Lg + ((size_t)(unit * 16 + dvt) * 8) * 256 + lt * 8);
    const int rr = lt >> 4, j = (lt & 15) ^ rr;
    const bf16* qb = Qp + (size_t)(row0 + rr) * 512 + h * 128 + j * 8;
    r.q0 = *(const v4u*)(qb); r.q1 = *(const v4u*)(qb + 16 * 512); r.q2 = *(const v4u*)(qb + 32 * 512); r.q3 = *(const v4u*)(qb + 48 * 512);
    if (lt < 32) r.x = *(const v4u*)(gamma + (size_t)unit * 128 + lt * 4);
    else if (lt >= 128) { const int go = lt - 128; r.x = *(const v4u*)(OI + (size_t)(row0 + (go >> 1)) * 1024 + h * 256 + 16 * dvt + (go & 1) * 8); }
}
__device__ __forceinline__ void ch_store(const ChReg& r, LAS unsigned char* st, int lt) {
    *(LAS v4u*)(st + CH_L + lt * 16) = r.l;
    *(LAS v4u*)(st + CH_Q + lt * 16) = r.q0; *(LAS v4u*)(st + CH_Q + (lt + 256) * 16) = r.q1; *(LAS v4u*)(st + CH_Q + (lt + 512) * 16) = r.q2; *(LAS v4u*)(st + CH_Q + (lt + 768) * 16) = r.q3;
    if (lt < 32) *(LAS v4u*)(st + CH_G + lt * 16) = r.x; else if (lt >= 128) *(LAS v4u*)(st + CH_O + (lt - 128) * 16) = r.x;
}
__device__ __forceinline__ void gla_chain_phase(const Args& a, LAS unsigned char* lds, int tid, int lane, int wave, int G, int st_en) {
    asm volatile("" : "+v"(tid), "+v"(lane));
    unsigned char* ws = a.ws;
    const bf16* Qp = (const bf16*)(ws + WS_QP); bf16* OI = (bf16*)(ws + WS_OI); const bf16* Lg = (const bf16*)(ws + WS_L); const float* gamma = (const float*)(ws + WS_GAMMA); float* SS = (float*)(ws + WS_SS);
    const int l15 = lane & 15, quad = lane >> 4, lt = tid - 256, it = wave;
    const int vcu = (G % 8 == 0) ? ((int)blockIdx.x % 8) * (G / 8) + (int)blockIdx.x / 8 : (int)blockIdx.x;
    for (int item = vcu; item < 256; item += G) {
        const int bh = item >> 4, dvt = item & 15, b = bh >> 2, h = bh & 3, unit0 = bh * 64, rowb = b * SEQ;
        if (wave >= 4) {
            ChReg r0, r1, r2, r3, r4, r5, r6, r7;
#define CH_LD(rr, st) ch_load(rr, Lg, gamma, Qp, OI, unit0 + (st), dvt, rowb + (st) * 64, h, lt)
            CH_LD(r0, 0); CH_LD(r1, 1); ch_store(r0, lds, lt); ch_store(r1, lds + CH_STAGE, lt);
            CH_LD(r0, 2); CH_LD(r1, 3); CH_LD(r2, 4); CH_LD(r3, 5); CH_LD(r4, 6); CH_LD(r5, 7); CH_LD(r6, 8); CH_LD(r7, 9);
            __syncthreads();
#pragma unroll 1
            for (int q = 0; q < 8; ++q) {
#pragma unroll
                for (int j = 0; j < 4; ++j) {
                    const int sI = 4 * q + j, c0 = 2 * sI + 2, c1 = 2 * sI + 3;
                    const int n0 = (c0 + 8 < 64) ? c0 + 8 : 63, n1 = (c1 + 8 < 64) ? c1 + 8 : 63;
                    LAS unsigned char* s0 = lds + (c0 & 3) * CH_STAGE; LAS unsigned char* s1 = lds + (c1 & 3) * CH_STAGE;
#define CH_ROT2(ra, rb) do { ch_store(ra, s0, lt); ch_store(rb, s1, lt); CH_LD(ra, n0); CH_LD(rb, n1); } while (0)
                    if (j == 0) CH_ROT2(r0, r1); else if (j == 1) CH_ROT2(r2, r3); else if (j == 2) CH_ROT2(r4, r5); else CH_ROT2(r6, r7);
#undef CH_ROT2
                    __syncthreads();
                }
            }
#undef CH_LD
        } else {
            f32x4 S[8];
#pragma unroll
            for (int R = 0; R < 8; ++R) S[R] = (f32x4){0.f, 0.f, 0.f, 0.f};
            __syncthreads();
#pragma unroll 1
            for (int c2 = 0; c2 < 32; ++c2) {
#pragma unroll
              for (int u2 = 0; u2 < 2; ++u2) { const int c = 2 * c2 + u2;
                const LAS unsigned char* st = lds + (c & 3) * CH_STAGE;
                const int r = 16 * it + l15; const int row = rowb + c * 64 + r;
                f32x4 acc = {0.f, 0.f, 0.f, 0.f};
#pragma unroll
                for (int ks = 0; ks < 4; ++ks) { const int jq = 4 * ks + (quad >> 1), sub = (quad & 1) * 8;
                    const v2u qlo = *(const LAS v2u*)(st + CH_Q + r * 256 + ((jq ^ l15) << 4) + sub), qhi = *(const LAS v2u*)(st + CH_Q + r * 256 + (((jq + 2) ^ l15) << 4) + sub);
                    v4u sa; sa.x = pk2(S[2 * ks][0], S[2 * ks][1]); sa.y = pk2(S[2 * ks][2], S[2 * ks][3]); sa.z = pk2(S[2 * ks + 1][0], S[2 * ks + 1][1]); sa.w = pk2(S[2 * ks + 1][2], S[2 * ks + 1][3]);
                    acc = mfma16(__builtin_bit_cast(bf16x8, sa), mk8(qlo, qhi), acc); }
                const v2u oi = *(const LAS v2u*)(st + CH_O + r * 32 + quad * 8);
                const float o0 = acc[0] + bflo(oi.x), o1 = acc[1] + bfhi(oi.x), o2 = acc[2] + bflo(oi.y), o3 = acc[3] + bfhi(oi.y);
                v2u w; w.x = pk2(o0, o1); w.y = pk2(o2, o3);
                if (st_en) *(v2u*)(OI + (size_t)row * 1024 + h * 256 + 16 * dvt + 4 * quad) = w;
                float s = (o0 * o0 + o1 * o1) + (o2 * o2 + o3 * o3); s += __shfl_xor(s, 16); s += __shfl_xor(s, 32);
                if (quad == 0 && st_en) SS[(size_t)row * 64 + h * 16 + dvt] = s;
#pragma unroll
                for (int R = 0; R < 8; ++R) { const v2u Lr = *(const LAS v2u*)(st + CH_L + R * 512 + lane * 8); const f32x4 gm = *(const LAS f32x4*)(st + CH_G + (16 * R + 4 * quad) * 4);
                    S[R][0] = gm[0] * S[R][0] + bflo(Lr.x); S[R][1] = gm[1] * S[R][1] + bfhi(Lr.x); S[R][2] = gm[2] * S[R][2] + bflo(Lr.y); S[R][3] = gm[3] * S[R][3] + bfhi(Lr.y); }
              }
                __syncthreads();
            }
        }
    }
}

constexpr int ATS_V = 16384, ATS_SLOT = 32768;
struct AtUnit { int b, h, dsh, r, qt; };
__device__ __forceinline__ AtUnit at_decode(int unit) { AtUnit U; const int u = unit & 31, hb = unit >> 5; U.h = hb % 24; U.b = hb / 24; U.dsh = 2 * (U.h >> 3); const int ntc = 32 >> U.dsh; U.r = u / ntc; U.qt = u - U.r * ntc; return U; }
__device__ __forceinline__ const bf16* at_qbase(const bf16* PROJ, const AtUnit& U) { return PROJ + ((size_t)(U.b * 24 + U.h) * 4096 + ((size_t)U.r << (12 - U.dsh))) * 64; }
__device__ __forceinline__ void at_dma_chunk(const bf16* PROJ, const AtUnit& U, int c, LAS unsigned char* slot, int wave, int lane) {
    constexpr size_t WHICH = (size_t)T * 1536;
    const bf16* Pb = at_qbase(PROJ, U) + (size_t)c * 128 * 64;
    const int rl = lane >> 3, j = (lane & 7) ^ rl;
#pragma unroll
    for (int i = 0; i < 2; ++i) { const int rb = wave + 8 * i; const bf16* src = Pb + (size_t)(rb * 8 + rl) * 64 + j * 8;
        __builtin_amdgcn_global_load_lds((const unsigned*)(src + WHICH), (LAS unsigned*)(slot + rb * 1024), 16, 0, 0);
        __builtin_amdgcn_global_load_lds((const unsigned*)(src + 2 * WHICH), (LAS unsigned*)(slot + ATS_V + rb * 1024), 16, 0, 0); }
}
__device__ __forceinline__ void attn_phase(const Args& a, LAS unsigned char* lds, int tid, int lane, int wave, int G) {
    asm volatile("" : "+v"(tid), "+v"(lane));
    unsigned char* ws = a.ws; const bf16* PROJ = (const bf16*)(ws + WS_PROJA);
    bf16* OG = (bf16*)(ws + WS_OG); float* ML = (float*)(ws + WS_ML);
    const int l15 = lane & 15, quad = lane >> 4, w = wave;
    const int vcu = (G % 8 == 0) ? ((int)blockIdx.x % 8) * (G / 8) + (int)blockIdx.x / 8 : (int)blockIdx.x;
    const int tpb = (3072 + G - 1) / G, t0 = vcu * tpb, t1 = (t0 + tpb < 3072) ? t0 + tpb : 3072;
    bf16x8 QB[2];
    if (t0 < t1) { const AtUnit U = at_decode(t0);
        if (U.qt > 0) at_dma_chunk(PROJ, U, U.qt - 1, lds + ((t0 + 2) % 3) * ATS_SLOT, wave, lane);
        at_dma_chunk(PROJ, U, U.qt, lds + (t0 % 3) * ATS_SLOT, wave, lane);
        const bf16* qp = at_qbase(PROJ, U) + (size_t)(128 * U.qt + 16 * w + l15) * 64 + 8 * quad; QB[0] = *(const bf16x8*)qp; QB[1] = *(const bf16x8*)(qp + 32); }
    v2u pend[4]; float pmx = 0.f, pl = 0.f; size_t prow = 0; int ph = 0; bool have = false;
    for (int unit = t0; unit < t1; ++unit) {
        const AtUnit U = at_decode(unit);
        const int sc = unit % 3, sp = (U.qt > 0) ? (unit + 2) % 3 : sc;
        asm volatile("s_waitcnt vmcnt(0)" ::: "memory");
        __syncthreads();
        if (have) {
#pragma unroll
            for (int dt = 0; dt < 4; ++dt) *(v2u*)(OG + prow * 1536 + ph * 64 + 16 * dt + 4 * quad) = pend[dt];
            if (quad == 0) { v2u mlv; mlv.x = __float_as_uint(pmx); mlv.y = __float_as_uint(pl); *(v2u*)(ML + prow * 48 + ph * 2) = mlv; } }
        const bf16x8 q0 = QB[0], q1 = QB[1];
        if (unit + 1 < t1) { const AtUnit Un = at_decode(unit + 1); at_dma_chunk(PROJ, Un, Un.qt, lds + ((unit + 1) % 3) * ATS_SLOT, wave, lane);
            const bf16* qp = at_qbase(PROJ, Un) + (size_t)(128 * Un.qt + 16 * w + l15) * 64 + 8 * quad; QB[0] = *(const bf16x8*)qp; QB[1] = *(const bf16x8*)(qp + 32); }
        {
            const int qt = U.qt;
            const LAS unsigned char* bp = lds + sp * ATS_SLOT; const LAS unsigned char* bc = lds + sc * ATS_SLOT;
            f32x4 ST[9]; float mx = -INFINITY;
#pragma unroll
            for (int Tt = 0; Tt < 9; ++Tt) { f32x4 acc = {0.f, 0.f, 0.f, 0.f}; const int kr = ((16 * (w + Tt)) & 127) + l15; const LAS unsigned char* kb = (w + Tt >= 8) ? bc : bp;
                acc = mfma16(*(const LAS bf16x8*)(kb + kr * 128 + (((0 + quad) ^ (kr & 7)) << 4)), q0, acc);
                acc = mfma16(*(const LAS bf16x8*)(kb + kr * 128 + (((4 + quad) ^ (kr & 7)) << 4)), q1, acc);
#pragma unroll
                for (int e = 0; e < 4; ++e) { const int kk = 4 * quad + e; bool valid = true; if (Tt == 0) valid = kk >= l15; if (Tt == 8) valid = kk <= l15;
                    if (qt == 0) valid = valid && (w + Tt >= 8);
                    acc[e] = valid ? acc[e] : -INFINITY; mx = fmaxf(mx, acc[e]); }
                ST[Tt] = acc; }
            mx = fmaxf(mx, __shfl_xor(mx, 16)); mx = fmaxf(mx, __shfl_xor(mx, 32));
            float l = 0.f;
#pragma unroll
            for (int Tt = 0; Tt < 9; ++Tt)
#pragma unroll
                for (int e = 0; e < 4; ++e) { const float pv = __builtin_amdgcn_exp2f(ST[Tt][e] - mx); ST[Tt][e] = pv; l += pv; }
            l += __shfl_xor(l, 16); l += __shfl_xor(l, 32);
            f32x4 O[4];
#pragma unroll
            for (int dt = 0; dt < 4; ++dt) O[dt] = (f32x4){0.f, 0.f, 0.f, 0.f};
#pragma unroll
            for (int pr = 0; pr < 5; ++pr) { const int T1 = 2 * pr, T2 = (2 * pr + 1 < 9) ? 2 * pr + 1 : 8;
                v4u pf; pf.x = pk2(ST[T1][0], ST[T1][1]); pf.y = pk2(ST[T1][2], ST[T1][3]);
                if (pr < 4) { pf.z = pk2(ST[T2][0], ST[T2][1]); pf.w = pk2(ST[T2][2], ST[T2][3]); } else { pf.z = 0u; pf.w = 0u; }
                const int k1 = ((16 * (w + T1)) & 127) + 4 * quad + (l15 >> 2), k2 = ((16 * (w + T2)) & 127) + 4 * quad + (l15 >> 2);
                const LAS unsigned char* v1 = ((w + T1 >= 8) ? bc : bp) + ATS_V; const LAS unsigned char* v2 = ((w + T2 >= 8) ? bc : bp) + ATS_V;
#pragma unroll
                for (int dt = 0; dt < 4; ++dt) {
                    const int jv = 2 * dt + ((l15 & 3) >> 1), sub = (l15 & 1) * 8;
                    const s16x4 lo = __builtin_amdgcn_ds_read_tr16_b64_v4i16((LAS s16x4*)(v1 + k1 * 128 + ((jv ^ (k1 & 7)) << 4) + sub));
                    const s16x4 hi = (pr < 4) ? __builtin_amdgcn_ds_read_tr16_b64_v4i16((LAS s16x4*)(v2 + k2 * 128 + ((jv ^ (k2 & 7)) << 4) + sub)) : lo;
                    bf16x8 av; av[0] = lo[0]; av[1] = lo[1]; av[2] = lo[2]; av[3] = lo[3]; av[4] = hi[0]; av[5] = hi[1]; av[6] = hi[2]; av[7] = hi[3];
                    O[dt] = mfma16(av, __builtin_bit_cast(bf16x8, pf), O[dt]); } }
            const float inv = 1.0f / l;
            const int tokq = ((128 * qt + 16 * w + l15) << U.dsh) + U.r; const size_t trow = (size_t)U.b * SEQ + tokq;
#pragma unroll
            for (int dt = 0; dt < 4; ++dt) { pend[dt].x = pk2(O[dt][0] * inv, O[dt][1] * inv); pend[dt].y = pk2(O[dt][2] * inv, O[dt][3] * inv); }
            pmx = mx; pl = l; prow = trow; ph = U.h; have = true;
        }
    }
    if (have) {
#pragma unroll
        for (int dt = 0; dt < 4; ++dt) *(v2u*)(OG + prow * 1536 + ph * 64 + 16 * dt + 4 * quad) = pend[dt];
        if (quad == 0) { v2u mlv; mlv.x = __float_as_uint(pmx); mlv.y = __float_as_uint(pl); *(v2u*)(ML + prow * 48 + ph * 2) = mlv; } }
    asm volatile("s_waitcnt vmcnt(0)" ::: "memory"); __syncthreads();
}
__device__ __forceinline__ void prep_a_phase(const Args& a, int tid, int G, int row_base, int nrows, int row_stride) {
    asm volatile("" : "+v"(tid));
    unsigned char* ws = a.ws; const bf16* OG = (const bf16*)(ws + WS_OG); const float* ML = (const float*)(ws + WS_ML); const bf16* ZA = (const bf16*)(ws + WS_ZA);
    bf16* AA = (bf16*)(ws + WS_AA);
    for (int rb = row_base; rb < T; rb += row_stride)
    for (int p = tid; p < nrows * 64; p += 512) { const int t = rb + (p >> 6), col = (p & 63) * 8, s = col >> 6, dc = col & 63;
        v4u o[3]; float m[3], l[3];
#pragma unroll
        for (int g = 0; g < 3; ++g) { const int hh = 8 * g + s; o[g] = *(const v4u*)(OG + (size_t)t * 1536 + hh * 64 + dc); m[g] = ML[(size_t)t * 48 + hh * 2]; l[g] = ML[(size_t)t * 48 + hh * 2 + 1]; }
        const float M = fmaxf(m[0], fmaxf(m[1], m[2]));
        float w0 = l[0] * __builtin_amdgcn_exp2f(m[0] - M), w1 = l[1] * __builtin_amdgcn_exp2f(m[1] - M), w2 = l[2] * __builtin_amdgcn_exp2f(m[2] - M);
        const float iw = 1.0f / (w0 + w1 + w2); w0 *= iw; w1 *= iw; w2 *= iw;
        const v4u z8 = *(const v4u*)(ZA + (size_t)t * 512 + col);
        v4u w;
        w.x = pk2((w0 * bflo(o[0].x) + w1 * bflo(o[1].x) + w2 * bflo(o[2].x)) * siluf_(bflo(z8.x)), (w0 * bfhi(o[0].x) + w1 * bfhi(o[1].x) + w2 * bfhi(o[2].x)) * siluf_(bfhi(z8.x)));
        w.y = pk2((w0 * bflo(o[0].y) + w1 * bflo(o[1].y) + w2 * bflo(o[2].y)) * siluf_(bflo(z8.y)), (w0 * bfhi(o[0].y) + w1 * bfhi(o[1].y) + w2 * bfhi(o[2].y)) * siluf_(bfhi(z8.y)));
        w.z = pk2((w0 * bflo(o[0].z) + w1 * bflo(o[1].z) + w2 * bflo(o[2].z)) * siluf_(bflo(z8.z)), (w0 * bfhi(o[0].z) + w1 * bfhi(o[1].z) + w2 * bfhi(o[2].z)) * siluf_(bfhi(z8.z)));
        w.w = pk2((w0 * bflo(o[0].w) + w1 * bflo(o[1].w) + w2 * bflo(o[2].w)) * siluf_(bflo(z8.w)), (w0 * bfhi(o[0].w) + w1 * bfhi(o[1].w) + w2 * bfhi(o[2].w)) * siluf_(bfhi(z8.w)));
        pg8::st_sc1_16(AA + (size_t)t * 512 + col, w); }
}

#ifndef REP_MASK
#define REP_MASK 0
#endif
#ifndef DBG_STOP
#define DBG_STOP 0
#endif
#if DBG_STOP
__device__ __forceinline__ float dbg_san(float v) { return (fabsf(v) < 1e30f) ? v : 777.0f; }
__device__ __forceinline__ float dbg_sum_bf16(const void* p, size_t bytes, int gtid, int NT) { const unsigned* q = (const unsigned*)p; float s = 0.f; for (size_t i = gtid; i < bytes / 4; i += NT) { const unsigned w = q[i]; s += dbg_san(bflo(w)) + dbg_san(bfhi(w)); } return s; }
__device__ __forceinline__ float dbg_sum_f32(const void* p, size_t bytes, int gtid, int NT) { const float* q = (const float*)p; float s = 0.f; for (size_t i = gtid; i < bytes / 4; i += NT) s += dbg_san(q[i]); return s; }
#define DBG_DUMP(k, NS, ...) if (DBG_STOP == (k)) { const int gtid_ = blockIdx.x * 512 + tid, NT_ = G * 512; float sv_[NS] = { __VA_ARGS__ }; GRID_SYNC(); \
    for (size_t i = gtid_; i < (size_t)T * D; i += NT_) args.out[i] = 0.f; _Pragma("unroll") for (int q_ = 0; q_ < NS; ++q_) args.out[(size_t)q_ * NT_ + gtid_] = sv_[q_]; return; }
#define SB(off, mib) dbg_sum_bf16(ws + (off), (size_t)(mib) * MiB, gtid_, NT_)
#define SF(off, mib) dbg_sum_f32(ws + (off), (size_t)(mib) * MiB, gtid_, NT_)
#else
#define DBG_DUMP(k, NS, ...)
#endif
typedef __attribute__((address_space(1))) unsigned gu32;
#define XB_TMO      128
#define XB_XCNT(j)  (256  + 64 * (j))
#define XB_XSUB(j)  (1280 + 64 * (j))
#define XB_XGEN(j)  (2304 + 64 * (j))
#define XB_TOP      3328
#define XB_TOPGEN   3392
#define XCD_BAR_WORDS 3456
#define XB_SPIN_CAP (1u << 18)

__device__ __forceinline__ unsigned xb_ld(unsigned* p)              { return __hip_atomic_load(p, __ATOMIC_RELAXED, __HIP_MEMORY_SCOPE_AGENT); }
__device__ __forceinline__ unsigned xb_add(unsigned* p, unsigned v) { return __hip_atomic_fetch_add(p, v, __ATOMIC_RELAXED, __HIP_MEMORY_SCOPE_AGENT); }
__device__ __forceinline__ unsigned xb_xcc_id() { return (unsigned)__builtin_amdgcn_s_getreg((3 << 11) | 20) & 0xFu; }
#define XB_SPIN(cond, bar) do { unsigned _sp = 0; while (cond) { __builtin_amdgcn_s_sleep(1); \
    if ((++_sp & 255u) == 0u) { if (xb_ld(&(bar)[XB_TMO])) break; if (_sp > XB_SPIN_CAP) { atomicAdd(&(bar)[XB_TMO], 1u); break; } } } } while (0)

struct XcdBarrier {
    unsigned* bar; unsigned x;
    volatile LAS unsigned* st;
};

__device__ __forceinline__ XcdBarrier xcd_barrier_post(unsigned* bar, volatile LAS unsigned* st) {
    XcdBarrier b; b.bar = bar; b.x = xb_xcc_id(); b.st = st;
    if (threadIdx.x == 0) (void)xb_add(&bar[XB_XCNT(b.x)], 1u);
    return b;
}
__device__ __forceinline__ void xcd_barrier_complete(unsigned* bar, unsigned x, unsigned& nloc, unsigned& nx) {
    const unsigned G = gridDim.x * gridDim.y * gridDim.z;
    unsigned sum, cnt, mine, sp = 0u;
    for (;;) {
        sum = 0u; cnt = 0u; mine = 0u;
#pragma unroll
        for (unsigned j = 0; j < 16; ++j) { const unsigned c = xb_ld(&bar[XB_XCNT(j)]); sum += c; cnt += (c > 0u) ? 1u : 0u; mine = (j == x) ? c : mine; }
        if (sum == G) break;
        __builtin_amdgcn_s_sleep(1);
        if ((++sp & 255u) == 0u) { if (xb_ld(&bar[XB_TMO])) break; if (sp > XB_SPIN_CAP) { atomicAdd(&bar[XB_TMO], 1u); break; } }
    }
    nloc = mine > 0u ? mine : 1u; nx = cnt > 0u ? cnt : 1u;
}

__device__ __forceinline__ void xcd_barrier(const XcdBarrier& b) {
    asm volatile("s_waitcnt vmcnt(0)" ::: "memory");
    __syncthreads();
    if (threadIdx.x == 0) {
        unsigned* bar = b.bar;
        __builtin_amdgcn_s_waitcnt(0);
        unsigned nloc = b.st[0], nx = b.st[1];
        if (nloc == 0u) { xcd_barrier_complete(bar, b.x, nloc, nx); b.st[0] = nloc; b.st[1] = nx; }
        const unsigned old = xb_add(&bar[XB_XSUB(b.x)], 1u);
        const unsigned gen = old / nloc;
        if (old + 1u == (gen + 1u) * nloc) {
            __builtin_amdgcn_fence(__ATOMIC_RELEASE, "agent");
            asm volatile("s_waitcnt vmcnt(0)" ::: "memory");
            const unsigned og = xb_add(&bar[XB_TOP], 1u);
            const unsigned tg = og / nx;
            if (og + 1u == (tg + 1u) * nx) xb_add(&bar[XB_TOPGEN], 1u);
            else XB_SPIN(xb_ld(&bar[XB_TOPGEN]) == tg, bar);
            __builtin_amdgcn_fence(__ATOMIC_ACQUIRE, "agent");
            xb_add(&bar[XB_XGEN(b.x)], 1u);
            asm volatile("s_waitcnt vmcnt(0)" ::: "memory");
        } else {
            XB_SPIN(xb_ld(&bar[XB_XGEN(b.x)]) == gen, bar);
            __builtin_amdgcn_fence(__ATOMIC_ACQUIRE, "agent");
            asm volatile("s_waitcnt vmcnt(0)" ::: "memory");
        }
    }
    __syncthreads();
}


__device__ __forceinline__ void panel_handoff(unsigned* cnt, int pm, unsigned want) {
    asm volatile("s_waitcnt vmcnt(0)" ::: "memory");
    __syncthreads();
    if (threadIdx.x == 0) {
        unsigned* c = cnt + 64 * pm;
        __hip_atomic_fetch_add(c, 1u, __ATOMIC_RELAXED, __HIP_MEMORY_SCOPE_AGENT);
        unsigned sp = 0;
        while (__hip_atomic_load(c, __ATOMIC_RELAXED, __HIP_MEMORY_SCOPE_AGENT) < want) { __builtin_amdgcn_s_sleep(1); if (++sp > (1u << 22)) break; }
        __builtin_amdgcn_fence(__ATOMIC_ACQUIRE, "agent");
        asm volatile("s_waitcnt vmcnt(0)" ::: "memory");
    }
    __syncthreads();
}
#define GRID_SYNC_CG() do { asm volatile("s_waitcnt vmcnt(0) lgkmcnt(0)" ::: "memory"); grid.sync(); __builtin_amdgcn_fence(__ATOMIC_ACQUIRE, "agent"); asm volatile("s_waitcnt vmcnt(0)" ::: "memory"); } while (0)
#define GRID_SYNC() xcd_barrier(xbar)
__global__ void __launch_bounds__(NWAVES * 64, 2) mega_fwd(Args args) {
    extern __shared__ __attribute__((aligned(16))) unsigned char lds_raw[];
    LAS unsigned char* lds = (LAS unsigned char*)lds_raw;
    cg::grid_group grid = cg::this_grid();
    const int tid = threadIdx.x, lane = tid & 63, wave = __builtin_amdgcn_readfirstlane(tid >> 6), G = gridDim.x;
    unsigned char* ws = args.ws;
    if (tid < 32) ((LAS unsigned*)(lds + MISC_OFF))[tid] = 0u;
    __syncthreads();
    const XcdBarrier xbar = xcd_barrier_post((unsigned*)(ws + WS_BAR), (volatile LAS unsigned*)(lds + MISC_OFF) + 8);
    const pg8::bf16_t* hb = (const pg8::bf16_t*)args.out;
    const pg8::bf16_t* AB = (const pg8::bf16_t*)args.out + (size_t)T * 1024;

#if REP_MASK & 32
    for (int q_ = 0; q_ < 10; ++q_) { GRID_SYNC(); }
#endif
    phase0(args, lds, tid, lane, wave, G);
#if REP_MASK & 1
    phase0(args, lds, tid, lane, wave, G);
#endif
    if (args.zero) { GRID_SYNC_CG(); }
    GRID_SYNC();
    glr_step(args, lane, wave, G);
    { pg8::Gemm g{hb, hb, hb, (const pg8::bf16_t*)(ws + WS_W1G), (const pg8::bf16_t*)(ws + WS_W1G), (const pg8::bf16_t*)(ws + WS_W1G), 16, 16, 16, 1024, 1024};
      pg8::SegOrder S; S.init(T, PG, G, (int)blockIdx.x, 1); pg8::EpiBf16 E{(pg8::bf16_t*)(ws + WS_PROJG), PG};
      pg8::gemm_phase<pg8::EpiBf16, pg8::SegOrder, true, true>(lds, g, S, E); }
#if REP_MASK & 128
    { pg8::Gemm g{hb, hb, hb, (const pg8::bf16_t*)(ws + WS_W1G), (const pg8::bf16_t*)(ws + WS_W1G), (const pg8::bf16_t*)(ws + WS_W1G), 16, 16, 16, 1024, 1024};
      pg8::SegOrder S; S.init(T, PG, G, (int)blockIdx.x, 1); pg8::EpiBf16 E{(pg8::bf16_t*)(ws + WS_PROJG), PG};
      pg8::gemm_phase<pg8::EpiBf16, pg8::SegOrder, true, true>(lds, g, S, E); }
#endif
    GRID_SYNC();
    DBG_DUMP(2, 7, SB(WS_W1A, 10), SB(WS_W1G, 6), SB(WS_WGT, 4), SF(WS_ROT, 1), dbg_sum_bf16(args.out, 32 * MiB, gtid_, NT_), SF(WS_GLR, 1), SB(WS_PROJG, 96))
    gla_local_phase(args, lds, tid, lane, wave, G);
#if REP_MASK & 2
    gla_local_phase(args, lds, tid, lane, wave, G);
#endif
    GRID_SYNC();
    DBG_DUMP(3, 4, SB(WS_QP, 16), SB(WS_OI, 32), SB(WS_L, 64), SF(WS_GAMMA, 0.5))
    DBG_DUMP(31, 1, SB(WS_QP, 16))
    DBG_DUMP(32, 1, SB(WS_OI, 32))
    DBG_DUMP(33, 1, SB(WS_L, 64))
    gla_chain_phase(args, lds, tid, lane, wave, G, args.one);
#if REP_MASK & 64
    gla_chain_phase(args, lds, tid, lane, wave, G, args.zero);
#endif
    GRID_SYNC();
    DBG_DUMP(4, 2, SB(WS_OI, 32), SF(WS_SS, 4))
    { pg8::Gemm g{hb, hb, hb, (const pg8::bf16_t*)(ws + WS_W1A), (const pg8::bf16_t*)(ws + WS_W1A), (const pg8::bf16_t*)(ws + WS_W1A), 16, 16, 16, 1024, 1024};
      pg8::SegOrder S; S.init(T, 6144, G, (int)blockIdx.x, 1);
      pg8::EpiQKV E{(pg8::bf16_t*)(ws + WS_PROJA), (pg8::bf16_t*)(ws + WS_ZA), args.gq, args.gk, (const float*)(ws + WS_ROT), EPS, (const pg8::bf16_t*)(ws + WS_OI), (const float*)(ws + WS_SS), args.gla_g, (pg8::bf16_t*)args.out + (size_t)T * 1024};
      pg8::gemm_phase<pg8::EpiQKV, pg8::SegOrder, true, true>(lds, g, S, E); }
#if REP_MASK & 256
    { pg8::Gemm g{hb, hb, hb, (const pg8::bf16_t*)(ws + WS_W1A), (const pg8::bf16_t*)(ws + WS_W1A), (const pg8::bf16_t*)(ws + WS_W1A), 16, 16, 16, 1024, 1024};
      pg8::SegOrder S; S.init(T, 6144, G, (int)blockIdx.x, 1);
      pg8::EpiQKV E{(pg8::bf16_t*)(ws + WS_PROJA), (pg8::bf16_t*)(ws + WS_ZA), args.gq, args.gk, (const float*)(ws + WS_ROT), EPS, (const pg8::bf16_t*)(ws + WS_OI), (const float*)(ws + WS_SS), args.gla_g, (pg8::bf16_t*)args.out + (size_t)T * 1024};
      pg8::gemm_phase<pg8::EpiQKV, pg8::SegOrder, true, true>(lds, g, S, E); }
#endif
    GRID_SYNC();
    attn_phase(args, lds, tid, lane, wave, G);
#if REP_MASK & 8
    attn_phase(args, lds, tid, lane, wave, G);
#endif
    GRID_SYNC();
    pg8::SegOrder SP; SP.init(T, 1024, G, (int)blockIdx.x, 1); pg8::Unit up; const bool panel_mode = (SP.nwg == G) && SP.next(0, up);
    if (panel_mode) prep_a_phase(args, tid, G, up.pm * 256 + up.pn * 64, 64, T);
    else { prep_a_phase(args, tid, G, (int)blockIdx.x * 64, 64, G * 64); GRID_SYNC(); }
    { bf16* pb = (bf16*)(ws + WS_PB);
      for (int i = blockIdx.x * 512 + tid; i < T * 256 / 8; i += G * 512) { const f32x4 v0 = ((const f32x4*)args.p)[2 * i], v1 = ((const f32x4*)args.p)[2 * i + 1];
          v4u w; w.x = pk2(v0[0], v0[1]); w.y = pk2(v0[2], v0[3]); w.z = pk2(v1[0], v1[1]); w.w = pk2(v1[2], v1[3]); ((v4u*)pb)[i] = w; } }
    { const pg8::bf16_t* WGT = (const pg8::bf16_t*)(ws + WS_WGT);
      pg8::Gemm g{hb, hb, hb, WGT, WGT + (size_t)1024 * 1024, WGT, 16, 16, 16, 1024, 1024};
      pg8::SegOrder S; S.init(T, 1024, G, (int)blockIdx.x, 2); pg8::EpiSig2 E{(pg8::bf16_t*)(ws + WS_SGA), (pg8::bf16_t*)(ws + WS_SGB), 1024};
      pg8::gemm_phase<pg8::EpiSig2, pg8::SegOrder, true, true>(lds, g, S, E); }
    if (panel_mode) panel_handoff((unsigned*)(ws + WS_PCNT) + 4096, up.pm, 4u);
    { const pg8::bf16_t* AA = (const pg8::bf16_t*)(ws + WS_AA); const pg8::bf16_t* WPA = (const pg8::bf16_t*)(ws + WS_WPA);
      pg8::Gemm g{AA, AA, AA, WPA, WPA, WPA, 8, 8, 8, 512, 512};
      pg8::SegOrder S; S.init(T, 1024, G, (int)blockIdx.x, 1); pg8::EpiGateMul E{(const pg8::bf16_t*)(ws + WS_SGA), (pg8::bf16_t*)(ws + WS_T1), 1024};
      pg8::gemm_phase<pg8::EpiGateMul, pg8::SegOrder, true, true>(lds, g, S, E); }
    { const pg8::bf16_t* WPB = (const pg8::bf16_t*)(ws + WS_WPB);
      pg8::Gemm g{AB, AB, AB, WPB, WPB, WPB, 16, 16, 16, 1024, 1024};
      pg8::SegOrder S; S.init(T, 1024, G, (int)blockIdx.x, 1); pg8::EpiMergeY E{(const pg8::bf16_t*)(ws + WS_SGB), (const pg8::bf16_t*)(ws + WS_T1), (pg8::bf16_t*)(ws + WS_Y), 1024};
      pg8::gemm_phase<pg8::EpiMergeY, pg8::SegOrder, true, true>(lds, g, S, E); }
#if REP_MASK & 512
    { const pg8::bf16_t* WGT = (const pg8::bf16_t*)(ws + WS_WGT);
      pg8::Gemm g{hb, hb, hb, WGT, WGT + (size_t)1024 * 1024, WGT, 16, 16, 16, 1024, 1024};
      pg8::SegOrder S; S.init(T, 1024, G, (int)blockIdx.x, 2); pg8::EpiSig2 E{(pg8::bf16_t*)(ws + WS_SGA), (pg8::bf16_t*)(ws + WS_SGB), 1024};
      pg8::gemm_phase<pg8::EpiSig2, pg8::SegOrder, true, true>(lds, g, S, E); }
    { const pg8::bf16_t* AA = (const pg8::bf16_t*)(ws + WS_AA); const pg8::bf16_t* WPA = (const pg8::bf16_t*)(ws + WS_WPA);
      pg8::Gemm g{AA, AA, AA, WPA, WPA, WPA, 8, 8, 8, 512, 512};
      pg8::SegOrder S; S.init(T, 1024, G, (int)blockIdx.x, 1); pg8::EpiGateMul E{(const pg8::bf16_t*)(ws + WS_SGA), (pg8::bf16_t*)(ws + WS_T1), 1024};
      pg8::gemm_phase<pg8::EpiGateMul, pg8::SegOrder, true, true>(lds, g, S, E); }
    { const pg8::bf16_t* WPB = (const pg8::bf16_t*)(ws + WS_WPB);
      pg8::Gemm g{AB, AB, AB, WPB, WPB, WPB, 16, 16, 16, 1024, 1024};
      pg8::SegOrder S; S.init(T, 1024, G, (int)blockIdx.x, 1); pg8::EpiMergeY E{(const pg8::bf16_t*)(ws + WS_SGB), (const pg8::bf16_t*)(ws + WS_T1), (pg8::bf16_t*)(ws + WS_Y), 1024};
      pg8::gemm_phase<pg8::EpiMergeY, pg8::SegOrder, true, true>(lds, g, S, E); }
#endif
    GRID_SYNC();
    DBG_DUMP(9, 5, SF(WS_TMP1, 64), SF(WS_TMP2, 64), SB(WS_Y, 32), SB(WS_PB, 8), SB(WS_WPA, 7))
    { const pg8::bf16_t* Y = (const pg8::bf16_t*)(ws + WS_Y); const pg8::bf16_t* W = (const pg8::bf16_t*)(ws + WS_WOUT);
      pg8::Gemm g{Y, Y, Y, W, W, W, 16, 16, 16, 1024, 1024};
      pg8::SegOrder S; S.init(T, 1024, G, (int)blockIdx.x, 1); pg8::EpiResid E{args.x, args.out, (pg8::bf16_t*)(ws + WS_X1B), (float*)(ws + WS_PS), 1024};
      pg8::gemm_phase<pg8::EpiResid, pg8::SegOrder, true, true>(lds, g, S, E); }
#if REP_MASK & 1024
    { const pg8::bf16_t* Y = (const pg8::bf16_t*)(ws + WS_Y); const pg8::bf16_t* W = (const pg8::bf16_t*)(ws + WS_WOUT);
      pg8::Gemm g{Y, Y, Y, W, W, W, 16, 16, 16, 1024, 1024};
      pg8::SegOrder S; S.init(T, 1024, G, (int)blockIdx.x, 1); pg8::EpiResid E{args.x, args.out, (pg8::bf16_t*)(ws + WS_X1B), (float*)(ws + WS_PS), 1024};
      pg8::gemm_phase<pg8::EpiResid, pg8::SegOrder, true, true>(lds, g, S, E); }
#endif
    { pg8::SegOrder S; S.init(T, 1024, G, (int)blockIdx.x, 1); pg8::Unit u0;
      if (S.nwg == G && S.next(0, u0)) panel_handoff((unsigned*)(ws + WS_PCNT), u0.pm, 4u); else { GRID_SYNC(); } }
    DBG_DUMP(10, 3, SB(WS_X1B, 32), SF(WS_PS, 1), dbg_sum_f32(args.out, 64 * MiB, gtid_, NT_))
    { const pg8::bf16_t* X1 = (const pg8::bf16_t*)(ws + WS_X1B); const pg8::bf16_t* W = (const pg8::bf16_t*)(ws + WS_WPG);
      pg8::Gemm g{X1, X1, X1, W, W, W, 16, 16, 16, 1024, 1024};
      pg8::SegOrder S; S.init(T, 1024, G, (int)blockIdx.x, 1); pg8::EpiSigRow E{(const float*)(ws + WS_PS), (pg8::bf16_t*)(ws + WS_SGA), 1024, EPS};
      pg8::gemm_phase<pg8::EpiSigRow, pg8::SegOrder, true, true>(lds, g, S, E); }
#if REP_MASK & 2048
    { const pg8::bf16_t* X1 = (const pg8::bf16_t*)(ws + WS_X1B); const pg8::bf16_t* W = (const pg8::bf16_t*)(ws + WS_WPG);
      pg8::Gemm g{X1, X1, X1, W, W, W, 16, 16, 16, 1024, 1024};
      pg8::SegOrder S; S.init(T, 1024, G, (int)blockIdx.x, 1); pg8::EpiSigRow E{(const float*)(ws + WS_PS), (pg8::bf16_t*)(ws + WS_SGA), 1024, EPS};
      pg8::gemm_phase<pg8::EpiSigRow, pg8::SegOrder, true, true>(lds, g, S, E); }
#endif
    { const pg8::bf16_t* PBm = (const pg8::bf16_t*)(ws + WS_PB); const pg8::bf16_t* W = (const pg8::bf16_t*)(ws + WS_WPLE);
      pg8::Gemm g{PBm, PBm, PBm, W, W, W, 4, 4, 4, 256, 256};
      pg8::SegOrder S; S.init(T, 1024, G, (int)blockIdx.x, 1); pg8::EpiPle2 E{args.out, (const pg8::bf16_t*)(ws + WS_SGA), 1024};
      pg8::gemm_phase<pg8::EpiPle2, pg8::SegOrder, true, true>(lds, g, S, E); }
}

extern "C" void kernel_launch(void* const* d_in, const int* in_sizes, int n_in, void* d_out, int out_size, void* d_ws, size_t ws_size, hipStream_t stream) {
    static int grid = 0;
    if (grid == 0) {
        if (n_in != 16 || out_size != T * D || ws_size < WS_END) { fprintf(stderr, "kernel_launch: unexpected shapes (n_in %d out %d ws %zu)\n", n_in, out_size, ws_size); grid = -1; return; }
        int dev = 0, cus = 0, per_cu = 0;
        (void)hipGetDevice(&dev); (void)hipDeviceGetAttribute(&cus, hipDeviceAttributeMultiprocessorCount, dev);
        (void)hipFuncSetAttribute((const void*)mega_fwd, hipFuncAttributeMaxDynamicSharedMemorySize, LDS_BYTES);
        (void)hipOccupancyMaxActiveBlocksPerMultiprocessor(&per_cu, (const void*)mega_fwd, NWAVES * 64, LDS_BYTES);
        if (per_cu < 1) { fprintf(stderr, "kernel_launch: occupancy query says %d blocks per CU\n", per_cu); per_cu = 1; }
        (void)hipGetLastError();
        grid = cus;
    }
    if (grid < 0) return;
    Args a{};
    a.x = (const float*)d_in[0]; a.p = (const float*)d_in[1]; a.pos = (const int*)d_in[2]; a.norm_g = (const float*)d_in[3]; a.w_in = (const float*)d_in[4];
    a.gq = (const float*)d_in[5]; a.gk = (const float*)d_in[6]; a.gate_w2 = (const float*)d_in[7]; a.gate_b = (const float*)d_in[8]; a.gla_g = (const float*)d_in[9];
    a.w_att = (const float*)d_in[10]; a.w_gla = (const float*)d_in[11]; a.w_out = (const float*)d_in[12]; a.ple_g = (const float*)d_in[13]; a.w_pg = (const float*)d_in[14]; a.w_ple = (const float*)d_in[15];
    a.out = (float*)d_out; a.ws = (unsigned char*)d_ws; a.one = 1; a.zero = 0;
    if (hipMemsetAsync((char*)d_ws + WS_BAR, 0, BAR_BYTES, stream) != hipSuccess) { fprintf(stderr, "kernel_launch: memset of barrier words failed\n"); return; }
    void* kargs[] = {&a};
    hipError_t e = hipLaunchCooperativeKernel((const void*)mega_fwd, dim3(grid), dim3(NWAVES * 64), kargs, LDS_BYTES, stream);
    if (e != hipSuccess) fprintf(stderr, "cooperative launch failed: %s (grid %d)\n", hipGetErrorString(e), grid);
}
```

```cpp
#define REP_MASK 0
#define DBG_STOP 0
#include <hip/hip_runtime.h>
#include <hip/hip_cooperative_groups.h>
#include <cstdio>
#include <cstdint>
namespace cg = cooperative_groups;

namespace pg8 {
#define PG8_LAS __attribute__((address_space(3)))
typedef unsigned short bf16_t;
typedef short bf16x8 __attribute__((ext_vector_type(8)));
typedef float f32x4 __attribute__((ext_vector_type(4)));
typedef unsigned u32x4 __attribute__((ext_vector_type(4)));
typedef unsigned u32x2 __attribute__((ext_vector_type(2)));
constexpr int BM = 256, BK = 64, HALF = 128, HTB = HALF * BK * 2  , STAGE_BYTES = 8 * HTB, NXCD = 8, WGM = 8;

__host__ __device__ __forceinline__ int lds_byte(int r, int c) { const int st = (r >> 4) * 2 + (c >> 5), rr = r & 15, cc = c & 31, ob = rr * 64 + cc * 2; return st * 1024 + (ob ^ (((ob >> 9) & 1) << 5)); }
__host__ __device__ __forceinline__ void stage_rc(int b, int& R, int& C) { const int st = b / 1024, sb = b % 1024, swz = sb ^ (((sb >> 9) & 1) << 5); R = (st >> 1) * 16 + swz / 64; C = (st & 1) * 32 + (swz % 64) / 2; }
__host__ __device__ __forceinline__ int perm32(int rho) { const int n = rho >> 4, i = rho & 15; return 8 * (i >> 2) + 4 * n + (i & 3); }

struct Unit { int pm, pn, seg; };
struct Gemm {
    const bf16_t* A0; const bf16_t* A1; const bf16_t* A2; const bf16_t* B0; const bf16_t* B1; const bf16_t* B2; int nt0, nt1, nt2, lda, ldb;
    __device__ __forceinline__ const bf16_t* selA(int s) const { const bf16_t* a0 = +A0; const bf16_t* a1 = +A1; const bf16_t* a2 = +A2; return s == 0 ? +a0 : (s == 1 ? +a1 : +a2); }
    __device__ __forceinline__ const bf16_t* selB(int s) const { const bf16_t* b0 = +B0; const bf16_t* b1 = +B1; const bf16_t* b2 = +B2; return s == 0 ? +b0 : (s == 1 ? +b1 : +b2); }
    __device__ __forceinline__ int selNt(int s) const { const int n0 = +nt0, n1 = +nt1, n2 = +nt2; return s == 0 ? +n0 : (s == 1 ? +n1 : +n2); }
};
struct SegOrder {
    int nM, nN, nwg, G, c, nseg;
    __device__ void init(int M, int N, int G_, int c_, int nseg_) { nM = M / BM; nN = N / BM; nwg = nM * nN; G = G_; c = c_; nseg = nseg_; }
    __device__ bool next(int i, Unit& u) const {
        const int ti = i / nseg; u.seg = i - ti * nseg;
        const long L = (long)ti * G + c; if (L >= nwg) return false;
        int wgid = (int)L; { const int q = nwg / NXCD, r = nwg % NXCD, xcd = wgid % NXCD, off = wgid / NXCD; wgid = (xcd < r ? xcd * (q + 1) : r * (q + 1) + (xcd - r) * q) + off; }
        const int nig = WGM * nN, gid = wgid / nig, fm = gid * WGM, gsz = (nM - fm) < WGM ? (nM - fm) : WGM;
        u.pm = fm + ((wgid % nig) % gsz); u.pn = (wgid % nig) / gsz; return true;
    }
    __device__ __forceinline__ void a_ready(const Unit&) const {}
    __device__ __forceinline__ void done(const Unit&) const {}
};
typedef __bf16 bf16x2_t __attribute__((ext_vector_type(2)));
typedef float f32x2_t __attribute__((ext_vector_type(2)));
__device__ __forceinline__ unsigned cvt_pk_bf16(float lo, float hi) { f32x2_t f = {lo, hi}; bf16x2_t v = __builtin_convertvector(f, bf16x2_t); return __builtin_bit_cast(unsigned, v); }
__device__ __forceinline__ float sigmoidf_(float x) { return __builtin_amdgcn_rcpf(1.0f + __expf(-x)); }

struct EpiBf16 {
    static constexpr bool PERM = true, AFTER_DRAIN = false;
    bf16_t* O; int ldc;
    __device__ __forceinline__ void operator()(const f32x4 (&acc)[2][2][4][2], const Unit& u, int wr, int wc, int fr, int fq) const {
        const int row0 = u.pm * BM + wr * 64 + fr; const int col0 = u.pn * BM + wc * 32 + 8 * fq;
#pragma unroll
        for (int ai = 0; ai < 2; ++ai)
#pragma unroll
            for (int m = 0; m < 4; ++m) { bf16_t* rowp = O + (size_t)(row0 + ai * HALF + m * 16) * ldc + col0;
#pragma unroll
                for (int bj = 0; bj < 2; ++bj) { const f32x4 v0 = acc[ai][bj][m][0], v1 = acc[ai][bj][m][1];
                    u32x4 w; w.x = cvt_pk_bf16(v0[0], v0[1]); w.y = cvt_pk_bf16(v0[2], v0[3]); w.z = cvt_pk_bf16(v1[0], v1[1]); w.w = cvt_pk_bf16(v1[2], v1[3]);
                    *(u32x4*)(rowp + bj * HALF) = w; } }
    }
};
#define PG8_FOR_ACC(body) \
    _Pragma("unroll") for (int ai = 0; ai < 2; ++ai) _Pragma("unroll") for (int m = 0; m < 4; ++m) { const int row = u.pm * BM + ai * HALF + wr * 64 + m * 16 + fr; \
    _Pragma("unroll") for (int bj = 0; bj < 2; ++bj) _Pragma("unroll") for (int n = 0; n < 2; ++n) { const size_t off = (size_t)row * ldc + (u.pn * BM + bj * HALF + wc * 32 + n * 16 + 4 * fq); const f32x4 a = acc[ai][bj][m][n]; body } }
struct EpiStoreF32 {
    static constexpr bool PERM = false, AFTER_DRAIN = false;
    float* tmp; int ldc;
    __device__ __forceinline__ void operator()(const f32x4 (&acc)[2][2][4][2], const Unit& u, int wr, int wc, int fr, int fq) const {
        PG8_FOR_ACC( *(f32x4*)(tmp + off) = a; )
    }
};
struct EpiMerge {
    static constexpr bool PERM = false, AFTER_DRAIN = false;
    float* tmp1; float* tmp2; bf16_t* y; int ldc;
    __device__ __forceinline__ void operator()(const f32x4 (&acc)[2][2][4][2], const Unit& u, int wr, int wc, int fr, int fq) const {
        if (u.seg == 0) {
            PG8_FOR_ACC( f32x4 t = *(const f32x4*)(tmp1 + off); t[0] *= sigmoidf_(a[0]); t[1] *= sigmoidf_(a[1]); t[2] *= sigmoidf_(a[2]); t[3] *= sigmoidf_(a[3]); *(f32x4*)(tmp1 + off) = t; )
        } else if (u.seg == 1) {
            PG8_FOR_ACC( *(f32x4*)(tmp2 + off) = a; )
        } else {
            PG8_FOR_ACC( const f32x4 t1 = *(const f32x4*)(tmp1 + off); const f32x4 t2 = *(const f32x4*)(tmp2 + off);
                u32x2 w; w.x = cvt_pk_bf16(t1[0] + sigmoidf_(a[0]) * t2[0], t1[1] + sigmoidf_(a[1]) * t2[1]); w.y = cvt_pk_bf16(t1[2] + sigmoidf_(a[2]) * t2[2], t1[3] + sigmoidf_(a[3]) * t2[3]);
                *(u32x2*)(y + off) = w; )
        }
    }
};
__device__ __forceinline__ void unpack_bf16x8(u32x4 w, f32x4& lo, f32x4& hi) { lo[0] = __uint_as_float(w.x << 16); lo[1] = __uint_as_float(w.x & 0xffff0000u); lo[2] = __uint_as_float(w.y << 16); lo[3] = __uint_as_float(w.y & 0xffff0000u);
    hi[0] = __uint_as_float(w.z << 16); hi[1] = __uint_as_float(w.z & 0xffff0000u); hi[2] = __uint_as_float(w.w << 16); hi[3] = __uint_as_float(w.w & 0xffff0000u); }
__device__ __forceinline__ u32x4 pack_bf16x8(f32x4 lo, f32x4 hi) { u32x4 w; w.x = cvt_pk_bf16(lo[0], lo[1]); w.y = cvt_pk_bf16(lo[2], lo[3]); w.z = cvt_pk_bf16(hi[0], hi[1]); w.w = cvt_pk_bf16(hi[2], hi[3]); return w; }
__device__ __forceinline__ void st_sc1_16(void* p, u32x4 w) { asm volatile("global_store_dwordx4 %0, %1, off sc1\n\ts_nop 2" :: "v"(p), "v"(w) : "memory"); }
struct EpiResid {
    static constexpr bool PERM = true, AFTER_DRAIN = false;
    const float* x; bf16_t* xlo; bf16_t* x1b; float* ps; int ldc;
    __device__ __forceinline__ void operator()(const f32x4 (&acc)[2][2][4][2], const Unit& u, int wr, int wc, int fr, int fq) const {
#pragma unroll
        for (int ai = 0; ai < 2; ++ai)
#pragma unroll
            for (int m = 0; m < 4; ++m) { const int row = u.pm * BM + ai * HALF + wr * 64 + m * 16 + fr; float s = 0.f;
#pragma unroll
                for (int bj = 0; bj < 2; ++bj) { const size_t off = (size_t)row * ldc + (u.pn * BM + bj * HALF + wc * 32 + 8 * fq);
                    const f32x4 v0 = *(const f32x4*)(x + off) + acc[ai][bj][m][0], v1 = *(const f32x4*)(x + off + 4) + acc[ai][bj][m][1];
                    u32x4 w; w.x = cvt_pk_bf16(v0[0], v0[1]); w.y = cvt_pk_bf16(v0[2], v0[3]); w.z = cvt_pk_bf16(v1[0], v1[1]); w.w = cvt_pk_bf16(v1[2], v1[3]);
                    st_sc1_16(x1b + off, w);
                    f32x4 h0, h1; unpack_bf16x8(w, h0, h1);
                    *(u32x4*)(xlo + off) = pack_bf16x8(v0 - h0, v1 - h1);
                    s += ((v0[0] * v0[0] + v0[1] * v0[1]) + (v0[2] * v0[2] + v0[3] * v0[3])) + ((v1[0] * v1[0] + v1[1] * v1[1]) + (v1[2] * v1[2] + v1[3] * v1[3])); }
                s += __shfl_xor(s, 16); s += __shfl_xor(s, 32);
                if (fq == 0) __hip_atomic_store(ps + (size_t)row * 16 + u.pn * 4 + wc, s, __ATOMIC_RELAXED, __HIP_MEMORY_SCOPE_AGENT);
                asm volatile("" ::: "memory"); }
    }
};
struct EpiPle {
    static constexpr bool PERM = false, AFTER_DRAIN = false;
    float* out; const float* tmp; const float* ps; int ldc; float eps;
    __device__ __forceinline__ void operator()(const f32x4 (&acc)[2][2][4][2], const Unit& u, int wr, int wc, int fr, int fq) const {
#pragma unroll
        for (int ai = 0; ai < 2; ++ai)
#pragma unroll
            for (int m = 0; m < 4; ++m) { const int row = u.pm * BM + ai * HALF + wr * 64 + m * 16 + fr;
                const f32x4* pp = (const f32x4*)(ps + (size_t)row * 16); const f32x4 p0 = pp[0], p1 = pp[1], p2 = pp[2], p3 = pp[3];
                const float ss = ((p0[0] + p0[1]) + (p0[2] + p0[3])) + ((p1[0] + p1[1]) + (p1[2] + p1[3])) + ((p2[0] + p2[1]) + (p2[2] + p2[3])) + ((p3[0] + p3[1]) + (p3[2] + p3[3]));
                const float rstd = rsqrtf(ss * (1.0f / 1024.0f) + eps);
#pragma unroll
                for (int bj = 0; bj < 2; ++bj)
#pragma unroll
                    for (int n = 0; n < 2; ++n) { const size_t off = (size_t)row * ldc + (u.pn * BM + bj * HALF + wc * 32 + n * 16 + 4 * fq);
                        const f32x4 a = acc[ai][bj][m][n]; const f32x4 t = *(const f32x4*)(tmp + off); f32x4 o = *(const f32x4*)(out + off);
                        o[0] += t[0] * sigmoidf_(rstd * a[0]); o[1] += t[1] * sigmoidf_(rstd * a[1]); o[2] += t[2] * sigmoidf_(rstd * a[2]); o[3] += t[3] * sigmoidf_(rstd * a[3]);
                        *(f32x4*)(out + off) = o; } }
    }
};

__device__ __forceinline__ f32x4 unpack_bf16x4(u32x2 w) { f32x4 r; r[0] = __uint_as_float(w.x << 16); r[1] = __uint_as_float(w.x & 0xffff0000u); r[2] = __uint_as_float(w.y << 16); r[3] = __uint_as_float(w.y & 0xffff0000u); return r; }
#define PG8_FOR_ACC8(...) \
    _Pragma("unroll") for (int ai = 0; ai < 2; ++ai) _Pragma("unroll") for (int m = 0; m < 4; ++m) { const int row = u.pm * BM + ai * HALF + wr * 64 + m * 16 + fr; \
    _Pragma("unroll") for (int bj = 0; bj < 2; ++bj) { const size_t off = (size_t)row * ldc + (u.pn * BM + bj * HALF + wc * 32 + 8 * fq); const f32x4 a0 = acc[ai][bj][m][0], a1 = acc[ai][bj][m][1]; __VA_ARGS__ } }
__device__ __forceinline__ f32x4 sig4(f32x4 a) { f32x4 r; r[0] = sigmoidf_(a[0]); r[1] = sigmoidf_(a[1]); r[2] = sigmoidf_(a[2]); r[3] = sigmoidf_(a[3]); return r; }
struct EpiSig2 {
    static constexpr bool PERM = true, AFTER_DRAIN = false;
    bf16_t* s0; bf16_t* s1; int ldc;
    __device__ __forceinline__ void operator()(const f32x4 (&acc)[2][2][4][2], const Unit& u, int wr, int wc, int fr, int fq) const {
        bf16_t* dst = u.seg == 0 ? s0 : s1;
        PG8_FOR_ACC8( *(u32x4*)(dst + off) = pack_bf16x8(sig4(a0), sig4(a1)); )
    }
};
struct EpiGateMul {
    static constexpr bool PERM = true, AFTER_DRAIN = false;
    const bf16_t* sg; bf16_t* t1; int ldc;
    __device__ __forceinline__ void operator()(const f32x4 (&acc)[2][2][4][2], const Unit& u, int wr, int wc, int fr, int fq) const {
        PG8_FOR_ACC8( f32x4 g0, g1; unpack_bf16x8(*(const u32x4*)(sg + off), g0, g1); *(u32x4*)(t1 + off) = pack_bf16x8(g0 * a0, g1 * a1); )
    }
};
struct EpiMergeY {
    static constexpr bool PERM = true, AFTER_DRAIN = false;
    const bf16_t* sg; const bf16_t* t1; bf16_t* y; int ldc;
    __device__ __forceinline__ void operator()(const f32x4 (&acc)[2][2][4][2], const Unit& u, int wr, int wc, int fr, int fq) const {
        PG8_FOR_ACC8( f32x4 g0, g1, t0, t1v; unpack_bf16x8(*(const u32x4*)(sg + off), g0, g1); unpack_bf16x8(*(const u32x4*)(t1 + off), t0, t1v);
            *(u32x4*)(y + off) = pack_bf16x8(t0 + g0 * a0, t1v + g1 * a1); )
    }
};
struct EpiSigRow {
    static constexpr bool PERM = true, AFTER_DRAIN = false;
    const float* ps; bf16_t* sg; int ldc; float eps;
    __device__ __forceinline__ void operator()(const f32x4 (&acc)[2][2][4][2], const Unit& u, int wr, int wc, int fr, int fq) const {
#pragma unroll
        for (int ai = 0; ai < 2; ++ai)
#pragma unroll
            for (int m = 0; m < 4; ++m) { const int row = u.pm * BM + ai * HALF + wr * 64 + m * 16 + fr;
                const f32x4* pp = (const f32x4*)(ps + (size_t)row * 16); const f32x4 p0 = pp[0], p1 = pp[1], p2 = pp[2], p3 = pp[3];
                const float ss = ((p0[0] + p0[1]) + (p0[2] + p0[3])) + ((p1[0] + p1[1]) + (p1[2] + p1[3])) + ((p2[0] + p2[1]) + (p2[2] + p2[3])) + ((p3[0] + p3[1]) + (p3[2] + p3[3]));
                const float rstd = rsqrtf(ss * (1.0f / 1024.0f) + eps);
#pragma unroll
                for (int bj = 0; bj < 2; ++bj) { const size_t off = (size_t)row * ldc + (u.pn * BM + bj * HALF + wc * 32 + 8 * fq);
                    const f32x4 a0 = acc[ai][bj][m][0], a1 = acc[ai][bj][m][1];
                    u32x4 w; w.x = cvt_pk_bf16(sigmoidf_(rstd * a0[0]), sigmoidf_(rstd * a0[1])); w.y = cvt_pk_bf16(sigmoidf_(rstd * a0[2]), sigmoidf_(rstd * a0[3]));
                    w.z = cvt_pk_bf16(sigmoidf_(rstd * a1[0]), sigmoidf_(rstd * a1[1])); w.w = cvt_pk_bf16(sigmoidf_(rstd * a1[2]), sigmoidf_(rstd * a1[3]));
                    *(u32x4*)(sg + off) = w; } }
    }
};
struct EpiPle2 {
    static constexpr bool PERM = true, AFTER_DRAIN = false;
    float* out; const bf16_t* sg; const bf16_t* x1b; const bf16_t* xlo; int ldc;
    __device__ __forceinline__ void operator()(const f32x4 (&acc)[2][2][4][2], const Unit& u, int wr, int wc, int fr, int fq) const {
#pragma unroll
        for (int ai = 0; ai < 2; ++ai)
#pragma unroll
            for (int m = 0; m < 4; ++m) { const int row = u.pm * BM + ai * HALF + wr * 64 + m * 16 + fr;
#pragma unroll
                for (int bj = 0; bj < 2; ++bj) { const size_t off = (size_t)row * ldc + (u.pn * BM + bj * HALF + wc * 32 + 8 * fq);
                    const u32x4 g8 = *(const u32x4*)(sg + off); const f32x4 a0 = acc[ai][bj][m][0], a1 = acc[ai][bj][m][1];
                    f32x4 o0, o1, l0, l1; unpack_bf16x8(*(const u32x4*)(x1b + off), o0, o1); unpack_bf16x8(*(const u32x4*)(xlo + off), l0, l1); o0 = o0 + l0; o1 = o1 + l1;
                    o0[0] += a0[0] * __uint_as_float(g8.x << 16); o0[1] += a0[1] * __uint_as_float(g8.x & 0xffff0000u); o0[2] += a0[2] * __uint_as_float(g8.y << 16); o0[3] += a0[3] * __uint_as_float(g8.y & 0xffff0000u);
                    o1[0] += a1[0] * __uint_as_float(g8.z << 16); o1[1] += a1[1] * __uint_as_float(g8.z & 0xffff0000u); o1[2] += a1[2] * __uint_as_float(g8.w << 16); o1[3] += a1[3] * __uint_as_float(g8.w & 0xffff0000u);
                    *(f32x4*)(out + off) = o0; *(f32x4*)(out + off + 4) = o1; }
                asm volatile("" ::: "memory"); }
    }
};

struct EpiQKV {
    static constexpr bool PERM = true, AFTER_DRAIN = false;
    bf16_t* QKV; bf16_t* ZA; const float* gq; const float* gk; const float* rot; float eps;
    const bf16_t* OI; const float* SS; const float* gla_g; bf16_t* AB;
    __device__ __forceinline__ void operator()(const f32x4 (&acc)[2][2][4][2], const Unit& u, int wr, int wc, int fr, int fq) const {
        const int row0 = u.pm * BM + wr * 64 + fr; const int cl = u.pn * BM + 64 * wc;
        if (cl >= 5120) {
            const int zc0 = cl - 5120 + 8 * fq, hB = (cl - 5120) >> 8;
            const f32x4 ga0 = *(const f32x4*)(gla_g + (zc0 & 255)), ga1 = *(const f32x4*)(gla_g + (zc0 & 255) + 4), gb0 = *(const f32x4*)(gla_g + ((zc0 + 32) & 255)), gb1 = *(const f32x4*)(gla_g + ((zc0 + 32) & 255) + 4);
#pragma unroll
            for (int ai = 0; ai < 2; ++ai)
#pragma unroll
                for (int m = 0; m < 4; ++m) { const int row = row0 + ai * HALF + m * 16;
                    const f32x4* sp = (const f32x4*)(SS + (size_t)row * 64 + hB * 16); const f32x4 s0 = sp[0], s1 = sp[1], s2 = sp[2], s3 = sp[3];
                    const float ss = ((s0[0] + s0[1]) + (s0[2] + s0[3])) + ((s1[0] + s1[1]) + (s1[2] + s1[3])) + ((s2[0] + s2[1]) + (s2[2] + s2[3])) + ((s3[0] + s3[1]) + (s3[2] + s3[3]));
                    const float rstd = rsqrtf(ss * (1.0f / 256.0f) + eps);
#pragma unroll
                    for (int bj = 0; bj < 2; ++bj) { const size_t off = (size_t)row * 1024 + zc0 + 32 * bj; const u32x4 o8 = *(const u32x4*)(OI + off);
                        const f32x4 z0 = acc[ai][bj][m][0], z1 = acc[ai][bj][m][1]; const f32x4 g0 = bj ? gb0 : ga0, g1 = bj ? gb1 : ga1;
                        u32x4 w;
                        w.x = cvt_pk_bf16(__uint_as_float(o8.x << 16) * rstd * g0[0] * (z0[0] * sigmoidf_(z0[0])), __uint_as_float(o8.x & 0xffff0000u) * rstd * g0[1] * (z0[1] * sigmoidf_(z0[1])));
                        w.y = cvt_pk_bf16(__uint_as_float(o8.y << 16) * rstd * g0[2] * (z0[2] * sigmoidf_(z0[2])), __uint_as_float(o8.y & 0xffff0000u) * rstd * g0[3] * (z0[3] * sigmoidf_(z0[3])));
                        w.z = cvt_pk_bf16(__uint_as_float(o8.z << 16) * rstd * g1[0] * (z1[0] * sigmoidf_(z1[0])), __uint_as_float(o8.z & 0xffff0000u) * rstd * g1[1] * (z1[1] * sigmoidf_(z1[1])));
                        w.w = cvt_pk_bf16(__uint_as_float(o8.w << 16) * rstd * g1[2] * (z1[2] * sigmoidf_(z1[2])), __uint_as_float(o8.w & 0xffff0000u) * rstd * g1[3] * (z1[3] * sigmoidf_(z1[3])));
                        *(u32x4*)(AB + off) = w; } }
            return;
        }
        if (cl >= 4608) {
#pragma unroll
            for (int ai = 0; ai < 2; ++ai)
#pragma unroll
                for (int m = 0; m < 4; ++m) { const int row = row0 + ai * HALF + m * 16;
#pragma unroll
                    for (int bj = 0; bj < 2; ++bj) { const f32x4 v0 = acc[ai][bj][m][0], v1 = acc[ai][bj][m][1];
                        u32x4 w; w.x = cvt_pk_bf16(v0[0], v0[1]); w.y = cvt_pk_bf16(v0[2], v0[3]); w.z = cvt_pk_bf16(v1[0], v1[1]); w.w = cvt_pk_bf16(v1[2], v1[3]);
                        *(u32x4*)(ZA + (size_t)row * 512 + (cl - 4608) + 32 * bj + 8 * fq) = w; } }
            return;
        }
        const int which = cl / 1536, hc = cl - which * 1536, h = hc >> 6, dsh = 2 * (h >> 3);
        bf16_t* base = QKV + (size_t)which * ((size_t)16384 * 1536) + 8 * fq;
        const bool qk = which < 2;
        const float* gp = which == 0 ? gq : gk; const float sc = which == 0 ? 0.125f * 1.4426950408889634f : 1.0f;
        f32x4 g00 = {1.f, 1.f, 1.f, 1.f}, g01 = g00, g10 = g00, g11 = g00;
        if (qk) { g00 = *(const f32x4*)(gp + 8 * fq); g01 = *(const f32x4*)(gp + 8 * fq + 4); g10 = *(const f32x4*)(gp + 32 + 8 * fq); g11 = *(const f32x4*)(gp + 32 + 8 * fq + 4); }
#pragma unroll
        for (int ai = 0; ai < 2; ++ai)
#pragma unroll
            for (int m = 0; m < 4; ++m) { const int row = row0 + ai * HALF + m * 16; const int b = row >> 12, t = row & 4095;
                const int idx = ((t & ((1 << dsh) - 1)) << (12 - dsh)) + (t >> dsh);
                bf16_t* dst = base + ((size_t)(b * 24 + h) * 4096 + idx) * 64;
                f32x4 a0 = acc[ai][0][m][0], a1 = acc[ai][0][m][1], c0 = acc[ai][1][m][0], c1 = acc[ai][1][m][1];
                if (qk) {
                    float ss = ((a0[0] * a0[0] + a0[1] * a0[1]) + (a0[2] * a0[2] + a0[3] * a0[3])) + ((a1[0] * a1[0] + a1[1] * a1[1]) + (a1[2] * a1[2] + a1[3] * a1[3]))
                             + ((c0[0] * c0[0] + c0[1] * c0[1]) + (c0[2] * c0[2] + c0[3] * c0[3])) + ((c1[0] * c1[0] + c1[1] * c1[1]) + (c1[2] * c1[2] + c1[3] * c1[3]));
                    ss += __shfl_xor(ss, 16); ss += __shfl_xor(ss, 32);
                    const float rstd = rsqrtf(ss * (1.0f / 64.0f) + eps);
                    a0 = a0 * rstd * g00; a1 = a1 * rstd * g01; c0 = c0 * rstd * g10; c1 = c1 * rstd * g11;
                    f32x4 p0, p1;
                    p0[0] = __shfl_xor(a0[0], 16); p0[1] = __shfl_xor(a0[1], 16); p0[2] = __shfl_xor(a0[2], 16); p0[3] = __shfl_xor(a0[3], 16);
                    p1[0] = __shfl_xor(a1[0], 16); p1[1] = __shfl_xor(a1[1], 16); p1[2] = __shfl_xor(a1[2], 16); p1[3] = __shfl_xor(a1[3], 16);
                    if (fq < 2) { const float* rp = rot + (size_t)row * 16; const f32x4 cs0 = *(const f32x4*)(rp), cs1 = *(const f32x4*)(rp + 4), sn0 = *(const f32x4*)(rp + 8), sn1 = *(const f32x4*)(rp + 12);
                        const float sg = fq == 0 ? -1.f : 1.f; a0 = a0 * cs0 + (p0 * sn0) * sg; a1 = a1 * cs1 + (p1 * sn1) * sg; }
                    a0 = a0 * sc; a1 = a1 * sc; c0 = c0 * sc; c1 = c1 * sc;
                }
                u32x4 w0, w1; w0.x = cvt_pk_bf16(a0[0], a0[1]); w0.y = cvt_pk_bf16(a0[2], a0[3]); w0.z = cvt_pk_bf16(a1[0], a1[1]); w0.w = cvt_pk_bf16(a1[2], a1[3]);
                w1.x = cvt_pk_bf16(c0[0], c0[1]); w1.y = cvt_pk_bf16(c0[2], c0[3]); w1.z = cvt_pk_bf16(c1[0], c1[1]); w1.w = cvt_pk_bf16(c1[2], c1[3]);
                *(u32x4*)dst = w0; *(u32x4*)(dst + 32) = w1; }
    }
};

template <class Epi, class Sched, bool ALIGN_EPI = false, bool SP2 = false>
__device__ __forceinline__ void gemm_phase(PG8_LAS unsigned char* lds, const Gemm g, const Sched& S, const Epi& E) {
    int tid_ = threadIdx.x; asm volatile("" : "+v"(tid_));
    const int tid = tid_, wid = __builtin_amdgcn_readfirstlane(tid >> 6), lane = tid & 63, wr = wid >> 2, wc = wid & 3, fr = lane & 15, fq = lane >> 4;
    const int lda = g.lda, ldb = g.ldb;
    unsigned voffA[2], voffB[2];
#pragma unroll
    for (int i = 0; i < 2; ++i) { int R, C; stage_rc(tid * 16 + i * 8192, R, C); const int Rb = Epi::PERM ? ((R & ~31) + perm32(R & 31)) : R;
        voffA[i] = (unsigned)(R * lda + C) * 2u; voffB[i] = (unsigned)(Rb * ldb + C) * 2u; }
    const size_t kstep = (size_t)(BK * 2);
    const size_t hstepA = (size_t)HALF * lda * 2, hstepB = (size_t)HALF * ldb * 2;
    const size_t tstepA = 2 * hstepA, tstepB = 2 * hstepB;
    const unsigned ldsw = (unsigned)wid * 1024u;
    const int aoff = lds_byte(wr * 64 + fr, fq * 8), boff = lds_byte(wc * 32 + fr, fq * 8);
#define PG8_SA(b, h) (((b) * 2 + (h)) * HTB)
#define PG8_SB(b, h) ((4 + (b) * 2 + (h)) * HTB)
#define PG8_STAGE(bufoff, gbase, voff) do { _Pragma("unroll") for (int _i = 0; _i < 2; ++_i) \
        __builtin_amdgcn_global_load_lds((const unsigned*)((const char*)(gbase) + (voff)[_i]), (PG8_LAS unsigned*)(lds + (bufoff) + ldsw + _i * 8192), 16, 0, 0); } while (0)
#define PG8_LDA(dst, b, h) do { _Pragma("unroll") for (int m = 0; m < 4; ++m) _Pragma("unroll") for (int k = 0; k < 2; ++k) dst[m][k] = *(const PG8_LAS bf16x8*)(lds + PG8_SA(b, h) + aoff + m * 2048 + k * 1024); } while (0)
#define PG8_LDB(dst, b, h) do { _Pragma("unroll") for (int n = 0; n < 2; ++n) _Pragma("unroll") for (int k = 0; k < 2; ++k) dst[n][k] = *(const PG8_LAS bf16x8*)(lds + PG8_SB(b, h) + boff + n * 2048 + k * 1024); } while (0)
#define PG8_MMA(ai, bj, At, Bt) do { __builtin_amdgcn_s_setprio(1); _Pragma("unroll") for (int m = 0; m < 4; ++m) _Pragma("unroll") for (int n = 0; n < 2; ++n) _Pragma("unroll") for (int k = 0; k < 2; ++k) \
        acc[ai][bj][m][n] = __builtin_amdgcn_mfma_f32_16x16x32_bf16(Bt[n][k], At[m][k], acc[ai][bj][m][n], 0, 0, 0); __builtin_amdgcn_s_setprio(0); } while (0)
#define PG8_WAIT_V(n) asm volatile("s_waitcnt vmcnt(" #n ")" ::: "memory")
#define PG8_WAIT_L(n) asm volatile("s_waitcnt lgkmcnt(" #n ")" ::: "memory")
#define PG8_BAR __builtin_amdgcn_s_barrier()
#define PG8_SCHED __builtin_amdgcn_sched_barrier(0)
    Unit cur, nxt; int ui = 0;
    if (!S.next(0, cur)) return;
    f32x4 acc[2][2][4][2];
#pragma unroll
    for (int a = 0; a < 2; ++a)
#pragma unroll
        for (int b = 0; b < 2; ++b)
#pragma unroll
            for (int m = 0; m < 4; ++m)
#pragma unroll
                for (int n = 0; n < 2; ++n) acc[a][b][m][n] = (f32x4){0.f, 0.f, 0.f, 0.f};
    bf16x8 At[4][2], B0[2][2], B1[2][2];
    const char* cA = (const char*)g.selA(cur.seg) + (size_t)cur.pm * tstepA; const char* cB = (const char*)g.selB(cur.seg) + (size_t)cur.pn * tstepB;
    S.a_ready(cur);
    if constexpr (SP2) {
        PG8_STAGE(PG8_SB(0, 0), cB, voffB); PG8_STAGE(PG8_SB(0, 1), cB + hstepB, voffB); PG8_STAGE(PG8_SA(0, 0), cA, voffA); PG8_STAGE(PG8_SA(0, 1), cA + hstepA, voffA);
        if (wr == 1) PG8_BAR;
        PG8_WAIT_V(2); PG8_BAR;
        PG8_STAGE(PG8_SB(1, 0), cB + kstep, voffB); PG8_STAGE(PG8_SA(1, 0), cA + kstep, voffA); PG8_STAGE(PG8_SB(1, 1), cB + hstepB + kstep, voffB);
        PG8_WAIT_V(6); PG8_BAR;
    } else {
        PG8_STAGE(PG8_SB(0, 0), cB, voffB); PG8_STAGE(PG8_SA(0, 0), cA, voffA); PG8_STAGE(PG8_SB(0, 1), cB + hstepB, voffB); PG8_STAGE(PG8_SA(0, 1), cA + hstepA, voffA);
        if (wr == 1) PG8_BAR;
        PG8_WAIT_V(4); PG8_BAR;
        PG8_STAGE(PG8_SB(1, 0), cB + kstep, voffB); PG8_STAGE(PG8_SA(1, 0), cA + kstep, voffA); PG8_STAGE(PG8_SB(1, 1), cB + hstepB + kstep, voffB);
        PG8_WAIT_V(6); PG8_BAR;
    }
    for (;;) {
        const bool has_next = S.next(ui + 1, nxt);
        const char* nA = has_next ? (const char*)g.selA(nxt.seg) + (size_t)nxt.pm * tstepA : cA; const char* nB = has_next ? (const char*)g.selB(nxt.seg) + (size_t)nxt.pn * tstepB : cB;
        const int nt = g.selNt(cur.seg);
        for (int t = 0; t < nt; t += 2) {
            const bool last = (t == nt - 2);
            const char* a1 = cA + (size_t)(t + 1) * kstep;
            const char* a2 = last ? nA : cA + (size_t)(t + 2) * kstep; const char* b2 = last ? nB : cB + (size_t)(t + 2) * kstep;
            const char* a3 = a2 + kstep; const char* b3 = b2 + kstep;
            if (last && has_next) S.a_ready(nxt);
            if constexpr (SP2) {
            PG8_LDB(B0, 0, 0); PG8_LDB(B1, 0, 1); PG8_SCHED; PG8_LDA(At, 0, 0); PG8_STAGE(PG8_SA(1, 1), a1 + hstepA, voffA);
            PG8_WAIT_V(8); PG8_WAIT_L(0); PG8_BAR; PG8_MMA(0, 0, At, B0); PG8_MMA(0, 1, At, B1); PG8_BAR; PG8_SCHED;
            PG8_LDA(At, 0, 1); PG8_STAGE(PG8_SB(0, 0), b2, voffB); PG8_STAGE(PG8_SB(0, 1), b2 + hstepB, voffB); PG8_STAGE(PG8_SA(0, 0), a2, voffA);
            PG8_WAIT_V(8); PG8_WAIT_L(0); PG8_BAR; PG8_MMA(1, 0, At, B0); PG8_MMA(1, 1, At, B1); PG8_BAR; PG8_SCHED;
            PG8_LDB(B0, 1, 0); PG8_LDB(B1, 1, 1); PG8_SCHED; PG8_LDA(At, 1, 0); PG8_STAGE(PG8_SA(0, 1), a2 + hstepA, voffA);
            PG8_WAIT_V(8); PG8_WAIT_L(0); PG8_BAR; PG8_MMA(0, 0, At, B0); PG8_MMA(0, 1, At, B1); PG8_BAR; PG8_SCHED;
            PG8_LDA(At, 1, 1); PG8_STAGE(PG8_SB(1, 0), b3, voffB); PG8_STAGE(PG8_SB(1, 1), b3 + hstepB, voffB); PG8_STAGE(PG8_SA(1, 0), a3, voffA);
            PG8_WAIT_V(8); PG8_WAIT_L(0); PG8_BAR; PG8_MMA(1, 0, At, B0); PG8_MMA(1, 1, At, B1); PG8_BAR; PG8_SCHED;
            } else {
            PG8_LDB(B0, 0, 0); PG8_SCHED; PG8_LDA(At, 0, 0); PG8_STAGE(PG8_SA(1, 1), a1 + hstepA, voffA);
            PG8_WAIT_L(8); PG8_BAR; PG8_WAIT_L(0); PG8_MMA(0, 0, At, B0); PG8_BAR; PG8_SCHED;
            PG8_LDB(B1, 0, 1); PG8_STAGE(PG8_SB(0, 0), b2, voffB);
            PG8_BAR; PG8_WAIT_L(0); PG8_MMA(0, 1, At, B1); PG8_BAR;
            PG8_LDA(At, 0, 1); PG8_STAGE(PG8_SA(0, 0), a2, voffA);
            PG8_BAR; PG8_WAIT_L(0); PG8_MMA(1, 0, At, B0); PG8_BAR; PG8_SCHED;
            PG8_STAGE(PG8_SB(0, 1), b2 + hstepB, voffB);
            PG8_WAIT_V(6); PG8_BAR; PG8_MMA(1, 1, At, B1); PG8_BAR;
            PG8_LDB(B0, 1, 0); PG8_SCHED; PG8_LDA(At, 1, 0); PG8_STAGE(PG8_SA(0, 1), a2 + hstepA, voffA);
            PG8_WAIT_L(8); PG8_BAR; PG8_WAIT_L(0); PG8_MMA(0, 0, At, B0); PG8_BAR; PG8_SCHED;
            PG8_LDB(B1, 1, 1); PG8_STAGE(PG8_SB(1, 0), b3, voffB);
            PG8_BAR; PG8_WAIT_L(0); PG8_MMA(0, 1, At, B1); PG8_BAR;
            PG8_LDA(At, 1, 1); PG8_STAGE(PG8_SA(1, 0), a3, voffA);
            PG8_BAR; PG8_WAIT_L(0); PG8_MMA(1, 0, At, B0); PG8_BAR; PG8_SCHED;
            PG8_STAGE(PG8_SB(1, 1), b3 + hstepB, voffB);
            PG8_WAIT_V(6); PG8_BAR; PG8_MMA(1, 1, At, B1); PG8_BAR;
            }
        }
        if constexpr (ALIGN_EPI) { if (wr == 0) PG8_BAR; }
        if constexpr (!Epi::AFTER_DRAIN) { E(acc, cur, wr, wc, fr, fq); S.done(cur); }
        if (!has_next) break;
#pragma unroll
        for (int a = 0; a < 2; ++a)
#pragma unroll
            for (int b = 0; b < 2; ++b)
#pragma unroll
                for (int m = 0; m < 4; ++m)
#pragma unroll
                    for (int n = 0; n < 2; ++n) acc[a][b][m][n] = (f32x4){0.f, 0.f, 0.f, 0.f};
        cur = nxt; cA = nA; cB = nB; ++ui;
        if constexpr (ALIGN_EPI) { if (wr == 1) PG8_BAR; }
    }
    PG8_WAIT_V(0);
    if constexpr (!ALIGN_EPI) { if (wr == 0) PG8_BAR; }
    PG8_BAR;
    if constexpr (Epi::AFTER_DRAIN) { E.fused(acc, cur, wr, wc, fr, fq, lds, wid, lane); S.done(cur); }
#undef PG8_SA
#undef PG8_SB
#undef PG8_STAGE
#undef PG8_LDA
#undef PG8_LDB
#undef PG8_MMA
#undef PG8_WAIT_V
#undef PG8_WAIT_L
#undef PG8_BAR
#undef PG8_SCHED
}
}

constexpr int NWAVES = 8;
constexpr int T = 16384, D = 1024, SEQ = 4096, INC = 10256;
constexpr int PA = 5120;
constexpr int PG = 2048;
constexpr float EPS = 1e-6f;
constexpr size_t MiB = 1u << 20;
constexpr size_t WS_W1A = 0, WS_W1G = 12 * MiB, WS_WGT = 16 * MiB, WS_WPA = 20 * MiB, WS_WPB = 21 * MiB, WS_WOUT = 23 * MiB, WS_WPG = 25 * MiB, WS_WPLE = 27 * MiB, WS_WGLR = 27 * MiB + 512 * 1024;
constexpr size_t WS_ROT = 28 * MiB, WS_GLR = 29 * MiB, WS_GAMMA = 30 * MiB, WS_ML = 29 * MiB  , WS_PS = 29 * MiB  ;
constexpr size_t WS_PROJG = 32 * MiB, WS_QP = 96 * MiB, WS_L = 112 * MiB, WS_OI = 192 * MiB, WS_SS = 224 * MiB;
constexpr size_t WS_PROJA = 32 * MiB, WS_ZA = 176 * MiB  , WS_OG = 192 * MiB, WS_AA = 240 * MiB;
constexpr size_t WS_TMP1 = 32 * MiB, WS_TMP2 = 96 * MiB, WS_SGA = 32 * MiB, WS_SGB = 64 * MiB, WS_T1 = 96 * MiB, WS_XLO = 96 * MiB  , WS_Y = 136 * MiB, WS_PB = 128 * MiB, WS_X1B = 208 * MiB, WS_END = 256 * MiB;
constexpr int LDS_BYTES = 147456, MISC_OFF = 131072 + 320;
constexpr size_t WS_BAR = 27 * MiB + 512 * 1024 + 65536, WS_PCNT = WS_BAR + 16384, BAR_BYTES = 16384 + 2 * 16384;

#define LAS __attribute__((address_space(3)))
typedef unsigned short bf16;
typedef unsigned v4u __attribute__((ext_vector_type(4)));
typedef unsigned v2u __attribute__((ext_vector_type(2)));
typedef float f32x4 __attribute__((ext_vector_type(4)));
typedef short bf16x8 __attribute__((ext_vector_type(8)));
typedef short s16x4 __attribute__((ext_vector_type(4)));
__device__ __forceinline__ float bflo(unsigned w) { return __uint_as_float(w << 16); }
__device__ __forceinline__ float bfhi(unsigned w) { return __uint_as_float(w & 0xffff0000u); }
__device__ __forceinline__ float bf2f(unsigned short b) { return __uint_as_float(((unsigned)b) << 16); }
__device__ __forceinline__ unsigned pk2(float lo, float hi) { return pg8::cvt_pk_bf16(lo, hi); }
__device__ __forceinline__ bf16x8 mk8(v2u lo, v2u hi) { v4u t; t.x = lo.x; t.y = lo.y; t.z = hi.x; t.w = hi.y; return __builtin_bit_cast(bf16x8, t); }
__device__ __forceinline__ f32x4 mfma16(bf16x8 a, bf16x8 b, f32x4 c) { return __builtin_amdgcn_mfma_f32_16x16x32_bf16(a, b, c, 0, 0, 0); }
__device__ __forceinline__ float siluf_(float x) { return x * pg8::sigmoidf_(x); }
#define LDS_WAIT() asm volatile("s_waitcnt lgkmcnt(0)" ::: "memory")

struct Args {
    const float* x; const float* p; const int* pos; const float* norm_g; const float* w_in; const float* gq; const float* gk; const float* gate_w2; const float* gate_b;
    const float* gla_g; const float* w_att; const float* w_gla; const float* w_out; const float* ple_g; const float* w_pg; const float* w_ple; float* out; unsigned char* ws; int one; int zero;
};

__device__ __forceinline__ float wave_sum(float v) {
#pragma unroll
    for (int o = 1; o < 64; o <<= 1) v += __shfl_xor(v, o);
    return v;
}
__device__ __forceinline__ void p0_transpose_item(const float* W, int wpitch, int ncols, const float* kscale, bf16* WT, int tpitch, int row_off, LAS float* scr, int item, int lane, bool headperm = false) {
    const int nblk = ncols / 32, kb = item / nblk, nb = item % nblk, k0 = 64 * kb, n0 = 32 * nb;
    const int d0 = headperm ? ((nb & ~7) + (nb & 1) * 4 + ((nb & 7) >> 1)) * 32 : n0;
#pragma unroll
    for (int i = 0; i < 8; ++i) { const int kk = 8 * i + (lane >> 3), c4 = 4 * (lane & 7);
        f32x4 v = *(const f32x4*)(W + (size_t)(k0 + kk) * wpitch + n0 + c4); if (kscale) v = v * kscale[k0 + kk];
        scr[kk * 33 + c4] = v[0]; scr[kk * 33 + c4 + 1] = v[1]; scr[kk * 33 + c4 + 2] = v[2]; scr[kk * 33 + c4 + 3] = v[3]; }
    LDS_WAIT(); asm volatile("" ::: "memory");
    const int c = lane & 7;
#pragma unroll
    for (int j = 0; j < 4; ++j) { const int n = (lane >> 3) + 8 * j; const LAS float* s = scr + (8 * c) * 33 + n;
        v4u o; o.x = pk2(s[0 * 33], s[1 * 33]); o.y = pk2(s[2 * 33], s[3 * 33]); o.z = pk2(s[4 * 33], s[5 * 33]); o.w = pk2(s[6 * 33], s[7 * 33]);
        *(v4u*)(WT + (size_t)(row_off + d0 + n) * tpitch + k0 + 8 * c) = o; }
    LDS_WAIT(); asm volatile("" ::: "memory");
}

__device__ __forceinline__ void phase0(const Args& a, LAS unsigned char* lds, int tid, int lane, int wave, int G) {
    unsigned char* ws = a.ws;
    LAS float* scr = (LAS float*)(lds + wave * 16384);
    const int gw = blockIdx.x * NWAVES + wave, NGW = G * NWAVES;
    constexpr int I0 = 16 * 160, I1 = 16 * 64, I2 = 16 * 32, I3 = 16 * 64, I4 = 8 * 32, I5 = 16 * 32, I6 = 16 * 32, I7 = 16 * 32, I8 = 4 * 32;
    constexpr int NITEMS = I0 + I1 + I2 + I3 + I4 + I5 + I6 + I7 + I8;
    for (int it = gw; it < NITEMS; it += NGW) {
        int r = it;
        if (r < I0) { p0_transpose_item(a.w_in, INC, 5120, nullptr, (bf16*)(ws + WS_W1A), 1024, 0, scr, r, lane, true); continue; } r -= I0;
        if (r < I1) { p0_transpose_item(a.w_in + 5120, INC, 2048, nullptr, (bf16*)(ws + WS_W1G), 1024, 0, scr, r, lane); continue; } r -= I1;
        if (r < I2) { p0_transpose_item(a.w_in + 7184, INC, 1024, nullptr, (bf16*)(ws + WS_W1A), 1024, 5120, scr, r, lane, true); continue; } r -= I2;
        if (r < I3) { p0_transpose_item(a.w_in + 8208, INC, 2048, nullptr, (bf16*)(ws + WS_WGT), 1024, 0, scr, r, lane); continue; } r -= I3;
        if (r < I4) { p0_transpose_item(a.w_att, 1024, 1024, nullptr, (bf16*)(ws + WS_WPA), 512, 0, scr, r, lane); continue; } r -= I4;
        if (r < I5) { p0_transpose_item(a.w_gla, 1024, 1024, nullptr, (bf16*)(ws + WS_WPB), 1024, 0, scr, r, lane); continue; } r -= I5;
        if (r < I6) { p0_transpose_item(a.w_out, 1024, 1024, nullptr, (bf16*)(ws + WS_WOUT), 1024, 0, scr, r, lane); continue; } r -= I6;
        if (r < I7) { p0_transpose_item(a.w_pg, 1024, 1024, a.ple_g, (bf16*)(ws + WS_WPG), 1024, 0, scr, r, lane); continue; } r -= I7;
        p0_transpose_item(a.w_ple, 1024, 1024, nullptr, (bf16*)(ws + WS_WPLE), 256, 0, scr, r, lane);
    }
    const int gtid = blockIdx.x * 512 + tid, NT = G * 512;
    for (int i = gtid; i < 16 * 1024; i += NT) { const int k = i >> 4, r = i & 15; ((bf16*)(ws + WS_WGLR))[r * 1024 + k] = (bf16)(pk2(a.w_in[(size_t)k * INC + 7168 + r], 0.f) & 0xffffu); }
    for (int i = gtid; i < T * 8; i += NT) { const int t = i >> 3, j = i & 7;
        const float inv = exp2f(-(float)j * 0.125f * 18.931568569324174f);
        const float ang = (float)a.pos[t] * inv;
        const double ad = (double)ang; const double kq = __builtin_rint(ad * 0.15915494309189535); const float rf = (float)(ad - kq * 6.283185307179586);
        float* rt = (float*)(ws + WS_ROT) + (size_t)t * 16; rt[j] = __cosf(rf); rt[8 + j] = __sinf(rf); }
    bf16* hb = (bf16*)a.out;
    for (int m = gw; m < T; m += NGW) {
        const f32x4* xr = (const f32x4*)(a.x + (size_t)m * D) + lane; const f32x4* gr = (const f32x4*)a.norm_g + lane;
        f32x4 v[4]; float s = 0.f;
#pragma unroll
        for (int j = 0; j < 4; ++j) { v[j] = xr[64 * j]; s += (v[j][0] * v[j][0] + v[j][1] * v[j][1]) + (v[j][2] * v[j][2] + v[j][3] * v[j][3]); }
        const float rstd = rsqrtf(wave_sum(s) * (1.f / D) + EPS);
        v2u* o8 = (v2u*)(hb + (size_t)m * D) + lane;
#pragma unroll
        for (int j = 0; j < 4; ++j) { const f32x4 g = gr[64 * j]; v2u w; w.x = pk2(v[j][0] * rstd * g[0], v[j][1] * rstd * g[1]); w.y = pk2(v[j][2] * rstd * g[2], v[j][3] * rstd * g[3]); o8[64 * j] = w; }
    }
}

__device__ __forceinline__ void glr_step(const Args& a, int lane, int wave, int G) {
    const bf16* hb = (const bf16*)a.out; const bf16* wg = (const bf16*)(a.ws + WS_WGLR); float* glr = (float*)(a.ws + WS_GLR);
    const int l15 = lane & 15, quad = lane >> 4;
    for (int rt = blockIdx.x * NWAVES + wave; rt < T / 16; rt += G * NWAVES) {
        f32x4 acc = {0.f, 0.f, 0.f, 0.f};
        const bf16* ap = hb + (size_t)(rt * 16 + l15) * 1024 + 8 * quad; const bf16* bp = wg + (size_t)l15 * 1024 + 8 * quad;
#pragma unroll 8
        for (int i = 0; i < 32; ++i) acc = mfma16(*(const bf16x8*)(ap + 32 * i), *(const bf16x8*)(bp + 32 * i), acc);
#pragma unroll
        for (int j = 0; j < 4; ++j) glr[(size_t)(rt * 16 + 4 * quad + j) * 16 + l15] = acc[j];
    }
}

constexpr int GL_GLR = 0, GL_CUMX = 4096, GL_QS = 6144, GL_KS = GL_QS + 64 * 272, GL_KT = GL_KS + 64 * 272, GL_VS = GL_KT + 128 * 144, GL_AT = GL_VS + 64 * 528, GL_END = GL_AT + 64 * 144;
static_assert(GL_END <= 131072, "gla lds");
__device__ __forceinline__ void gla_local_phase(const Args& a, LAS unsigned char* lds, int tid, int lane, int wave, int G) {
    asm volatile("" : "+v"(tid), "+v"(lane));
    unsigned char* ws = a.ws;
    const bf16* PROJ = (const bf16*)(ws + WS_PROJG); const float* glr = (const float*)(ws + WS_GLR);
    bf16* Qp = (bf16*)(ws + WS_QP); bf16* OI = (bf16*)(ws + WS_OI); bf16* Lg = (bf16*)(ws + WS_L); float* gamma = (float*)(ws + WS_GAMMA);
    const int d = tid & 127, tg = tid >> 7, l15 = lane & 15, quad = lane >> 4;
    for (int unit = blockIdx.x; unit < 1024; unit += G) {
        const int b = unit >> 8, h = (unit >> 6) & 3, c = unit & 63; const int row0 = b * SEQ + c * 64;
        const bf16* P = PROJ + (size_t)row0 * PG;
#pragma unroll
        for (int i = 0; i < 2; ++i) { const int p = tid + 512 * i, tok = p >> 4, part = p & 15;
            *(LAS v4u*)(lds + GL_QS + tok * 272 + part * 16) = *(const v4u*)(P + (size_t)tok * PG + h * 128 + part * 8);
            *(LAS v4u*)(lds + GL_KS + tok * 272 + part * 16) = *(const v4u*)(P + (size_t)tok * PG + 512 + h * 128 + part * 8); }
        if (tid < 256) ((LAS f32x4*)(lds + GL_GLR))[tid] = ((const f32x4*)(glr + (size_t)row0 * 16))[tid];
#pragma unroll
        for (int i = 0; i < 4; ++i) { const int p = tid + 512 * i, tok = p >> 5, part = p & 31;
            *(LAS v4u*)(lds + GL_VS + tok * 528 + part * 16) = *(const v4u*)(P + (size_t)tok * PG + 1024 + h * 256 + part * 8); }
        float w2r[16];
#pragma unroll
        for (int r = 0; r < 16; ++r) w2r[r] = a.gate_w2[r * 512 + h * 128 + d];
        const float bias = a.gate_b[h * 128 + d];
        __syncthreads();
        float cum[16]; float run = 0.f;
#pragma unroll
        for (int i = 0; i < 16; ++i) { const int t = tg * 16 + i; const LAS f32x4* gp = (const LAS f32x4*)(lds + GL_GLR + t * 64);
            const f32x4 g0 = gp[0], g1 = gp[1], g2 = gp[2], g3 = gp[3];
            float lo = bias;
            lo += g0[0] * w2r[0] + g0[1] * w2r[1] + g0[2] * w2r[2] + g0[3] * w2r[3];
            lo += g1[0] * w2r[4] + g1[1] * w2r[5] + g1[2] * w2r[6] + g1[3] * w2r[7];
            lo += g2[0] * w2r[8] + g2[1] * w2r[9] + g2[2] * w2r[10] + g2[3] * w2r[11];
            lo += g3[0] * w2r[12] + g3[1] * w2r[13] + g3[2] * w2r[14] + g3[3] * w2r[15];
            const float ls = fminf(lo, 0.f) - __logf(1.0f + __expf(-fabsf(lo)));
            run += ls * (1.0f / 16.0f); cum[i] = run; }
        ((LAS float*)(lds + GL_CUMX))[tg * 128 + d] = run;
        __syncthreads();
        float prefix = 0.f, last = 0.f;
#pragma unroll
        for (int g = 0; g < 4; ++g) { const float v = ((LAS float*)(lds + GL_CUMX))[g * 128 + d]; last += v; if (g < tg) prefix += v; }
        unsigned ktp[8];
#pragma unroll
        for (int i = 0; i < 16; ++i) { const int t = tg * 16 + i; const float cm = cum[i] + prefix; const float q = bf2f(*(const LAS unsigned short*)(lds + GL_QS + t * 272 + d * 2)), k = bf2f(*(const LAS unsigned short*)(lds + GL_KS + t * 272 + d * 2));
            const float qp = q * __expf(cm) * 0.08838834764831845f, kp = k * __expf(-cm), kpp = k * __expf(last - cm);
            const unsigned qb = pk2(qp, 0.f) & 0xffffu;
            *(LAS unsigned short*)(lds + GL_QS + t * 272 + d * 2) = (unsigned short)qb;
            *(LAS unsigned short*)(lds + GL_KS + t * 272 + d * 2) = (unsigned short)(pk2(kp, 0.f) & 0xffffu);
            const unsigned kb = pk2(kpp, 0.f) & 0xffffu;
            if (i & 1) ktp[i >> 1] |= kb << 16; else ktp[i >> 1] = kb; }
        { v4u w0, w1; w0.x = ktp[0]; w0.y = ktp[1]; w0.z = ktp[2]; w0.w = ktp[3]; w1.x = ktp[4]; w1.y = ktp[5]; w1.z = ktp[6]; w1.w = ktp[7];
          *(LAS v4u*)(lds + GL_KT + d * 144 + tg * 32) = w0; *(LAS v4u*)(lds + GL_KT + d * 144 + tg * 32 + 16) = w1; }
        if (tg == 0) gamma[(size_t)unit * 128 + d] = __expf(last);
        __syncthreads();
#pragma unroll
        for (int i = 0; i < 2; ++i) { const int p = tid + 512 * i, tok = p >> 4, part = p & 15;
            *(v4u*)(Qp + (size_t)(row0 + tok) * 512 + h * 128 + part * 8) = *(const LAS v4u*)(lds + GL_QS + tok * 272 + part * 16); }
        { const int it = wave >> 1;
#pragma unroll
          for (int jj = 0; jj < 2; ++jj) { const int jt = (wave & 1) * 2 + jj; f32x4 acc = {0.f, 0.f, 0.f, 0.f};
#pragma unroll
            for (int ks = 0; ks < 4; ++ks) { const bf16x8 ka = *(const LAS bf16x8*)(lds + GL_KS + (16 * jt + l15) * 272 + (32 * ks + 8 * quad) * 2);
                const bf16x8 qb = *(const LAS bf16x8*)(lds + GL_QS + (16 * it + l15) * 272 + (32 * ks + 8 * quad) * 2); acc = mfma16(ka, qb, acc); }
            const int i = 16 * it + l15, j0 = 16 * jt + 4 * quad;
            v2u w; w.x = pk2(j0 + 0 <= i ? acc[0] : 0.f, j0 + 1 <= i ? acc[1] : 0.f); w.y = pk2(j0 + 2 <= i ? acc[2] : 0.f, j0 + 3 <= i ? acc[3] : 0.f);
            *(LAS v2u*)(lds + GL_AT + i * 144 + j0 * 2) = w; } }
        __syncthreads();
#pragma unroll 1
        for (int dd = 0; dd < 2; ++dd) { const int dvt = 2 * wave + dd;
            bf16x8 VF[2];
#pragma unroll
            for (int ks = 0; ks < 2; ++ks) { unsigned short e[8];
#pragma unroll
                for (int q = 0; q < 8; ++q) e[q] = *(const LAS unsigned short*)(lds + GL_VS + (32 * ks + 8 * quad + q) * 528 + (16 * dvt + l15) * 2);
                v4u t; t.x = e[0] | ((unsigned)e[1] << 16); t.y = e[2] | ((unsigned)e[3] << 16); t.z = e[4] | ((unsigned)e[5] << 16); t.w = e[6] | ((unsigned)e[7] << 16);
                VF[ks] = __builtin_bit_cast(bf16x8, t); }
#pragma unroll
            for (int it = 0; it < 4; ++it) { f32x4 acc = {0.f, 0.f, 0.f, 0.f};
#pragma unroll
                for (int ks = 0; ks < 2; ++ks) acc = mfma16(VF[ks], *(const LAS bf16x8*)(lds + GL_AT + (16 * it + l15) * 144 + (32 * ks + 8 * quad) * 2), acc);
                v2u w; w.x = pk2(acc[0], acc[1]); w.y = pk2(acc[2], acc[3]);
                *(v2u*)(OI + (size_t)(row0 + 16 * it + l15) * 1024 + h * 256 + 16 * dvt + 4 * quad) = w; }
#pragma unroll
            for (int R = 0; R < 8; ++R) { f32x4 acc = {0.f, 0.f, 0.f, 0.f};
#pragma unroll
                for (int ks = 0; ks < 2; ++ks) acc = mfma16(*(const LAS bf16x8*)(lds + GL_KT + (16 * R + l15) * 144 + (32 * ks + 8 * quad) * 2), VF[ks], acc);
                v2u w; w.x = pk2(acc[0], acc[1]); w.y = pk2(acc[2], acc[3]);
                *(v2u*)(Lg + ((size_t)(unit * 16 + dvt) * 8 + R) * 256 + lane * 4) = w; }
        }
        __syncthreads();
    }
}

constexpr int CH_L = 0, CH_Q = 4096, CH_G = 20480, CH_O = 20992, CH_STAGE = 23040;
struct ChReg { v4u l, q0, q1, q2, q3, x; };
__device__ __forceinline__ void ch_load(ChReg& r, const bf16* Lg, const float* gamma, const bf16* Qp, const bf16* OI, int unit, int dvt, int row0, int h, int lt) {
    r.l = *(const v4u*)(Lg + ((size_t)(unit * 16 + dvt) * 8) * 256 + lt * 8);
    const int rr = lt >> 4, j = (lt & 15) ^ rr;
    const bf16* qb = Qp + (size_t)(row0 + rr) * 512 + h * 128 + j * 8;
    r.q0 = *(const v4u*)(qb); r.q1 = *(const v4u*)(qb + 16 * 512); r.q2 = *(const v4u*)(qb + 32 * 512); r.q3 = *(const v4u*)(qb + 48 * 512);
    if (lt < 32) r.x = *(const v4u*)(gamma + (size_t)unit * 128 + lt * 4);
    else if (lt >= 128) { const int go = lt - 128; r.x = *(const v4u*)(OI + (size_t)(row0 + (go >> 1)) * 1024 + h * 256 + 16 * dvt + (go & 1) * 8); }
}
__device__ __forceinline__ void ch_store(const ChReg& r, LAS unsigned char* st, int lt) {
    *(LAS v4u*)(st + CH_L + lt * 16) = r.l;
    *(LAS v4u*)(st + CH_Q + lt * 16) = r.q0; *(LAS v4u*)(st + CH_Q + (lt + 256) * 16) = r.q1; *(LAS v4u*)(st + CH_Q + (lt + 512) * 16) = r.q2; *(LAS v4u*)(st + CH_Q + (lt + 768) * 16) = r.q3;
    if (lt < 32) *(LAS v4u*)(st + CH_G + lt * 16) = r.x; else if (lt >= 128) *(LAS v4u*)(st + CH_O + (lt - 128) * 16) = r.x;
}
__device__ __forceinline__ void gla_chain_phase(const Args& a, LAS unsigned char* lds, int tid, int lane, int wave, int G, int st_en) {
    asm volatile("" : "+v"(tid), "+v"(lane));
    unsigned char* ws = a.ws;
    const bf16* Qp = (const bf16*)(ws + WS_QP); bf16* OI = (bf16*)(ws + WS_OI); const bf16* Lg = (const bf16*)(ws + WS_L); const float* gamma = (const float*)(ws + WS_GAMMA); float* SS = (float*)(ws + WS_SS);
    const int l15 = lane & 15, quad = lane >> 4, lt = tid - 256, it = wave;
    const int vcu = (G % 8 == 0) ? ((int)blockIdx.x % 8) * (G / 8) + (int)blockIdx.x / 8 : (int)blockIdx.x;
    for (int item = vcu; item < 256; item += G) {
        const int bh = item >> 4, dvt = item & 15, b = bh >> 2, h = bh & 3, unit0 = bh * 64, rowb = b * SEQ;
        if (wave >= 4) {
            ChReg r0, r1, r2, r3, r4, r5, r6, r7;
#define CH_LD(rr, st) ch_load(rr, Lg, gamma, Qp, OI, unit0 + (st), dvt, rowb + (st) * 64, h, lt)
            CH_LD(r0, 0); CH_LD(r1, 1); ch_store(r0, lds, lt); ch_store(r1, lds + CH_STAGE, lt);
            CH_LD(r0, 2); CH_LD(r1, 3); CH_LD(r2, 4); CH_LD(r3, 5); CH_LD(r4, 6); CH_LD(r5, 7); CH_LD(r6, 8); CH_LD(r7, 9);
            __syncthreads();
#pragma unroll 1
            for (int q = 0; q < 8; ++q) {
#pragma unroll
                for (int j = 0; j < 4; ++j) {
                    const int sI = 4 * q + j, c0 = 2 * sI + 2, c1 = 2 * sI + 3;
                    const int n0 = (c0 + 8 < 64) ? c0 + 8 : 63, n1 = (c1 + 8 < 64) ? c1 + 8 : 63;
                    LAS unsigned char* s0 = lds + (c0 & 3) * CH_STAGE; LAS unsigned char* s1 = lds + (c1 & 3) * CH_STAGE;
#define CH_ROT2(ra, rb) do { ch_store(ra, s0, lt); ch_store(rb, s1, lt); CH_LD(ra, n0); CH_LD(rb, n1); } while (0)
                    if (j == 0) CH_ROT2(r0, r1); else if (j == 1) CH_ROT2(r2, r3); else if (j == 2) CH_ROT2(r4, r5); else CH_ROT2(r6, r7);
#undef CH_ROT2
                    __syncthreads();
                }
            }
#undef CH_LD
        } else {
            f32x4 S[8];
#pragma unroll
            for (int R = 0; R < 8; ++R) S[R] = (f32x4){0.f, 0.f, 0.f, 0.f};
            __syncthreads();
#pragma unroll 1
            for (int c2 = 0; c2 < 32; ++c2) {
#pragma unroll
              for (int u2 = 0; u2 < 2; ++u2) { const int c = 2 * c2 + u2;
                const LAS unsigned char* st = lds + (c & 3) * CH_STAGE;
                const int r = 16 * it + l15; const int row = rowb + c * 64 + r;
                f32x4 acc = {0.f, 0.f, 0.f, 0.f};
#pragma unroll
                for (int ks = 0; ks < 4; ++ks) { const int jq = 4 * ks + (quad >> 1), sub = (quad & 1) * 8;
                    const v2u qlo = *(const LAS v2u*)(st + CH_Q + r * 256 + ((jq ^ l15) << 4) + sub), qhi = *(const LAS v2u*)(st + CH_Q + r * 256 + (((jq + 2) ^ l15) << 4) + sub);
                    v4u sa; sa.x = pk2(S[2 * ks][0], S[2 * ks][1]); sa.y = pk2(S[2 * ks][2], S[2 * ks][3]); sa.z = pk2(S[2 * ks + 1][0], S[2 * ks + 1][1]); sa.w = pk2(S[2 * ks + 1][2], S[2 * ks + 1][3]);
                    acc = mfma16(__builtin_bit_cast(bf16x8, sa), mk8(qlo, qhi), acc); }
                const v2u oi = *(const LAS v2u*)(st + CH_O + r * 32 + quad * 8);
                const float o0 = acc[0] + bflo(oi.x), o1 = acc[1] + bfhi(oi.x), o2 = acc[2] + bflo(oi.y), o3 = acc[3] + bfhi(oi.y);
                v2u w; w.x = pk2(o0, o1); w.y = pk2(o2, o3);
                if (st_en) *(v2u*)(OI + (size_t)row * 1024 + h * 256 + 16 * dvt + 4 * quad) = w;
                float s = (o0 * o0 + o1 * o1) + (o2 * o2 + o3 * o3); s += __shfl_xor(s, 16); s += __shfl_xor(s, 32);
                if (quad == 0 && st_en) SS[(size_t)row * 64 + h * 16 + dvt] = s;
#pragma unroll
                for (int R = 0; R < 8; ++R) { const v2u Lr = *(const LAS v2u*)(st + CH_L + R * 512 + lane * 8); const f32x4 gm = *(const LAS f32x4*)(st + CH_G + (16 * R + 4 * quad) * 4);
                    S[R][0] = gm[0] * S[R][0] + bflo(Lr.x); S[R][1] = gm[1] * S[R][1] + bfhi(Lr.x); S[R][2] = gm[2] * S[R][2] + bflo(Lr.y); S[R][3] = gm[3] * S[R][3] + bfhi(Lr.y); }
              }
                __syncthreads();
            }
        }
    }
}

constexpr int ATS_V = 16384, ATS_SLOT = 32768;
struct AtUnit { int b, h, dsh, r, qt; };
__device__ __forceinline__ AtUnit at_decode(int unit) { AtUnit U; const int u = unit & 31, hb = unit >> 5; U.h = hb % 24; U.b = hb / 24; U.dsh = 2 * (U.h >> 3); const int ntc = 32 >> U.dsh; U.r = u / ntc; U.qt = u - U.r * ntc; return U; }
__device__ __forceinline__ const bf16* at_qbase(const bf16* PROJ, const AtUnit& U) { return PROJ + ((size_t)(U.b * 24 + U.h) * 4096 + ((size_t)U.r << (12 - U.dsh))) * 64; }
__device__ __forceinline__ void at_dma_chunk(const bf16* PROJ, const AtUnit& U, int c, LAS unsigned char* slot, int wave, int lane) {
    constexpr size_t WHICH = (size_t)T * 1536;
    const bf16* Pb = at_qbase(PROJ, U) + (size_t)c * 128 * 64;
    const int rl = lane >> 3, j = (lane & 7) ^ rl;
#pragma unroll
    for (int i = 0; i < 2; ++i) { const int rb = wave + 8 * i; const bf16* src = Pb + (size_t)(rb * 8 + rl) * 64 + j * 8;
        __builtin_amdgcn_global_load_lds((const unsigned*)(src + WHICH), (LAS unsigned*)(slot + rb * 1024), 16, 0, 0);
        __builtin_amdgcn_global_load_lds((const unsigned*)(src + 2 * WHICH), (LAS unsigned*)(slot + ATS_V + rb * 1024), 16, 0, 0); }
}
__device__ __forceinline__ void attn_phase(const Args& a, LAS unsigned char* lds, int tid, int lane, int wave, int G) {
    asm volatile("" : "+v"(tid), "+v"(lane));
    unsigned char* ws = a.ws; const bf16* PROJ = (const bf16*)(ws + WS_PROJA);
    bf16* OG = (bf16*)(ws + WS_OG); float* ML = (float*)(ws + WS_ML);
    const int l15 = lane & 15, quad = lane >> 4, w = wave;
    const int vcu = (G % 8 == 0) ? ((int)blockIdx.x % 8) * (G / 8) + (int)blockIdx.x / 8 : (int)blockIdx.x;
    const int tpb = (3072 + G - 1) / G, t0 = vcu * tpb, t1 = (t0 + tpb < 3072) ? t0 + tpb : 3072;
    bf16x8 QB[2];
    if (t0 < t1) { const AtUnit U = at_decode(t0);
        if (U.qt > 0) at_dma_chunk(PROJ, U, U.qt - 1, lds + ((t0 + 2) % 3) * ATS_SLOT, wave, lane);
        at_dma_chunk(PROJ, U, U.qt, lds + (t0 % 3) * ATS_SLOT, wave, lane);
        const bf16* qp = at_qbase(PROJ, U) + (size_t)(128 * U.qt + 16 * w + l15) * 64 + 8 * quad; QB[0] = *(const bf16x8*)qp; QB[1] = *(const bf16x8*)(qp + 32); }
    v2u pend[4]; float pmx = 0.f, pl = 0.f; size_t prow = 0; int ph = 0; bool have = false;
    for (int unit = t0; unit < t1; ++unit) {
        const AtUnit U = at_decode(unit);
        const int sc = unit % 3, sp = (U.qt > 0) ? (unit + 2) % 3 : sc;
        asm volatile("s_waitcnt vmcnt(0)" ::: "memory");
        __syncthreads();
        if (have) {
#pragma unroll
            for (int dt = 0; dt < 4; ++dt) *(v2u*)(OG + prow * 1536 + ph * 64 + 16 * dt + 4 * quad) = pend[dt];
            if (quad == 0) { v2u mlv; mlv.x = __float_as_uint(pmx); mlv.y = __float_as_uint(pl); *(v2u*)(ML + prow * 48 + ph * 2) = mlv; } }
        const bf16x8 q0 = QB[0], q1 = QB[1];
        if (unit + 1 < t1) { const AtUnit Un = at_decode(unit + 1); at_dma_chunk(PROJ, Un, Un.qt, lds + ((unit + 1) % 3) * ATS_SLOT, wave, lane);
            const bf16* qp = at_qbase(PROJ, Un) + (size_t)(128 * Un.qt + 16 * w + l15) * 64 + 8 * quad; QB[0] = *(const bf16x8*)qp; QB[1] = *(const bf16x8*)(qp + 32); }
        {
            const int qt = U.qt;
            const LAS unsigned char* bp = lds + sp * ATS_SLOT; const LAS unsigned char* bc = lds + sc * ATS_SLOT;
            f32x4 ST[9]; float mx = -INFINITY;
#pragma unroll
            for (int Tt = 0; Tt < 9; ++Tt) { f32x4 acc = {0.f, 0.f, 0.f, 0.f}; const int kr = ((16 * (w + Tt)) & 127) + l15; const LAS unsigned char* kb = (w + Tt >= 8) ? bc : bp;
                acc = mfma16(*(const LAS bf16x8*)(kb + kr * 128 + (((0 + quad) ^ (kr & 7)) << 4)), q0, acc);
                acc = mfma16(*(const LAS bf16x8*)(kb + kr * 128 + (((4 + quad) ^ (kr & 7)) << 4)), q1, acc);
#pragma unroll
                for (int e = 0; e < 4; ++e) { const int kk = 4 * quad + e; bool valid = true; if (Tt == 0) valid = kk >= l15; if (Tt == 8) valid = kk <= l15;
                    if (qt == 0) valid = valid && (w + Tt >= 8);
                    acc[e] = valid ? acc[e] : -INFINITY; mx = fmaxf(mx, acc[e]); }
                ST[Tt] = acc; }
            mx = fmaxf(mx, __shfl_xor(mx, 16)); mx = fmaxf(mx, __shfl_xor(mx, 32));
            float l = 0.f;
#pragma unroll
            for (int Tt = 0; Tt < 9; ++Tt)
#pragma unroll
                for (int e = 0; e < 4; ++e) { const float pv = __builtin_amdgcn_exp2f(ST[Tt][e] - mx); ST[Tt][e] = pv; l += pv; }
            l += __shfl_xor(l, 16); l += __shfl_xor(l, 32);
            f32x4 O[4];
#pragma unroll
            for (int dt = 0; dt < 4; ++dt) O[dt] = (f32x4){0.f, 0.f, 0.f, 0.f};
#pragma unroll
            for (int pr = 0; pr < 5; ++pr) { const int T1 = 2 * pr, T2 = (2 * pr + 1 < 9) ? 2 * pr + 1 : 8;
                v4u pf; pf.x = pk2(ST[T1][0], ST[T1][1]); pf.y = pk2(ST[T1][2], ST[T1][3]);
                if (pr < 4) { pf.z = pk2(ST[T2][0], ST[T2][1]); pf.w = pk2(ST[T2][2], ST[T2][3]); } else { pf.z = 0u; pf.w = 0u; }
                const int k1 = ((16 * (w + T1)) & 127) + 4 * quad + (l15 >> 2), k2 = ((16 * (w + T2)) & 127) + 4 * quad + (l15 >> 2);
                const LAS unsigned char* v1 = ((w + T1 >= 8) ? bc : bp) + ATS_V; const LAS unsigned char* v2 = ((w + T2 >= 8) ? bc : bp) + ATS_V;
#pragma unroll
                for (int dt = 0; dt < 4; ++dt) {
                    const int jv = 2 * dt + ((l15 & 3) >> 1), sub = (l15 & 1) * 8;
                    const s16x4 lo = __builtin_amdgcn_ds_read_tr16_b64_v4i16((LAS s16x4*)(v1 + k1 * 128 + ((jv ^ (k1 & 7)) << 4) + sub));
                    const s16x4 hi = (pr < 4) ? __builtin_amdgcn_ds_read_tr16_b64_v4i16((LAS s16x4*)(v2 + k2 * 128 + ((jv ^ (k2 & 7)) << 4) + sub)) : lo;
                    bf16x8 av; av[0] = lo[0]; av[1] = lo[1]; av[2] = lo[2]; av[3] = lo[3]; av[4] = hi[0]; av[5] = hi[1]; av[6] = hi[2]; av[7] = hi[3];
                    O[dt] = mfma16(av, __builtin_bit_cast(bf16x8, pf), O[dt]); } }
            const float inv = 1.0f / l;
            const int tokq = ((128 * qt + 16 * w + l15) << U.dsh) + U.r; const size_t trow = (size_t)U.b * SEQ + tokq;
#pragma unroll
            for (int dt = 0; dt < 4; ++dt) { pend[dt].x = pk2(O[dt][0] * inv, O[dt][1] * inv); pend[dt].y = pk2(O[dt][2] * inv, O[dt][3] * inv); }
            pmx = mx; pl = l; prow = trow; ph = U.h; have = true;
        }
    }
    if (have) {
#pragma unroll
        for (int dt = 0; dt < 4; ++dt) *(v2u*)(OG + prow * 1536 + ph * 64 + 16 * dt + 4 * quad) = pend[dt];
        if (quad == 0) { v2u mlv; mlv.x = __float_as_uint(pmx); mlv.y = __float_as_uint(pl); *(v2u*)(ML + prow * 48 + ph * 2) = mlv; } }
    asm volatile("s_waitcnt vmcnt(0)" ::: "memory"); __syncthreads();
}
__device__ __forceinline__ void prep_a_phase(const Args& a, int tid, int G, int row_base, int nrows, int row_stride) {
    asm volatile("" : "+v"(tid));
    unsigned char* ws = a.ws; const bf16* OG = (const bf16*)(ws + WS_OG); const float* ML = (const float*)(ws + WS_ML); const bf16* ZA = (const bf16*)(ws + WS_ZA);
    bf16* AA = (bf16*)(ws + WS_AA);
    for (int rb = row_base; rb < T; rb += row_stride)
    for (int p = tid; p < nrows * 64; p += 512) { const int t = rb + (p >> 6), col = (p & 63) * 8, s = col >> 6, dc = col & 63;
        v4u o[3]; float m[3], l[3];
#pragma unroll
        for (int g = 0; g < 3; ++g) { const int hh = 8 * g + s; o[g] = *(const v4u*)(OG + (size_t)t * 1536 + hh * 64 + dc); m[g] = ML[(size_t)t * 48 + hh * 2]; l[g] = ML[(size_t)t * 48 + hh * 2 + 1]; }
        const float M = fmaxf(m[0], fmaxf(m[1], m[2]));
        float w0 = l[0] * __builtin_amdgcn_exp2f(m[0] - M), w1 = l[1] * __builtin_amdgcn_exp2f(m[1] - M), w2 = l[2] * __builtin_amdgcn_exp2f(m[2] - M);
        const float iw = 1.0f / (w0 + w1 + w2); w0 *= iw; w1 *= iw; w2 *= iw;
        const v4u z8 = *(const v4u*)(ZA + (size_t)t * 512 + col);
        v4u w;
        w.x = pk2((w0 * bflo(o[0].x) + w1 * bflo(o[1].x) + w2 * bflo(o[2].x)) * siluf_(bflo(z8.x)), (w0 * bfhi(o[0].x) + w1 * bfhi(o[1].x) + w2 * bfhi(o[2].x)) * siluf_(bfhi(z8.x)));
        w.y = pk2((w0 * bflo(o[0].y) + w1 * bflo(o[1].y) + w2 * bflo(o[2].y)) * siluf_(bflo(z8.y)), (w0 * bfhi(o[0].y) + w1 * bfhi(o[1].y) + w2 * bfhi(o[2].y)) * siluf_(bfhi(z8.y)));
        w.z = pk2((w0 * bflo(o[0].z) + w1 * bflo(o[1].z) + w2 * bflo(o[2].z)) * siluf_(bflo(z8.z)), (w0 * bfhi(o[0].z) + w1 * bfhi(o[1].z) + w2 * bfhi(o[2].z)) * siluf_(bfhi(z8.z)));
        w.w = pk2((w0 * bflo(o[0].w) + w1 * bflo(o[1].w) + w2 * bflo(o[2].w)) * siluf_(bflo(z8.w)), (w0 * bfhi(o[0].w) + w1 * bfhi(o[1].w) + w2 * bfhi(o[2].w)) * siluf_(bfhi(z8.w)));
        pg8::st_sc1_16(AA + (size_t)t * 512 + col, w); }
}

#ifndef REP_MASK
#define REP_MASK 0
#endif
#ifndef DBG_STOP
#define DBG_STOP 0
#endif
#if DBG_STOP
__device__ __forceinline__ float dbg_san(float v) { return (fabsf(v) < 1e30f) ? v : 777.0f; }
__device__ __forceinline__ float dbg_sum_bf16(const void* p, size_t bytes, int gtid, int NT) { const unsigned* q = (const unsigned*)p; float s = 0.f; for (size_t i = gtid; i < bytes / 4; i += NT) { const unsigned w = q[i]; s += dbg_san(bflo(w)) + dbg_san(bfhi(w)); } return s; }
__device__ __forceinline__ float dbg_sum_f32(const void* p, size_t bytes, int gtid, int NT) { const float* q = (const float*)p; float s = 0.f; for (size_t i = gtid; i < bytes / 4; i += NT) s += dbg_san(q[i]); return s; }
#define DBG_DUMP(k, NS, ...) if (DBG_STOP == (k)) { const int gtid_ = blockIdx.x * 512 + tid, NT_ = G * 512; float sv_[NS] = { __VA_ARGS__ }; GRID_SYNC(); \
    for (size_t i = gtid_; i < (size_t)T * D; i += NT_) args.out[i] = 0.f; _Pragma("unroll") for (int q_ = 0; q_ < NS; ++q_) args.out[(size_t)q_ * NT_ + gtid_] = sv_[q_]; return; }
#define SB(off, mib) dbg_sum_bf16(ws + (off), (size_t)(mib) * MiB, gtid_, NT_)
#define SF(off, mib) dbg_sum_f32(ws + (off), (size_t)(mib) * MiB, gtid_, NT_)
#else
#define DBG_DUMP(k, NS, ...)
#endif
typedef __attribute__((address_space(1))) unsigned gu32;
#define XB_TMO      128
#define XB_XCNT(j)  (256  + 64 * (j))
#define XB_XSUB(j)  (1280 + 64 * (j))
#define XB_XGEN(j)  (2304 + 64 * (j))
#define XB_TOP      3328
#define XB_TOPGEN   3392
#define XCD_BAR_WORDS 3456
#define XB_SPIN_CAP (1u << 18)

__device__ __forceinline__ unsigned xb_ld(unsigned* p)              { return __hip_atomic_load(p, __ATOMIC_RELAXED, __HIP_MEMORY_SCOPE_AGENT); }
__device__ __forceinline__ unsigned xb_add(unsigned* p, unsigned v) { return __hip_atomic_fetch_add(p, v, __ATOMIC_RELAXED, __HIP_MEMORY_SCOPE_AGENT); }
__device__ __forceinline__ unsigned xb_xcc_id() { return (unsigned)__builtin_amdgcn_s_getreg((3 << 11) | 20) & 0xFu; }
#define XB_SPIN(cond, bar) do { unsigned _sp = 0; while (cond) { __builtin_amdgcn_s_sleep(1); \
    if ((++_sp & 255u) == 0u) { if (xb_ld(&(bar)[XB_TMO])) break; if (_sp > XB_SPIN_CAP) { atomicAdd(&(bar)[XB_TMO], 1u); break; } } } } while (0)

struct XcdBarrier {
    unsigned* bar; unsigned x;
    volatile LAS unsigned* st;
};

__device__ __forceinline__ XcdBarrier xcd_barrier_post(unsigned* bar, volatile LAS unsigned* st) {
    XcdBarrier b; b.bar = bar; b.x = xb_xcc_id(); b.st = st;
    if (threadIdx.x == 0) (void)xb_add(&bar[XB_XCNT(b.x)], 1u);
    return b;
}
__device__ __forceinline__ void xcd_barrier_complete(unsigned* bar, unsigned x, unsigned& nloc, unsigned& nx) {
    const unsigned G = gridDim.x * gridDim.y * gridDim.z;
    unsigned sum, cnt, mine, sp = 0u;
    for (;;) {
        sum = 0u; cnt = 0u; mine = 0u;
#pragma unroll
        for (unsigned j = 0; j < 16; ++j) { const unsigned c = xb_ld(&bar[XB_XCNT(j)]); sum += c; cnt += (c > 0u) ? 1u : 0u; mine = (j == x) ? c : mine; }
        if (sum == G) break;
        __builtin_amdgcn_s_sleep(1);
        if ((++sp & 255u) == 0u) { if (xb_ld(&bar[XB_TMO])) break; if (sp > XB_SPIN_CAP) { atomicAdd(&bar[XB_TMO], 1u); break; } }
    }
    nloc = mine > 0u ? mine : 1u; nx = cnt > 0u ? cnt : 1u;
}

__device__ __forceinline__ void xcd_barrier(const XcdBarrier& b) {
    asm volatile("s_waitcnt vmcnt(0)" ::: "memory");
    __syncthreads();
    if (threadIdx.x == 0) {
        unsigned* bar = b.bar;
        __builtin_amdgcn_s_waitcnt(0);
        unsigned nloc = b.st[0], nx = b.st[1];
        if (nloc == 0u) { xcd_barrier_complete(bar, b.x, nloc, nx); b.st[0] = nloc; b.st[1] = nx; }
        const unsigned old = xb_add(&bar[XB_XSUB(b.x)], 1u);
        const unsigned gen = old / nloc;
        if (old + 1u == (gen + 1u) * nloc) {
            __builtin_amdgcn_fence(__ATOMIC_RELEASE, "agent");
            asm volatile("s_waitcnt vmcnt(0)" ::: "memory");
            const unsigned og = xb_add(&bar[XB_TOP], 1u);
            const unsigned tg = og / nx;
            if (og + 1u == (tg + 1u) * nx) xb_add(&bar[XB_TOPGEN], 1u);
            else XB_SPIN(xb_ld(&bar[XB_TOPGEN]) == tg, bar);
            __builtin_amdgcn_fence(__ATOMIC_ACQUIRE, "agent");
            xb_add(&bar[XB_XGEN(b.x)], 1u);
            asm volatile("s_waitcnt vmcnt(0)" ::: "memory");
        } else {
            XB_SPIN(xb_ld(&bar[XB_XGEN(b.x)]) == gen, bar);
            __builtin_amdgcn_fence(__ATOMIC_ACQUIRE, "agent");
            asm volatile("s_waitcnt vmcnt(0)" ::: "memory");
        }
    }
    __syncthreads();
}


__device__ __forceinline__ void panel_handoff(unsigned* cnt, int pm, unsigned want) {
    asm volatile("s_waitcnt vmcnt(0)" ::: "memory");
    __syncthreads();
    if (threadIdx.x == 0) {
        unsigned* c = cnt + 64 * pm;
        __hip_atomic_fetch_add(c, 1u, __ATOMIC_RELAXED, __HIP_MEMORY_SCOPE_AGENT);
        unsigned sp = 0;
        while (__hip_atomic_load(c, __ATOMIC_RELAXED, __HIP_MEMORY_SCOPE_AGENT) < want) { __builtin_amdgcn_s_sleep(1); if (++sp > (1u << 22)) break; }
        __builtin_amdgcn_fence(__ATOMIC_ACQUIRE, "agent");
        asm volatile("s_waitcnt vmcnt(0)" ::: "memory");
    }
    __syncthreads();
}
#define GRID_SYNC_CG() do { asm volatile("s_waitcnt vmcnt(0) lgkmcnt(0)" ::: "memory"); grid.sync(); __builtin_amdgcn_fence(__ATOMIC_ACQUIRE, "agent"); asm volatile("s_waitcnt vmcnt(0)" ::: "memory"); } while (0)
#define GRID_SYNC() xcd_barrier(xbar)
__global__ void __launch_bounds__(NWAVES * 64, 2) mega_fwd(Args args) {
    extern __shared__ __attribute__((aligned(16))) unsigned char lds_raw[];
    LAS unsigned char* lds = (LAS unsigned char*)lds_raw;
    cg::grid_group grid = cg::this_grid();
    const int tid = threadIdx.x, lane = tid & 63, wave = __builtin_amdgcn_readfirstlane(tid >> 6), G = gridDim.x;
    unsigned char* ws = args.ws;
    if (tid < 32) ((LAS unsigned*)(lds + MISC_OFF))[tid] = 0u;
    __syncthreads();
    const XcdBarrier xbar = xcd_barrier_post((unsigned*)(ws + WS_BAR), (volatile LAS unsigned*)(lds + MISC_OFF) + 8);
    const pg8::bf16_t* hb = (const pg8::bf16_t*)args.out;
    const pg8::bf16_t* AB = (const pg8::bf16_t*)args.out + (size_t)T * 1024;

#if REP_MASK & 32
    for (int q_ = 0; q_ < 10; ++q_) { GRID_SYNC(); }
#endif
    phase0(args, lds, tid, lane, wave, G);
#if REP_MASK & 1
    phase0(args, lds, tid, lane, wave, G);
#endif
    if (args.zero) { GRID_SYNC_CG(); }
    GRID_SYNC();
    glr_step(args, lane, wave, G);
    { pg8::Gemm g{hb, hb, hb, (const pg8::bf16_t*)(ws + WS_W1G), (const pg8::bf16_t*)(ws + WS_W1G), (const pg8::bf16_t*)(ws + WS_W1G), 16, 16, 16, 1024, 1024};
      pg8::SegOrder S; S.init(T, PG, G, (int)blockIdx.x, 1); pg8::EpiBf16 E{(pg8::bf16_t*)(ws + WS_PROJG), PG};
      pg8::gemm_phase<pg8::EpiBf16, pg8::SegOrder, true, true>(lds, g, S, E); }
#if REP_MASK & 128
    { pg8::Gemm g{hb, hb, hb, (const pg8::bf16_t*)(ws + WS_W1G), (const pg8::bf16_t*)(ws + WS_W1G), (const pg8::bf16_t*)(ws + WS_W1G), 16, 16, 16, 1024, 1024};
      pg8::SegOrder S; S.init(T, PG, G, (int)blockIdx.x, 1); pg8::EpiBf16 E{(pg8::bf16_t*)(ws + WS_PROJG), PG};
      pg8::gemm_phase<pg8::EpiBf16, pg8::SegOrder, true, true>(lds, g, S, E); }
#endif
    GRID_SYNC();
    DBG_DUMP(2, 7, SB(WS_W1A, 10), SB(WS_W1G, 6), SB(WS_WGT, 4), SF(WS_ROT, 1), dbg_sum_bf16(args.out, 32 * MiB, gtid_, NT_), SF(WS_GLR, 1), SB(WS_PROJG, 96))
    gla_local_phase(args, lds, tid, lane, wave, G);
#if REP_MASK & 2
    gla_local_phase(args, lds, tid, lane, wave, G);
#endif
    GRID_SYNC();
    DBG_DUMP(3, 4, SB(WS_QP, 16), SB(WS_OI, 32), SB(WS_L, 64), SF(WS_GAMMA, 0.5))
    DBG_DUMP(31, 1, SB(WS_QP, 16))
    DBG_DUMP(32, 1, SB(WS_OI, 32))
    DBG_DUMP(33, 1, SB(WS_L, 64))
    gla_chain_phase(args, lds, tid, lane, wave, G, args.one);
#if REP_MASK & 64
    gla_chain_phase(args, lds, tid, lane, wave, G, args.zero);
#endif
    GRID_SYNC();
    DBG_DUMP(4, 2, SB(WS_OI, 32), SF(WS_SS, 4))
    { pg8::Gemm g{hb, hb, hb, (const pg8::bf16_t*)(ws + WS_W1A), (const pg8::bf16_t*)(ws + WS_W1A), (const pg8::bf16_t*)(ws + WS_W1A), 16, 16, 16, 1024, 1024};
      pg8::SegOrder S; S.init(T, 6144, G, (int)blockIdx.x, 1);
      pg8::EpiQKV E{(pg8::bf16_t*)(ws + WS_PROJA), (pg8::bf16_t*)(ws + WS_ZA), args.gq, args.gk, (const float*)(ws + WS_ROT), EPS, (const pg8::bf16_t*)(ws + WS_OI), (const float*)(ws + WS_SS), args.gla_g, (pg8::bf16_t*)args.out + (size_t)T * 1024};
      pg8::gemm_phase<pg8::EpiQKV, pg8::SegOrder, true, true>(lds, g, S, E); }
#if REP_MASK & 256
    { pg8::Gemm g{hb, hb, hb, (const pg8::bf16_t*)(ws + WS_W1A), (const pg8::bf16_t*)(ws + WS_W1A), (const pg8::bf16_t*)(ws + WS_W1A), 16, 16, 16, 1024, 1024};
      pg8::SegOrder S; S.init(T, 6144, G, (int)blockIdx.x, 1);
      pg8::EpiQKV E{(pg8::bf16_t*)(ws + WS_PROJA), (pg8::bf16_t*)(ws + WS_ZA), args.gq, args.gk, (const float*)(ws + WS_ROT), EPS, (const pg8::bf16_t*)(ws + WS_OI), (const float*)(ws + WS_SS), args.gla_g, (pg8::bf16_t*)args.out + (size_t)T * 1024};
      pg8::gemm_phase<pg8::EpiQKV, pg8::SegOrder, true, true>(lds, g, S, E); }
#endif
    GRID_SYNC();
    attn_phase(args, lds, tid, lane, wave, G);
#if REP_MASK & 8
    attn_phase(args, lds, tid, lane, wave, G);
#endif
    GRID_SYNC();
    pg8::SegOrder SP; SP.init(T, 1024, G, (int)blockIdx.x, 1); pg8::Unit up; const bool panel_mode = (SP.nwg == G) && SP.next(0, up);
    if (panel_mode) prep_a_phase(args, tid, G, up.pm * 256 + up.pn * 64, 64, T);
    else { prep_a_phase(args, tid, G, (int)blockIdx.x * 64, 64, G * 64); GRID_SYNC(); }
    { bf16* pb = (bf16*)(ws + WS_PB);
      for (int i = blockIdx.x * 512 + tid; i < T * 256 / 8; i += G * 512) { const f32x4 v0 = ((const f32x4*)args.p)[2 * i], v1 = ((const f32x4*)args.p)[2 * i + 1];
          v4u w; w.x = pk2(v0[0], v0[1]); w.y = pk2(v0[2], v0[3]); w.z = pk2(v1[0], v1[1]); w.w = pk2(v1[2], v1[3]); ((v4u*)pb)[i] = w; } }
    { const pg8::bf16_t* WGT = (const pg8::bf16_t*)(ws + WS_WGT);
      pg8::Gemm g{hb, hb, hb, WGT, WGT + (size_t)1024 * 1024, WGT, 16, 16, 16, 1024, 1024};
      pg8::SegOrder S; S.init(T, 1024, G, (int)blockIdx.x, 2); pg8::EpiSig2 E{(pg8::bf16_t*)(ws + WS_SGA), (pg8::bf16_t*)(ws + WS_SGB), 1024};
      pg8::gemm_phase<pg8::EpiSig2, pg8::SegOrder, true, true>(lds, g, S, E); }
    if (panel_mode) panel_handoff((unsigned*)(ws + WS_PCNT) + 4096, up.pm, 4u);
    { const pg8::bf16_t* AA = (const pg8::bf16_t*)(ws + WS_AA); const pg8::bf16_t* WPA = (const pg8::bf16_t*)(ws + WS_WPA);
      pg8::Gemm g{AA, AA, AA, WPA, WPA, WPA, 8, 8, 8, 512, 512};
      pg8::SegOrder S; S.init(T, 1024, G, (int)blockIdx.x, 1); pg8::EpiGateMul E{(const pg8::bf16_t*)(ws + WS_SGA), (pg8::bf16_t*)(ws + WS_T1), 1024};
      pg8::gemm_phase<pg8::EpiGateMul, pg8::SegOrder, true, true>(lds, g, S, E); }
    { const pg8::bf16_t* WPB = (const pg8::bf16_t*)(ws + WS_WPB);
      pg8::Gemm g{AB, AB, AB, WPB, WPB, WPB, 16, 16, 16, 1024, 1024};
      pg8::SegOrder S; S.init(T, 1024, G, (int)blockIdx.x, 1); pg8::EpiMergeY E{(const pg8::bf16_t*)(ws + WS_SGB), (const pg8::bf16_t*)(ws + WS_T1), (pg8::bf16_t*)(ws + WS_Y), 1024};
      pg8::gemm_phase<pg8::EpiMergeY, pg8::SegOrder, true, true>(lds, g, S, E); }
#if REP_MASK & 512
    { const pg8::bf16_t* WGT = (const pg8::bf16_t*)(ws + WS_WGT);
      pg8::Gemm g{hb, hb, hb, WGT, WGT + (size_t)1024 * 1024, WGT, 16, 16, 16, 1024, 1024};
      pg8::SegOrder S; S.init(T, 1024, G, (int)blockIdx.x, 2); pg8::EpiSig2 E{(pg8::bf16_t*)(ws + WS_SGA), (pg8::bf16_t*)(ws + WS_SGB), 1024};
      pg8::gemm_phase<pg8::EpiSig2, pg8::SegOrder, true, true>(lds, g, S, E); }
    { const pg8::bf16_t* AA = (const pg8::bf16_t*)(ws + WS_AA); const pg8::bf16_t* WPA = (const pg8::bf16_t*)(ws + WS_WPA);
      pg8::Gemm g{AA, AA, AA, WPA, WPA, WPA, 8, 8, 8, 512, 512};
      pg8::SegOrder S; S.init(T, 1024, G, (int)blockIdx.x, 1); pg8::EpiGateMul E{(const pg8::bf16_t*)(ws + WS_SGA), (pg8::bf16_t*)(ws + WS_T1), 1024};
      pg8::gemm_phase<pg8::EpiGateMul, pg8::SegOrder, true, true>(lds, g, S, E); }
    { const pg8::bf16_t* WPB = (const pg8::bf16_t*)(ws + WS_WPB);
      pg8::Gemm g{AB, AB, AB, WPB, WPB, WPB, 16, 16, 16, 1024, 1024};
      pg8::SegOrder S; S.init(T, 1024, G, (int)blockIdx.x, 1); pg8::EpiMergeY E{(const pg8::bf16_t*)(ws + WS_SGB), (const pg8::bf16_t*)(ws + WS_T1), (pg8::bf16_t*)(ws + WS_Y), 1024};
      pg8::gemm_phase<pg8::EpiMergeY, pg8::SegOrder, true, true>(lds, g, S, E); }
#endif
    GRID_SYNC();
    DBG_DUMP(9, 5, SF(WS_TMP1, 64), SF(WS_TMP2, 64), SB(WS_Y, 32), SB(WS_PB, 8), SB(WS_WPA, 7))
    { const pg8::bf16_t* Y = (const pg8::bf16_t*)(ws + WS_Y); const pg8::bf16_t* W = (const pg8::bf16_t*)(ws + WS_WOUT);
      pg8::Gemm g{Y, Y, Y, W, W, W, 16, 16, 16, 1024, 1024};
      pg8::SegOrder S; S.init(T, 1024, G, (int)blockIdx.x, 1); pg8::EpiResid E{args.x, (pg8::bf16_t*)(ws + WS_XLO), (pg8::bf16_t*)(ws + WS_X1B), (float*)(ws + WS_PS), 1024};
      pg8::gemm_phase<pg8::EpiResid, pg8::SegOrder, true, true>(lds, g, S, E); }
#if REP_MASK & 1024
    { const pg8::bf16_t* Y = (const pg8::bf16_t*)(ws + WS_Y); const pg8::bf16_t* W = (const pg8::bf16_t*)(ws + WS_WOUT);
      pg8::Gemm g{Y, Y, Y, W, W, W, 16, 16, 16, 1024, 1024};
      pg8::SegOrder S; S.init(T, 1024, G, (int)blockIdx.x, 1); pg8::EpiResid E{args.x, (pg8::bf16_t*)(ws + WS_XLO), (pg8::bf16_t*)(ws + WS_X1B), (float*)(ws + WS_PS), 1024};
      pg8::gemm_phase<pg8::EpiResid, pg8::SegOrder, true, true>(lds, g, S, E); }
#endif
    { pg8::SegOrder S; S.init(T, 1024, G, (int)blockIdx.x, 1); pg8::Unit u0;
      if (S.nwg == G && S.next(0, u0)) panel_handoff((unsigned*)(ws + WS_PCNT), u0.pm, 4u); else { GRID_SYNC(); } }
    DBG_DUMP(10, 3, SB(WS_X1B, 32), SF(WS_PS, 1), dbg_sum_f32(args.out, 64 * MiB, gtid_, NT_))
    { const pg8::bf16_t* X1 = (const pg8::bf16_t*)(ws + WS_X1B); const pg8::bf16_t* W = (const pg8::bf16_t*)(ws + WS_WPG);
      pg8::Gemm g{X1, X1, X1, W, W, W, 16, 16, 16, 1024, 1024};
      pg8::SegOrder S; S.init(T, 1024, G, (int)blockIdx.x, 1); pg8::EpiSigRow E{(const float*)(ws + WS_PS), (pg8::bf16_t*)(ws + WS_SGA), 1024, EPS};
      pg8::gemm_phase<pg8::EpiSigRow, pg8::SegOrder, true, true>(lds, g, S, E); }
#if REP_MASK & 2048
    { const pg8::bf16_t* X1 = (const pg8::bf16_t*)(ws + WS_X1B); const pg8::bf16_t* W = (const pg8::bf16_t*)(ws + WS_WPG);
      pg8::Gemm g{X1, X1, X1, W, W, W, 16, 16, 16, 1024, 1024};
      pg8::SegOrder S; S.init(T, 1024, G, (int)blockIdx.x, 1); pg8::EpiSigRow E{(const float*)(ws + WS_PS), (pg8::bf16_t*)(ws + WS_SGA), 1024, EPS};
      pg8::gemm_phase<pg8::EpiSigRow, pg8::SegOrder, true, true>(lds, g, S, E); }
#endif
    { const pg8::bf16_t* PBm = (const pg8::bf16_t*)(ws + WS_PB); const pg8::bf16_t* W = (const pg8::bf16_t*)(ws + WS_WPLE);
      pg8::Gemm g{PBm, PBm, PBm, W, W, W, 4, 4, 4, 256, 256};
      pg8::SegOrder S; S.init(T, 1024, G, (int)blockIdx.x, 1); pg8::EpiPle2 E{args.out, (const pg8::bf16_t*)(ws + WS_SGA), (const pg8::bf16_t*)(ws + WS_X1B), (const pg8::bf16_t*)(ws + WS_XLO), 1024};
      pg8::gemm_phase<pg8::EpiPle2, pg8::SegOrder, true, true>(lds, g, S, E); }
}

extern "C" void kernel_launch(void* const* d_in, const int* in_sizes, int n_in, void* d_out, int out_size, void* d_ws, size_t ws_size, hipStream_t stream) {
    static int grid = 0;
    if (grid == 0) {
        if (n_in != 16 || out_size != T * D || ws_size < WS_END) { fprintf(stderr, "kernel_launch: unexpected shapes (n_in %d out %d ws %zu)\n", n_in, out_size, ws_size); grid = -1; return; }
        int dev = 0, cus = 0, per_cu = 0;
        (void)hipGetDevice(&dev); (void)hipDeviceGetAttribute(&cus, hipDeviceAttributeMultiprocessorCount, dev);
        (void)hipFuncSetAttribute((const void*)mega_fwd, hipFuncAttributeMaxDynamicSharedMemorySize, LDS_BYTES);
        (void)hipOccupancyMaxActiveBlocksPerMultiprocessor(&per_cu, (const void*)mega_fwd, NWAVES * 64, LDS_BYTES);
        if (per_cu < 1) { fprintf(stderr, "kernel_launch: occupancy query says %d blocks per CU\n", per_cu); per_cu = 1; }
        (void)hipGetLastError();
        grid = cus;
    }
    if (grid < 0) return;
    Args a{};
    a.x = (const float*)d_in[0]; a.p = (const float*)d_in[1]; a.pos = (const int*)d_in[2]; a.norm_g = (const float*)d_in[3]; a.w_in = (const float*)d_in[4];
    a.gq = (const float*)d_in[5]; a.gk = (const float*)d_in[6]; a.gate_w2 = (const float*)d_in[7]; a.gate_b = (const float*)d_in[8]; a.gla_g = (const float*)d_in[9];
    a.w_att = (const float*)d_in[10]; a.w_gla = (const float*)d_in[11]; a.w_out = (const float*)d_in[12]; a.ple_g = (const float*)d_in[13]; a.w_pg = (const float*)d_in[14]; a.w_ple = (const float*)d_in[15];
    a.out = (float*)d_out; a.ws = (unsigned char*)d_ws; a.one = 1; a.zero = 0;
    if (hipMemsetAsync((char*)d_ws + WS_BAR, 0, BAR_BYTES, stream) != hipSuccess) { fprintf(stderr, "kernel_launch: memset of barrier words failed\n"); return; }
    void* kargs[] = {&a};
    hipError_t e = hipLaunchCooperativeKernel((const void*)mega_fwd, dim3(grid), dim3(NWAVES * 64), kargs, LDS_BYTES, stream);
    if (e != hipSuccess) fprintf(stderr, "cooperative launch failed: %s (grid %d)\n", hipGetErrorString(e), grid);
}
```
